# Optimizing an MI355X kernel written in HIP

```python
import jax, jax.numpy as jnp
from jax import lax
import numpy as np

D_MODEL = 2048
BATCH = 4
SEQ = 2048
DEPTH = 4
DEC_BATCH = 16
DEC_SEQ = 64
PAST_LEN = 4096

CHUNK = 64

CONV_DIM = D_MODEL // 4
CONV_HEADS = 4
CONV_WIDTH = 31
POOL_DIM = D_MODEL // 4
POOL_WINDOWS = (2, 4, 8, 16)
POOL_GROUPS = len(POOL_WINDOWS)
POOL_GROUP_DIM = POOL_DIM // POOL_GROUPS
POOL_MAX = max(POOL_WINDOWS)
RWKV_DIM = D_MODEL // 2
HEAD_SIZE = 64
RWKV_HEADS = RWKV_DIM // HEAD_SIZE
DECAY_LORA = 64
AAA_LORA = 64
GATE_LORA = 64
RWKV_PROJ = 3 * RWKV_DIM + DECAY_LORA + AAA_LORA + GATE_LORA
MIX_DIM = CONV_DIM + POOL_DIM + RWKV_DIM
IN_PROJ = 2 * CONV_DIM + POOL_DIM + RWKV_PROJ
D_FF = -(-(8 * D_MODEL) // (3 * 256)) * 256

RMS_EPS = 1e-6
LN_EPS = 1e-5
GN_EPS = 64e-5

kernel_name = 'hybrid_conv_pool_rwkv7_stream_step'


def rms_norm(x, g):
    xf = x.astype(jnp.float32)
    y = xf * lax.rsqrt(jnp.mean(xf * xf, axis=-1, keepdims=True) + RMS_EPS)
    return (y * g.astype(jnp.float32)).astype(x.dtype)


def conv_mixer(z, hist, conv_w, conv_b, ln_g, ln_b):
    val, gate = jnp.split(z, 2, axis=-1)
    u = val * jax.nn.sigmoid(gate)
    u_pad = jnp.concatenate([hist.astype(u.dtype), u], axis=1)
    h = lax.conv_general_dilated(u_pad, conv_w[:, None, :].astype(u.dtype), window_strides=(1,),
                                 padding='VALID', dimension_numbers=('NWC', 'WIO', 'NWC'),
                                 feature_group_count=CONV_DIM) + conv_b
    hf = h.astype(jnp.float32)
    mu = jnp.mean(hf, axis=-1, keepdims=True)
    var = jnp.mean(jnp.square(hf - mu), axis=-1, keepdims=True)
    hn = (hf - mu) * lax.rsqrt(var + LN_EPS) * ln_g.astype(jnp.float32) + ln_b.astype(jnp.float32)
    out = jax.nn.silu(hn).astype(z.dtype)
    return out, u_pad[:, -(CONV_WIDTH - 1):]


def pool_mixer(p, hist, start_pos, pool_w, pool_scale):
    B, L, _ = p.shape
    p_pad = jnp.concatenate([hist.astype(p.dtype), p], axis=1)
    pf = p_pad.astype(jnp.float32)
    csum = jnp.concatenate([jnp.zeros_like(pf[:, :1]), jnp.cumsum(pf, axis=1)], axis=1)
    end = csum[:, POOL_MAX:]
    pos = start_pos + jnp.arange(L)
    means = []
    for gi, w in enumerate(POOL_WINDOWS):
        sl = slice(gi * POOL_GROUP_DIM, (gi + 1) * POOL_GROUP_DIM)
        begin = csum[:, POOL_MAX - w:POOL_MAX - w + L, sl]
        cnt = jnp.minimum(w, pos + 1).astype(jnp.float32)[None, :, None]
        means.append((end[..., sl] - begin) / cnt)
    d = (jnp.concatenate(means, axis=-1) - pf[:, POOL_MAX - 1:]).astype(p.dtype)
    d = jnp.einsum('blgc,gcd->blgd', d.reshape(B, L, POOL_GROUPS, POOL_GROUP_DIM), pool_w)
    out = d.reshape(B, L, POOL_DIM) * pool_scale
    return out, p_pad[:, -(POOL_MAX - 1):]


def rwkv_mixer(q, shift_prev, wkv_state, mu, w0, w_up, a0, a_up, g_up, k_k, k_a, r_k, gn_g, gn_b):
    B, L, _ = q.shape
    H, N = RWKV_HEADS, HEAD_SIZE
    f32 = jnp.float32
    q_prev = jnp.concatenate([shift_prev.astype(q.dtype), q[:, :-1]], axis=1)
    qs = q + (q_prev - q) * mu
    c0 = 3 * RWKV_DIM
    r, k, v, w_lo, a_lo, g_lo = jnp.split(
        qs, [RWKV_DIM, 2 * RWKV_DIM, c0, c0 + DECAY_LORA, c0 + DECAY_LORA + AAA_LORA], axis=-1)
    w = -jax.nn.softplus(-(w0 + jnp.tanh(w_lo) @ w_up).astype(f32)) - 0.5
    decay = jnp.exp(-jnp.exp(w))
    a = jax.nn.sigmoid((a0 + a_lo @ a_up).astype(f32))
    g = jax.nn.sigmoid(g_lo) @ g_up
    hd = lambda t: t.astype(f32).reshape(B, L, H, N)
    r, k, v, decay, a = hd(r), hd(k), hd(v), hd(decay), hd(a)
    kk = k * k_k.astype(f32).reshape(H, N)
    kk = kk * lax.rsqrt(jnp.maximum(jnp.sum(kk * kk, axis=-1, keepdims=True), 1e-24))
    k = k * (1.0 + (a - 1.0) * k_a.astype(f32).reshape(H, N))

    def step(S, inp):
        r_t, w_t, k_t, v_t, kk_t, a_t = inp
        sa = jnp.einsum('bhij,bhj->bhi', S, -kk_t)
        S = (S * w_t[:, :, None, :] + sa[..., None] * (kk_t * a_t)[:, :, None, :]
             + v_t[..., None] * k_t[:, :, None, :])
        return S, jnp.einsum('bhij,bhj->bhi', S, r_t)

    xs = tuple(jnp.moveaxis(t, 1, 0) for t in (r, decay, k, v, kk, a))
    S_final, y = lax.scan(step, wkv_state.astype(f32), xs)
    y = jnp.moveaxis(y, 0, 1)
    ym = jnp.mean(y, axis=-1, keepdims=True)
    yv = jnp.mean(jnp.square(y - ym), axis=-1, keepdims=True)
    yn = (y - ym) * lax.rsqrt(yv + GN_EPS) * gn_g.astype(f32).reshape(H, N) + gn_b.astype(f32).reshape(H, N)
    bonus = jnp.sum(r * k * r_k.astype(f32), axis=-1, keepdims=True) * v
    out = (yn + bonus).reshape(B, L, RWKV_DIM).astype(q.dtype) * g
    return out, q[:, -1:], S_final


def trunk(x, cache_conv, cache_pool, state_shift, state_wkv, start_pos,
          norm_mix, w_in, conv_w, conv_b, conv_ln_g, conv_ln_b, pool_w, pool_scale,
          shift_mu, decay_w0, decay_up, iclr_a0, iclr_up, gate_up, k_k, k_a, r_k, gn_g, gn_b,
          w_out, norm_ffn, ffn_gate, ffn_up, ffn_down, norm_final):
    conv_list, pool_list, shift_list, wkv_list = [], [], [], []
    for l in range(DEPTH):
        h = rms_norm(x, norm_mix[l])
        z = h @ w_in[l]
        z_conv, z_pool, z_rwkv = jnp.split(z, [2 * CONV_DIM, 2 * CONV_DIM + POOL_DIM], axis=-1)
        o_conv, c_new = conv_mixer(z_conv, cache_conv[l], conv_w[l], conv_b[l], conv_ln_g[l], conv_ln_b[l])
        o_pool, p_new = pool_mixer(z_pool, cache_pool[l], start_pos, pool_w[l], pool_scale[l])
        o_rwkv, s_new, S_new = rwkv_mixer(z_rwkv, state_shift[l], state_wkv[l], shift_mu[l], decay_w0[l],
                                          decay_up[l], iclr_a0[l], iclr_up[l], gate_up[l], k_k[l], k_a[l],
                                          r_k[l], gn_g[l], gn_b[l])
        x = x + jnp.concatenate([o_conv, o_pool, o_rwkv], axis=-1) @ w_out[l]
        h = rms_norm(x, norm_ffn[l])
        x = x + (jax.nn.silu(h @ ffn_gate[l]) * (h @ ffn_up[l])) @ ffn_down[l]
        conv_list.append(c_new)
        pool_list.append(p_new)
        shift_list.append(s_new)
        wkv_list.append(S_new)
    y = rms_norm(x, norm_final)
    return (y, jnp.stack(conv_list), jnp.stack(pool_list), jnp.stack(shift_list), jnp.stack(wkv_list))


def setup_inputs(seed: int = 0) -> dict:
    key = jax.random.key(seed)
    ks = iter(jax.random.split(key, 40))
    nrm = lambda shape, s: jax.random.normal(next(ks), shape, jnp.float32) * s
    uni = lambda shape, lo, hi: jax.random.uniform(next(ks), shape, jnp.float32, lo, hi)
    H, N = RWKV_HEADS, HEAD_SIZE
    return {
        'x_prompt': nrm((BATCH, SEQ, D_MODEL), 1.0),
        'x_sample': nrm((DEC_BATCH, DEC_SEQ, D_MODEL), 1.0),
        'cache_conv': nrm((DEPTH, DEC_BATCH, CONV_WIDTH - 1, CONV_DIM), 0.5),
        'cache_pool': nrm((DEPTH, DEC_BATCH, POOL_MAX - 1, POOL_DIM), 1.0),
        'state_shift': nrm((DEPTH, DEC_BATCH, 1, RWKV_PROJ), 1.0),
        'state_wkv': nrm((DEPTH, DEC_BATCH, H, N, N), 0.5),
        'norm_mix': 1.0 + nrm((DEPTH, D_MODEL), 0.05),
        'w_in': nrm((DEPTH, D_MODEL, IN_PROJ), D_MODEL ** -0.5),
        'conv_w': nrm((DEPTH, CONV_WIDTH, CONV_DIM), CONV_WIDTH ** -0.5),
        'conv_b': nrm((DEPTH, CONV_DIM), 0.02),
        'conv_ln_g': 1.0 + nrm((DEPTH, CONV_DIM), 0.05),
        'conv_ln_b': nrm((DEPTH, CONV_DIM), 0.02),
        'pool_w': nrm((DEPTH, POOL_GROUPS, POOL_GROUP_DIM, POOL_GROUP_DIM), POOL_GROUP_DIM ** -0.5),
        'pool_scale': uni((DEPTH, POOL_DIM), 0.5, 1.5),
        'shift_mu': uni((DEPTH, RWKV_PROJ), 0.0, 1.0),
        'decay_w0': uni((DEPTH, RWKV_DIM), -5.0, 1.0),
        'decay_up': nrm((DEPTH, DECAY_LORA, RWKV_DIM), 0.1),
        'iclr_a0': nrm((DEPTH, RWKV_DIM), 0.1),
        'iclr_up': nrm((DEPTH, AAA_LORA, RWKV_DIM), AAA_LORA ** -0.5),
        'gate_up': nrm((DEPTH, GATE_LORA, RWKV_DIM), GATE_LORA ** -0.5),
        'k_k': 0.85 + nrm((DEPTH, RWKV_DIM), 0.05),
        'k_a': 1.0 + nrm((DEPTH, RWKV_DIM), 0.05),
        'r_k': nrm((DEPTH, H, N), 0.1),
        'gn_g': 1.0 + nrm((DEPTH, RWKV_DIM), 0.05),
        'gn_b': nrm((DEPTH, RWKV_DIM), 0.02),
        'w_out': nrm((DEPTH, MIX_DIM, D_MODEL), MIX_DIM ** -0.5),
        'norm_ffn': 1.0 + nrm((DEPTH, D_MODEL), 0.05),
        'ffn_gate': nrm((DEPTH, D_MODEL, D_FF), D_MODEL ** -0.5),
        'ffn_up': nrm((DEPTH, D_MODEL, D_FF), D_MODEL ** -0.5),
        'ffn_down': nrm((DEPTH, D_FF, D_MODEL), D_FF ** -0.5),
        'norm_final': 1.0 + nrm((D_MODEL,), 0.05),
    }


def reference(x_prompt, x_sample, cache_conv, cache_pool, state_shift, state_wkv,
              norm_mix, w_in, conv_w, conv_b, conv_ln_g, conv_ln_b, pool_w, pool_scale,
              shift_mu, decay_w0, decay_up, iclr_a0, iclr_up, gate_up, k_k, k_a, r_k, gn_g, gn_b,
              w_out, norm_ffn, ffn_gate, ffn_up, ffn_down, norm_final):
    weights = (norm_mix, w_in, conv_w, conv_b, conv_ln_g, conv_ln_b, pool_w, pool_scale,
               shift_mu, decay_w0, decay_up, iclr_a0, iclr_up, gate_up, k_k, k_a, r_k, gn_g, gn_b,
               w_out, norm_ffn, ffn_gate, ffn_up, ffn_down, norm_final)
    bp = x_prompt.shape[0]
    dt = x_prompt.dtype
    zc = jnp.zeros((DEPTH, bp, CONV_WIDTH - 1, CONV_DIM), dt)
    zp = jnp.zeros((DEPTH, bp, POOL_MAX - 1, POOL_DIM), dt)
    zs = jnp.zeros((DEPTH, bp, 1, RWKV_PROJ), dt)
    zw = jnp.zeros((DEPTH, bp, RWKV_HEADS, HEAD_SIZE, HEAD_SIZE), jnp.float32)
    y_prompt, p_conv, p_pool, p_shift, p_wkv = trunk(x_prompt, zc, zp, zs, zw, 0, *weights)
    y_sample, s_conv, s_pool, s_shift, s_wkv = trunk(x_sample, cache_conv, cache_pool, state_shift,
                                                     state_wkv, PAST_LEN, *weights)
    return (y_prompt, y_sample, p_conv, p_pool, p_shift, p_wkv, s_conv, s_pool, s_shift, s_wkv)
```

```cpp
#include <hip/hip_runtime.h>
#include <hip/hip_cooperative_groups.h>
#include <cstdio>
#include <cstdint>
namespace cg = cooperative_groups;

namespace pg8 {
#define PG8_LAS __attribute__((address_space(3)))
typedef unsigned short bf16_t;
typedef short bf16x8 __attribute__((ext_vector_type(8)));
typedef float f32x4 __attribute__((ext_vector_type(4)));
typedef unsigned u32x4 __attribute__((ext_vector_type(4)));
constexpr int BM = 256, BK = 64, HALF = 128, HTB = HALF * BK * 2  , STAGE_BYTES = 8 * HTB, NXCD = 8, WGM = 8;

__host__ __device__ __forceinline__ int lds_byte(int r, int c) { const int st = (r >> 4) * 2 + (c >> 5), rr = r & 15, cc = c & 31, ob = rr * 64 + cc * 2; return st * 1024 + (ob ^ (((ob >> 9) & 1) << 5)); }
__host__ __device__ __forceinline__ void stage_rc(int b, int& R, int& C) { const int st = b / 1024, sb = b % 1024, swz = sb ^ (((sb >> 9) & 1) << 5); R = (st >> 1) * 16 + swz / 64; C = (st & 1) * 32 + (swz % 64) / 2; }
__host__ __device__ __forceinline__ int perm32(int rho) { const int n = rho >> 4, i = rho & 15; return 8 * (i >> 2) + 4 * n + (i & 3); }

struct Unit { int pm, pn; };
struct Gemm { const bf16_t* A; const bf16_t* Bt; int M, N, K; };

struct StaticOrder {
    int nM, nN, nwg, G, c;
    __host__ __device__ void init(int M, int N, int G_, int c_) { nM = M / BM; nN = N / BM; nwg = nM * nN; G = G_; c = c_; }
    __host__ __device__ bool next(int i, Unit& u) const {
        const long L = (long)i * G + c; if (L >= nwg) return false;
        int wgid = (int)L; { const int q = nwg / NXCD, r = nwg % NXCD, xcd = wgid % NXCD, off = wgid / NXCD; wgid = (xcd < r ? xcd * (q + 1) : r * (q + 1) + (xcd - r) * q) + off; }
        const int nig = WGM * nN, gid = wgid / nig, fm = gid * WGM, gsz = (nM - fm) < WGM ? (nM - fm) : WGM;
        u.pm = fm + ((wgid % nig) % gsz); u.pn = (wgid % nig) / gsz; return true;
    }
    __device__ __forceinline__ void a_ready(const Unit&) const {}
    __device__ __forceinline__ void done(const Unit&) const {}
};

__device__ __forceinline__ unsigned cvt_pk_bf16(float lo, float hi) { unsigned r; asm volatile("v_cvt_pk_bf16_f32 %0, %1, %2" : "=v"(r) : "v"(lo), "v"(hi)); return r; }

struct EpiStoreF32 {
    static constexpr bool PERM = true, AFTER_DRAIN = false;
    float* O; int ldc;
    __device__ __forceinline__ void operator()(const f32x4 (&acc)[2][2][4][2], const Unit& u, int wr, int wc, int fr, int fq) const {
        const int row0 = u.pm * BM + wr * 64 + fr, col0 = u.pn * BM + wc * 32 + 8 * fq;
#pragma unroll
        for (int ai = 0; ai < 2; ++ai)
#pragma unroll
            for (int m = 0; m < 4; ++m) { float* rowp = O + (size_t)(row0 + ai * HALF + m * 16) * ldc + col0;
#pragma unroll
                for (int bj = 0; bj < 2; ++bj) { *(f32x4*)(rowp + bj * HALF) = acc[ai][bj][m][0]; *(f32x4*)(rowp + bj * HALF + 4) = acc[ai][bj][m][1]; } }
    }
};
struct EpiResAdd {
    static constexpr bool PERM = true, AFTER_DRAIN = false;
    float* O; int ldc;
    __device__ __forceinline__ void operator()(const f32x4 (&acc)[2][2][4][2], const Unit& u, int wr, int wc, int fr, int fq) const {
        const int row0 = u.pm * BM + wr * 64 + fr, col0 = u.pn * BM + wc * 32 + 8 * fq;
#pragma unroll
        for (int ai = 0; ai < 2; ++ai)
#pragma unroll
            for (int m = 0; m < 4; ++m) { float* rowp = O + (size_t)(row0 + ai * HALF + m * 16) * ldc + col0;
#pragma unroll
                for (int bj = 0; bj < 2; ++bj) {
                    f32x4 a = *(const f32x4*)(rowp + bj * HALF), b = *(const f32x4*)(rowp + bj * HALF + 4);
                    *(f32x4*)(rowp + bj * HALF) = a + acc[ai][bj][m][0]; *(f32x4*)(rowp + bj * HALF + 4) = b + acc[ai][bj][m][1]; } }
    }
};
struct EpiSwiGLU {
    static constexpr bool PERM = true, AFTER_DRAIN = false;
    bf16_t* O; int ldc;
    __device__ __forceinline__ void operator()(const f32x4 (&acc)[2][2][4][2], const Unit& u, int wr, int wc, int fr, int fq) const {
        const int row0 = u.pm * BM + wr * 64 + fr, col0 = u.pn * HALF + wc * 32 + 8 * fq;
#pragma unroll
        for (int ai = 0; ai < 2; ++ai)
#pragma unroll
            for (int m = 0; m < 4; ++m) { bf16_t* rowp = O + (size_t)(row0 + ai * HALF + m * 16) * ldc + col0;
                float o[8];
#pragma unroll
                for (int n = 0; n < 2; ++n)
#pragma unroll
                    for (int j = 0; j < 4; ++j) { const float g = acc[ai][0][m][n][j], up = acc[ai][1][m][n][j]; o[n * 4 + j] = g * up * __builtin_amdgcn_rcpf(1.0f + __expf(-g)); }
                u32x4 w; w.x = cvt_pk_bf16(o[0], o[1]); w.y = cvt_pk_bf16(o[2], o[3]); w.z = cvt_pk_bf16(o[4], o[5]); w.w = cvt_pk_bf16(o[6], o[7]);
                *(u32x4*)rowp = w; }
    }
};

template <class Epi, class Sched, bool ALIGN_EPI = false, bool SP2 = false>
__device__ __forceinline__ void gemm_phase(PG8_LAS unsigned char* lds, const Gemm g, const Sched& S, const Epi& E, const int tid) {
    const int wid = __builtin_amdgcn_readfirstlane(tid >> 6), lane = tid & 63, wr = wid >> 2, wc = wid & 3, fr = lane & 15, fq = lane >> 4;
    const int K = g.K, nt = K / BK;
    unsigned voffA[2], voffB[2];
#pragma unroll
    for (int i = 0; i < 2; ++i) { int R, C; stage_rc(tid * 16 + i * 8192, R, C); const int Rb = Epi::PERM ? ((R & ~31) + perm32(R & 31)) : R;
        voffA[i] = (unsigned)(R * K + C) * 2u; voffB[i] = (unsigned)(Rb * K + C) * 2u; }
    const size_t kstep = (size_t)(BK * 2);
    const size_t hstep = (size_t)HALF * K * 2;
    const size_t tstep = 2 * hstep;
    const unsigned ldsw = (unsigned)wid * 1024u;
    const int aoff = lds_byte(wr * 64 + fr, fq * 8), boff = lds_byte(wc * 32 + fr, fq * 8);
#define PG8_SA(b, h) (((b) * 2 + (h)) * HTB)
#define PG8_SB(b, h) ((4 + (b) * 2 + (h)) * HTB)
#define PG8_STAGE(bufoff, gbase, voff) do { _Pragma("unroll") for (int _i = 0; _i < 2; ++_i) \
        __builtin_amdgcn_global_load_lds((const unsigned*)((const char*)(gbase) + (voff)[_i]), (PG8_LAS unsigned*)(lds + (bufoff) + ldsw + _i * 8192), 16, 0, 0); } while (0)
#define PG8_LDA(dst, b, h) do { _Pragma("unroll") for (int m = 0; m < 4; ++m) _Pragma("unroll") for (int k = 0; k < 2; ++k) dst[m][k] = *(const PG8_LAS bf16x8*)(lds + PG8_SA(b, h) + aoff + m * 2048 + k * 1024); } while (0)
#define PG8_LDB(dst, b, h) do { _Pragma("unroll") for (int n = 0; n < 2; ++n) _Pragma("unroll") for (int k = 0; k < 2; ++k) dst[n][k] = *(const PG8_LAS bf16x8*)(lds + PG8_SB(b, h) + boff + n * 2048 + k * 1024); } while (0)
#define PG8_MMA(ai, bj, At, Bt) do { __builtin_amdgcn_s_setprio(1); _Pragma("unroll") for (int m = 0; m < 4; ++m) _Pragma("unroll") for (int n = 0; n < 2; ++n) _Pragma("unroll") for (int k = 0; k < 2; ++k) \
        acc[ai][bj][m][n] = __builtin_amdgcn_mfma_f32_16x16x32_bf16(Bt[n][k], At[m][k], acc[ai][bj][m][n], 0, 0, 0); __builtin_amdgcn_s_setprio(0); } while (0)
#define PG8_WAIT_V(n) asm volatile("s_waitcnt vmcnt(" #n ")" ::: "memory")
#define PG8_WAIT_L(n) asm volatile("s_waitcnt lgkmcnt(" #n ")" ::: "memory")
#define PG8_BAR __builtin_amdgcn_s_barrier()
#define PG8_SCHED __builtin_amdgcn_sched_barrier(0)
    Unit cur, nxt; int ui = 0;
    if (!S.next(0, cur)) return;
    f32x4 acc[2][2][4][2];
#pragma unroll
    for (int a = 0; a < 2; ++a)
#pragma unroll
        for (int b = 0; b < 2; ++b)
#pragma unroll
            for (int m = 0; m < 4; ++m)
#pragma unroll
                for (int n = 0; n < 2; ++n) acc[a][b][m][n] = (f32x4){0.f, 0.f, 0.f, 0.f};
    bf16x8 At[4][2], B0[2][2], B1[2][2];
    const char* cA = (const char*)g.A + (size_t)cur.pm * tstep; const char* cB = (const char*)g.Bt + (size_t)cur.pn * tstep;
    S.a_ready(cur);
    if constexpr (SP2) {
        PG8_STAGE(PG8_SB(0, 0), cB, voffB); PG8_STAGE(PG8_SB(0, 1), cB + hstep, voffB); PG8_STAGE(PG8_SA(0, 0), cA, voffA); PG8_STAGE(PG8_SA(0, 1), cA + hstep, voffA);
        if (wr == 1) PG8_BAR;
        PG8_WAIT_V(2); PG8_BAR;
        PG8_STAGE(PG8_SB(1, 0), cB + kstep, voffB); PG8_STAGE(PG8_SA(1, 0), cA + kstep, voffA); PG8_STAGE(PG8_SB(1, 1), cB + hstep + kstep, voffB);
        PG8_WAIT_V(6); PG8_BAR;
    } else {
        PG8_STAGE(PG8_SB(0, 0), cB, voffB); PG8_STAGE(PG8_SA(0, 0), cA, voffA); PG8_STAGE(PG8_SB(0, 1), cB + hstep, voffB); PG8_STAGE(PG8_SA(0, 1), cA + hstep, voffA);
        if (wr == 1) PG8_BAR;
        PG8_WAIT_V(4); PG8_BAR;
        PG8_STAGE(PG8_SB(1, 0), cB + kstep, voffB); PG8_STAGE(PG8_SA(1, 0), cA + kstep, voffA); PG8_STAGE(PG8_SB(1, 1), cB + hstep + kstep, voffB);
        PG8_WAIT_V(6); PG8_BAR;
    }
    for (;;) {
        const bool has_next = S.next(ui + 1, nxt);
        const char* nA = has_next ? (const char*)g.A + (size_t)nxt.pm * tstep : cA; const char* nB = has_next ? (const char*)g.Bt + (size_t)nxt.pn * tstep : cB;
        for (int t = 0; t < nt; t += 2) {
            const bool last = (t == nt - 2);
            const char* a1 = cA + (size_t)(t + 1) * kstep;
            const char* a2 = last ? nA : cA + (size_t)(t + 2) * kstep; const char* b2 = last ? nB : cB + (size_t)(t + 2) * kstep;
            const char* a3 = a2 + kstep; const char* b3 = b2 + kstep;
            if (last && has_next) S.a_ready(nxt);
            if constexpr (SP2) {
            PG8_LDB(B0, 0, 0); PG8_LDB(B1, 0, 1); PG8_SCHED; PG8_LDA(At, 0, 0); PG8_STAGE(PG8_SA(1, 1), a1 + hstep, voffA);
            PG8_WAIT_V(8); PG8_WAIT_L(0); PG8_BAR; PG8_MMA(0, 0, At, B0); PG8_MMA(0, 1, At, B1); PG8_BAR; PG8_SCHED;
            PG8_LDA(At, 0, 1); PG8_STAGE(PG8_SB(0, 0), b2, voffB); PG8_STAGE(PG8_SB(0, 1), b2 + hstep, voffB); PG8_STAGE(PG8_SA(0, 0), a2, voffA);
            PG8_WAIT_V(8); PG8_WAIT_L(0); PG8_BAR; PG8_MMA(1, 0, At, B0); PG8_MMA(1, 1, At, B1); PG8_BAR; PG8_SCHED;
            PG8_LDB(B0, 1, 0); PG8_LDB(B1, 1, 1); PG8_SCHED; PG8_LDA(At, 1, 0); PG8_STAGE(PG8_SA(0, 1), a2 + hstep, voffA);
            PG8_WAIT_V(8); PG8_WAIT_L(0); PG8_BAR; PG8_MMA(0, 0, At, B0); PG8_MMA(0, 1, At, B1); PG8_BAR; PG8_SCHED;
            PG8_LDA(At, 1, 1); PG8_STAGE(PG8_SB(1, 0), b3, voffB); PG8_STAGE(PG8_SB(1, 1), b3 + hstep, voffB); PG8_STAGE(PG8_SA(1, 0), a3, voffA);
            PG8_WAIT_V(8); PG8_WAIT_L(0); PG8_BAR; PG8_MMA(1, 0, At, B0); PG8_MMA(1, 1, At, B1); PG8_BAR; PG8_SCHED;
            } else {
            PG8_LDB(B0, 0, 0); PG8_SCHED; PG8_LDA(At, 0, 0); PG8_STAGE(PG8_SA(1, 1), a1 + hstep, voffA);
            PG8_WAIT_L(8); PG8_BAR; PG8_WAIT_L(0); PG8_MMA(0, 0, At, B0); PG8_BAR; PG8_SCHED;
            PG8_LDB(B1, 0, 1); PG8_STAGE(PG8_SB(0, 0), b2, voffB);
            PG8_BAR; PG8_WAIT_L(0); PG8_MMA(0, 1, At, B1); PG8_BAR;
            PG8_LDA(At, 0, 1); PG8_STAGE(PG8_SA(0, 0), a2, voffA);
            PG8_BAR; PG8_WAIT_L(0); PG8_MMA(1, 0, At, B0); PG8_BAR; PG8_SCHED;
            PG8_STAGE(PG8_SB(0, 1), b2 + hstep, voffB);
            PG8_WAIT_V(6); PG8_BAR; PG8_MMA(1, 1, At, B1); PG8_BAR;
            PG8_LDB(B0, 1, 0); PG8_SCHED; PG8_LDA(At, 1, 0); PG8_STAGE(PG8_SA(0, 1), a2 + hstep, voffA);
            PG8_WAIT_L(8); PG8_BAR; PG8_WAIT_L(0); PG8_MMA(0, 0, At, B0); PG8_BAR; PG8_SCHED;
            PG8_LDB(B1, 1, 1); PG8_STAGE(PG8_SB(1, 0), b3, voffB);
            PG8_BAR; PG8_WAIT_L(0); PG8_MMA(0, 1, At, B1); PG8_BAR;
            PG8_LDA(At, 1, 1); PG8_STAGE(PG8_SA(1, 0), a3, voffA);
            PG8_BAR; PG8_WAIT_L(0); PG8_MMA(1, 0, At, B0); PG8_BAR; PG8_SCHED;
            PG8_STAGE(PG8_SB(1, 1), b3 + hstep, voffB);
            PG8_WAIT_V(6); PG8_BAR; PG8_MMA(1, 1, At, B1); PG8_BAR;
            }
        }
        if constexpr (ALIGN_EPI) { if (wr == 0) PG8_BAR; }
        if constexpr (!Epi::AFTER_DRAIN) { E(acc, cur, wr, wc, fr, fq); S.done(cur); }
        if (!has_next) break;
#pragma unroll
        for (int a = 0; a < 2; ++a)
#pragma unroll
            for (int b = 0; b < 2; ++b)
#pragma unroll
                for (int m = 0; m < 4; ++m)
#pragma unroll
                    for (int n = 0; n < 2; ++n) acc[a][b][m][n] = (f32x4){0.f, 0.f, 0.f, 0.f};
        cur = nxt; cA = nA; cB = nB; ++ui;
        if constexpr (ALIGN_EPI) { if (wr == 1) PG8_BAR; }
    }
    PG8_WAIT_V(0);
    if constexpr (!ALIGN_EPI) { if (wr == 0) PG8_BAR; }
    PG8_BAR;
    if constexpr (Epi::AFTER_DRAIN) { E.fused(acc, cur, wr, wc, fr, fq, lds, wid, lane); S.done(cur); }
#undef PG8_SA
#undef PG8_SB
#undef PG8_STAGE
#undef PG8_LDA
#undef PG8_LDB
#undef PG8_MMA
#undef PG8_WAIT_V
#undef PG8_WAIT_L
#undef PG8_BAR
#undef PG8_SCHED
}
}

#define LAS __attribute__((address_space(3)))
typedef unsigned short bf16;
typedef float f32x4 __attribute__((ext_vector_type(4)));
typedef float f32x2 __attribute__((ext_vector_type(2)));
typedef unsigned u32x4 __attribute__((ext_vector_type(4)));
typedef unsigned u32x2 __attribute__((ext_vector_type(2)));

constexpr int NWAVES = 8, NTHR = 512;
constexpr int TP = 8192, TS = 1024, T = 9216, D = 2048, NIN = 4800, NZ = 4864, FF = 5632, NGU = 11264;
constexpr int NH = 16, HS = 64, RD = 1024, RP = 3264, DEPTH = 4;
constexpr int ZQ = 1536;
constexpr float RMS_EPS = 1e-6f, LN_EPS = 1e-5f, GN_EPS = 64e-5f;
constexpr int SCR = 384;
constexpr size_t O_Y = 0;
constexpr size_t O_CONV_P = (size_t)T * D;
constexpr size_t O_POOL_P = O_CONV_P + (size_t)DEPTH * 4 * 30 * 512;
constexpr size_t O_SHIFT_P = O_POOL_P + (size_t)DEPTH * 4 * 15 * 512;
constexpr size_t O_WKV_P = O_SHIFT_P + (size_t)DEPTH * 4 * RP;
constexpr size_t O_CONV_S = O_WKV_P + (size_t)DEPTH * 4 * NH * 4096;
constexpr size_t O_POOL_S = O_CONV_S + (size_t)DEPTH * 16 * 30 * 512;
constexpr size_t O_SHIFT_S = O_POOL_S + (size_t)DEPTH * 16 * 15 * 512;
constexpr size_t O_WKV_S = O_SHIFT_S + (size_t)DEPTH * 16 * RP;
constexpr size_t O_END = O_WKV_S + (size_t)DEPTH * 16 * NH * 4096;
constexpr size_t WS_WIN = 1u << 20;
constexpr size_t WS_WOUT = WS_WIN + (size_t)NZ * D * 2;
constexpr size_t WS_WGU = WS_WOUT + (size_t)D * D * 2;
constexpr size_t WS_WDN = WS_WGU + (size_t)NGU * D * 2;
constexpr size_t WS_X = WS_WDN + (size_t)D * FF * 2;
constexpr size_t WS_XN = WS_X + (size_t)T * D * 4;
constexpr size_t WS_MIX = WS_XN + (size_t)T * D * 2;
constexpr size_t WS_Z = WS_MIX + (size_t)T * D * 2;
constexpr size_t WS_ACT = WS_Z;
constexpr size_t WS_SC = WS_Z + (size_t)T * NZ * 4;
constexpr size_t WS_Y = WS_SC + (size_t)T * NH * SCR * 4;
constexpr size_t WS_G = WS_Y + (size_t)T * RD * 4;
constexpr size_t WS_RK = WS_G + (size_t)T * RD * 4;
constexpr size_t WS_END = WS_RK + (size_t)T * NH * 4;
static_assert((size_t)T * FF * 2 <= (size_t)T * NZ * 4, "act overlay fits in z");
constexpr int LDS_BYTES = 147456;

#ifdef NO_SYNC
#define GSYNC() __syncthreads()
#else
#define GSYNC() grid.sync()
#endif
struct Params { const float* in[31]; float* out; unsigned char* ws; };
typedef const __attribute__((address_space(4))) Params* KP;
__device__ __forceinline__ KP kargs() { KP k = (KP)__builtin_amdgcn_kernarg_segment_ptr(); asm volatile("" : "+s"(k)); return k; }
__device__ __forceinline__ int launder_v(int v) { asm volatile("" : "+v"(v)); return v; }
#define PH_BEGIN() KP kp = kargs(); const int tid = launder_v((int)threadIdx.x); const int lane = tid & 63; const int wave = __builtin_amdgcn_readfirstlane(tid >> 6); \
    const int nb = gridDim.x, bid = blockIdx.x, gw = bid * NWAVES + wave, ngw = nb * NWAVES; unsigned char* const ws = kp->ws; (void)lane; (void)wave; (void)gw; (void)ngw; (void)ws; (void)nb; (void)bid

__device__ __forceinline__ float wave_sum(float v) {
#pragma unroll
    for (int o = 1; o < 64; o <<= 1) v += __shfl_xor(v, o);
    return v;
}
__device__ __forceinline__ unsigned f2bf(float f) { unsigned u = __builtin_bit_cast(unsigned, f); return (u + 0x7fffu + ((u >> 16) & 1u)) >> 16; }
__device__ __forceinline__ unsigned pk2(float lo, float hi) { return f2bf(lo) | (f2bf(hi) << 16); }
__device__ __forceinline__ float sigm(float x) { return 1.0f / (1.0f + __expf(-x)); }

__device__ __forceinline__ void transpose_item(const float* W, int K, int N, bf16* WT, int mode, LAS float* scr, int item, int lane) {
    const int nblk = N / 32, kb = item / nblk, nb = item % nblk, k0 = 64 * kb, n0 = 32 * nb;
    const int drow0 = (mode == 0) ? n0 : ((n0 >> 7) * 256 + (n0 & 127) + (mode == 2 ? 128 : 0));
#pragma unroll 8
    for (int i = 0; i < 32; ++i) { const int kk = 2 * i + (lane >> 5); scr[kk * 33 + (lane & 31)] = W[(size_t)(k0 + kk) * N + n0 + (lane & 31)]; }
    asm volatile("s_waitcnt lgkmcnt(0)" ::: "memory");
    const int c = lane & 7;
#pragma unroll
    for (int j = 0; j < 4; ++j) { const int n = (lane >> 3) + 8 * j; const LAS float* s = scr + (8 * c) * 33 + n;
        u32x4 o; o.x = pk2(s[0 * 33], s[1 * 33]); o.y = pk2(s[2 * 33], s[3 * 33]); o.z = pk2(s[4 * 33], s[5 * 33]); o.w = pk2(s[6 * 33], s[7 * 33]);
        *(u32x4*)(WT + (size_t)(drow0 + n) * K + k0 + 8 * c) = o; }
    asm volatile("s_waitcnt lgkmcnt(0)" ::: "memory");
}
__device__ __forceinline__ void convert_weights(KP kp, int l, LAS unsigned char* lds, int gw, int ngw, int wave, int lane) {
    LAS float* scr = (LAS float*)(lds + wave * 16384);
    unsigned char* ws = kp->ws;
    bf16* WIN = (bf16*)(ws + WS_WIN); bf16* WOUT = (bf16*)(ws + WS_WOUT); bf16* WGU = (bf16*)(ws + WS_WGU); bf16* WDN = (bf16*)(ws + WS_WDN);
    constexpr int I_IN = (D / 64) * (NIN / 32), I_OUT = (D / 64) * (D / 32), I_G = (D / 64) * (FF / 32), I_D = (FF / 64) * (D / 32);
    constexpr int NITEMS = I_IN + I_OUT + 2 * I_G + I_D;
    for (int it = gw; it < NITEMS; it += ngw) {
        int r = it;
        if (r < I_IN) { transpose_item(kp->in[7] + (size_t)l * D * NIN, D, NIN, WIN, 0, scr, r, lane); continue; } r -= I_IN;
        if (r < I_OUT) { transpose_item(kp->in[25] + (size_t)l * D * D, D, D, WOUT, 0, scr, r, lane); continue; } r -= I_OUT;
        if (r < I_G) { transpose_item(kp->in[27] + (size_t)l * D * FF, D, FF, WGU, 1, scr, r, lane); continue; } r -= I_G;
        if (r < I_G) { transpose_item(kp->in[28] + (size_t)l * D * FF, D, FF, WGU, 2, scr, r, lane); continue; } r -= I_G;
        transpose_item(kp->in[29] + (size_t)l * FF * D, FF, D, WDN, 0, scr, r, lane);
    }
    for (int e = gw * 64 + lane; e < 16384; e += ngw * 64) ((u32x4*)(WIN + (size_t)NIN * D))[e] = (u32x4){0u, 0u, 0u, 0u};
}
__device__ __forceinline__ void norm_rows(const float* sa, const float* sb, const float* g, float* xcopy, bf16* xn, float* fout, int gw, int ngw, int lane) {
    for (int m = gw; m < T; m += ngw) {
        const float* row = (m < TP) ? sa + (size_t)m * D : sb + (size_t)(m - TP) * D;
        f32x4 v[8]; float ss = 0.f;
#pragma unroll
        for (int j = 0; j < 8; ++j) { v[j] = ((const f32x4*)row)[lane + 64 * j]; ss += (v[j].x * v[j].x + v[j].y * v[j].y) + (v[j].z * v[j].z + v[j].w * v[j].w); }
        const float rinv = 1.0f / sqrtf(wave_sum(ss) * (1.0f / D) + RMS_EPS);
#pragma unroll
        for (int j = 0; j < 8; ++j) {
            if (xcopy) ((f32x4*)(xcopy + (size_t)m * D))[lane + 64 * j] = v[j];
            const f32x4 gj = ((const f32x4*)g)[lane + 64 * j];
            const f32x4 y = v[j] * rinv * gj;
            if (xn) { u32x2 o; o.x = pk2(y.x, y.y); o.y = pk2(y.z, y.w); ((u32x2*)(xn + (size_t)m * D))[lane + 64 * j] = o; }
            if (fout) ((f32x4*)(fout + (size_t)m * D))[lane + 64 * j] = y;
        }
    }
}

__device__ __forceinline__ void conv_item(KP kp, int l, int item, LAS float* lds, int tid) {
    const float* Z = (const float*)(kp->ws + WS_Z); bf16* MIX = (bf16*)(kp->ws + WS_MIX);
    const int t0 = item * 32;
    int s, tau0, Ls; bool prompt;
    if (t0 < TP) { s = t0 >> 11; tau0 = t0 & 2047; Ls = 2048; prompt = true; } else { s = (t0 - TP) >> 6; tau0 = (t0 - TP) & 63; Ls = 64; prompt = false; }
    const int c = tid;
    const float* cw = kp->in[8] + (size_t)l * 31 * 512;
    float w[31];
#pragma unroll
    for (int j = 0; j < 31; ++j) w[j] = cw[j * 512 + c];
    const float bias = kp->in[9][l * 512 + c];
    float acc[32];
#pragma unroll
    for (int i = 0; i < 32; ++i) acc[i] = bias;
    const bool first = (tau0 == 0), lastit = (tau0 + 32 == Ls);
    float* oc = prompt ? kp->out + O_CONV_P + (size_t)((l * 4 + s) * 30) * 512 : kp->out + O_CONV_S + (size_t)((l * 16 + s) * 30) * 512;
    const float* cc = kp->in[2] + (size_t)((l * 16 + s) * 30) * 512;
#pragma unroll
    for (int ii = 0; ii < 62; ++ii) {
        float u;
        if (ii < 30 && first) { u = prompt ? 0.f : cc[ii * 512 + c]; }
        else { const float* zr = Z + (size_t)(t0 + ii - 30) * NZ; const float val = zr[c], gate = zr[512 + c]; u = val * sigm(gate); }
        if (ii >= 32 && lastit) oc[(ii - 32) * 512 + c] = u;
#pragma unroll
        for (int oi = 0; oi < 32; ++oi) { const int j = ii - oi; if (j >= 0 && j <= 30) acc[oi] += w[j] * u; }
    }
#pragma unroll
    for (int oi = 0; oi < 32; ++oi) lds[oi * 512 + c] = acc[oi];
    __syncthreads();
    const int wave = tid >> 6, lane = tid & 63;
    const f32x4 g0 = *(const f32x4*)(kp->in[10] + l * 512 + lane * 8), g1 = *(const f32x4*)(kp->in[10] + l * 512 + lane * 8 + 4);
    const f32x4 b0 = *(const f32x4*)(kp->in[11] + l * 512 + lane * 8), b1 = *(const f32x4*)(kp->in[11] + l * 512 + lane * 8 + 4);
#pragma unroll
    for (int q = 0; q < 4; ++q) {
        const int oi = wave * 4 + q;
        f32x4 a = *(const LAS f32x4*)(lds + oi * 512 + lane * 8), b = *(const LAS f32x4*)(lds + oi * 512 + lane * 8 + 4);
        const float mean = wave_sum((a.x + a.y) + (a.z + a.w) + (b.x + b.y) + (b.z + b.w)) * (1.0f / 512.0f);
        a = a - mean; b = b - mean;
        const float var = wave_sum((a.x * a.x + a.y * a.y) + (a.z * a.z + a.w * a.w) + (b.x * b.x + b.y * b.y) + (b.z * b.z + b.w * b.w)) * (1.0f / 512.0f);
        const float rstd = 1.0f / sqrtf(var + LN_EPS);
        a = a * rstd * g0 + b0; b = b * rstd * g1 + b1;
        float o[8] = {a.x, a.y, a.z, a.w, b.x, b.y, b.z, b.w};
#pragma unroll
        for (int k = 0; k < 8; ++k) o[k] = o[k] * sigm(o[k]);
        u32x4 wv; wv.x = pk2(o[0], o[1]); wv.y = pk2(o[2], o[3]); wv.z = pk2(o[4], o[5]); wv.w = pk2(o[6], o[7]);
        *(u32x4*)(MIX + (size_t)(t0 + oi) * D + lane * 8) = wv;
    }
    __syncthreads();
}
__device__ __forceinline__ void pool_item(KP kp, int l, int item, LAS float* pp, int tid) {
    const float* Z = (const float*)(kp->ws + WS_Z); bf16* MIX = (bf16*)(kp->ws + WS_MIX);
    const int t0 = item * 32;
    int s, tau0, Ls; bool prompt;
    if (t0 < TP) { s = t0 >> 11; tau0 = t0 & 2047; Ls = 2048; prompt = true; } else { s = (t0 - TP) >> 6; tau0 = (t0 - TP) & 63; Ls = 64; prompt = false; }
    const int c = tid;
    const bool first = (tau0 == 0), lastit = (tau0 + 32 == Ls);
    float* op = prompt ? kp->out + O_POOL_P + (size_t)((l * 4 + s) * 15) * 512 : kp->out + O_POOL_S + (size_t)((l * 16 + s) * 15) * 512;
    const float* cp = kp->in[3] + (size_t)((l * 16 + s) * 15) * 512;
#pragma unroll 8
    for (int ii = 0; ii < 47; ++ii) {
        float val;
        if (ii < 15 && first) val = prompt ? 0.f : cp[ii * 512 + c];
        else val = Z[(size_t)(t0 + ii - 15) * NZ + 1024 + c];
        pp[ii * 512 + c] = val;
        if (ii >= 32 && lastit) op[(ii - 32) * 512 + c] = val;
    }
    const int gi = c >> 7, w = 2 << gi;
    for (int oi = 0; oi < 32; ++oi) {
        float sum = 0.f;
        for (int k = 0; k < w; ++k) sum += pp[(oi + 15 - k) * 512 + c];
        const int cnt = prompt ? min(w, tau0 + oi + 1) : w;
        const float d = sum / (float)cnt - pp[(oi + 15) * 512 + c];
        pp[oi * 512 + c] = d;
    }
    __syncthreads();
    const int n = tid, g = n >> 7, dp = n & 127;
    const float* pw = kp->in[12] + (size_t)((l * 4 + g) * 128) * 128 + dp;
    float acc[32];
#pragma unroll
    for (int i = 0; i < 32; ++i) acc[i] = 0.f;
    for (int c4 = 0; c4 < 32; ++c4) {
        const float w0 = pw[(4 * c4 + 0) * 128], w1 = pw[(4 * c4 + 1) * 128], w2 = pw[(4 * c4 + 2) * 128], w3 = pw[(4 * c4 + 3) * 128];
#pragma unroll
        for (int oi = 0; oi < 32; ++oi) { const f32x4 dv = *(const LAS f32x4*)(pp + oi * 512 + g * 128 + 4 * c4); acc[oi] += (dv.x * w0 + dv.y * w1) + (dv.z * w2 + dv.w * w3); }
    }
    const float scale = kp->in[13][l * 512 + n];
#pragma unroll
    for (int oi = 0; oi < 32; ++oi) MIX[(size_t)(t0 + oi) * D + 512 + n] = (bf16)f2bf(acc[oi] * scale);
    __syncthreads();
}
__device__ __forceinline__ void prep_item(KP kp, int l, int item, LAS float* lo, int tid) {
    const float* Z = (const float*)(kp->ws + WS_Z);
    float* SC = (float*)(kp->ws + WS_SC); float* G = (float*)(kp->ws + WS_G); float* RK = (float*)(kp->ws + WS_RK);
    const int t0 = item * 16;
    int s, tau0, Ls; bool prompt;
    if (t0 < TP) { s = t0 >> 11; tau0 = t0 & 2047; Ls = 2048; prompt = true; } else { s = (t0 - TP) >> 6; tau0 = (t0 - TP) & 63; Ls = 64; prompt = false; }
    const float* mu = kp->in[14] + (size_t)l * RP;
    const float* ssh = kp->in[4] + (size_t)(l * 16 + s) * RP;
    for (int e = tid; e < 16 * 192; e += NTHR) {
        const int tok = e / 192, col = e % 192, zc = 3072 + col, t = t0 + tok, tau = tau0 + tok;
        const float q = Z[(size_t)t * NZ + ZQ + zc];
        const float qp = tau > 0 ? Z[(size_t)(t - 1) * NZ + ZQ + zc] : (prompt ? 0.f : ssh[zc]);
        const float qs = q + (qp - q) * mu[zc];
        lo[tok * 192 + col] = col < 64 ? tanhf(qs) : (col < 128 ? qs : sigm(qs));
    }
    __syncthreads();
    const int lane = tid & 63;
#pragma unroll 1
    for (int cc = 0; cc < 2; ++cc) {
        const int c = tid + 512 * cc, h = c >> 6;
        float accw[16], acca[16], accg[16];
#pragma unroll
        for (int i = 0; i < 16; ++i) { accw[i] = 0.f; acca[i] = 0.f; accg[i] = 0.f; }
        const float* wu = kp->in[16] + (size_t)l * 64 * RD + c; const float* au = kp->in[18] + (size_t)l * 64 * RD + c; const float* gu = kp->in[19] + (size_t)l * 64 * RD + c;
#pragma unroll 2
        for (int j4 = 0; j4 < 16; ++j4) {
            const float w0 = wu[(4 * j4 + 0) * RD], w1 = wu[(4 * j4 + 1) * RD], w2 = wu[(4 * j4 + 2) * RD], w3 = wu[(4 * j4 + 3) * RD];
            const float a0 = au[(4 * j4 + 0) * RD], a1 = au[(4 * j4 + 1) * RD], a2 = au[(4 * j4 + 2) * RD], a3 = au[(4 * j4 + 3) * RD];
            const float g0 = gu[(4 * j4 + 0) * RD], g1 = gu[(4 * j4 + 1) * RD], g2 = gu[(4 * j4 + 2) * RD], g3 = gu[(4 * j4 + 3) * RD];
#pragma unroll
            for (int tok = 0; tok < 16; ++tok) {
                const f32x4 lw = *(const LAS f32x4*)(lo + tok * 192 + 4 * j4), la = *(const LAS f32x4*)(lo + tok * 192 + 64 + 4 * j4), lg = *(const LAS f32x4*)(lo + tok * 192 + 128 + 4 * j4);
                accw[tok] += (lw.x * w0 + lw.y * w1) + (lw.z * w2 + lw.w * w3);
                acca[tok] += (la.x * a0 + la.y * a1) + (la.z * a2 + la.w * a3);
                accg[tok] += (lg.x * g0 + lg.y * g1) + (lg.z * g2 + lg.w * g3);
            }
        }
        const float w0c = kp->in[15][l * RD + c], a0c = kp->in[17][l * RD + c], kkc = kp->in[20][l * RD + c], kac = kp->in[21][l * RD + c], rkc = kp->in[22][l * RD + c];
        const float mur = mu[c], muk = mu[RD + c], muv = mu[2 * RD + c];
        const float sr = prompt ? 0.f : ssh[c], sk = prompt ? 0.f : ssh[RD + c], sv = prompt ? 0.f : ssh[2 * RD + c];
#pragma unroll
        for (int tok = 0; tok < 16; ++tok) {
            const int t = t0 + tok, tau = tau0 + tok;
            const float* zr = Z + (size_t)t * NZ + ZQ;
            float r = zr[c], k = zr[RD + c], v = zr[2 * RD + c];
            float pr, pk, pv;
            if (tau > 0) { pr = zr[c - NZ]; pk = zr[RD + c - NZ]; pv = zr[2 * RD + c - NZ]; } else { pr = sr; pk = sk; pv = sv; }
            r += (pr - r) * mur; k += (pk - k) * muk; v += (pv - v) * muv;
            const float xw = -(w0c + accw[tok]);
            const float sp = fmaxf(xw, 0.f) + log1pf(expf(-fabsf(xw)));
            const float decay = expf(-expf(-sp - 0.5f));
            const float a = sigm(a0c + acca[tok]);
            const float kk = k * kkc;
            const float nrm = wave_sum(kk * kk);
            const float kkn = kk * (1.0f / sqrtf(fmaxf(nrm, 1e-24f)));
            const float kp = k * (1.0f + (a - 1.0f) * kac);
            const float b = kkn * a;
            const float rk = wave_sum(r * kp * rkc);
            float* sc = SC + ((size_t)t * NH + h) * SCR + lane;
            sc[0] = decay; sc[64] = kkn; sc[128] = b; sc[192] = kp; sc[256] = r; sc[320] = v;
            G[(size_t)t * RD + c] = accg[tok];
            if (lane == 0) RK[t * NH + h] = rk;
        }
    }
    if (tau0 + 16 == Ls) {
        float* osh = prompt ? kp->out + O_SHIFT_P + (size_t)(l * 4 + s) * RP : kp->out + O_SHIFT_S + (size_t)(l * 16 + s) * RP;
        const float* zr = Z + (size_t)(t0 + 15) * NZ + ZQ;
        for (int e = tid; e < RP; e += NTHR) osh[e] = zr[e];
    }
    __syncthreads();
}

__device__ __forceinline__ void scan_chain(const float* SC, float* Y, int tg0, int L, int h, const float* Sinit, float* Sout, LAS float* wl, int lane) {
    f32x2 S[32];
    if (Sinit) {
#pragma unroll
        for (int j = 0; j < 16; ++j) { const f32x4 v = ((const f32x4*)(Sinit + lane * 64))[j]; S[2 * j] = (f32x2){v.x, v.y}; S[2 * j + 1] = (f32x2){v.z, v.w}; }
    } else {
#pragma unroll
        for (int j = 0; j < 32; ++j) S[j] = (f32x2){0.f, 0.f};
    }
    for (int tc = 0; tc < L; tc += 8) {
        float vv[8];
#pragma unroll
        for (int s = 0; s < 8; ++s) {
            const float* rec = SC + ((size_t)(tg0 + tc + s) * NH + h) * SCR + lane;
#pragma unroll
            for (int k = 0; k < 5; ++k) wl[s * 320 + k * 64 + lane] = rec[k * 64];
            vv[s] = rec[320];
        }
        asm volatile("s_waitcnt lgkmcnt(0)" ::: "memory");
#pragma unroll
        for (int s = 0; s < 8; ++s) {
            const LAS f32x4* o = (const LAS f32x4*)(wl + s * 320);
            f32x2 d2 = (f32x2){0.f, 0.f};
#pragma unroll
            for (int j = 0; j < 16; ++j) { const f32x4 kk = o[16 + j]; d2 += S[2 * j] * (f32x2){kk.x, kk.y}; d2 += S[2 * j + 1] * (f32x2){kk.z, kk.w}; }
            const float sa = -(d2.x + d2.y);
            const f32x2 sa2 = (f32x2){sa, sa}, v2 = (f32x2){vv[s], vv[s]};
            f32x2 y2 = (f32x2){0.f, 0.f};
#pragma unroll
            for (int j = 0; j < 16; ++j) {
                const f32x4 w = o[j], b = o[32 + j], kp = o[48 + j], r = o[64 + j];
                f32x2 t0 = v2 * (f32x2){kp.x, kp.y}; t0 = sa2 * (f32x2){b.x, b.y} + t0; S[2 * j] = S[2 * j] * (f32x2){w.x, w.y} + t0; y2 += S[2 * j] * (f32x2){r.x, r.y};
                f32x2 t1 = v2 * (f32x2){kp.z, kp.w}; t1 = sa2 * (f32x2){b.z, b.w} + t1; S[2 * j + 1] = S[2 * j + 1] * (f32x2){w.z, w.w} + t1; y2 += S[2 * j + 1] * (f32x2){r.z, r.w};
            }
            Y[(size_t)(tg0 + tc + s) * RD + h * 64 + lane] = y2.x + y2.y;
        }
        asm volatile("s_waitcnt lgkmcnt(0)" ::: "memory");
    }
#pragma unroll
    for (int j = 0; j < 16; ++j) ((f32x4*)(Sout + lane * 64))[j] = (f32x4){S[2 * j].x, S[2 * j].y, S[2 * j + 1].x, S[2 * j + 1].y};
}
__device__ __forceinline__ void post_rows(KP kp, int l, int gw, int ngw, int lane) {
    const float* SC = (const float*)(kp->ws + WS_SC); const float* Y = (const float*)(kp->ws + WS_Y); const float* G = (const float*)(kp->ws + WS_G); const float* RK = (const float*)(kp->ws + WS_RK);
    bf16* MIX = (bf16*)(kp->ws + WS_MIX);
    for (int it = gw; it < T * NH; it += ngw) {
        const int t = it >> 4, h = it & 15, c = h * 64 + lane;
        const float y = Y[(size_t)t * RD + c];
        const float mean = wave_sum(y) * (1.0f / 64.0f);
        const float d = y - mean;
        const float var = wave_sum(d * d) * (1.0f / 64.0f);
        const float yn = d * (1.0f / sqrtf(var + GN_EPS)) * kp->in[23][l * RD + c] + kp->in[24][l * RD + c];
        const float v = SC[((size_t)t * NH + h) * SCR + 320 + lane];
        const float o = (yn + RK[it] * v) * G[(size_t)t * RD + c];
        MIX[(size_t)t * D + 1024 + c] = (bf16)f2bf(o);
    }
}

__global__ void __launch_bounds__(NTHR, 2) fwd_mega(Params p) {
    extern __shared__ __attribute__((aligned(16))) unsigned char lds_raw[];
    cg::grid_group grid = cg::this_grid();
    LAS unsigned char* lds = (LAS unsigned char*)lds_raw;

#pragma unroll 1
    for (int l = 0; l < DEPTH; ++l) {
        { PH_BEGIN();
#ifndef NO_CVT
          convert_weights(kp, l, lds, gw, ngw, wave, lane);
#endif
#ifndef NO_NORM
          float* X = (float*)(ws + WS_X); bf16* XN = (bf16*)(ws + WS_XN);
          if (l == 0) norm_rows(kp->in[0], kp->in[1], kp->in[6], X, XN, nullptr, gw, ngw, lane);
          else norm_rows(X, X + (size_t)TP * D, kp->in[6] + l * D, nullptr, XN, nullptr, gw, ngw, lane);
#endif
        }
        GSYNC();
#ifndef NO_GEMM1
        { PH_BEGIN(); pg8::Gemm g{(const bf16*)(ws + WS_XN), (const bf16*)(ws + WS_WIN), T, NZ, D}; pg8::StaticOrder S; S.init(T, NZ, nb, bid); pg8::EpiStoreF32 E{(float*)(ws + WS_Z), NZ};
          pg8::gemm_phase<pg8::EpiStoreF32, pg8::StaticOrder, true, true>(lds, g, S, E, tid); }
#endif
        GSYNC();
        { PH_BEGIN();
          for (int it = bid; it < 1152; it += nb) {
#ifndef NO_PREP
            if (it < 576) prep_item(kp, l, it, (LAS float*)lds, tid);
#endif
#ifndef NO_POOL
            if (it >= 576 && it < 864) pool_item(kp, l, it - 576, (LAS float*)lds, tid);
#endif
#ifndef NO_CONV
            if (it >= 864) conv_item(kp, l, it - 864, (LAS float*)lds, tid);
#endif
          }
        }
        GSYNC();
#ifndef NO_SCAN
        { PH_BEGIN();
            const float* SC = (const float*)(ws + WS_SC); float* Y = (float*)(ws + WS_Y);
            LAS float* wl = (LAS float*)(lds + wave * 10240);
            if (wave == 0) for (int pc = bid; pc < 256; pc += nb) if ((pc & 3) == 0) {
                const int ch = pc >> 2, s = ch >> 4, h = ch & 15;
                scan_chain(SC, Y, s * 2048, 2048, h, nullptr, kp->out + O_WKV_P + (size_t)((l * 4 + s) * NH + h) * 4096, wl, lane);
            }
            if (wave == 1) for (int ch = bid; ch < 256; ch += nb) {
                const int b = ch >> 4, h = ch & 15;
                scan_chain(SC, Y, TP + b * 64, 64, h, kp->in[5] + (size_t)((l * 16 + b) * NH + h) * 4096, kp->out + O_WKV_S + (size_t)((l * 16 + b) * NH + h) * 4096, wl, lane);
            }
        }
#endif
        GSYNC();
#ifndef NO_POST
        { PH_BEGIN(); post_rows(kp, l, gw, ngw, lane); }
#endif
        GSYNC();
#ifndef NO_GEMM2
        { PH_BEGIN(); pg8::Gemm g{(const bf16*)(ws + WS_MIX), (const bf16*)(ws + WS_WOUT), T, D, D}; pg8::StaticOrder S; S.init(T, D, nb, bid); pg8::EpiResAdd E{(float*)(ws + WS_X), D};
          pg8::gemm_phase<pg8::EpiResAdd, pg8::StaticOrder, true, true>(lds, g, S, E, tid); }
#endif
        GSYNC();
#ifndef NO_NORM
        { PH_BEGIN(); float* X = (float*)(ws + WS_X); norm_rows(X, X + (size_t)TP * D, kp->in[26] + l * D, nullptr, (bf16*)(ws + WS_XN), nullptr, gw, ngw, lane); }
#endif
        GSYNC();
#ifndef NO_GEMM3
        { PH_BEGIN(); pg8::Gemm g{(const bf16*)(ws + WS_XN), (const bf16*)(ws + WS_WGU), T, NGU, D}; pg8::StaticOrder S; S.init(T, NGU, nb, bid); pg8::EpiSwiGLU E{(bf16*)(ws + WS_ACT), FF};
          pg8::gemm_phase<pg8::EpiSwiGLU, pg8::StaticOrder, true, true>(lds, g, S, E, tid); }
#endif
        GSYNC();
#ifndef NO_GEMM4
        { PH_BEGIN(); pg8::Gemm g{(const bf16*)(ws + WS_ACT), (const bf16*)(ws + WS_WDN), T, D, FF}; pg8::StaticOrder S; S.init(T, D, nb, bid); pg8::EpiResAdd E{(float*)(ws + WS_X), D};
          pg8::gemm_phase<pg8::EpiResAdd, pg8::StaticOrder, true, true>(lds, g, S, E, tid); }
#endif
        GSYNC();
    }
#ifndef NO_NORM
    { PH_BEGIN(); float* X = (float*)(ws + WS_X); norm_rows(X, X + (size_t)TP * D, kp->in[30], nullptr, nullptr, kp->out + O_Y, gw, ngw, lane); }
#endif
}

extern "C" void kernel_launch(void* const* d_in, const int* in_sizes, int n_in, void* d_out, int out_size, void* d_ws, size_t ws_size, hipStream_t stream) {
    static int grid = 0;
    if (grid == 0) {
        if (n_in != 31 || (size_t)out_size != O_END || ws_size < WS_END) { fprintf(stderr, "kernel_launch: unexpected shapes: n_in %d out %d ws %zu (need %zu)\n", n_in, out_size, ws_size, (size_t)WS_END); grid = -1; return; }
        int dev = 0, cus = 0, per_cu = 0;
        hipGetDevice(&dev);
        hipDeviceGetAttribute(&cus, hipDeviceAttributeMultiprocessorCount, dev);
        if (hipFuncSetAttribute((const void*)fwd_mega, hipFuncAttributeMaxDynamicSharedMemorySize, LDS_BYTES) != hipSuccess) { fprintf(stderr, "kernel_launch: hipFuncSetAttribute failed\n"); grid = -1; return; }
        hipOccupancyMaxActiveBlocksPerMultiprocessor(&per_cu, (const void*)fwd_mega, NTHR, LDS_BYTES);
        (void)hipGetLastError();
        if (per_cu < 1) { fprintf(stderr, "kernel_launch: occupancy query says %d blocks per CU\n", per_cu); per_cu = 1; }
        grid = cus * 1;
    }
    if (grid < 0) return;
    Params p{};
    for (int i = 0; i < 31; ++i) p.in[i] = (const float*)d_in[i];
    p.out = (float*)d_out; p.ws = (unsigned char*)d_ws;
    void* args[] = {&p};
    hipError_t e = hipLaunchCooperativeKernel((const void*)fwd_mega, dim3(grid), dim3(NTHR), args, LDS_BYTES, stream);
    if (e != hipSuccess) fprintf(stderr, "cooperative launch failed: %s (grid %d)\n", hipGetErrorString(e), grid);
}
```

```cpp
#include <hip/hip_runtime.h>
#include <hip/hip_cooperative_groups.h>
#include <cstdio>
#include <cstdint>
namespace cg = cooperative_groups;

namespace pg8 {
#define PG8_LAS __attribute__((address_space(3)))
typedef unsigned short bf16_t;
typedef short bf16x8 __attribute__((ext_vector_type(8)));
typedef float f32x4 __attribute__((ext_vector_type(4)));
typedef unsigned u32x4 __attribute__((ext_vector_type(4)));
constexpr int BM = 256, BK = 64, HALF = 128, HTB = HALF * BK * 2  , STAGE_BYTES = 8 * HTB, NXCD = 8, WGM = 8;

__host__ __device__ __forceinline__ int lds_byte(int r, int c) { const int st = (r >> 4) * 2 + (c >> 5), rr = r & 15, cc = c & 31, ob = rr * 64 + cc * 2; return st * 1024 + (ob ^ (((ob >> 9) & 1) << 5)); }
__host__ __device__ __forceinline__ void stage_rc(int b, int& R, int& C) { const int st = b / 1024, sb = b % 1024, swz = sb ^ (((sb >> 9) & 1) << 5); R = (st >> 1) * 16 + swz / 64; C = (st & 1) * 32 + (swz % 64) / 2; }
__host__ __device__ __forceinline__ int perm32(int rho) { const int n = rho >> 4, i = rho & 15; return 8 * (i >> 2) + 4 * n + (i & 3); }

struct Unit { int pm, pn; };
struct Gemm { const bf16_t* A; const bf16_t* Bt; int M, N, K; };

struct StaticOrder {
    int nM, nN, nwg, G, c;
    __host__ __device__ void init(int M, int N, int G_, int c_) { nM = M / BM; nN = N / BM; nwg = nM * nN; G = G_; c = c_; }
    __host__ __device__ bool next(int i, Unit& u) const {
        const long L = (long)i * G + c; if (L >= nwg) return false;
        int wgid = (int)L; { const int q = nwg / NXCD, r = nwg % NXCD, xcd = wgid % NXCD, off = wgid / NXCD; wgid = (xcd < r ? xcd * (q + 1) : r * (q + 1) + (xcd - r) * q) + off; }
        const int nig = WGM * nN, gid = wgid / nig, fm = gid * WGM, gsz = (nM - fm) < WGM ? (nM - fm) : WGM;
        u.pm = fm + ((wgid % nig) % gsz); u.pn = (wgid % nig) / gsz; return true;
    }
    __device__ __forceinline__ void a_ready(const Unit&) const {}
    __device__ __forceinline__ void done(const Unit&) const {}
};

__device__ __forceinline__ unsigned cvt_pk_bf16(float lo, float hi) { unsigned r; asm volatile("v_cvt_pk_bf16_f32 %0, %1, %2" : "=v"(r) : "v"(lo), "v"(hi)); return r; }

struct EpiStoreF32 {
    static constexpr bool PERM = true, AFTER_DRAIN = false;
    float* O; int ldc;
    __device__ __forceinline__ void operator()(const f32x4 (&acc)[2][2][4][2], const Unit& u, int wr, int wc, int fr, int fq) const {
        const int row0 = u.pm * BM + wr * 64 + fr, col0 = u.pn * BM + wc * 32 + 8 * fq;
#pragma unroll
        for (int ai = 0; ai < 2; ++ai)
#pragma unroll
            for (int m = 0; m < 4; ++m) { float* rowp = O + (size_t)(row0 + ai * HALF + m * 16) * ldc + col0;
#pragma unroll
                for (int bj = 0; bj < 2; ++bj) { *(f32x4*)(rowp + bj * HALF) = acc[ai][bj][m][0]; *(f32x4*)(rowp + bj * HALF + 4) = acc[ai][bj][m][1]; } }
    }
};
struct EpiResAdd {
    static constexpr bool PERM = true, AFTER_DRAIN = false;
    float* O; int ldc;
    __device__ __forceinline__ void operator()(const f32x4 (&acc)[2][2][4][2], const Unit& u, int wr, int wc, int fr, int fq) const {
        const int row0 = u.pm * BM + wr * 64 + fr, col0 = u.pn * BM + wc * 32 + 8 * fq;
#pragma unroll
        for (int ai = 0; ai < 2; ++ai)
#pragma unroll
            for (int m = 0; m < 4; ++m) { float* rowp = O + (size_t)(row0 + ai * HALF + m * 16) * ldc + col0;
#pragma unroll
                for (int bj = 0; bj < 2; ++bj) {
                    f32x4 a = *(const f32x4*)(rowp + bj * HALF), b = *(const f32x4*)(rowp + bj * HALF + 4);
                    *(f32x4*)(rowp + bj * HALF) = a + acc[ai][bj][m][0]; *(f32x4*)(rowp + bj * HALF + 4) = b + acc[ai][bj][m][1]; } }
    }
};
struct EpiSwiGLU {
    static constexpr bool PERM = true, AFTER_DRAIN = false;
    bf16_t* O; int ldc;
    __device__ __forceinline__ void operator()(const f32x4 (&acc)[2][2][4][2], const Unit& u, int wr, int wc, int fr, int fq) const {
        const int row0 = u.pm * BM + wr * 64 + fr, col0 = u.pn * HALF + wc * 32 + 8 * fq;
#pragma unroll
        for (int ai = 0; ai < 2; ++ai)
#pragma unroll
            for (int m = 0; m < 4; ++m) { bf16_t* rowp = O + (size_t)(row0 + ai * HALF + m * 16) * ldc + col0;
                float o[8];
#pragma unroll
                for (int n = 0; n < 2; ++n)
#pragma unroll
                    for (int j = 0; j < 4; ++j) { const float g = acc[ai][0][m][n][j], up = acc[ai][1][m][n][j]; o[n * 4 + j] = g * up * __builtin_amdgcn_rcpf(1.0f + __expf(-g)); }
                u32x4 w; w.x = cvt_pk_bf16(o[0], o[1]); w.y = cvt_pk_bf16(o[2], o[3]); w.z = cvt_pk_bf16(o[4], o[5]); w.w = cvt_pk_bf16(o[6], o[7]);
                *(u32x4*)rowp = w; }
    }
};

template <class Epi, class Sched, bool ALIGN_EPI = false, bool SP2 = false>
__device__ __forceinline__ void gemm_phase(PG8_LAS unsigned char* lds, const Gemm g, const Sched& S, const Epi& E, const int tid) {
    const int wid = __builtin_amdgcn_readfirstlane(tid >> 6), lane = tid & 63, wr = wid >> 2, wc = wid & 3, fr = lane & 15, fq = lane >> 4;
    const int K = g.K, nt = K / BK;
    unsigned voffA[2], voffB[2];
#pragma unroll
    for (int i = 0; i < 2; ++i) { int R, C; stage_rc(tid * 16 + i * 8192, R, C); const int Rb = Epi::PERM ? ((R & ~31) + perm32(R & 31)) : R;
        voffA[i] = (unsigned)(R * K + C) * 2u; voffB[i] = (unsigned)(Rb * K + C) * 2u; }
    const size_t kstep = (size_t)(BK * 2);
    const size_t hstep = (size_t)HALF * K * 2;
    const size_t tstep = 2 * hstep;
    const unsigned ldsw = (unsigned)wid * 1024u;
    const int aoff = lds_byte(wr * 64 + fr, fq * 8), boff = lds_byte(wc * 32 + fr, fq * 8);
#define PG8_SA(b, h) (((b) * 2 + (h)) * HTB)
#define PG8_SB(b, h) ((4 + (b) * 2 + (h)) * HTB)
#define PG8_STAGE(bufoff, gbase, voff) do { _Pragma("unroll") for (int _i = 0; _i < 2; ++_i) \
        __builtin_amdgcn_global_load_lds((const unsigned*)((const char*)(gbase) + (voff)[_i]), (PG8_LAS unsigned*)(lds + (bufoff) + ldsw + _i * 8192), 16, 0, 0); } while (0)
#define PG8_LDA(dst, b, h) do { _Pragma("unroll") for (int m = 0; m < 4; ++m) _Pragma("unroll") for (int k = 0; k < 2; ++k) dst[m][k] = *(const PG8_LAS bf16x8*)(lds + PG8_SA(b, h) + aoff + m * 2048 + k * 1024); } while (0)
#define PG8_LDB(dst, b, h) do { _Pragma("unroll") for (int n = 0; n < 2; ++n) _Pragma("unroll") for (int k = 0; k < 2; ++k) dst[n][k] = *(const PG8_LAS bf16x8*)(lds + PG8_SB(b, h) + boff + n * 2048 + k * 1024); } while (0)
#define PG8_MMA(ai, bj, At, Bt) do { __builtin_amdgcn_s_setprio(1); _Pragma("unroll") for (int m = 0; m < 4; ++m) _Pragma("unroll") for (int n = 0; n < 2; ++n) _Pragma("unroll") for (int k = 0; k < 2; ++k) \
        acc[ai][bj][m][n] = __builtin_amdgcn_mfma_f32_16x16x32_bf16(Bt[n][k], At[m][k], acc[ai][bj][m][n], 0, 0, 0); __builtin_amdgcn_s_setprio(0); } while (0)
#define PG8_WAIT_V(n) asm volatile("s_waitcnt vmcnt(" #n ")" ::: "memory")
#define PG8_WAIT_L(n) asm volatile("s_waitcnt lgkmcnt(" #n ")" ::: "memory")
#define PG8_BAR __builtin_amdgcn_s_barrier()
#define PG8_SCHED __builtin_amdgcn_sched_barrier(0)
    Unit cur, nxt; int ui = 0;
    if (!S.next(0, cur)) return;
    f32x4 acc[2][2][4][2];
#pragma unroll
    for (int a = 0; a < 2; ++a)
#pragma unroll
        for (int b = 0; b < 2; ++b)
#pragma unroll
            for (int m = 0; m < 4; ++m)
#pragma unroll
                for (int n = 0; n < 2; ++n) acc[a][b][m][n] = (f32x4){0.f, 0.f, 0.f, 0.f};
    bf16x8 At[4][2], B0[2][2], B1[2][2];
    const char* cA = (const char*)g.A + (size_t)cur.pm * tstep; const char* cB = (const char*)g.Bt + (size_t)cur.pn * tstep;
    S.a_ready(cur);
    if constexpr (SP2) {
        PG8_STAGE(PG8_SB(0, 0), cB, voffB); PG8_STAGE(PG8_SB(0, 1), cB + hstep, voffB); PG8_STAGE(PG8_SA(0, 0), cA, voffA); PG8_STAGE(PG8_SA(0, 1), cA + hstep, voffA);
        if (wr == 1) PG8_BAR;
        PG8_WAIT_V(2); PG8_BAR;
        PG8_STAGE(PG8_SB(1, 0), cB + kstep, voffB); PG8_STAGE(PG8_SA(1, 0), cA + kstep, voffA); PG8_STAGE(PG8_SB(1, 1), cB + hstep + kstep, voffB);
        PG8_WAIT_V(6); PG8_BAR;
    } else {
        PG8_STAGE(PG8_SB(0, 0), cB, voffB); PG8_STAGE(PG8_SA(0, 0), cA, voffA); PG8_STAGE(PG8_SB(0, 1), cB + hstep, voffB); PG8_STAGE(PG8_SA(0, 1), cA + hstep, voffA);
        if (wr == 1) PG8_BAR;
        PG8_WAIT_V(4); PG8_BAR;
        PG8_STAGE(PG8_SB(1, 0), cB + kstep, voffB); PG8_STAGE(PG8_SA(1, 0), cA + kstep, voffA); PG8_STAGE(PG8_SB(1, 1), cB + hstep + kstep, voffB);
        PG8_WAIT_V(6); PG8_BAR;
    }
    for (;;) {
        const bool has_next = S.next(ui + 1, nxt);
        const char* nA = has_next ? (const char*)g.A + (size_t)nxt.pm * tstep : cA; const char* nB = has_next ? (const char*)g.Bt + (size_t)nxt.pn * tstep : cB;
        for (int t = 0; t < nt; t += 2) {
            const bool last = (t == nt - 2);
            const char* a1 = cA + (size_t)(t + 1) * kstep;
            const char* a2 = last ? nA : cA + (size_t)(t + 2) * kstep; const char* b2 = last ? nB : cB + (size_t)(t + 2) * kstep;
            const char* a3 = a2 + kstep; const char* b3 = b2 + kstep;
            if (last && has_next) S.a_ready(nxt);
            if constexpr (SP2) {
            PG8_LDB(B0, 0, 0); PG8_LDB(B1, 0, 1); PG8_SCHED; PG8_LDA(At, 0, 0); PG8_STAGE(PG8_SA(1, 1), a1 + hstep, voffA);
            PG8_WAIT_V(8); PG8_WAIT_L(0); PG8_BAR; PG8_MMA(0, 0, At, B0); PG8_MMA(0, 1, At, B1); PG8_BAR; PG8_SCHED;
            PG8_LDA(At, 0, 1); PG8_STAGE(PG8_SB(0, 0), b2, voffB); PG8_STAGE(PG8_SB(0, 1), b2 + hstep, voffB); PG8_STAGE(PG8_SA(0, 0), a2, voffA);
            PG8_WAIT_V(8); PG8_WAIT_L(0); PG8_BAR; PG8_MMA(1, 0, At, B0); PG8_MMA(1, 1, At, B1); PG8_BAR; PG8_SCHED;
            PG8_LDB(B0, 1, 0); PG8_LDB(B1, 1, 1); PG8_SCHED; PG8_LDA(At, 1, 0); PG8_STAGE(PG8_SA(0, 1), a2 + hstep, voffA);
            PG8_WAIT_V(8); PG8_WAIT_L(0); PG8_BAR; PG8_MMA(0, 0, At, B0); PG8_MMA(0, 1, At, B1); PG8_BAR; PG8_SCHED;
            PG8_LDA(At, 1, 1); PG8_STAGE(PG8_SB(1, 0), b3, voffB); PG8_STAGE(PG8_SB(1, 1), b3 + hstep, voffB); PG8_STAGE(PG8_SA(1, 0), a3, voffA);
            PG8_WAIT_V(8); PG8_WAIT_L(0); PG8_BAR; PG8_MMA(1, 0, At, B0); PG8_MMA(1, 1, At, B1); PG8_BAR; PG8_SCHED;
            } else {
            PG8_LDB(B0, 0, 0); PG8_SCHED; PG8_LDA(At, 0, 0); PG8_STAGE(PG8_SA(1, 1), a1 + hstep, voffA);
            PG8_WAIT_L(8); PG8_BAR; PG8_WAIT_L(0); PG8_MMA(0, 0, At, B0); PG8_BAR; PG8_SCHED;
            PG8_LDB(B1, 0, 1); PG8_STAGE(PG8_SB(0, 0), b2, voffB);
            PG8_BAR; PG8_WAIT_L(0); PG8_MMA(0, 1, At, B1); PG8_BAR;
            PG8_LDA(At, 0, 1); PG8_STAGE(PG8_SA(0, 0), a2, voffA);
            PG8_BAR; PG8_WAIT_L(0); PG8_MMA(1, 0, At, B0); PG8_BAR; PG8_SCHED;
            PG8_STAGE(PG8_SB(0, 1), b2 + hstep, voffB);
            PG8_WAIT_V(6); PG8_BAR; PG8_MMA(1, 1, At, B1); PG8_BAR;
            PG8_LDB(B0, 1, 0); PG8_SCHED; PG8_LDA(At, 1, 0); PG8_STAGE(PG8_SA(0, 1), a2 + hstep, voffA);
            PG8_WAIT_L(8); PG8_BAR; PG8_WAIT_L(0); PG8_MMA(0, 0, At, B0); PG8_BAR; PG8_SCHED;
            PG8_LDB(B1, 1, 1); PG8_STAGE(PG8_SB(1, 0), b3, voffB);
            PG8_BAR; PG8_WAIT_L(0); PG8_MMA(0, 1, At, B1); PG8_BAR;
            PG8_LDA(At, 1, 1); PG8_STAGE(PG8_SA(1, 0), a3, voffA);
            PG8_BAR; PG8_WAIT_L(0); PG8_MMA(1, 0, At, B0); PG8_BAR; PG8_SCHED;
            PG8_STAGE(PG8_SB(1, 1), b3 + hstep, voffB);
            PG8_WAIT_V(6); PG8_BAR; PG8_MMA(1, 1, At, B1); PG8_BAR;
            }
        }
        if constexpr (ALIGN_EPI) { if (wr == 0) PG8_BAR; }
        if constexpr (!Epi::AFTER_DRAIN) { E(acc, cur, wr, wc, fr, fq); S.done(cur); }
        if (!has_next) break;
#pragma unroll
        for (int a = 0; a < 2; ++a)
#pragma unroll
            for (int b = 0; b < 2; ++b)
#pragma unroll
                for (int m = 0; m < 4; ++m)
#pragma unroll
                    for (int n = 0; n < 2; ++n) acc[a][b][m][n] = (f32x4){0.f, 0.f, 0.f, 0.f};
        cur = nxt; cA = nA; cB = nB; ++ui;
        if constexpr (ALIGN_EPI) { if (wr == 1) PG8_BAR; }
    }
    PG8_WAIT_V(0);
    if constexpr (!ALIGN_EPI) { if (wr == 0) PG8_BAR; }
    PG8_BAR;
    if constexpr (Epi::AFTER_DRAIN) { E.fused(acc, cur, wr, wc, fr, fq, lds, wid, lane); S.done(cur); }
#undef PG8_SA
#undef PG8_SB
#undef PG8_STAGE
#undef PG8_LDA
#undef PG8_LDB
#undef PG8_MMA
#undef PG8_WAIT_V
#undef PG8_WAIT_L
#undef PG8_BAR
#undef PG8_SCHED
}
}

#define LAS __attribute__((address_space(3)))
typedef unsigned short bf16;
typedef float f32x4 __attribute__((ext_vector_type(4)));
typedef float f32x2 __attribute__((ext_vector_type(2)));
typedef unsigned u32x4 __attribute__((ext_vector_type(4)));
typedef unsigned u32x2 __attribute__((ext_vector_type(2)));

constexpr int NWAVES = 8, NTHR = 512;
constexpr int TP = 8192, TS = 1024, T = 9216, D = 2048, NIN = 4800, NZ = 4864, FF = 5632, NGU = 11264;
constexpr int NH = 16, HS = 64, RD = 1024, RP = 3264, DEPTH = 4;
constexpr int ZQ = 1536;
constexpr float RMS_EPS = 1e-6f, LN_EPS = 1e-5f, GN_EPS = 64e-5f;
constexpr int SCR = 384;
constexpr size_t O_Y = 0;
constexpr size_t O_CONV_P = (size_t)T * D;
constexpr size_t O_POOL_P = O_CONV_P + (size_t)DEPTH * 4 * 30 * 512;
constexpr size_t O_SHIFT_P = O_POOL_P + (size_t)DEPTH * 4 * 15 * 512;
constexpr size_t O_WKV_P = O_SHIFT_P + (size_t)DEPTH * 4 * RP;
constexpr size_t O_CONV_S = O_WKV_P + (size_t)DEPTH * 4 * NH * 4096;
constexpr size_t O_POOL_S = O_CONV_S + (size_t)DEPTH * 16 * 30 * 512;
constexpr size_t O_SHIFT_S = O_POOL_S + (size_t)DEPTH * 16 * 15 * 512;
constexpr size_t O_WKV_S = O_SHIFT_S + (size_t)DEPTH * 16 * RP;
constexpr size_t O_END = O_WKV_S + (size_t)DEPTH * 16 * NH * 4096;
constexpr size_t WS_WIN = 1u << 20;
constexpr size_t WS_WOUT = WS_WIN + (size_t)NZ * D * 2;
constexpr size_t WS_WGU = WS_WOUT + (size_t)D * D * 2;
constexpr size_t WS_WDN = WS_WGU + (size_t)NGU * D * 2;
constexpr size_t WS_X = WS_WDN + (size_t)D * FF * 2;
constexpr size_t WS_XN = WS_X + (size_t)T * D * 4;
constexpr size_t WS_MIX = WS_XN + (size_t)T * D * 2;
constexpr size_t WS_Z = WS_MIX + (size_t)T * D * 2;
constexpr size_t WS_ACT = WS_Z;
constexpr size_t WS_SC = WS_Z + (size_t)T * NZ * 4;
constexpr size_t WS_Y = WS_SC + (size_t)T * NH * SCR * 4;
constexpr size_t WS_G = WS_Y + (size_t)T * RD * 4;
constexpr size_t WS_RK = WS_G + (size_t)T * RD * 4;
constexpr int NC = 16, CL = 128;
constexpr size_t WS_PQ = WS_RK + (size_t)T * NH * 4;
constexpr size_t WS_S0 = WS_PQ + (size_t)64 * (NC - 1) * 2 * 4096 * 4;
constexpr size_t WS_END = WS_S0 + (size_t)64 * NC * 4096 * 4;
static_assert((size_t)T * FF * 2 <= (size_t)T * NZ * 4, "act overlay fits in z");
constexpr int LDS_BYTES = 147456;

#ifdef NO_SYNC
#define GSYNC() __syncthreads()
#else
#define GSYNC() cg::this_grid().sync()
#endif
struct Params { const float* in[31]; float* out; unsigned char* ws; };
typedef const __attribute__((address_space(4))) Params* KP;
__device__ __forceinline__ KP kargs() { KP k = (KP)__builtin_amdgcn_kernarg_segment_ptr(); asm volatile("" : "+s"(k)); return k; }
__device__ __forceinline__ int launder_v(int v) { asm volatile("" : "+v"(v)); return v; }
#define PH_BEGIN() KP kp = kargs(); const int tid = launder_v((int)threadIdx.x); const int lane = tid & 63; const int wave = __builtin_amdgcn_readfirstlane(tid >> 6); \
    const int nb = gridDim.x, bid = blockIdx.x, gw = bid * NWAVES + wave, ngw = nb * NWAVES; unsigned char* const ws = kp->ws; (void)lane; (void)wave; (void)gw; (void)ngw; (void)ws; (void)nb; (void)bid

__device__ __forceinline__ float wave_sum(float v) {
#pragma unroll
    for (int o = 1; o < 64; o <<= 1) v += __shfl_xor(v, o);
    return v;
}
__device__ __forceinline__ unsigned f2bf(float f) { unsigned u = __builtin_bit_cast(unsigned, f); return (u + 0x7fffu + ((u >> 16) & 1u)) >> 16; }
__device__ __forceinline__ unsigned pk2(float lo, float hi) { return f2bf(lo) | (f2bf(hi) << 16); }
__device__ __forceinline__ float sigm(float x) { return 1.0f / (1.0f + __expf(-x)); }

__device__ __forceinline__ void transpose_item(const float* W, int K, int N, bf16* WT, int mode, LAS float* scr, int item, int lane) {
    const int nblk = N / 32, kb = item / nblk, nb = item % nblk, k0 = 64 * kb, n0 = 32 * nb;
    const int drow0 = (mode == 0) ? n0 : ((n0 >> 7) * 256 + (n0 & 127) + (mode == 2 ? 128 : 0));
#pragma unroll 8
    for (int i = 0; i < 32; ++i) { const int kk = 2 * i + (lane >> 5); scr[kk * 33 + (lane & 31)] = W[(size_t)(k0 + kk) * N + n0 + (lane & 31)]; }
    asm volatile("s_waitcnt lgkmcnt(0)" ::: "memory");
    const int c = lane & 7;
#pragma unroll
    for (int j = 0; j < 4; ++j) { const int n = (lane >> 3) + 8 * j; const LAS float* s = scr + (8 * c) * 33 + n;
        u32x4 o; o.x = pk2(s[0 * 33], s[1 * 33]); o.y = pk2(s[2 * 33], s[3 * 33]); o.z = pk2(s[4 * 33], s[5 * 33]); o.w = pk2(s[6 * 33], s[7 * 33]);
        *(u32x4*)(WT + (size_t)(drow0 + n) * K + k0 + 8 * c) = o; }
    asm volatile("s_waitcnt lgkmcnt(0)" ::: "memory");
}
__device__ __forceinline__ void convert_weights(KP kp, int l, LAS unsigned char* lds, int gw, int ngw, int wave, int lane) {
    LAS float* scr = (LAS float*)(lds + wave * 16384);
    unsigned char* ws = kp->ws;
    bf16* WIN = (bf16*)(ws + WS_WIN); bf16* WOUT = (bf16*)(ws + WS_WOUT); bf16* WGU = (bf16*)(ws + WS_WGU); bf16* WDN = (bf16*)(ws + WS_WDN);
    constexpr int I_IN = (D / 64) * (NIN / 32), I_OUT = (D / 64) * (D / 32), I_G = (D / 64) * (FF / 32), I_D = (FF / 64) * (D / 32);
    constexpr int NITEMS = I_IN + I_OUT + 2 * I_G + I_D;
    for (int it = gw; it < NITEMS; it += ngw) {
        int r = it;
        if (r < I_IN) { transpose_item(kp->in[7] + (size_t)l * D * NIN, D, NIN, WIN, 0, scr, r, lane); continue; } r -= I_IN;
        if (r < I_OUT) { transpose_item(kp->in[25] + (size_t)l * D * D, D, D, WOUT, 0, scr, r, lane); continue; } r -= I_OUT;
        if (r < I_G) { transpose_item(kp->in[27] + (size_t)l * D * FF, D, FF, WGU, 1, scr, r, lane); continue; } r -= I_G;
        if (r < I_G) { transpose_item(kp->in[28] + (size_t)l * D * FF, D, FF, WGU, 2, scr, r, lane); continue; } r -= I_G;
        transpose_item(kp->in[29] + (size_t)l * FF * D, FF, D, WDN, 0, scr, r, lane);
    }
    for (int e = gw * 64 + lane; e < 16384; e += ngw * 64) ((u32x4*)(WIN + (size_t)NIN * D))[e] = (u32x4){0u, 0u, 0u, 0u};
}
__device__ __forceinline__ void norm_rows(const float* sa, const float* sb, const float* g, float* xcopy, bf16* xn, float* fout, int gw, int ngw, int lane) {
    for (int m = gw; m < T; m += ngw) {
        const float* row = (m < TP) ? sa + (size_t)m * D : sb + (size_t)(m - TP) * D;
        f32x4 v[8]; float ss = 0.f;
#pragma unroll
        for (int j = 0; j < 8; ++j) { v[j] = ((const f32x4*)row)[lane + 64 * j]; ss += (v[j].x * v[j].x + v[j].y * v[j].y) + (v[j].z * v[j].z + v[j].w * v[j].w); }
        const float rinv = 1.0f / sqrtf(wave_sum(ss) * (1.0f / D) + RMS_EPS);
#pragma unroll
        for (int j = 0; j < 8; ++j) {
            if (xcopy) ((f32x4*)(xcopy + (size_t)m * D))[lane + 64 * j] = v[j];
            const f32x4 gj = ((const f32x4*)g)[lane + 64 * j];
            const f32x4 y = v[j] * rinv * gj;
            if (xn) { u32x2 o; o.x = pk2(y.x, y.y); o.y = pk2(y.z, y.w); ((u32x2*)(xn + (size_t)m * D))[lane + 64 * j] = o; }
            if (fout) ((f32x4*)(fout + (size_t)m * D))[lane + 64 * j] = y;
        }
    }
}

__device__ __forceinline__ void conv_item(KP kp, int l, int item, LAS float* lds, int tid) {
    const float* Z = (const float*)(kp->ws + WS_Z); bf16* MIX = (bf16*)(kp->ws + WS_MIX);
    const int t0 = item * 32;
    int s, tau0, Ls; bool prompt;
    if (t0 < TP) { s = t0 >> 11; tau0 = t0 & 2047; Ls = 2048; prompt = true; } else { s = (t0 - TP) >> 6; tau0 = (t0 - TP) & 63; Ls = 64; prompt = false; }
    const int c = tid;
    const float* cw = kp->in[8] + (size_t)l * 31 * 512;
    float w[31];
#pragma unroll
    for (int j = 0; j < 31; ++j) w[j] = cw[j * 512 + c];
    const float bias = kp->in[9][l * 512 + c];
    float acc[32];
#pragma unroll
    for (int i = 0; i < 32; ++i) acc[i] = bias;
    const bool first = (tau0 == 0), lastit = (tau0 + 32 == Ls);
    float* oc = prompt ? kp->out + O_CONV_P + (size_t)((l * 4 + s) * 30) * 512 : kp->out + O_CONV_S + (size_t)((l * 16 + s) * 30) * 512;
    const float* cc = kp->in[2] + (size_t)((l * 16 + s) * 30) * 512;
#pragma unroll
    for (int ii = 0; ii < 62; ++ii) {
        float u;
        if (ii < 30 && first) { u = prompt ? 0.f : cc[ii * 512 + c]; }
        else { const float* zr = Z + (size_t)(t0 + ii - 30) * NZ; const float val = zr[c], gate = zr[512 + c]; u = val * sigm(gate); }
        if (ii >= 32 && lastit) oc[(ii - 32) * 512 + c] = u;
#pragma unroll
        for (int oi = 0; oi < 32; ++oi) { const int j = ii - oi; if (j >= 0 && j <= 30) acc[oi] += w[j] * u; }
    }
#pragma unroll
    for (int oi = 0; oi < 32; ++oi) lds[oi * 512 + c] = acc[oi];
    __syncthreads();
    const int wave = tid >> 6, lane = tid & 63;
    const f32x4 g0 = *(const f32x4*)(kp->in[10] + l * 512 + lane * 8), g1 = *(const f32x4*)(kp->in[10] + l * 512 + lane * 8 + 4);
    const f32x4 b0 = *(const f32x4*)(kp->in[11] + l * 512 + lane * 8), b1 = *(const f32x4*)(kp->in[11] + l * 512 + lane * 8 + 4);
#pragma unroll
    for (int q = 0; q < 4; ++q) {
        const int oi = wave * 4 + q;
        f32x4 a = *(const LAS f32x4*)(lds + oi * 512 + lane * 8), b = *(const LAS f32x4*)(lds + oi * 512 + lane * 8 + 4);
        const float mean = wave_sum((a.x + a.y) + (a.z + a.w) + (b.x + b.y) + (b.z + b.w)) * (1.0f / 512.0f);
        a = a - mean; b = b - mean;
        const float var = wave_sum((a.x * a.x + a.y * a.y) + (a.z * a.z + a.w * a.w) + (b.x * b.x + b.y * b.y) + (b.z * b.z + b.w * b.w)) * (1.0f / 512.0f);
        const float rstd = 1.0f / sqrtf(var + LN_EPS);
        a = a * rstd * g0 + b0; b = b * rstd * g1 + b1;
        float o[8] = {a.x, a.y, a.z, a.w, b.x, b.y, b.z, b.w};
#pragma unroll
        for (int k = 0; k < 8; ++k) o[k] = o[k] * sigm(o[k]);
        u32x4 wv; wv.x = pk2(o[0], o[1]); wv.y = pk2(o[2], o[3]); wv.z = pk2(o[4], o[5]); wv.w = pk2(o[6], o[7]);
        *(u32x4*)(MIX + (size_t)(t0 + oi) * D + lane * 8) = wv;
    }
    __syncthreads();
}
__device__ __forceinline__ void pool_item(KP kp, int l, int item, LAS float* pp, int tid) {
    const float* Z = (const float*)(kp->ws + WS_Z); bf16* MIX = (bf16*)(kp->ws + WS_MIX);
    const int t0 = item * 32;
    int s, tau0, Ls; bool prompt;
    if (t0 < TP) { s = t0 >> 11; tau0 = t0 & 2047; Ls = 2048; prompt = true; } else { s = (t0 - TP) >> 6; tau0 = (t0 - TP) & 63; Ls = 64; prompt = false; }
    const int c = tid;
    const bool first = (tau0 == 0), lastit = (tau0 + 32 == Ls);
    float* op = prompt ? kp->out + O_POOL_P + (size_t)((l * 4 + s) * 15) * 512 : kp->out + O_POOL_S + (size_t)((l * 16 + s) * 15) * 512;
    const float* cp = kp->in[3] + (size_t)((l * 16 + s) * 15) * 512;
#pragma unroll 8
    for (int ii = 0; ii < 47; ++ii) {
        float val;
        if (ii < 15 && first) val = prompt ? 0.f : cp[ii * 512 + c];
        else val = Z[(size_t)(t0 + ii - 15) * NZ + 1024 + c];
        pp[ii * 512 + c] = val;
        if (ii >= 32 && lastit) op[(ii - 32) * 512 + c] = val;
    }
    const int gi = c >> 7, w = 2 << gi;
    for (int oi = 0; oi < 32; ++oi) {
        float sum = 0.f;
        for (int k = 0; k < w; ++k) sum += pp[(oi + 15 - k) * 512 + c];
        const int cnt = prompt ? min(w, tau0 + oi + 1) : w;
        const float d = sum / (float)cnt - pp[(oi + 15) * 512 + c];
        pp[oi * 512 + c] = d;
    }
    __syncthreads();
    const int n = tid, g = n >> 7, dp = n & 127;
    const float* pw = kp->in[12] + (size_t)((l * 4 + g) * 128) * 128 + dp;
    float acc[32];
#pragma unroll
    for (int i = 0; i < 32; ++i) acc[i] = 0.f;
    for (int c4 = 0; c4 < 32; ++c4) {
        const float w0 = pw[(4 * c4 + 0) * 128], w1 = pw[(4 * c4 + 1) * 128], w2 = pw[(4 * c4 + 2) * 128], w3 = pw[(4 * c4 + 3) * 128];
#pragma unroll
        for (int oi = 0; oi < 32; ++oi) { const f32x4 dv = *(const LAS f32x4*)(pp + oi * 512 + g * 128 + 4 * c4); acc[oi] += (dv.x * w0 + dv.y * w1) + (dv.z * w2 + dv.w * w3); }
    }
    const float scale = kp->in[13][l * 512 + n];
#pragma unroll
    for (int oi = 0; oi < 32; ++oi) MIX[(size_t)(t0 + oi) * D + 512 + n] = (bf16)f2bf(acc[oi] * scale);
    __syncthreads();
}
__device__ __forceinline__ void prep_item(KP kp, int l, int item, LAS float* lo, int tid) {
    const float* Z = (const float*)(kp->ws + WS_Z);
    float* SC = (float*)(kp->ws + WS_SC); float* G = (float*)(kp->ws + WS_G); float* RK = (float*)(kp->ws + WS_RK);
    const int t0 = item * 16;
    int s, tau0, Ls; bool prompt;
    if (t0 < TP) { s = t0 >> 11; tau0 = t0 & 2047; Ls = 2048; prompt = true; } else { s = (t0 - TP) >> 6; tau0 = (t0 - TP) & 63; Ls = 64; prompt = false; }
    const float* mu = kp->in[14] + (size_t)l * RP;
    const float* ssh = kp->in[4] + (size_t)(l * 16 + s) * RP;
    for (int e = tid; e < 16 * 192; e += NTHR) {
        const int tok = e / 192, col = e % 192, zc = 3072 + col, t = t0 + tok, tau = tau0 + tok;
        const float q = Z[(size_t)t * NZ + ZQ + zc];
        const float qp = tau > 0 ? Z[(size_t)(t - 1) * NZ + ZQ + zc] : (prompt ? 0.f : ssh[zc]);
        const float qs = q + (qp - q) * mu[zc];
        lo[tok * 192 + col] = col < 64 ? tanhf(qs) : (col < 128 ? qs : sigm(qs));
    }
    __syncthreads();
    const int lane = tid & 63;
#pragma unroll 1
    for (int cc = 0; cc < 2; ++cc) {
        const int c = tid + 512 * cc, h = c >> 6;
        float accw[16], acca[16], accg[16];
#pragma unroll
        for (int i = 0; i < 16; ++i) { accw[i] = 0.f; acca[i] = 0.f; accg[i] = 0.f; }
        const float* wu = kp->in[16] + (size_t)l * 64 * RD + c; const float* au = kp->in[18] + (size_t)l * 64 * RD + c; const float* gu = kp->in[19] + (size_t)l * 64 * RD + c;
#pragma unroll 2
        for (int j4 = 0; j4 < 16; ++j4) {
            const float w0 = wu[(4 * j4 + 0) * RD], w1 = wu[(4 * j4 + 1) * RD], w2 = wu[(4 * j4 + 2) * RD], w3 = wu[(4 * j4 + 3) * RD];
            const float a0 = au[(4 * j4 + 0) * RD], a1 = au[(4 * j4 + 1) * RD], a2 = au[(4 * j4 + 2) * RD], a3 = au[(4 * j4 + 3) * RD];
            const float g0 = gu[(4 * j4 + 0) * RD], g1 = gu[(4 * j4 + 1) * RD], g2 = gu[(4 * j4 + 2) * RD], g3 = gu[(4 * j4 + 3) * RD];
#pragma unroll
            for (int tok = 0; tok < 16; ++tok) {
                const f32x4 lw = *(const LAS f32x4*)(lo + tok * 192 + 4 * j4), la = *(const LAS f32x4*)(lo + tok * 192 + 64 + 4 * j4), lg = *(const LAS f32x4*)(lo + tok * 192 + 128 + 4 * j4);
                accw[tok] += (lw.x * w0 + lw.y * w1) + (lw.z * w2 + lw.w * w3);
                acca[tok] += (la.x * a0 + la.y * a1) + (la.z * a2 + la.w * a3);
                accg[tok] += (lg.x * g0 + lg.y * g1) + (lg.z * g2 + lg.w * g3);
            }
        }
        const float w0c = kp->in[15][l * RD + c], a0c = kp->in[17][l * RD + c], kkc = kp->in[20][l * RD + c], kac = kp->in[21][l * RD + c], rkc = kp->in[22][l * RD + c];
        const float mur = mu[c], muk = mu[RD + c], muv = mu[2 * RD + c];
        const float sr = prompt ? 0.f : ssh[c], sk = prompt ? 0.f : ssh[RD + c], sv = prompt ? 0.f : ssh[2 * RD + c];
#pragma unroll
        for (int tok = 0; tok < 16; ++tok) {
            const int t = t0 + tok, tau = tau0 + tok;
            const float* zr = Z + (size_t)t * NZ + ZQ;
            float r = zr[c], k = zr[RD + c], v = zr[2 * RD + c];
            float pr, pk, pv;
            if (tau > 0) { pr = zr[c - NZ]; pk = zr[RD + c - NZ]; pv = zr[2 * RD + c - NZ]; } else { pr = sr; pk = sk; pv = sv; }
            r += (pr - r) * mur; k += (pk - k) * muk; v += (pv - v) * muv;
            const float xw = -(w0c + accw[tok]);
            const float sp = fmaxf(xw, 0.f) + log1pf(expf(-fabsf(xw)));
            const float decay = expf(-expf(-sp - 0.5f));
            const float a = sigm(a0c + acca[tok]);
            const float kk = k * kkc;
            const float nrm = wave_sum(kk * kk);
            const float kkn = kk * (1.0f / sqrtf(fmaxf(nrm, 1e-24f)));
            const float kp = k * (1.0f + (a - 1.0f) * kac);
            const float b = kkn * a;
            const float rk = wave_sum(r * kp * rkc);
            float* sc = SC + ((size_t)t * NH + h) * SCR + lane;
            sc[0] = decay; sc[64] = kkn; sc[128] = b; sc[192] = kp; sc[256] = r; sc[320] = v;
            G[(size_t)t * RD + c] = accg[tok];
            if (lane == 0) RK[t * NH + h] = rk;
        }
    }
    if (tau0 + 16 == Ls) {
        float* osh = prompt ? kp->out + O_SHIFT_P + (size_t)(l * 4 + s) * RP : kp->out + O_SHIFT_S + (size_t)(l * 16 + s) * RP;
        const float* zr = Z + (size_t)(t0 + 15) * NZ + ZQ;
        for (int e = tid; e < RP; e += NTHR) osh[e] = zr[e];
    }
    __syncthreads();
}

template <int MODE>
__device__ __forceinline__ void scan_run(const float* SC, int tg0, int nsteps, int h, LAS float* wl, int lane,
                                         const float* Sinit, int init_layout  , float* Y, float* Sout, float* PQout) {
    constexpr int NV = (MODE == 0) ? 4 : (MODE == 2 ? 3 : 5), GS = 8;
    f32x2 S[32];
    if (MODE == 2) {
        const int ln = launder_v(lane);
#pragma unroll
        for (int j = 0; j < 32; ++j) S[j] = (f32x2){(2 * j == ln) ? 1.f : 0.f, (2 * j + 1 == ln) ? 1.f : 0.f};
    } else if (MODE == 1 && init_layout == 1) {
#pragma unroll
        for (int j = 0; j < 16; ++j) { const f32x4 v = ((const f32x4*)(Sinit + lane * 64))[j]; S[2 * j] = (f32x2){v.x, v.y}; S[2 * j + 1] = (f32x2){v.z, v.w}; }
    } else if (MODE == 1 && init_layout == 2) {
#pragma unroll
        for (int j = 0; j < 16; ++j) { const f32x4 v = ((const f32x4*)Sinit)[j * 64 + lane]; S[2 * j] = (f32x2){v.x, v.y}; S[2 * j + 1] = (f32x2){v.z, v.w}; }
    } else {
#pragma unroll
        for (int j = 0; j < 32; ++j) S[j] = (f32x2){0.f, 0.f};
    }
    float pf[GS][NV], pv[GS];
    {
#pragma unroll
        for (int s = 0; s < GS; ++s) { const float* rec = SC + ((size_t)(tg0 + s) * NH + h) * SCR + lane;
#pragma unroll
            for (int k = 0; k < NV; ++k) pf[s][k] = rec[k * 64];
            pv[s] = (MODE == 2) ? 0.f : rec[320]; }
    }
    for (int tc = 0; tc < nsteps; tc += GS) {
        float vv[GS];
#pragma unroll
        for (int s = 0; s < GS; ++s) {
#pragma unroll
            for (int k = 0; k < NV; ++k) wl[s * 320 + k * 64 + lane] = pf[s][k];
            vv[s] = pv[s];
        }
        if (tc + GS < nsteps) {
#pragma unroll
            for (int s = 0; s < GS; ++s) { const float* rec = SC + ((size_t)(tg0 + tc + GS + s) * NH + h) * SCR + lane;
#pragma unroll
                for (int k = 0; k < NV; ++k) pf[s][k] = rec[k * 64];
                pv[s] = (MODE == 2) ? 0.f : rec[320]; }
        }
        asm volatile("s_waitcnt lgkmcnt(0)" ::: "memory");
#pragma unroll
        for (int s = 0; s < GS; ++s) {
            const LAS f32x4* o = (const LAS f32x4*)(wl + s * 320);
            f32x2 d2 = (f32x2){0.f, 0.f};
#pragma unroll
            for (int j = 0; j < 16; ++j) { const f32x4 kk = o[16 + j]; d2 += S[2 * j] * (f32x2){kk.x, kk.y}; d2 += S[2 * j + 1] * (f32x2){kk.z, kk.w}; }
            const float sa = -(d2.x + d2.y);
            const f32x2 sa2 = (f32x2){sa, sa}, v2 = (f32x2){vv[s], vv[s]};
            f32x2 y2 = (f32x2){0.f, 0.f};
#pragma unroll
            for (int j = 0; j < 16; ++j) {
                const f32x4 w = o[j], b = o[32 + j];
                if (MODE == 2) {
                    S[2 * j] = S[2 * j] * (f32x2){w.x, w.y} + sa2 * (f32x2){b.x, b.y}; S[2 * j + 1] = S[2 * j + 1] * (f32x2){w.z, w.w} + sa2 * (f32x2){b.z, b.w};
                } else {
                    const f32x4 kp = o[48 + j];
                    f32x2 t0 = v2 * (f32x2){kp.x, kp.y}; t0 = sa2 * (f32x2){b.x, b.y} + t0; S[2 * j] = S[2 * j] * (f32x2){w.x, w.y} + t0;
                    f32x2 t1 = v2 * (f32x2){kp.z, kp.w}; t1 = sa2 * (f32x2){b.z, b.w} + t1; S[2 * j + 1] = S[2 * j + 1] * (f32x2){w.z, w.w} + t1;
                    if (MODE == 1) { const f32x4 r = o[64 + j]; y2 += S[2 * j] * (f32x2){r.x, r.y}; y2 += S[2 * j + 1] * (f32x2){r.z, r.w}; }
                }
            }
            if (MODE == 1) Y[(size_t)(tg0 + tc + s) * RD + h * 64 + lane] = y2.x + y2.y;
        }
        asm volatile("s_waitcnt lgkmcnt(0)" ::: "memory");
    }
    if (MODE != 1) {
#pragma unroll
        for (int j = 0; j < 16; ++j) ((f32x4*)PQout)[j * 64 + lane] = (f32x4){S[2 * j].x, S[2 * j].y, S[2 * j + 1].x, S[2 * j + 1].y};
    } else if (Sout) {
#pragma unroll
        for (int j = 0; j < 16; ++j) ((f32x4*)(Sout + lane * 64))[j] = (f32x4){S[2 * j].x, S[2 * j].y, S[2 * j + 1].x, S[2 * j + 1].y};
    }
}
__device__ __forceinline__ void combine_chain(const float* PQ, float* S0, LAS unsigned char* lds, int tid, int wave, int lane) {
    LAS f32x4* pl = (LAS f32x4*)lds;
    LAS f32x4* xch = (LAS f32x4*)(lds + 16384);
    f32x2 S[32];
#pragma unroll
    for (int j = 0; j < 32; ++j) S[j] = (f32x2){0.f, 0.f};
    const int n4a = 2 * wave, n4b = 2 * wave + 1;
    for (int c = 0; c < NC - 1; ++c) {
        const f32x4* Pc = (const f32x4*)(PQ + (size_t)(c * 2) * 4096); const f32x4* Qc = (const f32x4*)(PQ + (size_t)(c * 2 + 1) * 4096);
        pl[tid] = Pc[tid]; pl[tid + 512] = Pc[tid + 512];
        f32x4 na = Qc[n4a * 64 + lane], nb = Qc[n4b * 64 + lane];
        __syncthreads();
        f32x2 a0 = (f32x2){na.x, na.y}, a1 = (f32x2){na.z, na.w}, b0 = (f32x2){nb.x, nb.y}, b1 = (f32x2){nb.z, nb.w};
#pragma unroll
        for (int j = 0; j < 32; ++j) {
            const f32x4 pa0 = pl[n4a * 64 + 2 * j], pb0 = pl[n4b * 64 + 2 * j], pa1 = pl[n4a * 64 + 2 * j + 1], pb1 = pl[n4b * 64 + 2 * j + 1];
            const f32x2 s0 = (f32x2){S[j].x, S[j].x}, s1 = (f32x2){S[j].y, S[j].y};
            a0 += s0 * (f32x2){pa0.x, pa0.y}; a1 += s0 * (f32x2){pa0.z, pa0.w}; b0 += s0 * (f32x2){pb0.x, pb0.y}; b1 += s0 * (f32x2){pb0.z, pb0.w};
            a0 += s1 * (f32x2){pa1.x, pa1.y}; a1 += s1 * (f32x2){pa1.z, pa1.w}; b0 += s1 * (f32x2){pb1.x, pb1.y}; b1 += s1 * (f32x2){pb1.z, pb1.w};
        }
        na = (f32x4){a0.x, a0.y, a1.x, a1.y}; nb = (f32x4){b0.x, b0.y, b1.x, b1.y};
        xch[n4a * 64 + lane] = na; xch[n4b * 64 + lane] = nb;
        f32x4* So = (f32x4*)(S0 + (size_t)(c + 1) * 4096);
        So[n4a * 64 + lane] = na; So[n4b * 64 + lane] = nb;
        __syncthreads();
#pragma unroll
        for (int j = 0; j < 16; ++j) { const f32x4 v = xch[j * 64 + lane]; S[2 * j] = (f32x2){v.x, v.y}; S[2 * j + 1] = (f32x2){v.z, v.w}; }
        __syncthreads();
    }
}
__device__ __forceinline__ void post_rows(KP kp, int l, int gw, int ngw, int lane) {
    const float* SC = (const float*)(kp->ws + WS_SC); const float* Y = (const float*)(kp->ws + WS_Y); const float* G = (const float*)(kp->ws + WS_G); const float* RK = (const float*)(kp->ws + WS_RK);
    bf16* MIX = (bf16*)(kp->ws + WS_MIX);
    for (int it = gw; it < T * NH; it += ngw) {
        const int t = it >> 4, h = it & 15, c = h * 64 + lane;
        const float y = Y[(size_t)t * RD + c];
        const float mean = wave_sum(y) * (1.0f / 64.0f);
        const float d = y - mean;
        const float var = wave_sum(d * d) * (1.0f / 64.0f);
        const float yn = d * (1.0f / sqrtf(var + GN_EPS)) * kp->in[23][l * RD + c] + kp->in[24][l * RD + c];
        const float v = SC[((size_t)t * NH + h) * SCR + 320 + lane];
        const float o = (yn + RK[it] * v) * G[(size_t)t * RD + c];
        MIX[(size_t)t * D + 1024 + c] = (bf16)f2bf(o);
    }
}

__global__ void __launch_bounds__(NTHR, 2) fwd_mega(Params p) {
    extern __shared__ __attribute__((aligned(16))) unsigned char lds_raw[];
    LAS unsigned char* lds = (LAS unsigned char*)lds_raw;

#pragma unroll 1
    for (int l = 0; l < DEPTH; ++l) {
        { PH_BEGIN();
#ifndef NO_CVT
          convert_weights(kp, l, lds, gw, ngw, wave, lane);
#endif
#ifndef NO_NORM
          float* X = (float*)(ws + WS_X); bf16* XN = (bf16*)(ws + WS_XN);
          if (l == 0) norm_rows(kp->in[0], kp->in[1], kp->in[6], X, XN, nullptr, gw, ngw, lane);
          else norm_rows(X, X + (size_t)TP * D, kp->in[6] + l * D, nullptr, XN, nullptr, gw, ngw, lane);
#endif
        }
        GSYNC();
#ifndef NO_GEMM1
        { PH_BEGIN(); pg8::Gemm g{(const bf16*)(ws + WS_XN), (const bf16*)(ws + WS_WIN), T, NZ, D}; pg8::StaticOrder S; S.init(T, NZ, nb, bid); pg8::EpiStoreF32 E{(float*)(ws + WS_Z), NZ};
          pg8::gemm_phase<pg8::EpiStoreF32, pg8::StaticOrder, true, true>(lds, g, S, E, tid); }
#endif
        GSYNC();
        { PH_BEGIN();
          for (int it = bid; it < 1152; it += nb) {
#ifndef NO_PREP
            if (it < 576) prep_item(kp, l, it, (LAS float*)lds, tid);
#endif
#ifndef NO_POOL
            if (it >= 576 && it < 864) pool_item(kp, l, it - 576, (LAS float*)lds, tid);
#endif
#ifndef NO_CONV
            if (it >= 864) conv_item(kp, l, it - 864, (LAS float*)lds, tid);
#endif
          }
        }
        GSYNC();
#ifndef NO_SCAN
        { PH_BEGIN();
            const float* SC = (const float*)(ws + WS_SC); float* Y = (float*)(ws + WS_Y); float* PQ = (float*)(ws + WS_PQ);
            LAS float* wl = (LAS float*)(lds + wave * 10240);
            constexpr int NPT = 64 * (NC - 1);
            for (int task = wave * nb + bid; task < 2 * NPT + 256; task += NWAVES * nb) {
                if (task < 2 * NPT) {
                    const int isP = task >= NPT, tk = isP ? task - NPT : task;
                    const int ch = tk / (NC - 1), c = tk % (NC - 1), s = ch >> 4, h = ch & 15;
                    float* pq = PQ + (size_t)((ch * (NC - 1) + c) * 2) * 4096;
                    if (isP) scan_run<2>(SC, s * 2048 + c * CL, CL, h, wl, lane, nullptr, 0, nullptr, nullptr, pq);
                    else scan_run<0>(SC, s * 2048 + c * CL, CL, h, wl, lane, nullptr, 0, nullptr, nullptr, pq + 4096);
                } else {
                    const int ch = task - 2 * NPT, b = ch >> 4, h = ch & 15;
                    scan_run<1>(SC, TP + b * 64, 64, h, wl, lane, kp->in[5] + (size_t)((l * 16 + b) * NH + h) * 4096, 1, Y, kp->out + O_WKV_S + (size_t)((l * 16 + b) * NH + h) * 4096, nullptr);
                }
            }
        }
        GSYNC();
        { PH_BEGIN();
#ifndef NO_COMB
            for (int ch = bid; ch < 64; ch += nb) combine_chain((const float*)(ws + WS_PQ) + (size_t)ch * (NC - 1) * 2 * 4096, (float*)(ws + WS_S0) + (size_t)ch * NC * 4096, lds, tid, wave, lane);
#endif
        }
        GSYNC();
        { PH_BEGIN();
            const float* SC = (const float*)(ws + WS_SC); float* Y = (float*)(ws + WS_Y); const float* S0 = (const float*)(ws + WS_S0);
            LAS float* wl = (LAS float*)(lds + wave * 10240);
            for (int task = wave * nb + bid; task < 64 * NC; task += NWAVES * nb) {
                const int ch = task / NC, c = task % NC, s = ch >> 4, h = ch & 15;
                scan_run<1>(SC, s * 2048 + c * CL, CL, h, wl, lane, S0 + (size_t)(ch * NC + c) * 4096, c == 0 ? 0 : 2, Y,
                            c == NC - 1 ? kp->out + O_WKV_P + (size_t)((l * 4 + s) * NH + h) * 4096 : nullptr, nullptr);
            }
        }
#endif
        GSYNC();
#ifndef NO_POST
        { PH_BEGIN(); post_rows(kp, l, gw, ngw, lane); }
#endif
        GSYNC();
#ifndef NO_GEMM2
        { PH_BEGIN(); pg8::Gemm g{(const bf16*)(ws + WS_MIX), (const bf16*)(ws + WS_WOUT), T, D, D}; pg8::StaticOrder S; S.init(T, D, nb, bid); pg8::EpiResAdd E{(float*)(ws + WS_X), D};
          pg8::gemm_phase<pg8::EpiResAdd, pg8::StaticOrder, true, true>(lds, g, S, E, tid); }
#endif
        GSYNC();
#ifndef NO_NORM
        { PH_BEGIN(); float* X = (float*)(ws + WS_X); norm_rows(X, X + (size_t)TP * D, kp->in[26] + l * D, nullptr, (bf16*)(ws + WS_XN), nullptr, gw, ngw, lane); }
#endif
        GSYNC();
#ifndef NO_GEMM3
        { PH_BEGIN(); pg8::Gemm g{(const bf16*)(ws + WS_XN), (const bf16*)(ws + WS_WGU), T, NGU, D}; pg8::StaticOrder S; S.init(T, NGU, nb, bid); pg8::EpiSwiGLU E{(bf16*)(ws + WS_ACT), FF};
          pg8::gemm_phase<pg8::EpiSwiGLU, pg8::StaticOrder, true, true>(lds, g, S, E, tid); }
#endif
        GSYNC();
#ifndef NO_GEMM4
        { PH_BEGIN(); pg8::Gemm g{(const bf16*)(ws + WS_ACT), (const bf16*)(ws + WS_WDN), T, D, FF}; pg8::StaticOrder S; S.init(T, D, nb, bid); pg8::EpiResAdd E{(float*)(ws + WS_X), D};
          pg8::gemm_phase<pg8::EpiResAdd, pg8::StaticOrder, true, true>(lds, g, S, E, tid); }
#endif
        GSYNC();
    }
#ifndef NO_NORM
    { PH_BEGIN(); float* X = (float*)(ws + WS_X); norm_rows(X, X + (size_t)TP * D, kp->in[30], nullptr, nullptr, kp->out + O_Y, gw, ngw, lane); }
#endif
}

extern "C" void kernel_launch(void* const* d_in, const int* in_sizes, int n_in, void* d_out, int out_size, void* d_ws, size_t ws_size, hipStream_t stream) {
    static int grid = 0;
    if (grid == 0) {
        if (n_in != 31 || (size_t)out_size != O_END || ws_size < WS_END) { fprintf(stderr, "kernel_launch: unexpected shapes: n_in %d out %d ws %zu (need %zu)\n", n_in, out_size, ws_size, (size_t)WS_END); grid = -1; return; }
        int dev = 0, cus = 0, per_cu = 0;
        hipGetDevice(&dev);
        hipDeviceGetAttribute(&cus, hipDeviceAttributeMultiprocessorCount, dev);
        if (hipFuncSetAttribute((const void*)fwd_mega, hipFuncAttributeMaxDynamicSharedMemorySize, LDS_BYTES) != hipSuccess) { fprintf(stderr, "kernel_launch: hipFuncSetAttribute failed\n"); grid = -1; return; }
        hipOccupancyMaxActiveBlocksPerMultiprocessor(&per_cu, (const void*)fwd_mega, NTHR, LDS_BYTES);
        (void)hipGetLastError();
        if (per_cu < 1) { fprintf(stderr, "kernel_launch: occupancy query says %d blocks per CU\n", per_cu); per_cu = 1; }
        grid = cus * 1;
    }
    if (grid < 0) return;
    Params p{};
    for (int i = 0; i < 31; ++i) p.in[i] = (const float*)d_in[i];
    p.out = (float*)d_out; p.ws = (unsigned char*)d_ws;
    void* args[] = {&p};
    hipError_t e = hipLaunchCooperativeKernel((const void*)fwd_mega, dim3(grid), dim3(NTHR), args, LDS_BYTES, stream);
    if (e != hipSuccess) fprintf(stderr, "cooperative launch failed: %s (grid %d)\n", hipGetErrorString(e), grid);
}
```

```cpp
#include <hip/hip_runtime.h>
#include <hip/hip_cooperative_groups.h>
#include <cstdio>
#include <cstdint>
namespace cg = cooperative_groups;

namespace pg8 {
#define PG8_LAS __attribute__((address_space(3)))
typedef unsigned short bf16_t;
typedef short bf16x8 __attribute__((ext_vector_type(8)));
typedef float f32x4 __attribute__((ext_vector_type(4)));
typedef unsigned u32x4 __attribute__((ext_vector_type(4)));
constexpr int BM = 256, BK = 64, HALF = 128, HTB = HALF * BK * 2  , STAGE_BYTES = 8 * HTB, NXCD = 8, WGM = 8;

__host__ __device__ __forceinline__ int lds_byte(int r, int c) { const int st = (r >> 4) * 2 + (c >> 5), rr = r & 15, cc = c & 31, ob = rr * 64 + cc * 2; return st * 1024 + (ob ^ (((ob >> 9) & 1) << 5)); }
__host__ __device__ __forceinline__ void stage_rc(int b, int& R, int& C) { const int st = b / 1024, sb = b % 1024, swz = sb ^ (((sb >> 9) & 1) << 5); R = (st >> 1) * 16 + swz / 64; C = (st & 1) * 32 + (swz % 64) / 2; }
__host__ __device__ __forceinline__ int perm32(int rho) { const int n = rho >> 4, i = rho & 15; return 8 * (i >> 2) + 4 * n + (i & 3); }

struct Unit { int pm, pn; };
struct Gemm { const bf16_t* A; const bf16_t* Bt; int M, N, K; };

struct StaticOrder {
    int nM, nN, nwg, G, c;
    __host__ __device__ void init(int M, int N, int G_, int c_) { nM = M / BM; nN = N / BM; nwg = nM * nN; G = G_; c = c_; }
    __host__ __device__ bool next(int i, Unit& u) const {
        const long L = (long)i * G + c; if (L >= nwg) return false;
        int wgid = (int)L; { const int q = nwg / NXCD, r = nwg % NXCD, xcd = wgid % NXCD, off = wgid / NXCD; wgid = (xcd < r ? xcd * (q + 1) : r * (q + 1) + (xcd - r) * q) + off; }
        const int nig = WGM * nN, gid = wgid / nig, fm = gid * WGM, gsz = (nM - fm) < WGM ? (nM - fm) : WGM;
        u.pm = fm + ((wgid % nig) % gsz); u.pn = (wgid % nig) / gsz; return true;
    }
    __device__ __forceinline__ void a_ready(const Unit&) const {}
    __device__ __forceinline__ void done(const Unit&) const {}
};

__device__ __forceinline__ unsigned cvt_pk_bf16(float lo, float hi) { unsigned r; asm volatile("v_cvt_pk_bf16_f32 %0, %1, %2" : "=v"(r) : "v"(lo), "v"(hi)); return r; }

struct EpiStoreF32 {
    static constexpr bool PERM = true, AFTER_DRAIN = false;
    float* O; int ldc;
    __device__ __forceinline__ void operator()(const f32x4 (&acc)[2][2][4][2], const Unit& u, int wr, int wc, int fr, int fq) const {
        const int row0 = u.pm * BM + wr * 64 + fr, col0 = u.pn * BM + wc * 32 + 8 * fq;
#pragma unroll
        for (int ai = 0; ai < 2; ++ai)
#pragma unroll
            for (int m = 0; m < 4; ++m) { float* rowp = O + (size_t)(row0 + ai * HALF + m * 16) * ldc + col0;
#pragma unroll
                for (int bj = 0; bj < 2; ++bj) { *(f32x4*)(rowp + bj * HALF) = acc[ai][bj][m][0]; *(f32x4*)(rowp + bj * HALF + 4) = acc[ai][bj][m][1]; } }
    }
};
struct EpiResAdd {
    static constexpr bool PERM = true, AFTER_DRAIN = false;
    float* O; int ldc;
    __device__ __forceinline__ void operator()(const f32x4 (&acc)[2][2][4][2], const Unit& u, int wr, int wc, int fr, int fq) const {
        const int row0 = u.pm * BM + wr * 64 + fr, col0 = u.pn * BM + wc * 32 + 8 * fq;
#pragma unroll
        for (int ai = 0; ai < 2; ++ai)
#pragma unroll
            for (int m = 0; m < 4; ++m) { float* rowp = O + (size_t)(row0 + ai * HALF + m * 16) * ldc + col0;
#pragma unroll
                for (int bj = 0; bj < 2; ++bj) {
                    f32x4 a = *(const f32x4*)(rowp + bj * HALF), b = *(const f32x4*)(rowp + bj * HALF + 4);
                    *(f32x4*)(rowp + bj * HALF) = a + acc[ai][bj][m][0]; *(f32x4*)(rowp + bj * HALF + 4) = b + acc[ai][bj][m][1]; } }
    }
};
struct EpiSwiGLU {
    static constexpr bool PERM = true, AFTER_DRAIN = false;
    bf16_t* O; int ldc;
    __device__ __forceinline__ void operator()(const f32x4 (&acc)[2][2][4][2], const Unit& u, int wr, int wc, int fr, int fq) const {
        const int row0 = u.pm * BM + wr * 64 + fr, col0 = u.pn * HALF + wc * 32 + 8 * fq;
#pragma unroll
        for (int ai = 0; ai < 2; ++ai)
#pragma unroll
            for (int m = 0; m < 4; ++m) { bf16_t* rowp = O + (size_t)(row0 + ai * HALF + m * 16) * ldc + col0;
                float o[8];
#pragma unroll
                for (int n = 0; n < 2; ++n)
#pragma unroll
                    for (int j = 0; j < 4; ++j) { const float g = acc[ai][0][m][n][j], up = acc[ai][1][m][n][j]; o[n * 4 + j] = g * up * __builtin_amdgcn_rcpf(1.0f + __expf(-g)); }
                u32x4 w; w.x = cvt_pk_bf16(o[0], o[1]); w.y = cvt_pk_bf16(o[2], o[3]); w.z = cvt_pk_bf16(o[4], o[5]); w.w = cvt_pk_bf16(o[6], o[7]);
                *(u32x4*)rowp = w; }
    }
};

template <class Epi, class Sched, bool ALIGN_EPI = false, bool SP2 = false>
__device__ __forceinline__ void gemm_phase(PG8_LAS unsigned char* lds, const Gemm g, const Sched& S, const Epi& E, const int tid) {
    const int wid = __builtin_amdgcn_readfirstlane(tid >> 6), lane = tid & 63, wr = wid >> 2, wc = wid & 3, fr = lane & 15, fq = lane >> 4;
    const int K = g.K, nt = K / BK;
    unsigned voffA[2], voffB[2];
#pragma unroll
    for (int i = 0; i < 2; ++i) { int R, C; stage_rc(tid * 16 + i * 8192, R, C); const int Rb = Epi::PERM ? ((R & ~31) + perm32(R & 31)) : R;
        voffA[i] = (unsigned)(R * K + C) * 2u; voffB[i] = (unsigned)(Rb * K + C) * 2u; }
    const size_t kstep = (size_t)(BK * 2);
    const size_t hstep = (size_t)HALF * K * 2;
    const size_t tstep = 2 * hstep;
    const unsigned ldsw = (unsigned)wid * 1024u;
    const int aoff = lds_byte(wr * 64 + fr, fq * 8), boff = lds_byte(wc * 32 + fr, fq * 8);
#define PG8_SA(b, h) (((b) * 2 + (h)) * HTB)
#define PG8_SB(b, h) ((4 + (b) * 2 + (h)) * HTB)
#define PG8_STAGE(bufoff, gbase, voff) do { _Pragma("unroll") for (int _i = 0; _i < 2; ++_i) \
        __builtin_amdgcn_global_load_lds((const unsigned*)((const char*)(gbase) + (voff)[_i]), (PG8_LAS unsigned*)(lds + (bufoff) + ldsw + _i * 8192), 16, 0, 0); } while (0)
#define PG8_LDA(dst, b, h) do { _Pragma("unroll") for (int m = 0; m < 4; ++m) _Pragma("unroll") for (int k = 0; k < 2; ++k) dst[m][k] = *(const PG8_LAS bf16x8*)(lds + PG8_SA(b, h) + aoff + m * 2048 + k * 1024); } while (0)
#define PG8_LDB(dst, b, h) do { _Pragma("unroll") for (int n = 0; n < 2; ++n) _Pragma("unroll") for (int k = 0; k < 2; ++k) dst[n][k] = *(const PG8_LAS bf16x8*)(lds + PG8_SB(b, h) + boff + n * 2048 + k * 1024); } while (0)
#define PG8_MMA(ai, bj, At, Bt) do { __builtin_amdgcn_s_setprio(1); _Pragma("unroll") for (int m = 0; m < 4; ++m) _Pragma("unroll") for (int n = 0; n < 2; ++n) _Pragma("unroll") for (int k = 0; k < 2; ++k) \
        acc[ai][bj][m][n] = __builtin_amdgcn_mfma_f32_16x16x32_bf16(Bt[n][k], At[m][k], acc[ai][bj][m][n], 0, 0, 0); __builtin_amdgcn_s_setprio(0); } while (0)
#define PG8_WAIT_V(n) asm volatile("s_waitcnt vmcnt(" #n ")" ::: "memory")
#define PG8_WAIT_L(n) asm volatile("s_waitcnt lgkmcnt(" #n ")" ::: "memory")
#define PG8_BAR __builtin_amdgcn_s_barrier()
#define PG8_SCHED __builtin_amdgcn_sched_barrier(0)
    Unit cur, nxt; int ui = 0;
    if (!S.next(0, cur)) return;
    f32x4 acc[2][2][4][2];
#pragma unroll
    for (int a = 0; a < 2; ++a)
#pragma unroll
        for (int b = 0; b < 2; ++b)
#pragma unroll
            for (int m = 0; m < 4; ++m)
#pragma unroll
                for (int n = 0; n < 2; ++n) acc[a][b][m][n] = (f32x4){0.f, 0.f, 0.f, 0.f};
    bf16x8 At[4][2], B0[2][2], B1[2][2];
    const char* cA = (const char*)g.A + (size_t)cur.pm * tstep; const char* cB = (const char*)g.Bt + (size_t)cur.pn * tstep;
    S.a_ready(cur);
    if constexpr (SP2) {
        PG8_STAGE(PG8_SB(0, 0), cB, voffB); PG8_STAGE(PG8_SB(0, 1), cB + hstep, voffB); PG8_STAGE(PG8_SA(0, 0), cA, voffA); PG8_STAGE(PG8_SA(0, 1), cA + hstep, voffA);
        if (wr == 1) PG8_BAR;
        PG8_WAIT_V(2); PG8_BAR;
        PG8_STAGE(PG8_SB(1, 0), cB + kstep, voffB); PG8_STAGE(PG8_SA(1, 0), cA + kstep, voffA); PG8_STAGE(PG8_SB(1, 1), cB + hstep + kstep, voffB);
        PG8_WAIT_V(6); PG8_BAR;
    } else {
        PG8_STAGE(PG8_SB(0, 0), cB, voffB); PG8_STAGE(PG8_SA(0, 0), cA, voffA); PG8_STAGE(PG8_SB(0, 1), cB + hstep, voffB); PG8_STAGE(PG8_SA(0, 1), cA + hstep, voffA);
        if (wr == 1) PG8_BAR;
        PG8_WAIT_V(4); PG8_BAR;
        PG8_STAGE(PG8_SB(1, 0), cB + kstep, voffB); PG8_STAGE(PG8_SA(1, 0), cA + kstep, voffA); PG8_STAGE(PG8_SB(1, 1), cB + hstep + kstep, voffB);
        PG8_WAIT_V(6); PG8_BAR;
    }
    for (;;) {
        const bool has_next = S.next(ui + 1, nxt);
        const char* nA = has_next ? (const char*)g.A + (size_t)nxt.pm * tstep : cA; const char* nB = has_next ? (const char*)g.Bt + (size_t)nxt.pn * tstep : cB;
        for (int t = 0; t < nt; t += 2) {
            const bool last = (t == nt - 2);
            const char* a1 = cA + (size_t)(t + 1) * kstep;
            const char* a2 = last ? nA : cA + (size_t)(t + 2) * kstep; const char* b2 = last ? nB : cB + (size_t)(t + 2) * kstep;
            const char* a3 = a2 + kstep; const char* b3 = b2 + kstep;
            if (last && has_next) S.a_ready(nxt);
            if constexpr (SP2) {
            PG8_LDB(B0, 0, 0); PG8_LDB(B1, 0, 1); PG8_SCHED; PG8_LDA(At, 0, 0); PG8_STAGE(PG8_SA(1, 1), a1 + hstep, voffA);
            PG8_WAIT_V(8); PG8_WAIT_L(0); PG8_BAR; PG8_MMA(0, 0, At, B0); PG8_MMA(0, 1, At, B1); PG8_BAR; PG8_SCHED;
            PG8_LDA(At, 0, 1); PG8_STAGE(PG8_SB(0, 0), b2, voffB); PG8_STAGE(PG8_SB(0, 1), b2 + hstep, voffB); PG8_STAGE(PG8_SA(0, 0), a2, voffA);
            PG8_WAIT_V(8); PG8_WAIT_L(0); PG8_BAR; PG8_MMA(1, 0, At, B0); PG8_MMA(1, 1, At, B1); PG8_BAR; PG8_SCHED;
            PG8_LDB(B0, 1, 0); PG8_LDB(B1, 1, 1); PG8_SCHED; PG8_LDA(At, 1, 0); PG8_STAGE(PG8_SA(0, 1), a2 + hstep, voffA);
            PG8_WAIT_V(8); PG8_WAIT_L(0); PG8_BAR; PG8_MMA(0, 0, At, B0); PG8_MMA(0, 1, At, B1); PG8_BAR; PG8_SCHED;
            PG8_LDA(At, 1, 1); PG8_STAGE(PG8_SB(1, 0), b3, voffB); PG8_STAGE(PG8_SB(1, 1), b3 + hstep, voffB); PG8_STAGE(PG8_SA(1, 0), a3, voffA);
            PG8_WAIT_V(8); PG8_WAIT_L(0); PG8_BAR; PG8_MMA(1, 0, At, B0); PG8_MMA(1, 1, At, B1); PG8_BAR; PG8_SCHED;
            } else {
            PG8_LDB(B0, 0, 0); PG8_SCHED; PG8_LDA(At, 0, 0); PG8_STAGE(PG8_SA(1, 1), a1 + hstep, voffA);
            PG8_WAIT_L(8); PG8_BAR; PG8_WAIT_L(0); PG8_MMA(0, 0, At, B0); PG8_BAR; PG8_SCHED;
            PG8_LDB(B1, 0, 1); PG8_STAGE(PG8_SB(0, 0), b2, voffB);
            PG8_BAR; PG8_WAIT_L(0); PG8_MMA(0, 1, At, B1); PG8_BAR;
            PG8_LDA(At, 0, 1); PG8_STAGE(PG8_SA(0, 0), a2, voffA);
            PG8_BAR; PG8_WAIT_L(0); PG8_MMA(1, 0, At, B0); PG8_BAR; PG8_SCHED;
            PG8_STAGE(PG8_SB(0, 1), b2 + hstep, voffB);
            PG8_WAIT_V(6); PG8_BAR; PG8_MMA(1, 1, At, B1); PG8_BAR;
            PG8_LDB(B0, 1, 0); PG8_SCHED; PG8_LDA(At, 1, 0); PG8_STAGE(PG8_SA(0, 1), a2 + hstep, voffA);
            PG8_WAIT_L(8); PG8_BAR; PG8_WAIT_L(0); PG8_MMA(0, 0, At, B0); PG8_BAR; PG8_SCHED;
            PG8_LDB(B1, 1, 1); PG8_STAGE(PG8_SB(1, 0), b3, voffB);
            PG8_BAR; PG8_WAIT_L(0); PG8_MMA(0, 1, At, B1); PG8_BAR;
            PG8_LDA(At, 1, 1); PG8_STAGE(PG8_SA(1, 0), a3, voffA);
            PG8_BAR; PG8_WAIT_L(0); PG8_MMA(1, 0, At, B0); PG8_BAR; PG8_SCHED;
            PG8_STAGE(PG8_SB(1, 1), b3 + hstep, voffB);
            PG8_WAIT_V(6); PG8_BAR; PG8_MMA(1, 1, At, B1); PG8_BAR;
            }
        }
        if constexpr (ALIGN_EPI) { if (wr == 0) PG8_BAR; }
        if constexpr (!Epi::AFTER_DRAIN) { E(acc, cur, wr, wc, fr, fq); S.done(cur); }
        if (!has_next) break;
#pragma unroll
        for (int a = 0; a < 2; ++a)
#pragma unroll
            for (int b = 0; b < 2; ++b)
#pragma unroll
                for (int m = 0; m < 4; ++m)
#pragma unroll
                    for (int n = 0; n < 2; ++n) acc[a][b][m][n] = (f32x4){0.f, 0.f, 0.f, 0.f};
        cur = nxt; cA = nA; cB = nB; ++ui;
        if constexpr (ALIGN_EPI) { if (wr == 1) PG8_BAR; }
    }
    PG8_WAIT_V(0);
    if constexpr (!ALIGN_EPI) { if (wr == 0) PG8_BAR; }
    PG8_BAR;
    if constexpr (Epi::AFTER_DRAIN) { E.fused(acc, cur, wr, wc, fr, fq, lds, wid, lane); S.done(cur); }
#undef PG8_SA
#undef PG8_SB
#undef PG8_STAGE
#undef PG8_LDA
#undef PG8_LDB
#undef PG8_MMA
#undef PG8_WAIT_V
#undef PG8_WAIT_L
#undef PG8_BAR
#undef PG8_SCHED
}
}

#define LAS __attribute__((address_space(3)))
typedef unsigned short bf16;
typedef float f32x4 __attribute__((ext_vector_type(4)));
typedef float f32x2 __attribute__((ext_vector_type(2)));
typedef unsigned u32x4 __attribute__((ext_vector_type(4)));
typedef unsigned u32x2 __attribute__((ext_vector_type(2)));

constexpr int NWAVES = 8, NTHR = 512;
constexpr int TP = 8192, TS = 1024, T = 9216, D = 2048, NIN = 4800, NZ = 4864, FF = 5632, NGU = 11264;
constexpr int NH = 16, HS = 64, RD = 1024, RP = 3264, DEPTH = 4;
constexpr int ZQ = 1536;
constexpr float RMS_EPS = 1e-6f, LN_EPS = 1e-5f, GN_EPS = 64e-5f;
constexpr int SCR = 384;
constexpr size_t O_Y = 0;
constexpr size_t O_CONV_P = (size_t)T * D;
constexpr size_t O_POOL_P = O_CONV_P + (size_t)DEPTH * 4 * 30 * 512;
constexpr size_t O_SHIFT_P = O_POOL_P + (size_t)DEPTH * 4 * 15 * 512;
constexpr size_t O_WKV_P = O_SHIFT_P + (size_t)DEPTH * 4 * RP;
constexpr size_t O_CONV_S = O_WKV_P + (size_t)DEPTH * 4 * NH * 4096;
constexpr size_t O_POOL_S = O_CONV_S + (size_t)DEPTH * 16 * 30 * 512;
constexpr size_t O_SHIFT_S = O_POOL_S + (size_t)DEPTH * 16 * 15 * 512;
constexpr size_t O_WKV_S = O_SHIFT_S + (size_t)DEPTH * 16 * RP;
constexpr size_t O_END = O_WKV_S + (size_t)DEPTH * 16 * NH * 4096;
constexpr size_t WS_WIN = 1u << 20;
constexpr size_t WS_WOUT = WS_WIN + (size_t)NZ * D * 2;
constexpr size_t WS_WGU = WS_WOUT + (size_t)D * D * 2;
constexpr size_t WS_WDN = WS_WGU + (size_t)NGU * D * 2;
constexpr size_t WS_X = WS_WDN + (size_t)D * FF * 2;
constexpr size_t WS_XN = WS_X + (size_t)T * D * 4;
constexpr size_t WS_MIX = WS_XN + (size_t)T * D * 2;
constexpr size_t WS_Z = WS_MIX + (size_t)T * D * 2;
constexpr size_t WS_ACT = WS_Z;
constexpr size_t WS_SC = WS_Z + (size_t)T * NZ * 4;
constexpr size_t WS_Y = WS_SC + (size_t)T * NH * SCR * 4;
constexpr size_t WS_G = WS_Y + (size_t)T * RD * 4;
constexpr size_t WS_RK = WS_G + (size_t)T * RD * 4;
constexpr int NC = 16, CL = 128;
constexpr size_t WS_PQ = WS_RK + (size_t)T * NH * 4;
constexpr size_t WS_S0 = WS_PQ + (size_t)64 * (NC - 1) * 2 * 4096 * 4;
constexpr size_t WS_END = WS_S0 + (size_t)64 * NC * 4096 * 4;
static_assert((size_t)T * FF * 2 <= (size_t)T * NZ * 4, "act overlay fits in z");
constexpr int LDS_BYTES = 147456;

#ifndef REP_MIXA
#define REP_MIXA 1
#endif
#ifndef REP_SCAN
#define REP_SCAN 1
#endif
#ifndef REP_POST
#define REP_POST 1
#endif
#ifndef REP_CVT
#define REP_CVT 1
#endif
#ifdef NO_SYNC
#define GSYNC() __syncthreads()
#else
#define GSYNC() cg::this_grid().sync()
#endif
struct Params { const float* in[31]; float* out; unsigned char* ws; };
typedef const __attribute__((address_space(4))) Params* KP;
__device__ __forceinline__ KP kargs() { KP k = (KP)__builtin_amdgcn_kernarg_segment_ptr(); asm volatile("" : "+s"(k)); return k; }
__device__ __forceinline__ int launder_v(int v) { asm volatile("" : "+v"(v)); return v; }
#define PH_BEGIN() KP kp = kargs(); const int tid = launder_v((int)threadIdx.x); const int lane = tid & 63; const int wave = __builtin_amdgcn_readfirstlane(tid >> 6); \
    const int nb = gridDim.x, bid = blockIdx.x, gw = bid * NWAVES + wave, ngw = nb * NWAVES; unsigned char* const ws = kp->ws; (void)lane; (void)wave; (void)gw; (void)ngw; (void)ws; (void)nb; (void)bid

__device__ __forceinline__ float wave_sum(float v) {
#pragma unroll
    for (int o = 1; o < 64; o <<= 1) v += __shfl_xor(v, o);
    return v;
}
__device__ __forceinline__ unsigned f2bf(float f) { unsigned u = __builtin_bit_cast(unsigned, f); return (u + 0x7fffu + ((u >> 16) & 1u)) >> 16; }
__device__ __forceinline__ unsigned pk2(float lo, float hi) { return f2bf(lo) | (f2bf(hi) << 16); }
__device__ __forceinline__ float sigm(float x) { return 1.0f / (1.0f + __expf(-x)); }

__device__ __forceinline__ void transpose_item(const float* W, int K, int N, bf16* WT, int mode, LAS float* scr, int item, int lane) {
    const int nblk = N / 32, kb = item / nblk, nb = item % nblk, k0 = 64 * kb, n0 = 32 * nb;
    const int drow0 = (mode == 0) ? n0 : ((n0 >> 7) * 256 + (n0 & 127) + (mode == 2 ? 128 : 0));
#pragma unroll 8
    for (int i = 0; i < 32; ++i) { const int kk = 2 * i + (lane >> 5); scr[kk * 33 + (lane & 31)] = W[(size_t)(k0 + kk) * N + n0 + (lane & 31)]; }
    asm volatile("s_waitcnt lgkmcnt(0)" ::: "memory");
    const int c = lane & 7;
#pragma unroll
    for (int j = 0; j < 4; ++j) { const int n = (lane >> 3) + 8 * j; const LAS float* s = scr + (8 * c) * 33 + n;
        u32x4 o; o.x = pk2(s[0 * 33], s[1 * 33]); o.y = pk2(s[2 * 33], s[3 * 33]); o.z = pk2(s[4 * 33], s[5 * 33]); o.w = pk2(s[6 * 33], s[7 * 33]);
        *(u32x4*)(WT + (size_t)(drow0 + n) * K + k0 + 8 * c) = o; }
    asm volatile("s_waitcnt lgkmcnt(0)" ::: "memory");
}
__device__ __forceinline__ void convert_weights(KP kp, int l, LAS unsigned char* lds, int gw, int ngw, int wave, int lane) {
    LAS float* scr = (LAS float*)(lds + wave * 16384);
    unsigned char* ws = kp->ws;
    bf16* WIN = (bf16*)(ws + WS_WIN); bf16* WOUT = (bf16*)(ws + WS_WOUT); bf16* WGU = (bf16*)(ws + WS_WGU); bf16* WDN = (bf16*)(ws + WS_WDN);
    constexpr int I_IN = (D / 64) * (NIN / 32), I_OUT = (D / 64) * (D / 32), I_G = (D / 64) * (FF / 32), I_D = (FF / 64) * (D / 32);
    constexpr int NITEMS = I_IN + I_OUT + 2 * I_G + I_D;
    for (int it = gw; it < NITEMS; it += ngw) {
        int r = it;
        if (r < I_IN) { transpose_item(kp->in[7] + (size_t)l * D * NIN, D, NIN, WIN, 0, scr, r, lane); continue; } r -= I_IN;
        if (r < I_OUT) { transpose_item(kp->in[25] + (size_t)l * D * D, D, D, WOUT, 0, scr, r, lane); continue; } r -= I_OUT;
        if (r < I_G) { transpose_item(kp->in[27] + (size_t)l * D * FF, D, FF, WGU, 1, scr, r, lane); continue; } r -= I_G;
        if (r < I_G) { transpose_item(kp->in[28] + (size_t)l * D * FF, D, FF, WGU, 2, scr, r, lane); continue; } r -= I_G;
        transpose_item(kp->in[29] + (size_t)l * FF * D, FF, D, WDN, 0, scr, r, lane);
    }
    for (int e = gw * 64 + lane; e < 16384; e += ngw * 64) ((u32x4*)(WIN + (size_t)NIN * D))[e] = (u32x4){0u, 0u, 0u, 0u};
}
__device__ __forceinline__ void norm_rows(const float* sa, const float* sb, const float* g, float* xcopy, bf16* xn, float* fout, int gw, int ngw, int lane) {
    for (int m = gw; m < T; m += ngw) {
        const float* row = (m < TP) ? sa + (size_t)m * D : sb + (size_t)(m - TP) * D;
        f32x4 v[8]; float ss = 0.f;
#pragma unroll
        for (int j = 0; j < 8; ++j) { v[j] = ((const f32x4*)row)[lane + 64 * j]; ss += (v[j].x * v[j].x + v[j].y * v[j].y) + (v[j].z * v[j].z + v[j].w * v[j].w); }
        const float rinv = 1.0f / sqrtf(wave_sum(ss) * (1.0f / D) + RMS_EPS);
#pragma unroll
        for (int j = 0; j < 8; ++j) {
            if (xcopy) ((f32x4*)(xcopy + (size_t)m * D))[lane + 64 * j] = v[j];
            const f32x4 gj = ((const f32x4*)g)[lane + 64 * j];
            const f32x4 y = v[j] * rinv * gj;
            if (xn) { u32x2 o; o.x = pk2(y.x, y.y); o.y = pk2(y.z, y.w); ((u32x2*)(xn + (size_t)m * D))[lane + 64 * j] = o; }
            if (fout) ((f32x4*)(fout + (size_t)m * D))[lane + 64 * j] = y;
        }
    }
}

__device__ __forceinline__ void conv_item(KP kp, int l, int item, LAS float* lds, int tid) {
    const float* Z = (const float*)(kp->ws + WS_Z); bf16* MIX = (bf16*)(kp->ws + WS_MIX);
    const int t0 = item * 32;
    int s, tau0, Ls; bool prompt;
    if (t0 < TP) { s = t0 >> 11; tau0 = t0 & 2047; Ls = 2048; prompt = true; } else { s = (t0 - TP) >> 6; tau0 = (t0 - TP) & 63; Ls = 64; prompt = false; }
    const int c = tid;
    const float* cw = kp->in[8] + (size_t)l * 31 * 512;
    float w[31];
#pragma unroll
    for (int j = 0; j < 31; ++j) w[j] = cw[j * 512 + c];
    const float bias = kp->in[9][l * 512 + c];
    float acc[32];
#pragma unroll
    for (int i = 0; i < 32; ++i) acc[i] = bias;
    const bool first = (tau0 == 0), lastit = (tau0 + 32 == Ls);
    float* oc = prompt ? kp->out + O_CONV_P + (size_t)((l * 4 + s) * 30) * 512 : kp->out + O_CONV_S + (size_t)((l * 16 + s) * 30) * 512;
    const float* cc = kp->in[2] + (size_t)((l * 16 + s) * 30) * 512;
#pragma unroll
    for (int ii = 0; ii < 62; ++ii) {
        float u;
        if (ii < 30 && first) { u = prompt ? 0.f : cc[ii * 512 + c]; }
        else { const float* zr = Z + (size_t)(t0 + ii - 30) * NZ; const float val = zr[c], gate = zr[512 + c]; u = val * sigm(gate); }
        if (ii >= 32 && lastit) oc[(ii - 32) * 512 + c] = u;
#pragma unroll
        for (int oi = 0; oi < 32; ++oi) { const int j = ii - oi; if (j >= 0 && j <= 30) acc[oi] += w[j] * u; }
    }
#pragma unroll
    for (int oi = 0; oi < 32; ++oi) lds[oi * 512 + c] = acc[oi];
    __syncthreads();
    const int wave = tid >> 6, lane = tid & 63;
    const f32x4 g0 = *(const f32x4*)(kp->in[10] + l * 512 + lane * 8), g1 = *(const f32x4*)(kp->in[10] + l * 512 + lane * 8 + 4);
    const f32x4 b0 = *(const f32x4*)(kp->in[11] + l * 512 + lane * 8), b1 = *(const f32x4*)(kp->in[11] + l * 512 + lane * 8 + 4);
#pragma unroll
    for (int q = 0; q < 4; ++q) {
        const int oi = wave * 4 + q;
        f32x4 a = *(const LAS f32x4*)(lds + oi * 512 + lane * 8), b = *(const LAS f32x4*)(lds + oi * 512 + lane * 8 + 4);
        const float mean = wave_sum((a.x + a.y) + (a.z + a.w) + (b.x + b.y) + (b.z + b.w)) * (1.0f / 512.0f);
        a = a - mean; b = b - mean;
        const float var = wave_sum((a.x * a.x + a.y * a.y) + (a.z * a.z + a.w * a.w) + (b.x * b.x + b.y * b.y) + (b.z * b.z + b.w * b.w)) * (1.0f / 512.0f);
        const float rstd = 1.0f / sqrtf(var + LN_EPS);
        a = a * rstd * g0 + b0; b = b * rstd * g1 + b1;
        float o[8] = {a.x, a.y, a.z, a.w, b.x, b.y, b.z, b.w};
#pragma unroll
        for (int k = 0; k < 8; ++k) o[k] = o[k] * sigm(o[k]);
        u32x4 wv; wv.x = pk2(o[0], o[1]); wv.y = pk2(o[2], o[3]); wv.z = pk2(o[4], o[5]); wv.w = pk2(o[6], o[7]);
        *(u32x4*)(MIX + (size_t)(t0 + oi) * D + lane * 8) = wv;
    }
    __syncthreads();
}
__device__ __forceinline__ void pool_item(KP kp, int l, int item, LAS float* pp, int tid) {
    const float* Z = (const float*)(kp->ws + WS_Z); bf16* MIX = (bf16*)(kp->ws + WS_MIX);
    const int t0 = item * 32;
    int s, tau0, Ls; bool prompt;
    if (t0 < TP) { s = t0 >> 11; tau0 = t0 & 2047; Ls = 2048; prompt = true; } else { s = (t0 - TP) >> 6; tau0 = (t0 - TP) & 63; Ls = 64; prompt = false; }
    const int c = tid;
    const bool first = (tau0 == 0), lastit = (tau0 + 32 == Ls);
    float* op = prompt ? kp->out + O_POOL_P + (size_t)((l * 4 + s) * 15) * 512 : kp->out + O_POOL_S + (size_t)((l * 16 + s) * 15) * 512;
    const float* cp = kp->in[3] + (size_t)((l * 16 + s) * 15) * 512;
#pragma unroll 8
    for (int ii = 0; ii < 47; ++ii) {
        float val;
        if (ii < 15 && first) val = prompt ? 0.f : cp[ii * 512 + c];
        else val = Z[(size_t)(t0 + ii - 15) * NZ + 1024 + c];
        pp[ii * 512 + c] = val;
        if (ii >= 32 && lastit) op[(ii - 32) * 512 + c] = val;
    }
    const int gi = c >> 7, w = 2 << gi;
    for (int oi = 0; oi < 32; ++oi) {
        float sum = 0.f;
        for (int k = 0; k < w; ++k) sum += pp[(oi + 15 - k) * 512 + c];
        const int cnt = prompt ? min(w, tau0 + oi + 1) : w;
        const float d = sum / (float)cnt - pp[(oi + 15) * 512 + c];
        pp[oi * 512 + c] = d;
    }
    __syncthreads();
    const int n = tid, g = n >> 7, dp = n & 127;
    const float* pw = kp->in[12] + (size_t)((l * 4 + g) * 128) * 128 + dp;
    float acc[32];
#pragma unroll
    for (int i = 0; i < 32; ++i) acc[i] = 0.f;
    for (int c4 = 0; c4 < 32; ++c4) {
        const float w0 = pw[(4 * c4 + 0) * 128], w1 = pw[(4 * c4 + 1) * 128], w2 = pw[(4 * c4 + 2) * 128], w3 = pw[(4 * c4 + 3) * 128];
#pragma unroll
        for (int oi = 0; oi < 32; ++oi) { const f32x4 dv = *(const LAS f32x4*)(pp + oi * 512 + g * 128 + 4 * c4); acc[oi] += (dv.x * w0 + dv.y * w1) + (dv.z * w2 + dv.w * w3); }
    }
    const float scale = kp->in[13][l * 512 + n];
#pragma unroll
    for (int oi = 0; oi < 32; ++oi) MIX[(size_t)(t0 + oi) * D + 512 + n] = (bf16)f2bf(acc[oi] * scale);
    __syncthreads();
}
__device__ __forceinline__ void prep_item(KP kp, int l, int item, LAS float* lo, int tid) {
    const float* Z = (const float*)(kp->ws + WS_Z);
    float* SC = (float*)(kp->ws + WS_SC); float* G = (float*)(kp->ws + WS_G); float* RK = (float*)(kp->ws + WS_RK);
    const int t0 = item * 16;
    int s, tau0, Ls; bool prompt;
    if (t0 < TP) { s = t0 >> 11; tau0 = t0 & 2047; Ls = 2048; prompt = true; } else { s = (t0 - TP) >> 6; tau0 = (t0 - TP) & 63; Ls = 64; prompt = false; }
    const float* mu = kp->in[14] + (size_t)l * RP;
    const float* ssh = kp->in[4] + (size_t)(l * 16 + s) * RP;
    for (int e = tid; e < 16 * 192; e += NTHR) {
        const int tok = e / 192, col = e % 192, zc = 3072 + col, t = t0 + tok, tau = tau0 + tok;
        const float q = Z[(size_t)t * NZ + ZQ + zc];
        const float qp = tau > 0 ? Z[(size_t)(t - 1) * NZ + ZQ + zc] : (prompt ? 0.f : ssh[zc]);
        const float qs = q + (qp - q) * mu[zc];
        lo[tok * 192 + col] = col < 64 ? tanhf(qs) : (col < 128 ? qs : sigm(qs));
    }
    __syncthreads();
    const int lane = tid & 63;
#pragma unroll 1
    for (int cc = 0; cc < 2; ++cc) {
        const int c = tid + 512 * cc, h = c >> 6;
        float accw[16], acca[16], accg[16];
#pragma unroll
        for (int i = 0; i < 16; ++i) { accw[i] = 0.f; acca[i] = 0.f; accg[i] = 0.f; }
        const float* wu = kp->in[16] + (size_t)l * 64 * RD + c; const float* au = kp->in[18] + (size_t)l * 64 * RD + c; const float* gu = kp->in[19] + (size_t)l * 64 * RD + c;
#pragma unroll 2
        for (int j4 = 0; j4 < 16; ++j4) {
            const float w0 = wu[(4 * j4 + 0) * RD], w1 = wu[(4 * j4 + 1) * RD], w2 = wu[(4 * j4 + 2) * RD], w3 = wu[(4 * j4 + 3) * RD];
            const float a0 = au[(4 * j4 + 0) * RD], a1 = au[(4 * j4 + 1) * RD], a2 = au[(4 * j4 + 2) * RD], a3 = au[(4 * j4 + 3) * RD];
            const float g0 = gu[(4 * j4 + 0) * RD], g1 = gu[(4 * j4 + 1) * RD], g2 = gu[(4 * j4 + 2) * RD], g3 = gu[(4 * j4 + 3) * RD];
#pragma unroll
            for (int tok = 0; tok < 16; ++tok) {
                const f32x4 lw = *(const LAS f32x4*)(lo + tok * 192 + 4 * j4), la = *(const LAS f32x4*)(lo + tok * 192 + 64 + 4 * j4), lg = *(const LAS f32x4*)(lo + tok * 192 + 128 + 4 * j4);
                accw[tok] += (lw.x * w0 + lw.y * w1) + (lw.z * w2 + lw.w * w3);
                acca[tok] += (la.x * a0 + la.y * a1) + (la.z * a2 + la.w * a3);
                accg[tok] += (lg.x * g0 + lg.y * g1) + (lg.z * g2 + lg.w * g3);
            }
        }
        const float w0c = kp->in[15][l * RD + c], a0c = kp->in[17][l * RD + c], kkc = kp->in[20][l * RD + c], kac = kp->in[21][l * RD + c], rkc = kp->in[22][l * RD + c];
        const float mur = mu[c], muk = mu[RD + c], muv = mu[2 * RD + c];
        const float sr = prompt ? 0.f : ssh[c], sk = prompt ? 0.f : ssh[RD + c], sv = prompt ? 0.f : ssh[2 * RD + c];
#pragma unroll
        for (int tok = 0; tok < 16; ++tok) {
            const int t = t0 + tok, tau = tau0 + tok;
            const float* zr = Z + (size_t)t * NZ + ZQ;
            float r = zr[c], k = zr[RD + c], v = zr[2 * RD + c];
            float pr, pk, pv;
            if (tau > 0) { pr = zr[c - NZ]; pk = zr[RD + c - NZ]; pv = zr[2 * RD + c - NZ]; } else { pr = sr; pk = sk; pv = sv; }
            r += (pr - r) * mur; k += (pk - k) * muk; v += (pv - v) * muv;
            const float xw = -(w0c + accw[tok]);
            const float sp = fmaxf(xw, 0.f) + log1pf(expf(-fabsf(xw)));
            const float decay = expf(-expf(-sp - 0.5f));
            const float a = sigm(a0c + acca[tok]);
            const float kk = k * kkc;
            const float nrm = wave_sum(kk * kk);
            const float kkn = kk * (1.0f / sqrtf(fmaxf(nrm, 1e-24f)));
            const float kp = k * (1.0f + (a - 1.0f) * kac);
            const float b = kkn * a;
            const float rk = wave_sum(r * kp * rkc);
            float* sc = SC + ((size_t)t * NH + h) * SCR + lane;
            sc[0] = decay; sc[64] = kkn; sc[128] = b; sc[192] = kp; sc[256] = r; sc[320] = v;
            G[(size_t)t * RD + c] = accg[tok];
            if (lane == 0) RK[t * NH + h] = rk;
        }
    }
    if (tau0 + 16 == Ls) {
        float* osh = prompt ? kp->out + O_SHIFT_P + (size_t)(l * 4 + s) * RP : kp->out + O_SHIFT_S + (size_t)(l * 16 + s) * RP;
        const float* zr = Z + (size_t)(t0 + 15) * NZ + ZQ;
        for (int e = tid; e < RP; e += NTHR) osh[e] = zr[e];
    }
    __syncthreads();
}

template <int MODE> __device__ __forceinline__ void sc_issue(f32x4 (&r)[4], const LAS f32x4* o, int c) {
    if (c < 4) {
#pragma unroll
        for (int i = 0; i < 4; ++i) r[i] = o[16 + 4 * c + i];
    } else if (MODE == 2) { const int j0 = 2 * (c - 4); r[0] = o[j0]; r[1] = o[32 + j0]; r[2] = o[j0 + 1]; r[3] = o[32 + j0 + 1]; }
    else { const int j = c - 4; r[0] = o[j]; r[1] = o[32 + j]; r[2] = o[48 + j]; if (MODE == 1) r[3] = o[64 + j]; }
}
template <int MODE>
__device__ __forceinline__ void scan_run(const float* SC, int tg0, int nsteps, int h, LAS float* wl, int lane,
                                         const float* Sinit, int init_layout  , float* Y, float* Sout, float* PQout) {
    constexpr int NV = (MODE == 0) ? 4 : (MODE == 2 ? 3 : 5), GS = 8;
    constexpr int NCH = (MODE == 2) ? 12 : 20;
    f32x2 S[32];
    if (MODE == 2) {
        const int ln = launder_v(lane);
#pragma unroll
        for (int j = 0; j < 32; ++j) S[j] = (f32x2){(2 * j == ln) ? 1.f : 0.f, (2 * j + 1 == ln) ? 1.f : 0.f};
    } else if (MODE == 1 && init_layout == 1) {
#pragma unroll
        for (int j = 0; j < 16; ++j) { const f32x4 v = ((const f32x4*)(Sinit + lane * 64))[j]; S[2 * j] = (f32x2){v.x, v.y}; S[2 * j + 1] = (f32x2){v.z, v.w}; }
    } else if (MODE == 1 && init_layout == 2) {
#pragma unroll
        for (int j = 0; j < 16; ++j) { const f32x4 v = ((const f32x4*)Sinit)[j * 64 + lane]; S[2 * j] = (f32x2){v.x, v.y}; S[2 * j + 1] = (f32x2){v.z, v.w}; }
    } else {
#pragma unroll
        for (int j = 0; j < 32; ++j) S[j] = (f32x2){0.f, 0.f};
    }
    float pf[GS][NV], pv[GS];
    {
#pragma unroll
        for (int s = 0; s < GS; ++s) { const float* rec = SC + ((size_t)(tg0 + s) * NH + h) * SCR + lane;
#pragma unroll
            for (int k = 0; k < NV; ++k) pf[s][k] = rec[k * 64];
            pv[s] = (MODE == 2) ? 0.f : rec[320]; }
    }
    for (int tc = 0; tc < nsteps; tc += GS) {
        float vv[GS];
#pragma unroll
        for (int s = 0; s < GS; ++s) {
#pragma unroll
            for (int k = 0; k < NV; ++k) wl[s * 320 + k * 64 + lane] = pf[s][k];
            vv[s] = pv[s];
        }
        if (tc + GS < nsteps) {
#pragma unroll
            for (int s = 0; s < GS; ++s) { const float* rec = SC + ((size_t)(tg0 + tc + GS + s) * NH + h) * SCR + lane;
#pragma unroll
                for (int k = 0; k < NV; ++k) pf[s][k] = rec[k * 64];
                pv[s] = (MODE == 2) ? 0.f : rec[320]; }
        }
        asm volatile("s_waitcnt lgkmcnt(0)" ::: "memory");
        f32x4 R[4][4];
#pragma unroll
        for (int q = 0; q < 3; ++q) sc_issue<MODE>(R[q & 3], (const LAS f32x4*)(wl + (q / NCH) * 320), q % NCH);
        __builtin_amdgcn_sched_barrier(0);
#pragma unroll
        for (int s = 0; s < GS; ++s) {
            f32x2 d2a = (f32x2){0.f, 0.f}, d2b = (f32x2){0.f, 0.f}, y2a = (f32x2){0.f, 0.f}, y2b = (f32x2){0.f, 0.f};
            f32x2 sa2 = (f32x2){0.f, 0.f};
            const f32x2 v2 = (f32x2){vv[s], vv[s]};
#pragma unroll
            for (int c = 0; c < NCH; ++c) {
                const int q = s * NCH + c, qn = q + 3;
                if (qn < GS * NCH) sc_issue<MODE>(R[qn & 3], (const LAS f32x4*)(wl + (qn / NCH) * 320), qn % NCH);
                __builtin_amdgcn_sched_barrier(0);
                f32x4 (&r)[4] = R[q & 3];
                if (c < 4) {
#pragma unroll
                    for (int i = 0; i < 4; ++i) { const int j = 4 * c + i; d2a += S[2 * j] * (f32x2){r[i].x, r[i].y}; d2b += S[2 * j + 1] * (f32x2){r[i].z, r[i].w}; }
                    if (c == 3) { const f32x2 d2 = d2a + d2b; const float sa = -(d2.x + d2.y); sa2 = (f32x2){sa, sa}; }
                } else if (MODE == 2) {
                    const int j0 = 2 * (c - 4);
                    S[2 * j0] = S[2 * j0] * (f32x2){r[0].x, r[0].y} + sa2 * (f32x2){r[1].x, r[1].y}; S[2 * j0 + 1] = S[2 * j0 + 1] * (f32x2){r[0].z, r[0].w} + sa2 * (f32x2){r[1].z, r[1].w};
                    S[2 * j0 + 2] = S[2 * j0 + 2] * (f32x2){r[2].x, r[2].y} + sa2 * (f32x2){r[3].x, r[3].y}; S[2 * j0 + 3] = S[2 * j0 + 3] * (f32x2){r[2].z, r[2].w} + sa2 * (f32x2){r[3].z, r[3].w};
                } else {
                    const int j = c - 4;
                    f32x2 t0 = v2 * (f32x2){r[2].x, r[2].y}; t0 = sa2 * (f32x2){r[1].x, r[1].y} + t0; S[2 * j] = S[2 * j] * (f32x2){r[0].x, r[0].y} + t0;
                    f32x2 t1 = v2 * (f32x2){r[2].z, r[2].w}; t1 = sa2 * (f32x2){r[1].z, r[1].w} + t1; S[2 * j + 1] = S[2 * j + 1] * (f32x2){r[0].z, r[0].w} + t1;
                    if (MODE == 1) { y2a += S[2 * j] * (f32x2){r[3].x, r[3].y}; y2b += S[2 * j + 1] * (f32x2){r[3].z, r[3].w}; }
                }
                __builtin_amdgcn_sched_barrier(0);
            }
            if (MODE == 1) { const f32x2 y2 = y2a + y2b; Y[(size_t)(tg0 + tc + s) * RD + h * 64 + lane] = y2.x + y2.y; }
        }
        asm volatile("s_waitcnt lgkmcnt(0)" ::: "memory");
    }
    if (MODE != 1) {
#pragma unroll
        for (int j = 0; j < 16; ++j) ((f32x4*)PQout)[j * 64 + lane] = (f32x4){S[2 * j].x, S[2 * j].y, S[2 * j + 1].x, S[2 * j + 1].y};
    } else if (Sout) {
#pragma unroll
        for (int j = 0; j < 16; ++j) ((f32x4*)(Sout + lane * 64))[j] = (f32x4){S[2 * j].x, S[2 * j].y, S[2 * j + 1].x, S[2 * j + 1].y};
    }
}
__device__ __forceinline__ void combine_chain(const float* PQ, float* S0, LAS unsigned char* lds, int tid, int wave, int lane) {
    LAS f32x4* pl = (LAS f32x4*)lds;
    LAS f32x4* xch = (LAS f32x4*)(lds + 16384);
    f32x2 S[32];
#pragma unroll
    for (int j = 0; j < 32; ++j) S[j] = (f32x2){0.f, 0.f};
    const int n4a = 2 * wave, n4b = 2 * wave + 1;
    for (int c = 0; c < NC - 1; ++c) {
        const f32x4* Pc = (const f32x4*)(PQ + (size_t)(c * 2) * 4096); const f32x4* Qc = (const f32x4*)(PQ + (size_t)(c * 2 + 1) * 4096);
        pl[tid] = Pc[tid]; pl[tid + 512] = Pc[tid + 512];
        f32x4 na = Qc[n4a * 64 + lane], nb = Qc[n4b * 64 + lane];
        __syncthreads();
        f32x2 a0 = (f32x2){na.x, na.y}, a1 = (f32x2){na.z, na.w}, b0 = (f32x2){nb.x, nb.y}, b1 = (f32x2){nb.z, nb.w};
#pragma unroll
        for (int j = 0; j < 32; ++j) {
            const f32x4 pa0 = pl[n4a * 64 + 2 * j], pb0 = pl[n4b * 64 + 2 * j], pa1 = pl[n4a * 64 + 2 * j + 1], pb1 = pl[n4b * 64 + 2 * j + 1];
            const f32x2 s0 = (f32x2){S[j].x, S[j].x}, s1 = (f32x2){S[j].y, S[j].y};
            a0 += s0 * (f32x2){pa0.x, pa0.y}; a1 += s0 * (f32x2){pa0.z, pa0.w}; b0 += s0 * (f32x2){pb0.x, pb0.y}; b1 += s0 * (f32x2){pb0.z, pb0.w};
            a0 += s1 * (f32x2){pa1.x, pa1.y}; a1 += s1 * (f32x2){pa1.z, pa1.w}; b0 += s1 * (f32x2){pb1.x, pb1.y}; b1 += s1 * (f32x2){pb1.z, pb1.w};
        }
        na = (f32x4){a0.x, a0.y, a1.x, a1.y}; nb = (f32x4){b0.x, b0.y, b1.x, b1.y};
        xch[n4a * 64 + lane] = na; xch[n4b * 64 + lane] = nb;
        f32x4* So = (f32x4*)(S0 + (size_t)(c + 1) * 4096);
        So[n4a * 64 + lane] = na; So[n4b * 64 + lane] = nb;
        __syncthreads();
#pragma unroll
        for (int j = 0; j < 16; ++j) { const f32x4 v = xch[j * 64 + lane]; S[2 * j] = (f32x2){v.x, v.y}; S[2 * j + 1] = (f32x2){v.z, v.w}; }
        __syncthreads();
    }
}
__device__ __forceinline__ void post_rows(KP kp, int l, int gw, int ngw, int lane) {
    const float* SC = (const float*)(kp->ws + WS_SC); const float* Y = (const float*)(kp->ws + WS_Y); const float* G = (const float*)(kp->ws + WS_G); const float* RK = (const float*)(kp->ws + WS_RK);
    bf16* MIX = (bf16*)(kp->ws + WS_MIX);
    for (int it = gw; it < T * NH; it += ngw) {
        const int t = it >> 4, h = it & 15, c = h * 64 + lane;
        const float y = Y[(size_t)t * RD + c];
        const float mean = wave_sum(y) * (1.0f / 64.0f);
        const float d = y - mean;
        const float var = wave_sum(d * d) * (1.0f / 64.0f);
        const float yn = d * (1.0f / sqrtf(var + GN_EPS)) * kp->in[23][l * RD + c] + kp->in[24][l * RD + c];
        const float v = SC[((size_t)t * NH + h) * SCR + 320 + lane];
        const float o = (yn + RK[it] * v) * G[(size_t)t * RD + c];
        MIX[(size_t)t * D + 1024 + c] = (bf16)f2bf(o);
    }
}

__global__ void __launch_bounds__(NTHR, 2) fwd_mega(Params p) {
    extern __shared__ __attribute__((aligned(16))) unsigned char lds_raw[];
    LAS unsigned char* lds = (LAS unsigned char*)lds_raw;

#pragma unroll 1
    for (int l = 0; l < DEPTH; ++l) {
        for (int rep = 0; rep < REP_CVT; ++rep) { PH_BEGIN();
#ifndef NO_CVT
          convert_weights(kp, l, lds, gw, ngw, wave, lane);
#endif
#ifndef NO_NORM
          float* X = (float*)(ws + WS_X); bf16* XN = (bf16*)(ws + WS_XN);
          if (l == 0) norm_rows(kp->in[0], kp->in[1], kp->in[6], X, XN, nullptr, gw, ngw, lane);
          else norm_rows(X, X + (size_t)TP * D, kp->in[6] + l * D, nullptr, XN, nullptr, gw, ngw, lane);
#endif
        }
        GSYNC();
#ifndef NO_GEMM1
        { PH_BEGIN(); pg8::Gemm g{(const bf16*)(ws + WS_XN), (const bf16*)(ws + WS_WIN), T, NZ, D}; pg8::StaticOrder S; S.init(T, NZ, nb, bid); pg8::EpiStoreF32 E{(float*)(ws + WS_Z), NZ};
          pg8::gemm_phase<pg8::EpiStoreF32, pg8::StaticOrder, true, true>(lds, g, S, E, tid); }
#endif
        GSYNC();
        for (int rep = 0; rep < REP_MIXA; ++rep) { PH_BEGIN();
          if (rep) __syncthreads();
          for (int it = bid; it < 1152; it += nb) {
#ifndef NO_PREP
            if (it < 576) prep_item(kp, l, it, (LAS float*)lds, tid);
#endif
#ifndef NO_POOL
            if (it >= 576 && it < 864) pool_item(kp, l, it - 576, (LAS float*)lds, tid);
#endif
#ifndef NO_CONV
            if (it >= 864) conv_item(kp, l, it - 864, (LAS float*)lds, tid);
#endif
          }
        }
        GSYNC();
#ifndef NO_SCAN
        for (int rep = 0; rep < REP_SCAN; ++rep) {
        if (rep) GSYNC();
        { PH_BEGIN();
            const float* SC = (const float*)(ws + WS_SC); float* Y = (float*)(ws + WS_Y); float* PQ = (float*)(ws + WS_PQ);
            LAS float* wl = (LAS float*)(lds + wave * 10240);
            constexpr int NPT = 64 * (NC - 1);
            for (int task = wave * nb + bid; task < 2 * NPT + 256; task += NWAVES * nb) {
                if (task < 2 * NPT) {
                    const int isP = task >= NPT, tk = isP ? task - NPT : task;
                    const int ch = tk / (NC - 1), c = tk % (NC - 1), s = ch >> 4, h = ch & 15;
                    float* pq = PQ + (size_t)((ch * (NC - 1) + c) * 2) * 4096;
                    if (isP) scan_run<2>(SC, s * 2048 + c * CL, CL, h, wl, lane, nullptr, 0, nullptr, nullptr, pq);
                    else scan_run<0>(SC, s * 2048 + c * CL, CL, h, wl, lane, nullptr, 0, nullptr, nullptr, pq + 4096);
                } else {
                    const int ch = task - 2 * NPT, b = ch >> 4, h = ch & 15;
                    scan_run<1>(SC, TP + b * 64, 64, h, wl, lane, kp->in[5] + (size_t)((l * 16 + b) * NH + h) * 4096, 1, Y, kp->out + O_WKV_S + (size_t)((l * 16 + b) * NH + h) * 4096, nullptr);
                }
            }
        }
        GSYNC();
        { PH_BEGIN();
#ifndef NO_COMB
            for (int ch = bid; ch < 64; ch += nb) combine_chain((const float*)(ws + WS_PQ) + (size_t)ch * (NC - 1) * 2 * 4096, (float*)(ws + WS_S0) + (size_t)ch * NC * 4096, lds, tid, wave, lane);
#endif
        }
        GSYNC();
        { PH_BEGIN();
            const float* SC = (const float*)(ws + WS_SC); float* Y = (float*)(ws + WS_Y); const float* S0 = (const float*)(ws + WS_S0);
            LAS float* wl = (LAS float*)(lds + wave * 10240);
            for (int task = wave * nb + bid; task < 64 * NC; task += NWAVES * nb) {
                const int ch = task / NC, c = task % NC, s = ch >> 4, h = ch & 15;
                scan_run<1>(SC, s * 2048 + c * CL, CL, h, wl, lane, S0 + (size_t)(ch * NC + c) * 4096, c == 0 ? 0 : 2, Y,
                            c == NC - 1 ? kp->out + O_WKV_P + (size_t)((l * 4 + s) * NH + h) * 4096 : nullptr, nullptr);
            }
        }
        }
#endif
        GSYNC();
#ifndef NO_POST
        for (int rep = 0; rep < REP_POST; ++rep) { PH_BEGIN(); post_rows(kp, l, gw, ngw, lane); }
#endif
        GSYNC();
#ifndef NO_GEMM2
        { PH_BEGIN(); pg8::Gemm g{(const bf16*)(ws + WS_MIX), (const bf16*)(ws + WS_WOUT), T, D, D}; pg8::StaticOrder S; S.init(T, D, nb, bid); pg8::EpiResAdd E{(float*)(ws + WS_X), D};
          pg8::gemm_phase<pg8::EpiResAdd, pg8::StaticOrder, true, true>(lds, g, S, E, tid); }
#endif
        GSYNC();
#ifndef NO_NORM
        { PH_BEGIN(); float* X = (float*)(ws + WS_X); norm_rows(X, X + (size_t)TP * D, kp->in[26] + l * D, nullptr, (bf16*)(ws + WS_XN), nullptr, gw, ngw, lane); }
#endif
        GSYNC();
#ifndef NO_GEMM3
        { PH_BEGIN(); pg8::Gemm g{(const bf16*)(ws + WS_XN), (const bf16*)(ws + WS_WGU), T, NGU, D}; pg8::StaticOrder S; S.init(T, NGU, nb, bid); pg8::EpiSwiGLU E{(bf16*)(ws + WS_ACT), FF};
          pg8::gemm_phase<pg8::EpiSwiGLU, pg8::StaticOrder, true, true>(lds, g, S, E, tid); }
#endif
        GSYNC();
#ifndef NO_GEMM4
        { PH_BEGIN(); pg8::Gemm g{(const bf16*)(ws + WS_ACT), (const bf16*)(ws + WS_WDN), T, D, FF}; pg8::StaticOrder S; S.init(T, D, nb, bid); pg8::EpiResAdd E{(float*)(ws + WS_X), D};
          pg8::gemm_phase<pg8::EpiResAdd, pg8::StaticOrder, true, true>(lds, g, S, E, tid); }
#endif
        GSYNC();
    }
#ifndef NO_NORM
    { PH_BEGIN(); float* X = (float*)(ws + WS_X); norm_rows(X, X + (size_t)TP * D, kp->in[30], nullptr, nullptr, kp->out + O_Y, gw, ngw, lane); }
#endif
}

extern "C" void kernel_launch(void* const* d_in, const int* in_sizes, int n_in, void* d_out, int out_size, void* d_ws, size_t ws_size, hipStream_t stream) {
    static int grid = 0;
    if (grid == 0) {
        if (n_in != 31 || (size_t)out_size != O_END || ws_size < WS_END) { fprintf(stderr, "kernel_launch: unexpected shapes: n_in %d out %d ws %zu (need %zu)\n", n_in, out_size, ws_size, (size_t)WS_END); grid = -1; return; }
        int dev = 0, cus = 0, per_cu = 0;
        hipGetDevice(&dev);
        hipDeviceGetAttribute(&cus, hipDeviceAttributeMultiprocessorCount, dev);
        if (hipFuncSetAttribute((const void*)fwd_mega, hipFuncAttributeMaxDynamicSharedMemorySize, LDS_BYTES) != hipSuccess) { fprintf(stderr, "kernel_launch: hipFuncSetAttribute failed\n"); grid = -1; return; }
        hipOccupancyMaxActiveBlocksPerMultiprocessor(&per_cu, (const void*)fwd_mega, NTHR, LDS_BYTES);
        (void)hipGetLastError();
        if (per_cu < 1) { fprintf(stderr, "kernel_launch: occupancy query says %d blocks per CU\n", per_cu); per_cu = 1; }
        grid = cus * 1;
    }
    if (grid < 0) return;
    Params p{};
    for (int i = 0; i < 31; ++i) p.in[i] = (const float*)d_in[i];
    p.out = (float*)d_out; p.ws = (unsigned char*)d_ws;
    void* args[] = {&p};
    hipError_t e = hipLaunchCooperativeKernel((const void*)fwd_mega, dim3(grid), dim3(NTHR), args, LDS_BYTES, stream);
    if (e != hipSuccess) fprintf(stderr, "cooperative launch failed: %s (grid %d)\n", hipGetErrorString(e), grid);
}
```

```cpp
#include <hip/hip_runtime.h>
#include <hip/hip_cooperative_groups.h>
#include <cstdio>
#include <cstdint>
namespace cg = cooperative_groups;

namespace pg8 {
#define PG8_LAS __attribute__((address_space(3)))
typedef unsigned short bf16_t;
typedef short bf16x8 __attribute__((ext_vector_type(8)));
typedef float f32x4 __attribute__((ext_vector_type(4)));
typedef unsigned u32x4 __attribute__((ext_vector_type(4)));
constexpr int BM = 256, BK = 64, HALF = 128, HTB = HALF * BK * 2  , STAGE_BYTES = 8 * HTB, NXCD = 8, WGM = 8;

__host__ __device__ __forceinline__ int lds_byte(int r, int c) { const int st = (r >> 4) * 2 + (c >> 5), rr = r & 15, cc = c & 31, ob = rr * 64 + cc * 2; return st * 1024 + (ob ^ (((ob >> 9) & 1) << 5)); }
__host__ __device__ __forceinline__ void stage_rc(int b, int& R, int& C) { const int st = b / 1024, sb = b % 1024, swz = sb ^ (((sb >> 9) & 1) << 5); R = (st >> 1) * 16 + swz / 64; C = (st & 1) * 32 + (swz % 64) / 2; }
__host__ __device__ __forceinline__ int perm32(int rho) { const int n = rho >> 4, i = rho & 15; return 8 * (i >> 2) + 4 * n + (i & 3); }

struct Unit { int pm, pn; };
struct Gemm { const bf16_t* A; const bf16_t* Bt; int M, N, K; };

struct StaticOrder {
    int nM, nN, nwg, G, c;
    __host__ __device__ void init(int M, int N, int G_, int c_) { nM = M / BM; nN = N / BM; nwg = nM * nN; G = G_; c = c_; }
    __host__ __device__ bool next(int i, Unit& u) const {
        const long L = (long)i * G + c; if (L >= nwg) return false;
        int wgid = (int)L; { const int q = nwg / NXCD, r = nwg % NXCD, xcd = wgid % NXCD, off = wgid / NXCD; wgid = (xcd < r ? xcd * (q + 1) : r * (q + 1) + (xcd - r) * q) + off; }
        const int nig = WGM * nN, gid = wgid / nig, fm = gid * WGM, gsz = (nM - fm) < WGM ? (nM - fm) : WGM;
        u.pm = fm + ((wgid % nig) % gsz); u.pn = (wgid % nig) / gsz; return true;
    }
    __device__ __forceinline__ void a_ready(const Unit&) const {}
    __device__ __forceinline__ void done(const Unit&) const {}
};

__device__ __forceinline__ unsigned cvt_pk_bf16(float lo, float hi) { unsigned r; asm volatile("v_cvt_pk_bf16_f32 %0, %1, %2" : "=v"(r) : "v"(lo), "v"(hi)); return r; }

struct EpiStoreF32 {
    static constexpr bool PERM = true, AFTER_DRAIN = false;
    float* O; int ldc;
    __device__ __forceinline__ void operator()(const f32x4 (&acc)[2][2][4][2], const Unit& u, int wr, int wc, int fr, int fq) const {
        const int row0 = u.pm * BM + wr * 64 + fr, col0 = u.pn * BM + wc * 32 + 8 * fq;
#pragma unroll
        for (int ai = 0; ai < 2; ++ai)
#pragma unroll
            for (int m = 0; m < 4; ++m) { float* rowp = O + (size_t)(row0 + ai * HALF + m * 16) * ldc + col0;
#pragma unroll
                for (int bj = 0; bj < 2; ++bj) { *(f32x4*)(rowp + bj * HALF) = acc[ai][bj][m][0]; *(f32x4*)(rowp + bj * HALF + 4) = acc[ai][bj][m][1]; } }
    }
};
struct EpiResAdd {
    static constexpr bool PERM = true, AFTER_DRAIN = false;
    float* O; int ldc;
    __device__ __forceinline__ void operator()(const f32x4 (&acc)[2][2][4][2], const Unit& u, int wr, int wc, int fr, int fq) const {
        const int row0 = u.pm * BM + wr * 64 + fr, col0 = u.pn * BM + wc * 32 + 8 * fq;
#pragma unroll
        for (int ai = 0; ai < 2; ++ai)
#pragma unroll
            for (int m = 0; m < 4; ++m) { float* rowp = O + (size_t)(row0 + ai * HALF + m * 16) * ldc + col0;
#pragma unroll
                for (int bj = 0; bj < 2; ++bj) {
                    f32x4 a = *(const f32x4*)(rowp + bj * HALF), b = *(const f32x4*)(rowp + bj * HALF + 4);
                    *(f32x4*)(rowp + bj * HALF) = a + acc[ai][bj][m][0]; *(f32x4*)(rowp + bj * HALF + 4) = b + acc[ai][bj][m][1]; } }
    }
};
struct EpiSwiGLU {
    static constexpr bool PERM = true, AFTER_DRAIN = false;
    bf16_t* O; int ldc;
    __device__ __forceinline__ void operator()(const f32x4 (&acc)[2][2][4][2], const Unit& u, int wr, int wc, int fr, int fq) const {
        const int row0 = u.pm * BM + wr * 64 + fr, col0 = u.pn * HALF + wc * 32 + 8 * fq;
#pragma unroll
        for (int ai = 0; ai < 2; ++ai)
#pragma unroll
            for (int m = 0; m < 4; ++m) { bf16_t* rowp = O + (size_t)(row0 + ai * HALF + m * 16) * ldc + col0;
                float o[8];
#pragma unroll
                for (int n = 0; n < 2; ++n)
#pragma unroll
                    for (int j = 0; j < 4; ++j) { const float g = acc[ai][0][m][n][j], up = acc[ai][1][m][n][j]; o[n * 4 + j] = g * up * __builtin_amdgcn_rcpf(1.0f + __expf(-g)); }
                u32x4 w; w.x = cvt_pk_bf16(o[0], o[1]); w.y = cvt_pk_bf16(o[2], o[3]); w.z = cvt_pk_bf16(o[4], o[5]); w.w = cvt_pk_bf16(o[6], o[7]);
                *(u32x4*)rowp = w; }
    }
};

template <class Epi, class Sched, bool ALIGN_EPI = false, bool SP2 = false>
__device__ __forceinline__ void gemm_phase(PG8_LAS unsigned char* lds, const Gemm g, const Sched& S, const Epi& E, const int tid) {
    const int wid = __builtin_amdgcn_readfirstlane(tid >> 6), lane = tid & 63, wr = wid >> 2, wc = wid & 3, fr = lane & 15, fq = lane >> 4;
    const int K = g.K, nt = K / BK;
    unsigned voffA[2], voffB[2];
#pragma unroll
    for (int i = 0; i < 2; ++i) { int R, C; stage_rc(tid * 16 + i * 8192, R, C); const int Rb = Epi::PERM ? ((R & ~31) + perm32(R & 31)) : R;
        voffA[i] = (unsigned)(R * K + C) * 2u; voffB[i] = (unsigned)(Rb * K + C) * 2u; }
    const size_t kstep = (size_t)(BK * 2);
    const size_t hstep = (size_t)HALF * K * 2;
    const size_t tstep = 2 * hstep;
    const unsigned ldsw = (unsigned)wid * 1024u;
    const int aoff = lds_byte(wr * 64 + fr, fq * 8), boff = lds_byte(wc * 32 + fr, fq * 8);
#define PG8_SA(b, h) (((b) * 2 + (h)) * HTB)
#define PG8_SB(b, h) ((4 + (b) * 2 + (h)) * HTB)
#define PG8_STAGE(bufoff, gbase, voff) do { _Pragma("unroll") for (int _i = 0; _i < 2; ++_i) \
        __builtin_amdgcn_global_load_lds((const unsigned*)((const char*)(gbase) + (voff)[_i]), (PG8_LAS unsigned*)(lds + (bufoff) + ldsw + _i * 8192), 16, 0, 0); } while (0)
#define PG8_LDA(dst, b, h) do { _Pragma("unroll") for (int m = 0; m < 4; ++m) _Pragma("unroll") for (int k = 0; k < 2; ++k) dst[m][k] = *(const PG8_LAS bf16x8*)(lds + PG8_SA(b, h) + aoff + m * 2048 + k * 1024); } while (0)
#define PG8_LDB(dst, b, h) do { _Pragma("unroll") for (int n = 0; n < 2; ++n) _Pragma("unroll") for (int k = 0; k < 2; ++k) dst[n][k] = *(const PG8_LAS bf16x8*)(lds + PG8_SB(b, h) + boff + n * 2048 + k * 1024); } while (0)
#define PG8_MMA(ai, bj, At, Bt) do { __builtin_amdgcn_s_setprio(1); _Pragma("unroll") for (int m = 0; m < 4; ++m) _Pragma("unroll") for (int n = 0; n < 2; ++n) _Pragma("unroll") for (int k = 0; k < 2; ++k) \
        acc[ai][bj][m][n] = __builtin_amdgcn_mfma_f32_16x16x32_bf16(Bt[n][k], At[m][k], acc[ai][bj][m][n], 0, 0, 0); __builtin_amdgcn_s_setprio(0); } while (0)
#define PG8_WAIT_V(n) asm volatile("s_waitcnt vmcnt(" #n ")" ::: "memory")
#define PG8_WAIT_L(n) asm volatile("s_waitcnt lgkmcnt(" #n ")" ::: "memory")
#define PG8_BAR __builtin_amdgcn_s_barrier()
#define PG8_SCHED __builtin_amdgcn_sched_barrier(0)
    Unit cur, nxt; int ui = 0;
    if (!S.next(0, cur)) return;
    f32x4 acc[2][2][4][2];
#pragma unroll
    for (int a = 0; a < 2; ++a)
#pragma unroll
        for (int b = 0; b < 2; ++b)
#pragma unroll
            for (int m = 0; m < 4; ++m)
#pragma unroll
                for (int n = 0; n < 2; ++n) acc[a][b][m][n] = (f32x4){0.f, 0.f, 0.f, 0.f};
    bf16x8 At[4][2], B0[2][2], B1[2][2];
    const char* cA = (const char*)g.A + (size_t)cur.pm * tstep; const char* cB = (const char*)g.Bt + (size_t)cur.pn * tstep;
    S.a_ready(cur);
    if constexpr (SP2) {
        PG8_STAGE(PG8_SB(0, 0), cB, voffB); PG8_STAGE(PG8_SB(0, 1), cB + hstep, voffB); PG8_STAGE(PG8_SA(0, 0), cA, voffA); PG8_STAGE(PG8_SA(0, 1), cA + hstep, voffA);
        if (wr == 1) PG8_BAR;
        PG8_WAIT_V(2); PG8_BAR;
        PG8_STAGE(PG8_SB(1, 0), cB + kstep, voffB); PG8_STAGE(PG8_SA(1, 0), cA + kstep, voffA); PG8_STAGE(PG8_SB(1, 1), cB + hstep + kstep, voffB);
        PG8_WAIT_V(6); PG8_BAR;
    } else {
        PG8_STAGE(PG8_SB(0, 0), cB, voffB); PG8_STAGE(PG8_SA(0, 0), cA, voffA); PG8_STAGE(PG8_SB(0, 1), cB + hstep, voffB); PG8_STAGE(PG8_SA(0, 1), cA + hstep, voffA);
        if (wr == 1) PG8_BAR;
        PG8_WAIT_V(4); PG8_BAR;
        PG8_STAGE(PG8_SB(1, 0), cB + kstep, voffB); PG8_STAGE(PG8_SA(1, 0), cA + kstep, voffA); PG8_STAGE(PG8_SB(1, 1), cB + hstep + kstep, voffB);
        PG8_WAIT_V(6); PG8_BAR;
    }
    for (;;) {
        const bool has_next = S.next(ui + 1, nxt);
        const char* nA = has_next ? (const char*)g.A + (size_t)nxt.pm * tstep : cA; const char* nB = has_next ? (const char*)g.Bt + (size_t)nxt.pn * tstep : cB;
        for (int t = 0; t < nt; t += 2) {
            const bool last = (t == nt - 2);
            const char* a1 = cA + (size_t)(t + 1) * kstep;
            const char* a2 = last ? nA : cA + (size_t)(t + 2) * kstep; const char* b2 = last ? nB : cB + (size_t)(t + 2) * kstep;
            const char* a3 = a2 + kstep; const char* b3 = b2 + kstep;
            if (last && has_next) S.a_ready(nxt);
            if constexpr (SP2) {
            PG8_LDB(B0, 0, 0); PG8_LDB(B1, 0, 1); PG8_SCHED; PG8_LDA(At, 0, 0); PG8_STAGE(PG8_SA(1, 1), a1 + hstep, voffA);
            PG8_WAIT_V(8); PG8_WAIT_L(0); PG8_BAR; PG8_MMA(0, 0, At, B0); PG8_MMA(0, 1, At, B1); PG8_BAR; PG8_SCHED;
            PG8_LDA(At, 0, 1); PG8_STAGE(PG8_SB(0, 0), b2, voffB); PG8_STAGE(PG8_SB(0, 1), b2 + hstep, voffB); PG8_STAGE(PG8_SA(0, 0), a2, voffA);
            PG8_WAIT_V(8); PG8_WAIT_L(0); PG8_BAR; PG8_MMA(1, 0, At, B0); PG8_MMA(1, 1, At, B1); PG8_BAR; PG8_SCHED;
            PG8_LDB(B0, 1, 0); PG8_LDB(B1, 1, 1); PG8_SCHED; PG8_LDA(At, 1, 0); PG8_STAGE(PG8_SA(0, 1), a2 + hstep, voffA);
            PG8_WAIT_V(8); PG8_WAIT_L(0); PG8_BAR; PG8_MMA(0, 0, At, B0); PG8_MMA(0, 1, At, B1); PG8_BAR; PG8_SCHED;
            PG8_LDA(At, 1, 1); PG8_STAGE(PG8_SB(1, 0), b3, voffB); PG8_STAGE(PG8_SB(1, 1), b3 + hstep, voffB); PG8_STAGE(PG8_SA(1, 0), a3, voffA);
            PG8_WAIT_V(8); PG8_WAIT_L(0); PG8_BAR; PG8_MMA(1, 0, At, B0); PG8_MMA(1, 1, At, B1); PG8_BAR; PG8_SCHED;
            } else {
            PG8_LDB(B0, 0, 0); PG8_SCHED; PG8_LDA(At, 0, 0); PG8_STAGE(PG8_SA(1, 1), a1 + hstep, voffA);
            PG8_WAIT_L(8); PG8_BAR; PG8_WAIT_L(0); PG8_MMA(0, 0, At, B0); PG8_BAR; PG8_SCHED;
            PG8_LDB(B1, 0, 1); PG8_STAGE(PG8_SB(0, 0), b2, voffB);
            PG8_BAR; PG8_WAIT_L(0); PG8_MMA(0, 1, At, B1); PG8_BAR;
            PG8_LDA(At, 0, 1); PG8_STAGE(PG8_SA(0, 0), a2, voffA);
            PG8_BAR; PG8_WAIT_L(0); PG8_MMA(1, 0, At, B0); PG8_BAR; PG8_SCHED;
            PG8_STAGE(PG8_SB(0, 1), b2 + hstep, voffB);
            PG8_WAIT_V(6); PG8_BAR; PG8_MMA(1, 1, At, B1); PG8_BAR;
            PG8_LDB(B0, 1, 0); PG8_SCHED; PG8_LDA(At, 1, 0); PG8_STAGE(PG8_SA(0, 1), a2 + hstep, voffA);
            PG8_WAIT_L(8); PG8_BAR; PG8_WAIT_L(0); PG8_MMA(0, 0, At, B0); PG8_BAR; PG8_SCHED;
            PG8_LDB(B1, 1, 1); PG8_STAGE(PG8_SB(1, 0), b3, voffB);
            PG8_BAR; PG8_WAIT_L(0); PG8_MMA(0, 1, At, B1); PG8_BAR;
            PG8_LDA(At, 1, 1); PG8_STAGE(PG8_SA(1, 0), a3, voffA);
            PG8_BAR; PG8_WAIT_L(0); PG8_MMA(1, 0, At, B0); PG8_BAR; PG8_SCHED;
            PG8_STAGE(PG8_SB(1, 1), b3 + hstep, voffB);
            PG8_WAIT_V(6); PG8_BAR; PG8_MMA(1, 1, At, B1); PG8_BAR;
            }
        }
        if constexpr (ALIGN_EPI) { if (wr == 0) PG8_BAR; }
        if constexpr (!Epi::AFTER_DRAIN) { E(acc, cur, wr, wc, fr, fq); S.done(cur); }
        if (!has_next) break;
#pragma unroll
        for (int a = 0; a < 2; ++a)
#pragma unroll
            for (int b = 0; b < 2; ++b)
#pragma unroll
                for (int m = 0; m < 4; ++m)
#pragma unroll
                    for (int n = 0; n < 2; ++n) acc[a][b][m][n] = (f32x4){0.f, 0.f, 0.f, 0.f};
        cur = nxt; cA = nA; cB = nB; ++ui;
        if constexpr (ALIGN_EPI) { if (wr == 1) PG8_BAR; }
    }
    PG8_WAIT_V(0);
    if constexpr (!ALIGN_EPI) { if (wr == 0) PG8_BAR; }
    PG8_BAR;
    if constexpr (Epi::AFTER_DRAIN) { E.fused(acc, cur, wr, wc, fr, fq, lds, wid, lane); S.done(cur); }
#undef PG8_SA
#undef PG8_SB
#undef PG8_STAGE
#undef PG8_LDA
#undef PG8_LDB
#undef PG8_MMA
#undef PG8_WAIT_V
#undef PG8_WAIT_L
#undef PG8_BAR
#undef PG8_SCHED
}
}

#define LAS __attribute__((address_space(3)))
typedef unsigned short bf16;
typedef float f32x4 __attribute__((ext_vector_type(4)));
typedef float f32x2 __attribute__((ext_vector_type(2)));
typedef unsigned u32x4 __attribute__((ext_vector_type(4)));
typedef unsigned u32x2 __attribute__((ext_vector_type(2)));
#define XB_TMO      128
#define XB_XCNT(j)  (256  + 64 * (j))
#define XB_XSUB(j)  (1280 + 64 * (j))
#define XB_XGEN(j)  (2304 + 64 * (j))
#define XB_TOP      3328
#define XB_TOPGEN   3392
#define XCD_BAR_WORDS 3456
#define XB_SPIN_CAP (1u << 18)

__device__ __forceinline__ unsigned xb_ld(unsigned* p)              { return __hip_atomic_load(p, __ATOMIC_RELAXED, __HIP_MEMORY_SCOPE_AGENT); }
__device__ __forceinline__ unsigned xb_add(unsigned* p, unsigned v) { return __hip_atomic_fetch_add(p, v, __ATOMIC_RELAXED, __HIP_MEMORY_SCOPE_AGENT); }
__device__ __forceinline__ unsigned xb_xcc_id() { return (unsigned)__builtin_amdgcn_s_getreg((3 << 11) | 20) & 0xFu; }
#define XB_SPIN(cond, bar) do { unsigned _sp = 0; while (cond) { __builtin_amdgcn_s_sleep(1); \
    if ((++_sp & 255u) == 0u) { if (xb_ld(&(bar)[XB_TMO])) break; if (_sp > XB_SPIN_CAP) { atomicAdd(&(bar)[XB_TMO], 1u); break; } } } } while (0)

struct XcdBarrier {
    unsigned* bar; unsigned x;
    volatile LAS unsigned* st;
};

__device__ __forceinline__ XcdBarrier xcd_barrier_post(unsigned* bar, volatile LAS unsigned* st, int tid) {
    XcdBarrier b; b.bar = bar; b.x = xb_xcc_id(); b.st = st;
    if (tid == 0) (void)xb_add(&bar[XB_XCNT(b.x)], 1u);
    return b;
}
__device__ __forceinline__ void xcd_barrier_complete(unsigned* bar, unsigned x, unsigned& nloc, unsigned& nx) {
    const unsigned G = gridDim.x * gridDim.y * gridDim.z;
    unsigned sum, cnt, mine, sp = 0u;
    for (;;) {
        sum = 0u; cnt = 0u; mine = 0u;
#pragma unroll
        for (unsigned j = 0; j < 16; ++j) { const unsigned c = xb_ld(&bar[XB_XCNT(j)]); sum += c; cnt += (c > 0u) ? 1u : 0u; mine = (j == x) ? c : mine; }
        if (sum == G) break;
        __builtin_amdgcn_s_sleep(1);
        if ((++sp & 255u) == 0u) { if (xb_ld(&bar[XB_TMO])) break; if (sp > XB_SPIN_CAP) { atomicAdd(&bar[XB_TMO], 1u); break; } }
    }
    nloc = mine > 0u ? mine : 1u; nx = cnt > 0u ? cnt : 1u;
}

__device__ __forceinline__ void xcd_barrier(const XcdBarrier& b, int tid) {
    asm volatile("s_waitcnt vmcnt(0)" ::: "memory");
    __syncthreads();
    if (tid == 0) {
        unsigned* bar = b.bar;
        __builtin_amdgcn_s_waitcnt(0);
        unsigned nloc = b.st[0], nx = b.st[1];
        if (nloc == 0u) { xcd_barrier_complete(bar, b.x, nloc, nx); b.st[0] = nloc; b.st[1] = nx; }
        const unsigned old = xb_add(&bar[XB_XSUB(b.x)], 1u);
        const unsigned gen = old / nloc;
        if (old + 1u == (gen + 1u) * nloc) {
            __builtin_amdgcn_fence(__ATOMIC_RELEASE, "agent");
            asm volatile("s_waitcnt vmcnt(0)" ::: "memory");
            const unsigned og = xb_add(&bar[XB_TOP], 1u);
            const unsigned tg = og / nx;
            if (og + 1u == (tg + 1u) * nx) xb_add(&bar[XB_TOPGEN], 1u);
            else XB_SPIN(xb_ld(&bar[XB_TOPGEN]) == tg, bar);
            __builtin_amdgcn_fence(__ATOMIC_ACQUIRE, "agent");
            xb_add(&bar[XB_XGEN(b.x)], 1u);
            asm volatile("s_waitcnt vmcnt(0)" ::: "memory");
        } else {
            XB_SPIN(xb_ld(&bar[XB_XGEN(b.x)]) == gen, bar);
            __builtin_amdgcn_fence(__ATOMIC_ACQUIRE, "agent");
            asm volatile("s_waitcnt vmcnt(0)" ::: "memory");
        }
    }
    __syncthreads();
}

constexpr int NWAVES = 8, NTHR = 512;
constexpr int TP = 8192, TS = 1024, T = 9216, D = 2048, NIN = 4800, NZ = 4864, FF = 5632, NGU = 11264;
constexpr int NH = 16, HS = 64, RD = 1024, RP = 3264, DEPTH = 4;
constexpr int ZQ = 1536;
constexpr float RMS_EPS = 1e-6f, LN_EPS = 1e-5f, GN_EPS = 64e-5f;
constexpr int SCR = 384;
constexpr size_t O_Y = 0;
constexpr size_t O_CONV_P = (size_t)T * D;
constexpr size_t O_POOL_P = O_CONV_P + (size_t)DEPTH * 4 * 30 * 512;
constexpr size_t O_SHIFT_P = O_POOL_P + (size_t)DEPTH * 4 * 15 * 512;
constexpr size_t O_WKV_P = O_SHIFT_P + (size_t)DEPTH * 4 * RP;
constexpr size_t O_CONV_S = O_WKV_P + (size_t)DEPTH * 4 * NH * 4096;
constexpr size_t O_POOL_S = O_CONV_S + (size_t)DEPTH * 16 * 30 * 512;
constexpr size_t O_SHIFT_S = O_POOL_S + (size_t)DEPTH * 16 * 15 * 512;
constexpr size_t O_WKV_S = O_SHIFT_S + (size_t)DEPTH * 16 * RP;
constexpr size_t O_END = O_WKV_S + (size_t)DEPTH * 16 * NH * 4096;
constexpr size_t WS_WIN = 1u << 20;
constexpr size_t WS_WOUT = WS_WIN + (size_t)NZ * D * 2;
constexpr size_t WS_WGU = WS_WOUT + (size_t)D * D * 2;
constexpr size_t WS_WDN = WS_WGU + (size_t)NGU * D * 2;
constexpr size_t WS_X = WS_WDN + (size_t)D * FF * 2;
constexpr size_t WS_XN = WS_X + (size_t)T * D * 4;
constexpr size_t WS_MIX = WS_XN + (size_t)T * D * 2;
constexpr size_t WS_Z = WS_MIX + (size_t)T * D * 2;
constexpr size_t WS_ACT = WS_Z;
constexpr size_t WS_SC = WS_Z + (size_t)T * NZ * 4;
constexpr size_t WS_Y = WS_SC + (size_t)T * NH * SCR * 4;
constexpr size_t WS_G = WS_Y + (size_t)T * RD * 4;
constexpr size_t WS_RK = WS_G + (size_t)T * RD * 4;
constexpr int NC = 16, CL = 128;
constexpr size_t WS_PQ = WS_RK + (size_t)T * NH * 4;
constexpr size_t WS_S0 = WS_PQ + (size_t)64 * NC * 2 * 4096 * 4;
constexpr size_t WS_GB = WS_S0 + (size_t)64 * NC * 4096 * 4;
constexpr size_t WS_END = WS_GB + (size_t)TP * RD * 4;
static_assert((size_t)T * FF * 2 <= (size_t)T * NZ * 4, "act overlay fits in z");
constexpr int LDS_BYTES = 147456;

#ifndef REP_P1
#define REP_P1 1
#endif
#ifndef REP_CB
#define REP_CB 1
#endif
#ifndef REP_MIXA
#define REP_MIXA 1
#endif
#ifndef REP_SCAN
#define REP_SCAN 1
#endif
#ifndef REP_POST
#define REP_POST 1
#endif
#ifndef REP_CVT
#define REP_CVT 1
#endif
#ifdef NO_SYNC
#define GSYNC() __syncthreads()
#else
#define GSYNC() do { int w_ = wave0; asm volatile("" : "+s"(w_)); xcd_barrier(xbar, w_ * 64 + (int)__builtin_amdgcn_mbcnt_hi(~0u, __builtin_amdgcn_mbcnt_lo(~0u, (unsigned)launder_v(0)))); } while (0)
#endif
struct Params { const float* in[31]; float* out; unsigned char* ws; };
typedef const __attribute__((address_space(4))) Params* KP;
__device__ __forceinline__ KP kargs() { KP k = (KP)__builtin_amdgcn_kernarg_segment_ptr(); asm volatile("" : "+s"(k)); return k; }
__device__ __forceinline__ int launder_v(int v) { asm volatile("" : "+v"(v)); return v; }
#define PH_BEGIN() KP kp = kargs(); int wave_ = wave0; asm volatile("" : "+s"(wave_)); const int wave = wave_; const int lane = (int)__builtin_amdgcn_mbcnt_hi(~0u, __builtin_amdgcn_mbcnt_lo(~0u, (unsigned)launder_v(0))); const int tid = wave * 64 + lane; \
    const int nb = gridDim.x, bid = blockIdx.x, gw = bid * NWAVES + wave, ngw = nb * NWAVES; unsigned char* const ws = kp->ws; (void)lane; (void)wave; (void)gw; (void)ngw; (void)ws; (void)nb; (void)bid

__device__ __forceinline__ float wave_sum(float v) {
#pragma unroll
    for (int o = 1; o < 64; o <<= 1) v += __shfl_xor(v, o);
    return v;
}
__device__ __forceinline__ unsigned f2bf(float f) { unsigned u = __builtin_bit_cast(unsigned, f); return (u + 0x7fffu + ((u >> 16) & 1u)) >> 16; }
__device__ __forceinline__ unsigned pk2(float lo, float hi) { return f2bf(lo) | (f2bf(hi) << 16); }
__device__ __forceinline__ float sigm(float x) { return 1.0f / (1.0f + __expf(-x)); }

__device__ __forceinline__ void transpose_item(const float* W, int K, int N, bf16* WT, int mode, LAS float* scr, int item, int lane) {
    const int nblk = N / 32, kb = item / nblk, nb = item % nblk, k0 = 64 * kb, n0 = 32 * nb;
    const int drow0 = (mode == 0) ? n0 : ((n0 >> 7) * 256 + (n0 & 127) + (mode == 2 ? 128 : 0));
#pragma unroll 8
    for (int i = 0; i < 32; ++i) { const int kk = 2 * i + (lane >> 5); scr[kk * 33 + (lane & 31)] = W[(size_t)(k0 + kk) * N + n0 + (lane & 31)]; }
    asm volatile("s_waitcnt lgkmcnt(0)" ::: "memory");
    const int c = lane & 7;
#pragma unroll
    for (int j = 0; j < 4; ++j) { const int n = (lane >> 3) + 8 * j; const LAS float* s = scr + (8 * c) * 33 + n;
        u32x4 o; o.x = pk2(s[0 * 33], s[1 * 33]); o.y = pk2(s[2 * 33], s[3 * 33]); o.z = pk2(s[4 * 33], s[5 * 33]); o.w = pk2(s[6 * 33], s[7 * 33]);
        *(u32x4*)(WT + (size_t)(drow0 + n) * K + k0 + 8 * c) = o; }
    asm volatile("s_waitcnt lgkmcnt(0)" ::: "memory");
}
__device__ __forceinline__ void convert_weights(KP kp, int l, LAS unsigned char* lds, int gw, int ngw, int wave, int lane) {
    LAS float* scr = (LAS float*)(lds + wave * 16384);
    unsigned char* ws = kp->ws;
    bf16* WIN = (bf16*)(ws + WS_WIN); bf16* WOUT = (bf16*)(ws + WS_WOUT); bf16* WGU = (bf16*)(ws + WS_WGU); bf16* WDN = (bf16*)(ws + WS_WDN);
    constexpr int I_IN = (D / 64) * (NIN / 32), I_OUT = (D / 64) * (D / 32), I_G = (D / 64) * (FF / 32), I_D = (FF / 64) * (D / 32);
    constexpr int NITEMS = I_IN + I_OUT + 2 * I_G + I_D;
    for (int it = gw; it < NITEMS; it += ngw) {
        int r = it;
        if (r < I_IN) { transpose_item(kp->in[7] + (size_t)l * D * NIN, D, NIN, WIN, 0, scr, r, lane); continue; } r -= I_IN;
        if (r < I_OUT) { transpose_item(kp->in[25] + (size_t)l * D * D, D, D, WOUT, 0, scr, r, lane); continue; } r -= I_OUT;
        if (r < I_G) { transpose_item(kp->in[27] + (size_t)l * D * FF, D, FF, WGU, 1, scr, r, lane); continue; } r -= I_G;
        if (r < I_G) { transpose_item(kp->in[28] + (size_t)l * D * FF, D, FF, WGU, 2, scr, r, lane); continue; } r -= I_G;
        transpose_item(kp->in[29] + (size_t)l * FF * D, FF, D, WDN, 0, scr, r, lane);
    }
    { const unsigned z = (unsigned)launder_v(0); for (int e = gw * 64 + lane; e < 16384; e += ngw * 64) ((u32x4*)(WIN + (size_t)NIN * D))[e] = (u32x4){z, z, z, z}; }
}
__device__ __forceinline__ void norm_rows(const float* sa, const float* sb, const float* g, float* xcopy, bf16* xn, float* fout, int gw, int ngw, int lane) {
    for (int m = gw; m < T; m += ngw) {
        const float* row = (m < TP) ? sa + (size_t)m * D : sb + (size_t)(m - TP) * D;
        f32x4 v[8]; float ss = 0.f;
#pragma unroll
        for (int j = 0; j < 8; ++j) { v[j] = ((const f32x4*)row)[lane + 64 * j]; ss += (v[j].x * v[j].x + v[j].y * v[j].y) + (v[j].z * v[j].z + v[j].w * v[j].w); }
        const float rinv = 1.0f / sqrtf(wave_sum(ss) * (1.0f / D) + RMS_EPS);
#pragma unroll
        for (int j = 0; j < 8; ++j) {
            if (xcopy) ((f32x4*)(xcopy + (size_t)m * D))[lane + 64 * j] = v[j];
            const f32x4 gj = ((const f32x4*)g)[lane + 64 * j];
            const f32x4 y = v[j] * rinv * gj;
            if (xn) { u32x2 o; o.x = pk2(y.x, y.y); o.y = pk2(y.z, y.w); ((u32x2*)(xn + (size_t)m * D))[lane + 64 * j] = o; }
            if (fout) ((f32x4*)(fout + (size_t)m * D))[lane + 64 * j] = y;
        }
    }
}

__device__ __forceinline__ void conv_item(KP kp, int l, int item, LAS float* lds, int tid) {
    const float* Z = (const float*)(kp->ws + WS_Z); bf16* MIX = (bf16*)(kp->ws + WS_MIX);
    const int t0 = item * 32;
    int s, tau0, Ls; bool prompt;
    if (t0 < TP) { s = t0 >> 11; tau0 = t0 & 2047; Ls = 2048; prompt = true; } else { s = (t0 - TP) >> 6; tau0 = (t0 - TP) & 63; Ls = 64; prompt = false; }
    const int c = tid;
    const float* cw = kp->in[8] + (size_t)l * 31 * 512;
    float w[31];
#pragma unroll
    for (int j = 0; j < 31; ++j) w[j] = cw[j * 512 + c];
    const float bias = kp->in[9][l * 512 + c];
    float acc[32];
#pragma unroll
    for (int i = 0; i < 32; ++i) acc[i] = bias;
    const bool first = (tau0 == 0), lastit = (tau0 + 32 == Ls);
    float* oc = prompt ? kp->out + O_CONV_P + (size_t)((l * 4 + s) * 30) * 512 : kp->out + O_CONV_S + (size_t)((l * 16 + s) * 30) * 512;
    const float* cc = kp->in[2] + (size_t)((l * 16 + s) * 30) * 512;
#pragma unroll
    for (int ii = 0; ii < 62; ++ii) {
        float u;
        if (ii < 30 && first) { u = prompt ? 0.f : cc[ii * 512 + c]; }
        else { const float* zr = Z + (size_t)(t0 + ii - 30) * NZ; const float val = zr[c], gate = zr[512 + c]; u = val * sigm(gate); }
        if (ii >= 32 && lastit) oc[(ii - 32) * 512 + c] = u;
#pragma unroll
        for (int oi = 0; oi < 32; ++oi) { const int j = ii - oi; if (j >= 0 && j <= 30) acc[oi] += w[j] * u; }
    }
#pragma unroll
    for (int oi = 0; oi < 32; ++oi) lds[oi * 512 + c] = acc[oi];
    __syncthreads();
    const int wave = tid >> 6, lane = tid & 63;
    const f32x4 g0 = *(const f32x4*)(kp->in[10] + l * 512 + lane * 8), g1 = *(const f32x4*)(kp->in[10] + l * 512 + lane * 8 + 4);
    const f32x4 b0 = *(const f32x4*)(kp->in[11] + l * 512 + lane * 8), b1 = *(const f32x4*)(kp->in[11] + l * 512 + lane * 8 + 4);
#pragma unroll
    for (int q = 0; q < 4; ++q) {
        const int oi = wave * 4 + q;
        f32x4 a = *(const LAS f32x4*)(lds + oi * 512 + lane * 8), b = *(const LAS f32x4*)(lds + oi * 512 + lane * 8 + 4);
        const float mean = wave_sum((a.x + a.y) + (a.z + a.w) + (b.x + b.y) + (b.z + b.w)) * (1.0f / 512.0f);
        a = a - mean; b = b - mean;
        const float var = wave_sum((a.x * a.x + a.y * a.y) + (a.z * a.z + a.w * a.w) + (b.x * b.x + b.y * b.y) + (b.z * b.z + b.w * b.w)) * (1.0f / 512.0f);
        const float rstd = 1.0f / sqrtf(var + LN_EPS);
        a = a * rstd * g0 + b0; b = b * rstd * g1 + b1;
        float o[8] = {a.x, a.y, a.z, a.w, b.x, b.y, b.z, b.w};
#pragma unroll
        for (int k = 0; k < 8; ++k) o[k] = o[k] * sigm(o[k]);
        u32x4 wv; wv.x = pk2(o[0], o[1]); wv.y = pk2(o[2], o[3]); wv.z = pk2(o[4], o[5]); wv.w = pk2(o[6], o[7]);
        *(u32x4*)(MIX + (size_t)(t0 + oi) * D + lane * 8) = wv;
    }
    __syncthreads();
}
__device__ __forceinline__ void pool_item(KP kp, int l, int item, LAS float* pp, int tid) {
    const float* Z = (const float*)(kp->ws + WS_Z); bf16* MIX = (bf16*)(kp->ws + WS_MIX);
    const int t0 = item * 32;
    int s, tau0, Ls; bool prompt;
    if (t0 < TP) { s = t0 >> 11; tau0 = t0 & 2047; Ls = 2048; prompt = true; } else { s = (t0 - TP) >> 6; tau0 = (t0 - TP) & 63; Ls = 64; prompt = false; }
    const int c = tid;
    const bool first = (tau0 == 0), lastit = (tau0 + 32 == Ls);
    float* op = prompt ? kp->out + O_POOL_P + (size_t)((l * 4 + s) * 15) * 512 : kp->out + O_POOL_S + (size_t)((l * 16 + s) * 15) * 512;
    const float* cp = kp->in[3] + (size_t)((l * 16 + s) * 15) * 512;
#pragma unroll 8
    for (int ii = 0; ii < 47; ++ii) {
        float val;
        if (ii < 15 && first) val = prompt ? 0.f : cp[ii * 512 + c];
        else val = Z[(size_t)(t0 + ii - 15) * NZ + 1024 + c];
        pp[ii * 512 + c] = val;
        if (ii >= 32 && lastit) op[(ii - 32) * 512 + c] = val;
    }
    const int gi = c >> 7, w = 2 << gi;
    for (int oi = 0; oi < 32; ++oi) {
        float sum = 0.f;
        for (int k = 0; k < w; ++k) sum += pp[(oi + 15 - k) * 512 + c];
        const int cnt = prompt ? min(w, tau0 + oi + 1) : w;
        const float d = sum / (float)cnt - pp[(oi + 15) * 512 + c];
        pp[oi * 512 + c] = d;
    }
    __syncthreads();
    const int n = tid, g = n >> 7, dp = n & 127;
    const float* pw = kp->in[12] + (size_t)((l * 4 + g) * 128) * 128 + dp;
    float acc[32];
#pragma unroll
    for (int i = 0; i < 32; ++i) acc[i] = 0.f;
    for (int c4 = 0; c4 < 32; ++c4) {
        const float w0 = pw[(4 * c4 + 0) * 128], w1 = pw[(4 * c4 + 1) * 128], w2 = pw[(4 * c4 + 2) * 128], w3 = pw[(4 * c4 + 3) * 128];
#pragma unroll
        for (int oi = 0; oi < 32; ++oi) { const f32x4 dv = *(const LAS f32x4*)(pp + oi * 512 + g * 128 + 4 * c4); acc[oi] += (dv.x * w0 + dv.y * w1) + (dv.z * w2 + dv.w * w3); }
    }
    const float scale = kp->in[13][l * 512 + n];
#pragma unroll
    for (int oi = 0; oi < 32; ++oi) MIX[(size_t)(t0 + oi) * D + 512 + n] = (bf16)f2bf(acc[oi] * scale);
    __syncthreads();
}
__device__ __forceinline__ void prep_item(KP kp, int l, int item, LAS float* lo, int tid) {
    const float* Z = (const float*)(kp->ws + WS_Z);
    float* SC = (float*)(kp->ws + WS_SC); float* G = (float*)(kp->ws + WS_G); float* RK = (float*)(kp->ws + WS_RK);
    const int t0 = item * 16;
    int s, tau0, Ls; bool prompt;
    if (t0 < TP) { s = t0 >> 11; tau0 = t0 & 2047; Ls = 2048; prompt = true; } else { s = (t0 - TP) >> 6; tau0 = (t0 - TP) & 63; Ls = 64; prompt = false; }
    const float* mu = kp->in[14] + (size_t)l * RP;
    const float* ssh = kp->in[4] + (size_t)(l * 16 + s) * RP;
    for (int e = tid; e < 16 * 192; e += NTHR) {
        const int tok = e / 192, col = e % 192, zc = 3072 + col, t = t0 + tok, tau = tau0 + tok;
        const float q = Z[(size_t)t * NZ + ZQ + zc];
        const float qp = tau > 0 ? Z[(size_t)(t - 1) * NZ + ZQ + zc] : (prompt ? 0.f : ssh[zc]);
        const float qs = q + (qp - q) * mu[zc];
        lo[tok * 192 + col] = col < 64 ? tanhf(qs) : (col < 128 ? qs : sigm(qs));
    }
    __syncthreads();
    const int lane = tid & 63;
#pragma unroll 1
    for (int cc = 0; cc < 2; ++cc) {
        const int c = tid + 512 * cc, h = c >> 6;
        float accw[16], acca[16], accg[16];
#pragma unroll
        for (int i = 0; i < 16; ++i) { accw[i] = 0.f; acca[i] = 0.f; accg[i] = 0.f; }
        const float* wu = kp->in[16] + (size_t)l * 64 * RD + c; const float* au = kp->in[18] + (size_t)l * 64 * RD + c; const float* gu = kp->in[19] + (size_t)l * 64 * RD + c;
#pragma unroll 2
        for (int j4 = 0; j4 < 16; ++j4) {
            const float w0 = wu[(4 * j4 + 0) * RD], w1 = wu[(4 * j4 + 1) * RD], w2 = wu[(4 * j4 + 2) * RD], w3 = wu[(4 * j4 + 3) * RD];
            const float a0 = au[(4 * j4 + 0) * RD], a1 = au[(4 * j4 + 1) * RD], a2 = au[(4 * j4 + 2) * RD], a3 = au[(4 * j4 + 3) * RD];
            const float g0 = gu[(4 * j4 + 0) * RD], g1 = gu[(4 * j4 + 1) * RD], g2 = gu[(4 * j4 + 2) * RD], g3 = gu[(4 * j4 + 3) * RD];
#pragma unroll
            for (int tok = 0; tok < 16; ++tok) {
                const f32x4 lw = *(const LAS f32x4*)(lo + tok * 192 + 4 * j4), la = *(const LAS f32x4*)(lo + tok * 192 + 64 + 4 * j4), lg = *(const LAS f32x4*)(lo + tok * 192 + 128 + 4 * j4);
                accw[tok] += (lw.x * w0 + lw.y * w1) + (lw.z * w2 + lw.w * w3);
                acca[tok] += (la.x * a0 + la.y * a1) + (la.z * a2 + la.w * a3);
                accg[tok] += (lg.x * g0 + lg.y * g1) + (lg.z * g2 + lg.w * g3);
            }
        }
        const float w0c = kp->in[15][l * RD + c], a0c = kp->in[17][l * RD + c], kkc = kp->in[20][l * RD + c], kac = kp->in[21][l * RD + c], rkc = kp->in[22][l * RD + c];
        const float mur = mu[c], muk = mu[RD + c], muv = mu[2 * RD + c];
        const float sr = prompt ? 0.f : ssh[c], sk = prompt ? 0.f : ssh[RD + c], sv = prompt ? 0.f : ssh[2 * RD + c];
#pragma unroll
        for (int tok = 0; tok < 16; ++tok) {
            const int t = t0 + tok, tau = tau0 + tok;
            const float* zr = Z + (size_t)t * NZ + ZQ;
            float r = zr[c], k = zr[RD + c], v = zr[2 * RD + c];
            float pr, pk, pv;
            if (tau > 0) { pr = zr[c - NZ]; pk = zr[RD + c - NZ]; pv = zr[2 * RD + c - NZ]; } else { pr = sr; pk = sk; pv = sv; }
            r += (pr - r) * mur; k += (pk - k) * muk; v += (pv - v) * muv;
            const float xw = -(w0c + accw[tok]);
            const float sp = fmaxf(xw, 0.f) + log1pf(expf(-fabsf(xw)));
            const float decay = expf(-expf(-sp - 0.5f));
            const float a = sigm(a0c + acca[tok]);
            const float kk = k * kkc;
            const float nrm = wave_sum(kk * kk);
            const float kkn = kk * (1.0f / sqrtf(fmaxf(nrm, 1e-24f)));
            const float kp = k * (1.0f + (a - 1.0f) * kac);
            const float b = kkn * a;
            const float rk = wave_sum(r * kp * rkc);
            float* sc = SC + ((size_t)t * NH + h) * SCR + lane;
            sc[0] = decay; sc[64] = kkn; sc[128] = b; sc[192] = kp; sc[256] = r; sc[320] = v;
            G[(size_t)t * RD + c] = accg[tok];
            if (lane == 0) RK[t * NH + h] = rk;
        }
    }
    if (tau0 + 16 == Ls) {
        float* osh = prompt ? kp->out + O_SHIFT_P + (size_t)(l * 4 + s) * RP : kp->out + O_SHIFT_S + (size_t)(l * 16 + s) * RP;
        const float* zr = Z + (size_t)(t0 + 15) * NZ + ZQ;
        for (int e = tid; e < RP; e += NTHR) osh[e] = zr[e];
    }
    __syncthreads();
}

__device__ __forceinline__ void sc_issue(f32x4 (&r)[4], const LAS f32x4* o, int c) {
    if (c < 4) {
#pragma unroll
        for (int i = 0; i < 4; ++i) r[i] = o[16 + 4 * c + i];
    } else { const int j = c - 4; r[0] = o[j]; r[1] = o[32 + j]; r[2] = o[48 + j]; r[3] = o[64 + j]; }
}
template <int MODE>
__device__ __forceinline__ void scan_run(const float* SC, int tg0, int nsteps, int h, LAS float* wl  , int lane,
                                         const float* Sinit, float* Y, float* GB, float* Sout, float* PQout) {
    constexpr int GS = 4, NCH = 20;
    f32x2 S[32];
    f32x2 P[(MODE == 3) ? 32 : 1];
    if (MODE == 3) {
        const int ln = launder_v(lane);
#pragma unroll
        for (int j = 0; j < 32; ++j) { S[j] = (f32x2){0.f, 0.f}; P[j] = (f32x2){(2 * j == ln) ? 1.f : 0.f, (2 * j + 1 == ln) ? 1.f : 0.f}; }
    } else {
#pragma unroll
        for (int j = 0; j < 16; ++j) { const f32x4 v = ((const f32x4*)(Sinit + lane * 64))[j]; S[2 * j] = (f32x2){v.x, v.y}; S[2 * j + 1] = (f32x2){v.z, v.w}; }
    }
#define SC_STAGE(g, buf) do { _Pragma("unroll") for (int s_ = 0; s_ < GS; ++s_) { const float* rec_ = SC + ((size_t)(tg0 + (g) * GS + s_) * NH + h) * SCR + lane; \
        _Pragma("unroll") for (int k_ = 0; k_ < 6; ++k_) __builtin_amdgcn_global_load_lds((const unsigned*)(rec_ + k_ * 64), (LAS unsigned*)(wl + ((buf) * GS + s_) * SCR + k_ * 64), 4, 0, 0); } } while (0)
    SC_STAGE(0, 0);
    const int ngroups = nsteps / GS;
    for (int g = 0; g < ngroups; ++g) {
        asm volatile("s_waitcnt vmcnt(0)" ::: "memory");
        if (g + 1 < ngroups) SC_STAGE(g + 1, (g + 1) & 1);
        const LAS float* wb = wl + (g & 1) * GS * SCR;
        f32x4 R[4][4];
#pragma unroll
        for (int q = 0; q < 3; ++q) sc_issue(R[q & 3], (const LAS f32x4*)(wb + (q / NCH) * SCR), q % NCH);
        __builtin_amdgcn_sched_barrier(0);
#pragma unroll
        for (int s = 0; s < GS; ++s) {
            f32x2 d2a = (f32x2){0.f, 0.f}, y2a = (f32x2){0.f, 0.f};
            f32x2 e2a = (f32x2){0.f, 0.f}, g2a = (f32x2){0.f, 0.f};
            f32x2 sa2 = (f32x2){0.f, 0.f}, sp2 = (f32x2){0.f, 0.f};
            const float vs = wb[s * SCR + 320 + lane];
            const f32x2 v2 = (f32x2){vs, vs};
#pragma unroll
            for (int c = 0; c < NCH; ++c) {
                const int q = s * NCH + c, qn = q + 3;
                if (qn < GS * NCH) sc_issue(R[qn & 3], (const LAS f32x4*)(wb + (qn / NCH) * SCR), qn % NCH);
                __builtin_amdgcn_sched_barrier(0);
                f32x4 (&r)[4] = R[q & 3];
                if (c < 4) {
#pragma unroll
                    for (int i = 0; i < 4; ++i) { const int j = 4 * c + i; d2a += S[2 * j] * (f32x2){r[i].x, r[i].y}; d2a += S[2 * j + 1] * (f32x2){r[i].z, r[i].w};
                        if (MODE == 3) { e2a += P[2 * j] * (f32x2){r[i].x, r[i].y}; e2a += P[2 * j + 1] * (f32x2){r[i].z, r[i].w}; } }
                    if (c == 3) { const f32x2 d2 = d2a; const float sa = -(d2.x + d2.y); sa2 = (f32x2){sa, sa};
                        if (MODE == 3) { const f32x2 e2 = e2a; const float sp = -(e2.x + e2.y); sp2 = (f32x2){sp, sp}; } }
                } else {
                    const int j = c - 4;
                    f32x2 t0 = v2 * (f32x2){r[2].x, r[2].y}; t0 = sa2 * (f32x2){r[1].x, r[1].y} + t0; S[2 * j] = S[2 * j] * (f32x2){r[0].x, r[0].y} + t0;
                    f32x2 t1 = v2 * (f32x2){r[2].z, r[2].w}; t1 = sa2 * (f32x2){r[1].z, r[1].w} + t1; S[2 * j + 1] = S[2 * j + 1] * (f32x2){r[0].z, r[0].w} + t1;
                    y2a += S[2 * j] * (f32x2){r[3].x, r[3].y}; y2a += S[2 * j + 1] * (f32x2){r[3].z, r[3].w};
                    if (MODE == 3) {
                        const f32x2 u0 = sp2 * (f32x2){r[1].x, r[1].y}, u1 = sp2 * (f32x2){r[1].z, r[1].w};
                        P[2 * j] = P[2 * j] * (f32x2){r[0].x, r[0].y} + u0; P[2 * j + 1] = P[2 * j + 1] * (f32x2){r[0].z, r[0].w} + u1;
                        g2a += P[2 * j] * (f32x2){r[3].x, r[3].y}; g2a += P[2 * j + 1] * (f32x2){r[3].z, r[3].w};
                    }
                }
                __builtin_amdgcn_sched_barrier(0);
            }
            { const f32x2 y2 = y2a; Y[(size_t)(tg0 + g * GS + s) * RD + h * 64 + lane] = y2.x + y2.y; }
            if (MODE == 3) { const f32x2 g2 = g2a; GB[(size_t)(tg0 + g * GS + s) * RD + h * 64 + lane] = g2.x + g2.y; }
        }
        asm volatile("s_waitcnt lgkmcnt(0)" ::: "memory");
    }
#undef SC_STAGE
    if (MODE == 3) {
#pragma unroll
        for (int j = 0; j < 16; ++j) { ((f32x4*)PQout)[j * 64 + lane] = (f32x4){P[2 * j].x, P[2 * j].y, P[2 * j + 1].x, P[2 * j + 1].y};
                                       ((f32x4*)(PQout + 4096))[j * 64 + lane] = (f32x4){S[2 * j].x, S[2 * j].y, S[2 * j + 1].x, S[2 * j + 1].y}; }
    } else {
#pragma unroll
        for (int j = 0; j < 16; ++j) ((f32x4*)(Sout + lane * 64))[j] = (f32x4){S[2 * j].x, S[2 * j].y, S[2 * j + 1].x, S[2 * j + 1].y};
    }
}
__device__ __forceinline__ void ycorr_task(const float* GB, float* Y, const float* S0q  , int tg0, int h, int lane) {
    const int n = lane & 15, kq = lane >> 4;
    float Bv[4][16];
#pragma unroll
    for (int nt = 0; nt < 4; ++nt)
#pragma unroll
        for (int ks = 0; ks < 16; ++ks) Bv[nt][ks] = S0q[(size_t)(ks * 64 + nt * 16 + n) * 4 + kq];
#pragma unroll 1
    for (int mt = 0; mt < CL / 16; ++mt) {
        const float* grow = GB + (size_t)(tg0 + mt * 16 + n) * RD + h * 64 + kq;
        float Av[16];
#pragma unroll
        for (int ks = 0; ks < 16; ++ks) Av[ks] = grow[ks * 4];
        f32x4 acc[4];
#pragma unroll
        for (int nt = 0; nt < 4; ++nt) acc[nt] = (f32x4){0.f, 0.f, 0.f, 0.f};
#pragma unroll
        for (int ks = 0; ks < 16; ++ks)
#pragma unroll
            for (int nt = 0; nt < 4; ++nt) acc[nt] = __builtin_amdgcn_mfma_f32_16x16x4f32(Av[ks], Bv[nt][ks], acc[nt], 0, 0, 0);
#pragma unroll
        for (int nt = 0; nt < 4; ++nt)
#pragma unroll
            for (int r = 0; r < 4; ++r) { float* yp = Y + (size_t)(tg0 + mt * 16 + 4 * kq + r) * RD + h * 64 + nt * 16 + n; *yp += acc[nt][r]; }
    }
}
__device__ __forceinline__ void combine_chain(const float* PQ, float* S0, float* Sfin, LAS unsigned char* lds, int tid, int wave, int lane) {
    LAS f32x4* pl = (LAS f32x4*)lds;
    LAS f32x4* xch = (LAS f32x4*)(lds + 16384);
    f32x2 S[32];
#pragma unroll
    for (int j = 0; j < 32; ++j) S[j] = (f32x2){0.f, 0.f};
    const int n4a = 2 * wave, n4b = 2 * wave + 1;
    const f32x4* Pc = (const f32x4*)PQ;
    f32x4 p0 = Pc[tid], p1 = Pc[tid + 512];
    for (int c = 0; c < NC; ++c) {
        const f32x4* Qc = (const f32x4*)(PQ + (size_t)(c * 2 + 1) * 4096);
        pl[tid] = p0; pl[tid + 512] = p1;
        f32x4 na = Qc[n4a * 64 + lane], nb = Qc[n4b * 64 + lane];
        if (c + 1 < NC) { const f32x4* Pn = (const f32x4*)(PQ + (size_t)((c + 1) * 2) * 4096); p0 = Pn[tid]; p1 = Pn[tid + 512]; }
        __syncthreads();
        f32x2 a0 = (f32x2){na.x, na.y}, a1 = (f32x2){na.z, na.w}, b0 = (f32x2){nb.x, nb.y}, b1 = (f32x2){nb.z, nb.w};
#pragma unroll
        for (int j = 0; j < 32; ++j) {
            const f32x4 pa0 = pl[n4a * 64 + 2 * j], pb0 = pl[n4b * 64 + 2 * j], pa1 = pl[n4a * 64 + 2 * j + 1], pb1 = pl[n4b * 64 + 2 * j + 1];
            const f32x2 s0 = (f32x2){S[j].x, S[j].x}, s1 = (f32x2){S[j].y, S[j].y};
            a0 += s0 * (f32x2){pa0.x, pa0.y}; a1 += s0 * (f32x2){pa0.z, pa0.w}; b0 += s0 * (f32x2){pb0.x, pb0.y}; b1 += s0 * (f32x2){pb0.z, pb0.w};
            a0 += s1 * (f32x2){pa1.x, pa1.y}; a1 += s1 * (f32x2){pa1.z, pa1.w}; b0 += s1 * (f32x2){pb1.x, pb1.y}; b1 += s1 * (f32x2){pb1.z, pb1.w};
            if ((j & 1) == 1) __builtin_amdgcn_sched_barrier(0);
        }
        na = (f32x4){a0.x, a0.y, a1.x, a1.y}; nb = (f32x4){b0.x, b0.y, b1.x, b1.y};
        if (c + 1 < NC) {
            xch[n4a * 64 + lane] = na; xch[n4b * 64 + lane] = nb;
            f32x4* So = (f32x4*)(S0 + (size_t)(c + 1) * 4096);
            So[n4a * 64 + lane] = na; So[n4b * 64 + lane] = nb;
            __syncthreads();
#pragma unroll
            for (int j = 0; j < 16; ++j) { const f32x4 v = xch[j * 64 + lane]; S[2 * j] = (f32x2){v.x, v.y}; S[2 * j + 1] = (f32x2){v.z, v.w}; }
        } else {
            *(f32x4*)(Sfin + lane * 64 + 8 * wave) = na; *(f32x4*)(Sfin + lane * 64 + 8 * wave + 4) = nb;
        }
        __syncthreads();
    }
}
__device__ __forceinline__ void post_rows(KP kp, int l, int gw, int ngw, int lane) {
    const float* SC = (const float*)(kp->ws + WS_SC); const float* Y = (const float*)(kp->ws + WS_Y); const float* G = (const float*)(kp->ws + WS_G); const float* RK = (const float*)(kp->ws + WS_RK);
    bf16* MIX = (bf16*)(kp->ws + WS_MIX);
    for (int it = gw; it < T * NH; it += ngw) {
        const int t = it >> 4, h = it & 15, c = h * 64 + lane;
        const float y = Y[(size_t)t * RD + c];
        const float mean = wave_sum(y) * (1.0f / 64.0f);
        const float d = y - mean;
        const float var = wave_sum(d * d) * (1.0f / 64.0f);
        const float yn = d * (1.0f / sqrtf(var + GN_EPS)) * kp->in[23][l * RD + c] + kp->in[24][l * RD + c];
        const float v = SC[((size_t)t * NH + h) * SCR + 320 + lane];
        const float o = (yn + RK[it] * v) * G[(size_t)t * RD + c];
        MIX[(size_t)t * D + 1024 + c] = (bf16)f2bf(o);
    }
}

__global__ void __launch_bounds__(NTHR, 2) fwd_mega(Params p) {
    extern __shared__ __attribute__((aligned(16))) unsigned char lds_raw[];
    LAS unsigned char* lds = (LAS unsigned char*)lds_raw;
    const int wave0 = __builtin_amdgcn_readfirstlane((int)threadIdx.x >> 6);
    volatile LAS unsigned* MISC = (volatile LAS unsigned*)(lds + 131072);
    if (threadIdx.x < 16) MISC[threadIdx.x] = 0u;
    __syncthreads();
    const XcdBarrier xbar = xcd_barrier_post((unsigned*)p.ws + 4096, MISC, (int)threadIdx.x);
    cg::this_grid().sync();

#pragma unroll 1
    for (int l = 0; l < DEPTH; ++l) {
        for (int rep = 0; rep < REP_CVT; ++rep) { PH_BEGIN();
#ifndef NO_CVT
          convert_weights(kp, l, lds, gw, ngw, wave, lane);
#endif
#ifndef NO_NORM
          float* X = (float*)(ws + WS_X); bf16* XN = (bf16*)(ws + WS_XN);
          if (l == 0) norm_rows(kp->in[0], kp->in[1], kp->in[6], X, XN, nullptr, gw, ngw, lane);
          else norm_rows(X, X + (size_t)TP * D, kp->in[6] + l * D, nullptr, XN, nullptr, gw, ngw, lane);
#endif
        }
        GSYNC();
#ifndef NO_GEMM1
        { PH_BEGIN(); pg8::Gemm g{(const bf16*)(ws + WS_XN), (const bf16*)(ws + WS_WIN), T, NZ, D}; pg8::StaticOrder S; S.init(T, NZ, nb, bid); pg8::EpiStoreF32 E{(float*)(ws + WS_Z), NZ};
          pg8::gemm_phase<pg8::EpiStoreF32, pg8::StaticOrder, true, true>(lds, g, S, E, tid); }
#endif
        GSYNC();
        for (int rep = 0; rep < REP_MIXA; ++rep) { PH_BEGIN();
          if (rep) __syncthreads();
          for (int it = bid; it < 1152; it += nb) {
#ifndef NO_PREP
            if (it < 576) prep_item(kp, l, it, (LAS float*)lds, tid);
#endif
#ifndef NO_POOL
            if (it >= 576 && it < 864) pool_item(kp, l, it - 576, (LAS float*)lds, tid);
#endif
#ifndef NO_CONV
            if (it >= 864) conv_item(kp, l, it - 864, (LAS float*)lds, tid);
#endif
          }
        }
        GSYNC();
#ifndef NO_SCAN
        for (int rep = 0; rep < REP_SCAN; ++rep) {
        if (rep) GSYNC();
        for (int rp = 0; rp < REP_P1; ++rp) { PH_BEGIN();
            const float* SC = (const float*)(ws + WS_SC); float* Y = (float*)(ws + WS_Y); float* PQ = (float*)(ws + WS_PQ); float* GB = (float*)(ws + WS_GB);
            LAS float* wl = (LAS float*)(lds + wave * 12288);
            for (int task = wave * nb + bid; task < 64 * NC + 256; task += NWAVES * nb) {
                if (task < 64 * NC) {
                    const int ch = task / NC, c = task % NC, s = ch >> 4, h = ch & 15;
                    scan_run<3>(SC, s * 2048 + c * CL, CL, h, wl, lane, nullptr, Y, GB, nullptr, PQ + (size_t)((ch * NC + c) * 2) * 4096);
                } else {
                    const int ch = task - 64 * NC, b = ch >> 4, h = ch & 15;
                    scan_run<1>(SC, TP + b * 64, 64, h, wl, lane, kp->in[5] + (size_t)((l * 16 + b) * NH + h) * 4096, Y, nullptr, kp->out + O_WKV_S + (size_t)((l * 16 + b) * NH + h) * 4096, nullptr);
                }
            }
        }
        GSYNC();
        for (int rp = 0; rp < REP_CB; ++rp) { PH_BEGIN();
            for (int ch = bid; ch < 64; ch += nb) { const int s = ch >> 4, h = ch & 15;
                combine_chain((const float*)(ws + WS_PQ) + (size_t)ch * NC * 2 * 4096, (float*)(ws + WS_S0) + (size_t)ch * NC * 4096, kp->out + O_WKV_P + (size_t)((l * 4 + s) * NH + h) * 4096, lds, tid, wave, lane); }
        }
        GSYNC();
        { PH_BEGIN();
            const float* GB = (const float*)(ws + WS_GB); float* Y = (float*)(ws + WS_Y); const float* S0 = (const float*)(ws + WS_S0);
            for (int task = wave * nb + bid; task < 64 * (NC - 1); task += NWAVES * nb) {
                const int ch = task / (NC - 1), c = 1 + task % (NC - 1), s = ch >> 4, h = ch & 15;
                ycorr_task(GB, Y, S0 + (size_t)(ch * NC + c) * 4096, s * 2048 + c * CL, h, lane);
            }
        }
        }
#endif
        GSYNC();
#ifndef NO_POST
        for (int rep = 0; rep < REP_POST; ++rep) { PH_BEGIN(); post_rows(kp, l, gw, ngw, lane); }
#endif
        GSYNC();
#ifndef NO_GEMM2
        { PH_BEGIN(); pg8::Gemm g{(const bf16*)(ws + WS_MIX), (const bf16*)(ws + WS_WOUT), T, D, D}; pg8::StaticOrder S; S.init(T, D, nb, bid); pg8::EpiResAdd E{(float*)(ws + WS_X), D};
          pg8::gemm_phase<pg8::EpiResAdd, pg8::StaticOrder, true, true>(lds, g, S, E, tid); }
#endif
        GSYNC();
#ifndef NO_NORM
        { PH_BEGIN(); float* X = (float*)(ws + WS_X); norm_rows(X, X + (size_t)TP * D, kp->in[26] + l * D, nullptr, (bf16*)(ws + WS_XN), nullptr, gw, ngw, lane); }
#endif
        GSYNC();
#ifndef NO_GEMM3
        { PH_BEGIN(); pg8::Gemm g{(const bf16*)(ws + WS_XN), (const bf16*)(ws + WS_WGU), T, NGU, D}; pg8::StaticOrder S; S.init(T, NGU, nb, bid); pg8::EpiSwiGLU E{(bf16*)(ws + WS_ACT), FF};
          pg8::gemm_phase<pg8::EpiSwiGLU, pg8::StaticOrder, true, true>(lds, g, S, E, tid); }
#endif
        GSYNC();
#ifndef NO_GEMM4
        { PH_BEGIN(); pg8::Gemm g{(const bf16*)(ws + WS_ACT), (const bf16*)(ws + WS_WDN), T, D, FF}; pg8::StaticOrder S; S.init(T, D, nb, bid); pg8::EpiResAdd E{(float*)(ws + WS_X), D};
          pg8::gemm_phase<pg8::EpiResAdd, pg8::StaticOrder, true, true>(lds, g, S, E, tid); }
#endif
        GSYNC();
    }
#ifndef NO_NORM
    { PH_BEGIN(); float* X = (float*)(ws + WS_X); norm_rows(X, X + (size_t)TP * D, kp->in[30], nullptr, nullptr, kp->out + O_Y, gw, ngw, lane); }
#endif
}

extern "C" void kernel_launch(void* const* d_in, const int* in_sizes, int n_in, void* d_out, int out_size, void* d_ws, size_t ws_size, hipStream_t stream) {
    static int grid = 0;
    if (grid == 0) {
        if (n_in != 31 || (size_t)out_size != O_END || ws_size < WS_END) { fprintf(stderr, "kernel_launch: unexpected shapes: n_in %d out %d ws %zu (need %zu)\n", n_in, out_size, ws_size, (size_t)WS_END); grid = -1; return; }
        int dev = 0, cus = 0, per_cu = 0;
        hipGetDevice(&dev);
        hipDeviceGetAttribute(&cus, hipDeviceAttributeMultiprocessorCount, dev);
        if (hipFuncSetAttribute((const void*)fwd_mega, hipFuncAttributeMaxDynamicSharedMemorySize, LDS_BYTES) != hipSuccess) { fprintf(stderr, "kernel_launch: hipFuncSetAttribute failed\n"); grid = -1; return; }
        hipOccupancyMaxActiveBlocksPerMultiprocessor(&per_cu, (const void*)fwd_mega, NTHR, LDS_BYTES);
        (void)hipGetLastError();
        if (per_cu < 1) { fprintf(stderr, "kernel_launch: occupancy query says %d blocks per CU\n", per_cu); per_cu = 1; }
        grid = cus * 1;
    }
    if (grid < 0) return;
    Params p{};
    for (int i = 0; i < 31; ++i) p.in[i] = (const float*)d_in[i];
    p.out = (float*)d_out; p.ws = (unsigned char*)d_ws;
    if (hipMemsetAsync(d_ws, 0, 65536, stream) != hipSuccess) { fprintf(stderr, "kernel_launch: memset failed\n"); return; }
    void* args[] = {&p};
    hipError_t e = hipLaunchCooperativeKernel((const void*)fwd_mega, dim3(grid), dim3(NTHR), args, LDS_BYTES, stream);
    if (e != hipSuccess) fprintf(stderr, "cooperative launch failed: %s (grid %d)\n", hipGetErrorString(e), grid);
}
```

```cpp
#include <hip/hip_runtime.h>
#include <hip/hip_cooperative_groups.h>
#include <cstdio>
#include <cstdint>
namespace cg = cooperative_groups;

namespace pg8 {
#define PG8_LAS __attribute__((address_space(3)))
typedef unsigned short bf16_t;
typedef short bf16x8 __attribute__((ext_vector_type(8)));
typedef float f32x4 __attribute__((ext_vector_type(4)));
typedef unsigned u32x4 __attribute__((ext_vector_type(4)));
constexpr int BM = 256, BK = 64, HALF = 128, HTB = HALF * BK * 2  , STAGE_BYTES = 8 * HTB, NXCD = 8, WGM = 8;

__host__ __device__ __forceinline__ int lds_byte(int r, int c) { const int st = (r >> 4) * 2 + (c >> 5), rr = r & 15, cc = c & 31, ob = rr * 64 + cc * 2; return st * 1024 + (ob ^ (((ob >> 9) & 1) << 5)); }
__host__ __device__ __forceinline__ void stage_rc(int b, int& R, int& C) { const int st = b / 1024, sb = b % 1024, swz = sb ^ (((sb >> 9) & 1) << 5); R = (st >> 1) * 16 + swz / 64; C = (st & 1) * 32 + (swz % 64) / 2; }
__host__ __device__ __forceinline__ int perm32(int rho) { const int n = rho >> 4, i = rho & 15; return 8 * (i >> 2) + 4 * n + (i & 3); }

struct Unit { int pm, pn; };
struct Gemm { const bf16_t* A; const bf16_t* Bt; int M, N, K; };

struct StaticOrder {
    int nM, nN, nwg, G, c;
    __host__ __device__ void init(int M, int N, int G_, int c_) { nM = M / BM; nN = N / BM; nwg = nM * nN; G = G_; c = c_; }
    __host__ __device__ bool next(int i, Unit& u) const {
        const long L = (long)i * G + c; if (L >= nwg) return false;
        int wgid = (int)L; { const int q = nwg / NXCD, r = nwg % NXCD, xcd = wgid % NXCD, off = wgid / NXCD; wgid = (xcd < r ? xcd * (q + 1) : r * (q + 1) + (xcd - r) * q) + off; }
        const int nig = WGM * nN, gid = wgid / nig, fm = gid * WGM, gsz = (nM - fm) < WGM ? (nM - fm) : WGM;
        u.pm = fm + ((wgid % nig) % gsz); u.pn = (wgid % nig) / gsz; return true;
    }
    __device__ __forceinline__ void a_ready(const Unit&) const {}
    __device__ __forceinline__ void done(const Unit&) const {}
};

__device__ __forceinline__ unsigned cvt_pk_bf16(float lo, float hi) { unsigned r; asm volatile("v_cvt_pk_bf16_f32 %0, %1, %2" : "=v"(r) : "v"(lo), "v"(hi)); return r; }

struct EpiStoreF32 {
    static constexpr bool PERM = true, AFTER_DRAIN = false;
    float* O; int ldc;
    __device__ __forceinline__ void operator()(const f32x4 (&acc)[2][2][4][2], const Unit& u, int wr, int wc, int fr, int fq) const {
        const int row0 = u.pm * BM + wr * 64 + fr, col0 = u.pn * BM + wc * 32 + 8 * fq;
#pragma unroll
        for (int ai = 0; ai < 2; ++ai)
#pragma unroll
            for (int m = 0; m < 4; ++m) { float* rowp = O + (size_t)(row0 + ai * HALF + m * 16) * ldc + col0;
#pragma unroll
                for (int bj = 0; bj < 2; ++bj) { *(f32x4*)(rowp + bj * HALF) = acc[ai][bj][m][0]; *(f32x4*)(rowp + bj * HALF + 4) = acc[ai][bj][m][1]; } }
    }
};
struct EpiResAdd {
    static constexpr bool PERM = true, AFTER_DRAIN = false;
    float* O; int ldc;
    __device__ __forceinline__ void operator()(const f32x4 (&acc)[2][2][4][2], const Unit& u, int wr, int wc, int fr, int fq) const {
        const int row0 = u.pm * BM + wr * 64 + fr, col0 = u.pn * BM + wc * 32 + 8 * fq;
#pragma unroll
        for (int ai = 0; ai < 2; ++ai)
#pragma unroll
            for (int m = 0; m < 4; ++m) { float* rowp = O + (size_t)(row0 + ai * HALF + m * 16) * ldc + col0;
#pragma unroll
                for (int bj = 0; bj < 2; ++bj) {
                    f32x4 a = *(const f32x4*)(rowp + bj * HALF), b = *(const f32x4*)(rowp + bj * HALF + 4);
                    *(f32x4*)(rowp + bj * HALF) = a + acc[ai][bj][m][0]; *(f32x4*)(rowp + bj * HALF + 4) = b + acc[ai][bj][m][1]; } }
    }
};
struct EpiSwiGLU {
    static constexpr bool PERM = true, AFTER_DRAIN = false;
    bf16_t* O; int ldc;
    __device__ __forceinline__ void operator()(const f32x4 (&acc)[2][2][4][2], const Unit& u, int wr, int wc, int fr, int fq) const {
        const int row0 = u.pm * BM + wr * 64 + fr, col0 = u.pn * HALF + wc * 32 + 8 * fq;
#pragma unroll
        for (int ai = 0; ai < 2; ++ai)
#pragma unroll
            for (int m = 0; m < 4; ++m) { bf16_t* rowp = O + (size_t)(row0 + ai * HALF + m * 16) * ldc + col0;
                float o[8];
#pragma unroll
                for (int n = 0; n < 2; ++n)
#pragma unroll
                    for (int j = 0; j < 4; ++j) { const float g = acc[ai][0][m][n][j], up = acc[ai][1][m][n][j]; o[n * 4 + j] = g * up * __builtin_amdgcn_rcpf(1.0f + __expf(-g)); }
                u32x4 w; w.x = cvt_pk_bf16(o[0], o[1]); w.y = cvt_pk_bf16(o[2], o[3]); w.z = cvt_pk_bf16(o[4], o[5]); w.w = cvt_pk_bf16(o[6], o[7]);
                *(u32x4*)rowp = w; }
    }
};

template <class Epi, class Sched, bool ALIGN_EPI = false, bool SP2 = false>
__device__ __forceinline__ void gemm_phase(PG8_LAS unsigned char* lds, const Gemm g, const Sched& S, const Epi& E, const int tid) {
    const int wid = __builtin_amdgcn_readfirstlane(tid >> 6), lane = tid & 63, wr = wid >> 2, wc = wid & 3, fr = lane & 15, fq = lane >> 4;
    const int K = g.K, nt = K / BK;
    unsigned voffA[2], voffB[2];
#pragma unroll
    for (int i = 0; i < 2; ++i) { int R, C; stage_rc(tid * 16 + i * 8192, R, C); const int Rb = Epi::PERM ? ((R & ~31) + perm32(R & 31)) : R;
        voffA[i] = (unsigned)(R * K + C) * 2u; voffB[i] = (unsigned)(Rb * K + C) * 2u; }
    const size_t kstep = (size_t)(BK * 2);
    const size_t hstep = (size_t)HALF * K * 2;
    const size_t tstep = 2 * hstep;
    const unsigned ldsw = (unsigned)wid * 1024u;
    const int aoff = lds_byte(wr * 64 + fr, fq * 8), boff = lds_byte(wc * 32 + fr, fq * 8);
#define PG8_SA(b, h) (((b) * 2 + (h)) * HTB)
#define PG8_SB(b, h) ((4 + (b) * 2 + (h)) * HTB)
#define PG8_STAGE(bufoff, gbase, voff) do { _Pragma("unroll") for (int _i = 0; _i < 2; ++_i) \
        __builtin_amdgcn_global_load_lds((const unsigned*)((const char*)(gbase) + (voff)[_i]), (PG8_LAS unsigned*)(lds + (bufoff) + ldsw + _i * 8192), 16, 0, 0); } while (0)
#define PG8_LDA(dst, b, h) do { _Pragma("unroll") for (int m = 0; m < 4; ++m) _Pragma("unroll") for (int k = 0; k < 2; ++k) dst[m][k] = *(const PG8_LAS bf16x8*)(lds + PG8_SA(b, h) + aoff + m * 2048 + k * 1024); } while (0)
#define PG8_LDB(dst, b, h) do { _Pragma("unroll") for (int n = 0; n < 2; ++n) _Pragma("unroll") for (int k = 0; k < 2; ++k) dst[n][k] = *(const PG8_LAS bf16x8*)(lds + PG8_SB(b, h) + boff + n * 2048 + k * 1024); } while (0)
#define PG8_MMA(ai, bj, At, Bt) do { __builtin_amdgcn_s_setprio(1); _Pragma("unroll") for (int m = 0; m < 4; ++m) _Pragma("unroll") for (int n = 0; n < 2; ++n) _Pragma("unroll") for (int k = 0; k < 2; ++k) \
        acc[ai][bj][m][n] = __builtin_amdgcn_mfma_f32_16x16x32_bf16(Bt[n][k], At[m][k], acc[ai][bj][m][n], 0, 0, 0); __builtin_amdgcn_s_setprio(0); } while (0)
#define PG8_WAIT_V(n) asm volatile("s_waitcnt vmcnt(" #n ")" ::: "memory")
#define PG8_WAIT_L(n) asm volatile("s_waitcnt lgkmcnt(" #n ")" ::: "memory")
#define PG8_BAR __builtin_amdgcn_s_barrier()
#define PG8_SCHED __builtin_amdgcn_sched_barrier(0)
    Unit cur, nxt; int ui = 0;
    if (!S.next(0, cur)) return;
    f32x4 acc[2][2][4][2];
#pragma unroll
    for (int a = 0; a < 2; ++a)
#pragma unroll
        for (int b = 0; b < 2; ++b)
#pragma unroll
            for (int m = 0; m < 4; ++m)
#pragma unroll
                for (int n = 0; n < 2; ++n) acc[a][b][m][n] = (f32x4){0.f, 0.f, 0.f, 0.f};
    bf16x8 At[4][2], B0[2][2], B1[2][2];
    const char* cA = (const char*)g.A + (size_t)cur.pm * tstep; const char* cB = (const char*)g.Bt + (size_t)cur.pn * tstep;
    S.a_ready(cur);
    if constexpr (SP2) {
        PG8_STAGE(PG8_SB(0, 0), cB, voffB); PG8_STAGE(PG8_SB(0, 1), cB + hstep, voffB); PG8_STAGE(PG8_SA(0, 0), cA, voffA); PG8_STAGE(PG8_SA(0, 1), cA + hstep, voffA);
        if (wr == 1) PG8_BAR;
        PG8_WAIT_V(2); PG8_BAR;
        PG8_STAGE(PG8_SB(1, 0), cB + kstep, voffB); PG8_STAGE(PG8_SA(1, 0), cA + kstep, voffA); PG8_STAGE(PG8_SB(1, 1), cB + hstep + kstep, voffB);
        PG8_WAIT_V(6); PG8_BAR;
    } else {
        PG8_STAGE(PG8_SB(0, 0), cB, voffB); PG8_STAGE(PG8_SA(0, 0), cA, voffA); PG8_STAGE(PG8_SB(0, 1), cB + hstep, voffB); PG8_STAGE(PG8_SA(0, 1), cA + hstep, voffA);
        if (wr == 1) PG8_BAR;
        PG8_WAIT_V(4); PG8_BAR;
        PG8_STAGE(PG8_SB(1, 0), cB + kstep, voffB); PG8_STAGE(PG8_SA(1, 0), cA + kstep, voffA); PG8_STAGE(PG8_SB(1, 1), cB + hstep + kstep, voffB);
        PG8_WAIT_V(6); PG8_BAR;
    }
    for (;;) {
        const bool has_next = S.next(ui + 1, nxt);
        const char* nA = has_next ? (const char*)g.A + (size_t)nxt.pm * tstep : cA; const char* nB = has_next ? (const char*)g.Bt + (size_t)nxt.pn * tstep : cB;
        for (int t = 0; t < nt; t += 2) {
            const bool last = (t == nt - 2);
            const char* a1 = cA + (size_t)(t + 1) * kstep;
            const char* a2 = last ? nA : cA + (size_t)(t + 2) * kstep; const char* b2 = last ? nB : cB + (size_t)(t + 2) * kstep;
            const char* a3 = a2 + kstep; const char* b3 = b2 + kstep;
            if (last && has_next) S.a_ready(nxt);
            if constexpr (SP2) {
            PG8_LDB(B0, 0, 0); PG8_LDB(B1, 0, 1); PG8_SCHED; PG8_LDA(At, 0, 0); PG8_STAGE(PG8_SA(1, 1), a1 + hstep, voffA);
            PG8_WAIT_V(8); PG8_WAIT_L(0); PG8_BAR; PG8_MMA(0, 0, At, B0); PG8_MMA(0, 1, At, B1); PG8_BAR; PG8_SCHED;
            PG8_LDA(At, 0, 1); PG8_STAGE(PG8_SB(0, 0), b2, voffB); PG8_STAGE(PG8_SB(0, 1), b2 + hstep, voffB); PG8_STAGE(PG8_SA(0, 0), a2, voffA);
            PG8_WAIT_V(8); PG8_WAIT_L(0); PG8_BAR; PG8_MMA(1, 0, At, B0); PG8_MMA(1, 1, At, B1); PG8_BAR; PG8_SCHED;
            PG8_LDB(B0, 1, 0); PG8_LDB(B1, 1, 1); PG8_SCHED; PG8_LDA(At, 1, 0); PG8_STAGE(PG8_SA(0, 1), a2 + hstep, voffA);
            PG8_WAIT_V(8); PG8_WAIT_L(0); PG8_BAR; PG8_MMA(0, 0, At, B0); PG8_MMA(0, 1, At, B1); PG8_BAR; PG8_SCHED;
            PG8_LDA(At, 1, 1); PG8_STAGE(PG8_SB(1, 0), b3, voffB); PG8_STAGE(PG8_SB(1, 1), b3 + hstep, voffB); PG8_STAGE(PG8_SA(1, 0), a3, voffA);
            PG8_WAIT_V(8); PG8_WAIT_L(0); PG8_BAR; PG8_MMA(1, 0, At, B0); PG8_MMA(1, 1, At, B1); PG8_BAR; PG8_SCHED;
            } else {
            PG8_LDB(B0, 0, 0); PG8_SCHED; PG8_LDA(At, 0, 0); PG8_STAGE(PG8_SA(1, 1), a1 + hstep, voffA);
            PG8_WAIT_L(8); PG8_BAR; PG8_WAIT_L(0); PG8_MMA(0, 0, At, B0); PG8_BAR; PG8_SCHED;
            PG8_LDB(B1, 0, 1); PG8_STAGE(PG8_SB(0, 0), b2, voffB);
            PG8_BAR; PG8_WAIT_L(0); PG8_MMA(0, 1, At, B1); PG8_BAR;
            PG8_LDA(At, 0, 1); PG8_STAGE(PG8_SA(0, 0), a2, voffA);
            PG8_BAR; PG8_WAIT_L(0); PG8_MMA(1, 0, At, B0); PG8_BAR; PG8_SCHED;
            PG8_STAGE(PG8_SB(0, 1), b2 + hstep, voffB);
            PG8_WAIT_V(6); PG8_BAR; PG8_MMA(1, 1, At, B1); PG8_BAR;
            PG8_LDB(B0, 1, 0); PG8_SCHED; PG8_LDA(At, 1, 0); PG8_STAGE(PG8_SA(0, 1), a2 + hstep, voffA);
            PG8_WAIT_L(8); PG8_BAR; PG8_WAIT_L(0); PG8_MMA(0, 0, At, B0); PG8_BAR; PG8_SCHED;
            PG8_LDB(B1, 1, 1); PG8_STAGE(PG8_SB(1, 0), b3, voffB);
            PG8_BAR; PG8_WAIT_L(0); PG8_MMA(0, 1, At, B1); PG8_BAR;
            PG8_LDA(At, 1, 1); PG8_STAGE(PG8_SA(1, 0), a3, voffA);
            PG8_BAR; PG8_WAIT_L(0); PG8_MMA(1, 0, At, B0); PG8_BAR; PG8_SCHED;
            PG8_STAGE(PG8_SB(1, 1), b3 + hstep, voffB);
            PG8_WAIT_V(6); PG8_BAR; PG8_MMA(1, 1, At, B1); PG8_BAR;
            }
        }
        if constexpr (ALIGN_EPI) { if (wr == 0) PG8_BAR; }
        if constexpr (!Epi::AFTER_DRAIN) { E(acc, cur, wr, wc, fr, fq); S.done(cur); }
        if (!has_next) break;
#pragma unroll
        for (int a = 0; a < 2; ++a)
#pragma unroll
            for (int b = 0; b < 2; ++b)
#pragma unroll
                for (int m = 0; m < 4; ++m)
#pragma unroll
                    for (int n = 0; n < 2; ++n) acc[a][b][m][n] = (f32x4){0.f, 0.f, 0.f, 0.f};
        cur = nxt; cA = nA; cB = nB; ++ui;
        if constexpr (ALIGN_EPI) { if (wr == 1) PG8_BAR; }
    }
    PG8_WAIT_V(0);
    if constexpr (!ALIGN_EPI) { if (wr == 0) PG8_BAR; }
    PG8_BAR;
    if constexpr (Epi::AFTER_DRAIN) { E.fused(acc, cur, wr, wc, fr, fq, lds, wid, lane); S.done(cur); }
#undef PG8_SA
#undef PG8_SB
#undef PG8_STAGE
#undef PG8_LDA
#undef PG8_LDB
#undef PG8_MMA
#undef PG8_WAIT_V
#undef PG8_WAIT_L
#undef PG8_BAR
#undef PG8_SCHED
}
}

#define LAS __attribute__((address_space(3)))
typedef unsigned short bf16;
typedef float f32x4 __attribute__((ext_vector_type(4)));
typedef float f32x2 __attribute__((ext_vector_type(2)));
typedef unsigned u32x4 __attribute__((ext_vector_type(4)));
typedef unsigned u32x2 __attribute__((ext_vector_type(2)));
typedef short bfx8 __attribute__((ext_vector_type(8)));
#define XB_TMO      128
#define XB_XCNT(j)  (256  + 64 * (j))
#define XB_XSUB(j)  (1280 + 64 * (j))
#define XB_XGEN(j)  (2304 + 64 * (j))
#define XB_TOP      3328
#define XB_TOPGEN   3392
#define XCD_BAR_WORDS 3456
#define XB_SPIN_CAP (1u << 18)

__device__ __forceinline__ unsigned xb_ld(unsigned* p)              { return __hip_atomic_load(p, __ATOMIC_RELAXED, __HIP_MEMORY_SCOPE_AGENT); }
__device__ __forceinline__ unsigned xb_add(unsigned* p, unsigned v) { return __hip_atomic_fetch_add(p, v, __ATOMIC_RELAXED, __HIP_MEMORY_SCOPE_AGENT); }
__device__ __forceinline__ unsigned xb_xcc_id() { return (unsigned)__builtin_amdgcn_s_getreg((3 << 11) | 20) & 0xFu; }
#define XB_SPIN(cond, bar) do { unsigned _sp = 0; while (cond) { __builtin_amdgcn_s_sleep(1); \
    if ((++_sp & 255u) == 0u) { if (xb_ld(&(bar)[XB_TMO])) break; if (_sp > XB_SPIN_CAP) { atomicAdd(&(bar)[XB_TMO], 1u); break; } } } } while (0)

struct XcdBarrier {
    unsigned* bar; unsigned x;
    volatile LAS unsigned* st;
};

__device__ __forceinline__ XcdBarrier xcd_barrier_post(unsigned* bar, volatile LAS unsigned* st, int tid) {
    XcdBarrier b; b.bar = bar; b.x = xb_xcc_id(); b.st = st;
    if (tid == 0) (void)xb_add(&bar[XB_XCNT(b.x)], 1u);
    return b;
}
__device__ __forceinline__ void xcd_barrier_complete(unsigned* bar, unsigned x, unsigned& nloc, unsigned& nx) {
    const unsigned G = gridDim.x * gridDim.y * gridDim.z;
    unsigned sum, cnt, mine, sp = 0u;
    for (;;) {
        sum = 0u; cnt = 0u; mine = 0u;
#pragma unroll
        for (unsigned j = 0; j < 16; ++j) { const unsigned c = xb_ld(&bar[XB_XCNT(j)]); sum += c; cnt += (c > 0u) ? 1u : 0u; mine = (j == x) ? c : mine; }
        if (sum == G) break;
        __builtin_amdgcn_s_sleep(1);
        if ((++sp & 255u) == 0u) { if (xb_ld(&bar[XB_TMO])) break; if (sp > XB_SPIN_CAP) { atomicAdd(&bar[XB_TMO], 1u); break; } }
    }
    nloc = mine > 0u ? mine : 1u; nx = cnt > 0u ? cnt : 1u;
}

__device__ __forceinline__ void xcd_barrier(const XcdBarrier& b, int tid) {
    asm volatile("s_waitcnt vmcnt(0)" ::: "memory");
    __syncthreads();
    if (tid == 0) {
        unsigned* bar = b.bar;
        __builtin_amdgcn_s_waitcnt(0);
        unsigned nloc = b.st[0], nx = b.st[1];
        if (nloc == 0u) { xcd_barrier_complete(bar, b.x, nloc, nx); b.st[0] = nloc; b.st[1] = nx; }
        const unsigned old = xb_add(&bar[XB_XSUB(b.x)], 1u);
        const unsigned gen = old / nloc;
        if (old + 1u == (gen + 1u) * nloc) {
            __builtin_amdgcn_fence(__ATOMIC_RELEASE, "agent");
            asm volatile("s_waitcnt vmcnt(0)" ::: "memory");
            const unsigned og = xb_add(&bar[XB_TOP], 1u);
            const unsigned tg = og / nx;
            if (og + 1u == (tg + 1u) * nx) xb_add(&bar[XB_TOPGEN], 1u);
            else XB_SPIN(xb_ld(&bar[XB_TOPGEN]) == tg, bar);
            __builtin_amdgcn_fence(__ATOMIC_ACQUIRE, "agent");
            xb_add(&bar[XB_XGEN(b.x)], 1u);
            asm volatile("s_waitcnt vmcnt(0)" ::: "memory");
        } else {
            XB_SPIN(xb_ld(&bar[XB_XGEN(b.x)]) == gen, bar);
            __builtin_amdgcn_fence(__ATOMIC_ACQUIRE, "agent");
            asm volatile("s_waitcnt vmcnt(0)" ::: "memory");
        }
    }
    __syncthreads();
}

constexpr int NWAVES = 8, NTHR = 512;
constexpr int TP = 8192, TS = 1024, T = 9216, D = 2048, NIN = 4800, NZ = 4864, FF = 5632, NGU = 11264;
constexpr int NH = 16, HS = 64, RD = 1024, RP = 3264, DEPTH = 4;
constexpr int ZQ = 1536;
constexpr float RMS_EPS = 1e-6f, LN_EPS = 1e-5f, GN_EPS = 64e-5f;
constexpr int SCR = 384;
constexpr size_t O_Y = 0;
constexpr size_t O_CONV_P = (size_t)T * D;
constexpr size_t O_POOL_P = O_CONV_P + (size_t)DEPTH * 4 * 30 * 512;
constexpr size_t O_SHIFT_P = O_POOL_P + (size_t)DEPTH * 4 * 15 * 512;
constexpr size_t O_WKV_P = O_SHIFT_P + (size_t)DEPTH * 4 * RP;
constexpr size_t O_CONV_S = O_WKV_P + (size_t)DEPTH * 4 * NH * 4096;
constexpr size_t O_POOL_S = O_CONV_S + (size_t)DEPTH * 16 * 30 * 512;
constexpr size_t O_SHIFT_S = O_POOL_S + (size_t)DEPTH * 16 * 15 * 512;
constexpr size_t O_WKV_S = O_SHIFT_S + (size_t)DEPTH * 16 * RP;
constexpr size_t O_END = O_WKV_S + (size_t)DEPTH * 16 * NH * 4096;
constexpr size_t WS_POOLW = 131072;
constexpr size_t WS_UPS = 262144;
constexpr size_t WS_WIN = 1u << 20;
constexpr size_t WS_WOUT = WS_WIN + (size_t)NZ * D * 2;
constexpr size_t WS_WGU = WS_WOUT + (size_t)D * D * 2;
constexpr size_t WS_WDN = WS_WGU + (size_t)NGU * D * 2;
constexpr size_t WS_X = WS_WDN + (size_t)D * FF * 2;
constexpr size_t WS_XN = WS_X + (size_t)T * D * 4;
constexpr size_t WS_MIX = WS_XN + (size_t)T * D * 2;
constexpr size_t WS_Z = WS_MIX + (size_t)T * D * 2;
constexpr size_t WS_ACT = WS_Z;
constexpr size_t WS_SC = WS_Z + (size_t)T * NZ * 4;
constexpr size_t WS_Y = WS_SC + (size_t)T * NH * SCR * 4;
constexpr size_t WS_G = WS_Y + (size_t)T * RD * 4;
constexpr size_t WS_RK = WS_G + (size_t)T * RD * 4;
constexpr int NC = 16, CL = 128;
constexpr size_t WS_PQ = WS_RK + (size_t)T * NH * 4;
constexpr size_t WS_S0 = WS_PQ + (size_t)64 * NC * 2 * 4096 * 4;
constexpr size_t WS_GB = WS_S0 + (size_t)64 * NC * 4096 * 4;
constexpr size_t WS_END = WS_GB + (size_t)TP * RD * 4;
static_assert((size_t)T * FF * 2 <= (size_t)T * NZ * 4, "act overlay fits in z");
constexpr int LDS_BYTES = 147456;

#ifndef REP_PREP
#define REP_PREP 1
#endif
#ifndef REP_POOL
#define REP_POOL 1
#endif
#ifndef REP_CONV
#define REP_CONV 1
#endif
#ifndef REP_P1
#define REP_P1 1
#endif
#ifndef REP_CB
#define REP_CB 1
#endif
#ifndef REP_MIXA
#define REP_MIXA 1
#endif
#ifndef REP_SCAN
#define REP_SCAN 1
#endif
#ifndef REP_POST
#define REP_POST 1
#endif
#ifndef REP_CVT
#define REP_CVT 1
#endif
#ifdef NO_SYNC
#define GSYNC() __syncthreads()
#else
#define GSYNC() do { int w_ = wave0; asm volatile("" : "+s"(w_)); xcd_barrier(xbar, w_ * 64 + (int)__builtin_amdgcn_mbcnt_hi(~0u, __builtin_amdgcn_mbcnt_lo(~0u, (unsigned)launder_v(0)))); } while (0)
#endif
struct Params { const float* in[31]; float* out; unsigned char* ws; };
typedef const __attribute__((address_space(4))) Params* KP;
__device__ __forceinline__ KP kargs() { KP k = (KP)__builtin_amdgcn_kernarg_segment_ptr(); asm volatile("" : "+s"(k)); return k; }
__device__ __forceinline__ int launder_v(int v) { asm volatile("" : "+v"(v)); return v; }
#define PH_BEGIN() KP kp = kargs(); int wave_ = wave0; asm volatile("" : "+s"(wave_)); const int wave = wave_; const int lane = (int)__builtin_amdgcn_mbcnt_hi(~0u, __builtin_amdgcn_mbcnt_lo(~0u, (unsigned)launder_v(0))); const int tid = wave * 64 + lane; \
    const int nb = gridDim.x, bid = blockIdx.x, gw = bid * NWAVES + wave, ngw = nb * NWAVES; unsigned char* const ws = kp->ws; (void)lane; (void)wave; (void)gw; (void)ngw; (void)ws; (void)nb; (void)bid

__device__ __forceinline__ float wave_sum(float v) {
#pragma unroll
    for (int o = 1; o < 64; o <<= 1) v += __shfl_xor(v, o);
    return v;
}
__device__ __forceinline__ unsigned f2bf(float f) { unsigned u = __builtin_bit_cast(unsigned, f); return (u + 0x7fffu + ((u >> 16) & 1u)) >> 16; }
__device__ __forceinline__ unsigned pk2(float lo, float hi) { return f2bf(lo) | (f2bf(hi) << 16); }
__device__ __forceinline__ float sigm(float x) { return 1.0f / (1.0f + __expf(-x)); }

__device__ __forceinline__ void transpose_item(const float* W, int K, int N, bf16* WT, int mode, LAS float* scr, int item, int lane) {
    const int nblk = N / 32, kb = item / nblk, nb = item % nblk, k0 = 64 * kb, n0 = 32 * nb;
    const int drow0 = (mode == 0) ? n0 : ((n0 >> 7) * 256 + (n0 & 127) + (mode == 2 ? 128 : 0));
#pragma unroll 8
    for (int i = 0; i < 32; ++i) { const int kk = 2 * i + (lane >> 5); scr[kk * 33 + (lane & 31)] = W[(size_t)(k0 + kk) * N + n0 + (lane & 31)]; }
    asm volatile("s_waitcnt lgkmcnt(0)" ::: "memory");
    const int c = lane & 7;
#pragma unroll
    for (int j = 0; j < 4; ++j) { const int n = (lane >> 3) + 8 * j; const LAS float* s = scr + (8 * c) * 33 + n;
        u32x4 o; o.x = pk2(s[0 * 33], s[1 * 33]); o.y = pk2(s[2 * 33], s[3 * 33]); o.z = pk2(s[4 * 33], s[5 * 33]); o.w = pk2(s[6 * 33], s[7 * 33]);
        *(u32x4*)(WT + (size_t)(drow0 + n) * K + k0 + 8 * c) = o; }
    asm volatile("s_waitcnt lgkmcnt(0)" ::: "memory");
}
__device__ __forceinline__ void convert_weights(KP kp, int l, LAS unsigned char* lds, int gw, int ngw, int wave, int lane) {
    LAS float* scr = (LAS float*)(lds + wave * 16384);
    unsigned char* ws = kp->ws;
    bf16* WIN = (bf16*)(ws + WS_WIN); bf16* WOUT = (bf16*)(ws + WS_WOUT); bf16* WGU = (bf16*)(ws + WS_WGU); bf16* WDN = (bf16*)(ws + WS_WDN);
    constexpr int I_IN = (D / 64) * (NIN / 32), I_OUT = (D / 64) * (D / 32), I_G = (D / 64) * (FF / 32), I_D = (FF / 64) * (D / 32);
    constexpr int I_P = 4 * 8, I_U = 3 * 32;
    constexpr int NITEMS = I_IN + I_OUT + 2 * I_G + I_D + I_P + I_U;
    for (int it = gw; it < NITEMS; it += ngw) {
        int r = it;
        if (r < I_IN) { transpose_item(kp->in[7] + (size_t)l * D * NIN, D, NIN, WIN, 0, scr, r, lane); continue; } r -= I_IN;
        if (r < I_OUT) { transpose_item(kp->in[25] + (size_t)l * D * D, D, D, WOUT, 0, scr, r, lane); continue; } r -= I_OUT;
        if (r < I_G) { transpose_item(kp->in[27] + (size_t)l * D * FF, D, FF, WGU, 1, scr, r, lane); continue; } r -= I_G;
        if (r < I_G) { transpose_item(kp->in[28] + (size_t)l * D * FF, D, FF, WGU, 2, scr, r, lane); continue; } r -= I_G;
        if (r < I_D) { transpose_item(kp->in[29] + (size_t)l * FF * D, FF, D, WDN, 0, scr, r, lane); continue; } r -= I_D;
        if (r < I_P) { const int g = r >> 3; transpose_item(kp->in[12] + (size_t)((l * 4 + g) * 128) * 128, 128, 128, (bf16*)(ws + WS_POOLW) + (size_t)g * 128 * 128, 0, scr, r & 7, lane); continue; } r -= I_P;
        { const int m = r >> 5; const float* src = (m == 0 ? kp->in[16] : (m == 1 ? kp->in[18] : kp->in[19])) + (size_t)l * 64 * RD;
          transpose_item(src, 64, RD, (bf16*)(ws + WS_UPS) + (size_t)m * RD * 64, 0, scr, r & 31, lane); }
    }
    { const unsigned z = (unsigned)launder_v(0); for (int e = gw * 64 + lane; e < 16384; e += ngw * 64) ((u32x4*)(WIN + (size_t)NIN * D))[e] = (u32x4){z, z, z, z}; }
}
__device__ __forceinline__ void norm_rows(const float* sa, const float* sb, const float* g, float* xcopy, bf16* xn, float* fout, int gw, int ngw, int lane) {
    for (int m = gw; m < T; m += ngw) {
        const float* row = (m < TP) ? sa + (size_t)m * D : sb + (size_t)(m - TP) * D;
        f32x4 v[8]; float ss = 0.f;
#pragma unroll
        for (int j = 0; j < 8; ++j) { v[j] = ((const f32x4*)row)[lane + 64 * j]; ss += (v[j].x * v[j].x + v[j].y * v[j].y) + (v[j].z * v[j].z + v[j].w * v[j].w); }
        const float rinv = 1.0f / sqrtf(wave_sum(ss) * (1.0f / D) + RMS_EPS);
#pragma unroll
        for (int j = 0; j < 8; ++j) {
            if (xcopy) ((f32x4*)(xcopy + (size_t)m * D))[lane + 64 * j] = v[j];
            const f32x4 gj = ((const f32x4*)g)[lane + 64 * j];
            const f32x4 y = v[j] * rinv * gj;
            if (xn) { u32x2 o; o.x = pk2(y.x, y.y); o.y = pk2(y.z, y.w); ((u32x2*)(xn + (size_t)m * D))[lane + 64 * j] = o; }
            if (fout) ((f32x4*)(fout + (size_t)m * D))[lane + 64 * j] = y;
        }
    }
}

__device__ __forceinline__ void conv_item(KP kp, int l, int item, LAS float* lds, int tid_in) {
    const int tid = launder_v(tid_in);
    const float* Z = (const float*)(kp->ws + WS_Z); bf16* MIX = (bf16*)(kp->ws + WS_MIX);
    const int t0 = item * 32;
    int s, tau0, Ls; bool prompt;
    if (t0 < TP) { s = t0 >> 11; tau0 = t0 & 2047; Ls = 2048; prompt = true; } else { s = (t0 - TP) >> 6; tau0 = (t0 - TP) & 63; Ls = 64; prompt = false; }
    const int c = tid;
    const float* cw = kp->in[8] + (size_t)l * 31 * 512;
    float w[31];
#pragma unroll
    for (int j = 0; j < 31; ++j) w[j] = cw[j * 512 + c];
    const float bias = kp->in[9][l * 512 + c];
    float acc[32];
#pragma unroll
    for (int i = 0; i < 32; ++i) acc[i] = bias;
    const bool first = (tau0 == 0), lastit = (tau0 + 32 == Ls);
    float* oc = prompt ? kp->out + O_CONV_P + (size_t)((l * 4 + s) * 30) * 512 : kp->out + O_CONV_S + (size_t)((l * 16 + s) * 30) * 512;
    const float* cc = kp->in[2] + (size_t)((l * 16 + s) * 30) * 512;
#pragma unroll
    for (int ii = 0; ii < 62; ++ii) {
        float u;
        if (ii < 30 && first) { u = prompt ? 0.f : cc[ii * 512 + c]; }
        else { const float* zr = Z + (size_t)(t0 + ii - 30) * NZ; const float val = zr[c], gate = zr[512 + c]; u = val * sigm(gate); }
        if (ii >= 32 && lastit) oc[(ii - 32) * 512 + c] = u;
#pragma unroll
        for (int oi = 0; oi < 32; ++oi) { const int j = ii - oi; if (j >= 0 && j <= 30) acc[oi] += w[j] * u; }
    }
#pragma unroll
    for (int oi = 0; oi < 32; ++oi) lds[oi * 512 + c] = acc[oi];
    __syncthreads();
    const int wave = tid >> 6, lane = tid & 63;
    const f32x4 g0 = *(const f32x4*)(kp->in[10] + l * 512 + lane * 8), g1 = *(const f32x4*)(kp->in[10] + l * 512 + lane * 8 + 4);
    const f32x4 b0 = *(const f32x4*)(kp->in[11] + l * 512 + lane * 8), b1 = *(const f32x4*)(kp->in[11] + l * 512 + lane * 8 + 4);
#pragma unroll
    for (int q = 0; q < 4; ++q) {
        const int oi = wave * 4 + q;
        f32x4 a = *(const LAS f32x4*)(lds + oi * 512 + lane * 8), b = *(const LAS f32x4*)(lds + oi * 512 + lane * 8 + 4);
        const float mean = wave_sum((a.x + a.y) + (a.z + a.w) + (b.x + b.y) + (b.z + b.w)) * (1.0f / 512.0f);
        a = a - mean; b = b - mean;
        const float var = wave_sum((a.x * a.x + a.y * a.y) + (a.z * a.z + a.w * a.w) + (b.x * b.x + b.y * b.y) + (b.z * b.z + b.w * b.w)) * (1.0f / 512.0f);
        const float rstd = 1.0f / sqrtf(var + LN_EPS);
        a = a * rstd * g0 + b0; b = b * rstd * g1 + b1;
        float o[8] = {a.x, a.y, a.z, a.w, b.x, b.y, b.z, b.w};
#pragma unroll
        for (int k = 0; k < 8; ++k) o[k] = o[k] * sigm(o[k]);
        u32x4 wv; wv.x = pk2(o[0], o[1]); wv.y = pk2(o[2], o[3]); wv.z = pk2(o[4], o[5]); wv.w = pk2(o[6], o[7]);
        *(u32x4*)(MIX + (size_t)(t0 + oi) * D + lane * 8) = wv;
    }
    __syncthreads();
}
__device__ __forceinline__ void pool_item(KP kp, int l, int item, LAS unsigned char* ldsb, int tid_in) {
    const int tid = launder_v(tid_in);
    const float* Z = (const float*)(kp->ws + WS_Z); bf16* MIX = (bf16*)(kp->ws + WS_MIX);
    LAS float* pp = (LAS float*)ldsb;
    LAS bf16* db = (LAS bf16*)(ldsb + 47 * 512 * 4);
    const int t0 = item * 32;
    int s, tau0, Ls; bool prompt;
    if (t0 < TP) { s = t0 >> 11; tau0 = t0 & 2047; Ls = 2048; prompt = true; } else { s = (t0 - TP) >> 6; tau0 = (t0 - TP) & 63; Ls = 64; prompt = false; }
    const int c = tid;
    const bool first = (tau0 == 0), lastit = (tau0 + 32 == Ls);
    float* op = prompt ? kp->out + O_POOL_P + (size_t)((l * 4 + s) * 15) * 512 : kp->out + O_POOL_S + (size_t)((l * 16 + s) * 15) * 512;
    const float* cp = kp->in[3] + (size_t)((l * 16 + s) * 15) * 512;
#pragma unroll 16
    for (int ii = 0; ii < 47; ++ii) {
        float val;
        if (ii < 15 && first) val = prompt ? 0.f : cp[ii * 512 + c];
        else val = Z[(size_t)(t0 + ii - 15) * NZ + 1024 + c];
        pp[ii * 512 + c] = val;
        if (ii >= 32 && lastit) op[(ii - 32) * 512 + c] = val;
    }
    const int gi = c >> 7, w = 2 << gi;
    for (int oi = 0; oi < 32; ++oi) {
        float sum = 0.f;
        for (int k = 0; k < w; ++k) sum += pp[(oi + 15 - k) * 512 + c];
        const int cnt = prompt ? min(w, tau0 + oi + 1) : w;
        const float d = sum / (float)cnt - pp[(oi + 15) * 512 + c];
        db[oi * 520 + c] = (bf16)f2bf(d);
    }
    __syncthreads();
    const int lane = tid & 63, wave = tid >> 6, n16 = lane & 15, q = lane >> 4, g = wave >> 1, nh = wave & 1;
    const bf16* WT = (const bf16*)(kp->ws + WS_POOLW) + (size_t)g * 128 * 128;
    bfx8 Bf[4][4];
#pragma unroll
    for (int nt = 0; nt < 4; ++nt)
#pragma unroll
        for (int ks = 0; ks < 4; ++ks) Bf[nt][ks] = *(const bfx8*)(WT + (size_t)(nh * 64 + nt * 16 + n16) * 128 + ks * 32 + q * 8);
    float scale[4];
#pragma unroll
    for (int nt = 0; nt < 4; ++nt) scale[nt] = kp->in[13][l * 512 + g * 128 + nh * 64 + nt * 16 + n16];
#pragma unroll
    for (int mt = 0; mt < 2; ++mt) {
        bfx8 Af[4];
#pragma unroll
        for (int ks = 0; ks < 4; ++ks) Af[ks] = *(const LAS bfx8*)(db + (mt * 16 + n16) * 520 + g * 128 + ks * 32 + q * 8);
        f32x4 acc[4];
#pragma unroll
        for (int nt = 0; nt < 4; ++nt) { acc[nt] = (f32x4){0.f, 0.f, 0.f, 0.f};
#pragma unroll
            for (int ks = 0; ks < 4; ++ks) acc[nt] = __builtin_amdgcn_mfma_f32_16x16x32_bf16(Af[ks], Bf[nt][ks], acc[nt], 0, 0, 0); }
#pragma unroll
        for (int nt = 0; nt < 4; ++nt)
#pragma unroll
            for (int r = 0; r < 4; ++r) MIX[(size_t)(t0 + mt * 16 + 4 * q + r) * D + 512 + g * 128 + nh * 64 + nt * 16 + n16] = (bf16)f2bf(acc[nt][r] * scale[nt]);
    }
    __syncthreads();
}
__device__ __forceinline__ float rowsum16(float v) { v += __shfl_xor(v, 1); v += __shfl_xor(v, 2); v += __shfl_xor(v, 4); v += __shfl_xor(v, 8); return v; }
__device__ __forceinline__ void prep_item(KP kp, int l, int item, LAS unsigned char* ldsb, int tid_in) {
    const int tid = launder_v(tid_in);
    const float* Z = (const float*)(kp->ws + WS_Z);
    float* SC = (float*)(kp->ws + WS_SC); float* G = (float*)(kp->ws + WS_G); float* RK = (float*)(kp->ws + WS_RK);
    const bf16* UPT = (const bf16*)(kp->ws + WS_UPS);
    LAS bf16* lo = (LAS bf16*)ldsb;
    const int t0 = item * 16;
    int s, tau0, Ls; bool prompt;
    if (t0 < TP) { s = t0 >> 11; tau0 = t0 & 2047; Ls = 2048; prompt = true; } else { s = (t0 - TP) >> 6; tau0 = (t0 - TP) & 63; Ls = 64; prompt = false; }
    const float* mu = kp->in[14] + (size_t)l * RP;
    const float* ssh = kp->in[4] + (size_t)(l * 16 + s) * RP;
    for (int e = tid; e < 16 * 192; e += NTHR) {
        const int tok = e / 192, col = e % 192, zc = 3072 + col, t = t0 + tok, tau = tau0 + tok;
        const float qv = Z[(size_t)t * NZ + ZQ + zc];
        const float qp = tau > 0 ? Z[(size_t)(t - 1) * NZ + ZQ + zc] : (prompt ? 0.f : ssh[zc]);
        const float qs = qv + (qp - qv) * mu[zc];
        const float val = col < 64 ? tanhf(qs) : (col < 128 ? qs : sigm(qs));
        lo[((col >> 6) * 16 + tok) * 72 + (col & 63)] = (bf16)f2bf(val);
    }
    __syncthreads();
    const int lane = tid & 63, wave = tid >> 6, n16 = lane & 15, q = lane >> 4;
#pragma unroll 1
    for (int hh = 0; hh < 2; ++hh) {
        const int h = wave * 2 + hh;
        f32x4 acc[3][4];
#pragma unroll
        for (int m = 0; m < 3; ++m) {
            bfx8 Af[2], Bf[4][2];
#pragma unroll
            for (int ks = 0; ks < 2; ++ks) Af[ks] = *(const LAS bfx8*)(lo + (m * 16 + n16) * 72 + ks * 32 + q * 8);
#pragma unroll
            for (int i = 0; i < 4; ++i)
#pragma unroll
                for (int ks = 0; ks < 2; ++ks) Bf[i][ks] = *(const bfx8*)(UPT + (size_t)(m * RD + h * 64 + i * 16 + n16) * 64 + ks * 32 + q * 8);
#pragma unroll
            for (int i = 0; i < 4; ++i) { acc[m][i] = (f32x4){0.f, 0.f, 0.f, 0.f};
#pragma unroll
                for (int ks = 0; ks < 2; ++ks) acc[m][i] = __builtin_amdgcn_mfma_f32_16x16x32_bf16(Af[ks], Bf[i][ks], acc[m][i], 0, 0, 0); }
        }
        float mur[4], muk[4], muv[4], w0c[4], a0c[4], kkc[4], kac[4], rkc[4], sr[4], sk[4], sv[4];
#pragma unroll
        for (int i = 0; i < 4; ++i) { const int c = h * 64 + i * 16 + n16;
            mur[i] = mu[c]; muk[i] = mu[RD + c]; muv[i] = mu[2 * RD + c];
            w0c[i] = kp->in[15][l * RD + c]; a0c[i] = kp->in[17][l * RD + c]; kkc[i] = kp->in[20][l * RD + c]; kac[i] = kp->in[21][l * RD + c]; rkc[i] = kp->in[22][l * RD + c];
            sr[i] = prompt ? 0.f : ssh[c]; sk[i] = prompt ? 0.f : ssh[RD + c]; sv[i] = prompt ? 0.f : ssh[2 * RD + c]; }
#pragma unroll
        for (int r = 0; r < 4; ++r) {
            const int tok = 4 * q + r, t = t0 + tok, tau = tau0 + tok;
            const float* zr = Z + (size_t)t * NZ + ZQ;
            float rv[4], kv[4], vv[4], av[4], dv[4], kk[4];
            float skk = 0.f;
#pragma unroll
            for (int i = 0; i < 4; ++i) { const int c = h * 64 + i * 16 + n16;
                float rr = zr[c], k = zr[RD + c], v = zr[2 * RD + c];
                float pr, pk, pv;
                if (tau > 0) { pr = zr[c - NZ]; pk = zr[RD + c - NZ]; pv = zr[2 * RD + c - NZ]; } else { pr = sr[i]; pk = sk[i]; pv = sv[i]; }
                rr += (pr - rr) * mur[i]; k += (pk - k) * muk[i]; v += (pv - v) * muv[i];
                const float xw = -(w0c[i] + acc[0][i][r]);
                const float sp = fmaxf(xw, 0.f) + log1pf(expf(-fabsf(xw)));
                dv[i] = expf(-expf(-sp - 0.5f));
                av[i] = sigm(a0c[i] + acc[1][i][r]);
                rv[i] = rr; kv[i] = k; vv[i] = v; kk[i] = k * kkc[i]; skk += kk[i] * kk[i];
                G[(size_t)t * RD + c] = acc[2][i][r];
                }
            skk = rowsum16(skk);
            const float rinv = 1.0f / sqrtf(fmaxf(skk, 1e-24f));
            float srk = 0.f;
#pragma unroll
            for (int i = 0; i < 4; ++i) {
                const float kkn = kk[i] * rinv, kpv = kv[i] * (1.0f + (av[i] - 1.0f) * kac[i]), bb = kkn * av[i];
                srk += rv[i] * kpv * rkc[i];
                float* sc = SC + ((size_t)t * NH + h) * SCR + i * 16 + n16;
                sc[0] = dv[i]; sc[64] = kkn; sc[128] = bb; sc[192] = kpv; sc[256] = rv[i]; sc[320] = vv[i];
            }
            srk = rowsum16(srk);
            if (n16 == 0) RK[t * NH + h] = srk;
            __builtin_amdgcn_sched_barrier(0);
        }
    }
    if (tau0 + 16 == Ls) {
        float* osh = prompt ? kp->out + O_SHIFT_P + (size_t)(l * 4 + s) * RP : kp->out + O_SHIFT_S + (size_t)(l * 16 + s) * RP;
        const float* zr = Z + (size_t)(t0 + 15) * NZ + ZQ;
        for (int e = tid; e < RP; e += NTHR) osh[e] = zr[e];
    }
    __syncthreads();
}

__device__ __forceinline__ void sc_issue(f32x4 (&r)[4], const LAS f32x4* o, int c) {
    if (c < 4) {
#pragma unroll
        for (int i = 0; i < 4; ++i) r[i] = o[16 + 4 * c + i];
    } else { const int j = c - 4; r[0] = o[j]; r[1] = o[32 + j]; r[2] = o[48 + j]; r[3] = o[64 + j]; }
}
template <int MODE>
__device__ __forceinline__ void scan_run(const float* SC, int tg0, int nsteps, int h, LAS float* wl  , int lane,
                                         const float* Sinit, float* Y, float* GB, float* Sout, float* PQout) {
    constexpr int GS = 4, NCH = 20;
    f32x2 S[32];
    f32x2 P[(MODE == 3) ? 32 : 1];
    if (MODE == 3) {
        const int ln = launder_v(lane);
#pragma unroll
        for (int j = 0; j < 32; ++j) { S[j] = (f32x2){0.f, 0.f}; P[j] = (f32x2){(2 * j == ln) ? 1.f : 0.f, (2 * j + 1 == ln) ? 1.f : 0.f}; }
    } else {
#pragma unroll
        for (int j = 0; j < 16; ++j) { const f32x4 v = ((const f32x4*)(Sinit + lane * 64))[j]; S[2 * j] = (f32x2){v.x, v.y}; S[2 * j + 1] = (f32x2){v.z, v.w}; }
    }
#define SC_STAGE(g, buf) do { _Pragma("unroll") for (int s_ = 0; s_ < GS; ++s_) { const float* rec_ = SC + ((size_t)(tg0 + (g) * GS + s_) * NH + h) * SCR + lane; \
        _Pragma("unroll") for (int k_ = 0; k_ < 6; ++k_) __builtin_amdgcn_global_load_lds((const unsigned*)(rec_ + k_ * 64), (LAS unsigned*)(wl + ((buf) * GS + s_) * SCR + k_ * 64), 4, 0, 0); } } while (0)
    SC_STAGE(0, 0);
    const int ngroups = nsteps / GS;
    for (int g = 0; g < ngroups; ++g) {
        asm volatile("s_waitcnt vmcnt(0)" ::: "memory");
        if (g + 1 < ngroups) SC_STAGE(g + 1, (g + 1) & 1);
        const LAS float* wb = wl + (g & 1) * GS * SCR;
        f32x4 R[4][4];
#pragma unroll
        for (int q = 0; q < 3; ++q) sc_issue(R[q & 3], (const LAS f32x4*)(wb + (q / NCH) * SCR), q % NCH);
        __builtin_amdgcn_sched_barrier(0);
#pragma unroll
        for (int s = 0; s < GS; ++s) {
            f32x2 d2a = (f32x2){0.f, 0.f}, y2a = (f32x2){0.f, 0.f};
            f32x2 e2a = (f32x2){0.f, 0.f}, g2a = (f32x2){0.f, 0.f};
            f32x2 sa2 = (f32x2){0.f, 0.f}, sp2 = (f32x2){0.f, 0.f};
            const float vs = wb[s * SCR + 320 + lane];
            const f32x2 v2 = (f32x2){vs, vs};
#pragma unroll
            for (int c = 0; c < NCH; ++c) {
                const int q = s * NCH + c, qn = q + 3;
                if (qn < GS * NCH) sc_issue(R[qn & 3], (const LAS f32x4*)(wb + (qn / NCH) * SCR), qn % NCH);
                __builtin_amdgcn_sched_barrier(0);
                f32x4 (&r)[4] = R[q & 3];
                if (c < 4) {
#pragma unroll
                    for (int i = 0; i < 4; ++i) { const int j = 4 * c + i; d2a += S[2 * j] * (f32x2){r[i].x, r[i].y}; d2a += S[2 * j + 1] * (f32x2){r[i].z, r[i].w};
                        if (MODE == 3) { e2a += P[2 * j] * (f32x2){r[i].x, r[i].y}; e2a += P[2 * j + 1] * (f32x2){r[i].z, r[i].w}; } }
                    if (c == 3) { const f32x2 d2 = d2a; const float sa = -(d2.x + d2.y); sa2 = (f32x2){sa, sa};
                        if (MODE == 3) { const f32x2 e2 = e2a; const float sp = -(e2.x + e2.y); sp2 = (f32x2){sp, sp}; } }
                } else {
                    const int j = c - 4;
                    f32x2 t0 = v2 * (f32x2){r[2].x, r[2].y}; t0 = sa2 * (f32x2){r[1].x, r[1].y} + t0; S[2 * j] = S[2 * j] * (f32x2){r[0].x, r[0].y} + t0;
                    f32x2 t1 = v2 * (f32x2){r[2].z, r[2].w}; t1 = sa2 * (f32x2){r[1].z, r[1].w} + t1; S[2 * j + 1] = S[2 * j + 1] * (f32x2){r[0].z, r[0].w} + t1;
                    y2a += S[2 * j] * (f32x2){r[3].x, r[3].y}; y2a += S[2 * j + 1] * (f32x2){r[3].z, r[3].w};
                    if (MODE == 3) {
                        const f32x2 u0 = sp2 * (f32x2){r[1].x, r[1].y}, u1 = sp2 * (f32x2){r[1].z, r[1].w};
                        P[2 * j] = P[2 * j] * (f32x2){r[0].x, r[0].y} + u0; P[2 * j + 1] = P[2 * j + 1] * (f32x2){r[0].z, r[0].w} + u1;
                        g2a += P[2 * j] * (f32x2){r[3].x, r[3].y}; g2a += P[2 * j + 1] * (f32x2){r[3].z, r[3].w};
                    }
                }
                __builtin_amdgcn_sched_barrier(0);
            }
            { const f32x2 y2 = y2a; Y[(size_t)(tg0 + g * GS + s) * RD + h * 64 + lane] = y2.x + y2.y; }
            if (MODE == 3) { const f32x2 g2 = g2a; GB[(size_t)(tg0 + g * GS + s) * RD + h * 64 + lane] = g2.x + g2.y; }
        }
        asm volatile("s_waitcnt lgkmcnt(0)" ::: "memory");
    }
#undef SC_STAGE
    if (MODE == 3) {
#pragma unroll
        for (int j = 0; j < 16; ++j) { ((f32x4*)PQout)[j * 64 + lane] = (f32x4){P[2 * j].x, P[2 * j].y, P[2 * j + 1].x, P[2 * j + 1].y};
                                       ((f32x4*)(PQout + 4096))[j * 64 + lane] = (f32x4){S[2 * j].x, S[2 * j].y, S[2 * j + 1].x, S[2 * j + 1].y}; }
    } else {
#pragma unroll
        for (int j = 0; j < 16; ++j) ((f32x4*)(Sout + lane * 64))[j] = (f32x4){S[2 * j].x, S[2 * j].y, S[2 * j + 1].x, S[2 * j + 1].y};
    }
}
__device__ __forceinline__ void ycorr_task(const float* GB, float* Y, const float* S0q  , int tg0, int h, int lane) {
    const int n = lane & 15, kq = lane >> 4;
    float Bv[4][16];
#pragma unroll
    for (int nt = 0; nt < 4; ++nt)
#pragma unroll
        for (int ks = 0; ks < 16; ++ks) Bv[nt][ks] = S0q[(size_t)(ks * 64 + nt * 16 + n) * 4 + kq];
#pragma unroll 1
    for (int mt = 0; mt < CL / 16; ++mt) {
        const float* grow = GB + (size_t)(tg0 + mt * 16 + n) * RD + h * 64 + kq;
        float Av[16];
#pragma unroll
        for (int ks = 0; ks < 16; ++ks) Av[ks] = grow[ks * 4];
        f32x4 acc[4];
#pragma unroll
        for (int nt = 0; nt < 4; ++nt) acc[nt] = (f32x4){0.f, 0.f, 0.f, 0.f};
#pragma unroll
        for (int ks = 0; ks < 16; ++ks)
#pragma unroll
            for (int nt = 0; nt < 4; ++nt) acc[nt] = __builtin_amdgcn_mfma_f32_16x16x4f32(Av[ks], Bv[nt][ks], acc[nt], 0, 0, 0);
#pragma unroll
        for (int nt = 0; nt < 4; ++nt)
#pragma unroll
            for (int r = 0; r < 4; ++r) { float* yp = Y + (size_t)(tg0 + mt * 16 + 4 * kq + r) * RD + h * 64 + nt * 16 + n; *yp += acc[nt][r]; }
    }
}
__device__ __forceinline__ void combine_chain(const float* PQ, float* S0, float* Sfin, LAS unsigned char* lds, int tid, int wave, int lane) {
    LAS f32x4* pl = (LAS f32x4*)lds;
    LAS f32x4* xch = (LAS f32x4*)(lds + 16384);
    f32x2 S[32];
#pragma unroll
    for (int j = 0; j < 32; ++j) S[j] = (f32x2){0.f, 0.f};
    const int n4a = 2 * wave, n4b = 2 * wave + 1;
    const f32x4* Pc = (const f32x4*)PQ;
    f32x4 p0 = Pc[tid], p1 = Pc[tid + 512];
    for (int c = 0; c < NC; ++c) {
        const f32x4* Qc = (const f32x4*)(PQ + (size_t)(c * 2 + 1) * 4096);
        pl[tid] = p0; pl[tid + 512] = p1;
        f32x4 na = Qc[n4a * 64 + lane], nb = Qc[n4b * 64 + lane];
        if (c + 1 < NC) { const f32x4* Pn = (const f32x4*)(PQ + (size_t)((c + 1) * 2) * 4096); p0 = Pn[tid]; p1 = Pn[tid + 512]; }
        __syncthreads();
        f32x2 a0 = (f32x2){na.x, na.y}, a1 = (f32x2){na.z, na.w}, b0 = (f32x2){nb.x, nb.y}, b1 = (f32x2){nb.z, nb.w};
#pragma unroll
        for (int j = 0; j < 32; ++j) {
            const f32x4 pa0 = pl[n4a * 64 + 2 * j], pb0 = pl[n4b * 64 + 2 * j], pa1 = pl[n4a * 64 + 2 * j + 1], pb1 = pl[n4b * 64 + 2 * j + 1];
            const f32x2 s0 = (f32x2){S[j].x, S[j].x}, s1 = (f32x2){S[j].y, S[j].y};
            a0 += s0 * (f32x2){pa0.x, pa0.y}; a1 += s0 * (f32x2){pa0.z, pa0.w}; b0 += s0 * (f32x2){pb0.x, pb0.y}; b1 += s0 * (f32x2){pb0.z, pb0.w};
            a0 += s1 * (f32x2){pa1.x, pa1.y}; a1 += s1 * (f32x2){pa1.z, pa1.w}; b0 += s1 * (f32x2){pb1.x, pb1.y}; b1 += s1 * (f32x2){pb1.z, pb1.w};
            if ((j & 1) == 1) __builtin_amdgcn_sched_barrier(0);
        }
        na = (f32x4){a0.x, a0.y, a1.x, a1.y}; nb = (f32x4){b0.x, b0.y, b1.x, b1.y};
        if (c + 1 < NC) {
            xch[n4a * 64 + lane] = na; xch[n4b * 64 + lane] = nb;
            f32x4* So = (f32x4*)(S0 + (size_t)(c + 1) * 4096);
            So[n4a * 64 + lane] = na; So[n4b * 64 + lane] = nb;
            __syncthreads();
#pragma unroll
            for (int j = 0; j < 16; ++j) { const f32x4 v = xch[j * 64 + lane]; S[2 * j] = (f32x2){v.x, v.y}; S[2 * j + 1] = (f32x2){v.z, v.w}; }
        } else {
            *(f32x4*)(Sfin + lane * 64 + 8 * wave) = na; *(f32x4*)(Sfin + lane * 64 + 8 * wave + 4) = nb;
        }
        __syncthreads();
    }
}
__device__ __forceinline__ void post_rows(KP kp, int l, int gw, int ngw, int lane) {
    const float* SC = (const float*)(kp->ws + WS_SC); const float* Y = (const float*)(kp->ws + WS_Y); const float* G = (const float*)(kp->ws + WS_G); const float* RK = (const float*)(kp->ws + WS_RK);
    bf16* MIX = (bf16*)(kp->ws + WS_MIX);
    for (int it = gw; it < T * NH; it += ngw) {
        const int t = it >> 4, h = it & 15, c = h * 64 + lane;
        const float y = Y[(size_t)t * RD + c];
        const float mean = wave_sum(y) * (1.0f / 64.0f);
        const float d = y - mean;
        const float var = wave_sum(d * d) * (1.0f / 64.0f);
        const float yn = d * (1.0f / sqrtf(var + GN_EPS)) * kp->in[23][l * RD + c] + kp->in[24][l * RD + c];
        const float v = SC[((size_t)t * NH + h) * SCR + 320 + lane];
        const float o = (yn + RK[it] * v) * G[(size_t)t * RD + c];
        MIX[(size_t)t * D + 1024 + c] = (bf16)f2bf(o);
    }
}

__global__ void __launch_bounds__(NTHR, 2) fwd_mega(Params p) {
    extern __shared__ __attribute__((aligned(16))) unsigned char lds_raw[];
    LAS unsigned char* lds = (LAS unsigned char*)lds_raw;
    const int wave0 = __builtin_amdgcn_readfirstlane((int)threadIdx.x >> 6);
    volatile LAS unsigned* MISC = (volatile LAS unsigned*)(lds + 131072);
    if (threadIdx.x < 16) MISC[threadIdx.x] = 0u;
    __syncthreads();
    const XcdBarrier xbar = xcd_barrier_post((unsigned*)p.ws + 4096, MISC, (int)threadIdx.x);
    cg::this_grid().sync();

#pragma unroll 1
    for (int l = 0; l < DEPTH; ++l) {
        for (int rep = 0; rep < REP_CVT; ++rep) { PH_BEGIN();
#ifndef NO_CVT
          convert_weights(kp, l, lds, gw, ngw, wave, lane);
#endif
#ifndef NO_NORM
          float* X = (float*)(ws + WS_X); bf16* XN = (bf16*)(ws + WS_XN);
          if (l == 0) norm_rows(kp->in[0], kp->in[1], kp->in[6], X, XN, nullptr, gw, ngw, lane);
          else norm_rows(X, X + (size_t)TP * D, kp->in[6] + l * D, nullptr, XN, nullptr, gw, ngw, lane);
#endif
        }
        GSYNC();
#ifndef NO_GEMM1
        { PH_BEGIN(); pg8::Gemm g{(const bf16*)(ws + WS_XN), (const bf16*)(ws + WS_WIN), T, NZ, D}; pg8::StaticOrder S; S.init(T, NZ, nb, bid); pg8::EpiStoreF32 E{(float*)(ws + WS_Z), NZ};
          pg8::gemm_phase<pg8::EpiStoreF32, pg8::StaticOrder, true, true>(lds, g, S, E, tid); }
#endif
        GSYNC();
        for (int rep = 0; rep < REP_MIXA; ++rep) { PH_BEGIN();
          if (rep) __syncthreads();
          for (int it = bid; it < 1152; it += nb) {
#ifndef NO_PREP
            if (it < 576) for (int r_ = 0; r_ < REP_PREP; ++r_) prep_item(kp, l, it, lds, tid);
#endif
#ifndef NO_POOL
            if (it >= 576 && it < 864) for (int r_ = 0; r_ < REP_POOL; ++r_) pool_item(kp, l, it - 576, lds, tid);
#endif
#ifndef NO_CONV
            if (it >= 864) for (int r_ = 0; r_ < REP_CONV; ++r_) conv_item(kp, l, it - 864, (LAS float*)lds, tid);
#endif
          }
        }
        GSYNC();
#ifndef NO_SCAN
        for (int rep = 0; rep < REP_SCAN; ++rep) {
        if (rep) GSYNC();
        for (int rp = 0; rp < REP_P1; ++rp) { PH_BEGIN();
            const float* SC = (const float*)(ws + WS_SC); float* Y = (float*)(ws + WS_Y); float* PQ = (float*)(ws + WS_PQ); float* GB = (float*)(ws + WS_GB);
            LAS float* wl = (LAS float*)(lds + wave * 12288);
            for (int task = wave * nb + bid; task < 64 * NC + 256; task += NWAVES * nb) {
                if (task < 64 * NC) {
                    const int ch = task / NC, c = task % NC, s = ch >> 4, h = ch & 15;
                    scan_run<3>(SC, s * 2048 + c * CL, CL, h, wl, lane, nullptr, Y, GB, nullptr, PQ + (size_t)((ch * NC + c) * 2) * 4096);
                } else {
                    const int ch = task - 64 * NC, b = ch >> 4, h = ch & 15;
                    scan_run<1>(SC, TP + b * 64, 64, h, wl, lane, kp->in[5] + (size_t)((l * 16 + b) * NH + h) * 4096, Y, nullptr, kp->out + O_WKV_S + (size_t)((l * 16 + b) * NH + h) * 4096, nullptr);
                }
            }
        }
        GSYNC();
        for (int rp = 0; rp < REP_CB; ++rp) { PH_BEGIN();
            for (int ch = bid; ch < 64; ch += nb) { const int s = ch >> 4, h = ch & 15;
                combine_chain((const float*)(ws + WS_PQ) + (size_t)ch * NC * 2 * 4096, (float*)(ws + WS_S0) + (size_t)ch * NC * 4096, kp->out + O_WKV_P + (size_t)((l * 4 + s) * NH + h) * 4096, lds, tid, wave, lane); }
        }
        GSYNC();
        { PH_BEGIN();
            const float* GB = (const float*)(ws + WS_GB); float* Y = (float*)(ws + WS_Y); const float* S0 = (const float*)(ws + WS_S0);
            for (int task = wave * nb + bid; task < 64 * (NC - 1); task += NWAVES * nb) {
                const int ch = task / (NC - 1), c = 1 + task % (NC - 1), s = ch >> 4, h = ch & 15;
                ycorr_task(GB, Y, S0 + (size_t)(ch * NC + c) * 4096, s * 2048 + c * CL, h, lane);
            }
        }
        }
#endif
        GSYNC();
#ifndef NO_POST
        for (int rep = 0; rep < REP_POST; ++rep) { PH_BEGIN(); post_rows(kp, l, gw, ngw, lane); }
#endif
        GSYNC();
#ifndef NO_GEMM2
        { PH_BEGIN(); pg8::Gemm g{(const bf16*)(ws + WS_MIX), (const bf16*)(ws + WS_WOUT), T, D, D}; pg8::StaticOrder S; S.init(T, D, nb, bid); pg8::EpiResAdd E{(float*)(ws + WS_X), D};
          pg8::gemm_phase<pg8::EpiResAdd, pg8::StaticOrder, true, true>(lds, g, S, E, tid); }
#endif
        GSYNC();
#ifndef NO_NORM
        { PH_BEGIN(); float* X = (float*)(ws + WS_X); norm_rows(X, X + (size_t)TP * D, kp->in[26] + l * D, nullptr, (bf16*)(ws + WS_XN), nullptr, gw, ngw, lane); }
#endif
        GSYNC();
#ifndef NO_GEMM3
        { PH_BEGIN(); pg8::Gemm g{(const bf16*)(ws + WS_XN), (const bf16*)(ws + WS_WGU), T, NGU, D}; pg8::StaticOrder S; S.init(T, NGU, nb, bid); pg8::EpiSwiGLU E{(bf16*)(ws + WS_ACT), FF};
          pg8::gemm_phase<pg8::EpiSwiGLU, pg8::StaticOrder, true, true>(lds, g, S, E, tid); }
#endif
        GSYNC();
#ifndef NO_GEMM4
        { PH_BEGIN(); pg8::Gemm g{(const bf16*)(ws + WS_ACT), (const bf16*)(ws + WS_WDN), T, D, FF}; pg8::StaticOrder S; S.init(T, D, nb, bid); pg8::EpiResAdd E{(float*)(ws + WS_X), D};
          pg8::gemm_phase<pg8::EpiResAdd, pg8::StaticOrder, true, true>(lds, g, S, E, tid); }
#endif
        GSYNC();
    }
#ifndef NO_NORM
    { PH_BEGIN(); float* X = (float*)(ws + WS_X); norm_rows(X, X + (size_t)TP * D, kp->in[30], nullptr, nullptr, kp->out + O_Y, gw, ngw, lane); }
#endif
}

extern "C" void kernel_launch(void* const* d_in, const int* in_sizes, int n_in, void* d_out, int out_size, void* d_ws, size_t ws_size, hipStream_t stream) {
    static int grid = 0;
    if (grid == 0) {
        if (n_in != 31 || (size_t)out_size != O_END || ws_size < WS_END) { fprintf(stderr, "kernel_launch: unexpected shapes: n_in %d out %d ws %zu (need %zu)\n", n_in, out_size, ws_size, (size_t)WS_END); grid = -1; return; }
        int dev = 0, cus = 0, per_cu = 0;
        hipGetDevice(&dev);
        hipDeviceGetAttribute(&cus, hipDeviceAttributeMultiprocessorCount, dev);
        if (hipFuncSetAttribute((const void*)fwd_mega, hipFuncAttributeMaxDynamicSharedMemorySize, LDS_BYTES) != hipSuccess) { fprintf(stderr, "kernel_launch: hipFuncSetAttribute failed\n"); grid = -1; return; }
        hipOccupancyMaxActiveBlocksPerMultiprocessor(&per_cu, (const void*)fwd_mega, NTHR, LDS_BYTES);
        (void)hipGetLastError();
        if (per_cu < 1) { fprintf(stderr, "kernel_launch: occupancy query says %d blocks per CU\n", per_cu); per_cu = 1; }
        grid = cus * 1;
    }
    if (grid < 0) return;
    Params p{};
    for (int i = 0; i < 31; ++i) p.in[i] = (const float*)d_in[i];
    p.out = (float*)d_out; p.ws = (unsigned char*)d_ws;
    if (hipMemsetAsync(d_ws, 0, 65536, stream) != hipSuccess) { fprintf(stderr, "kernel_launch: memset failed\n"); return; }
    void* args[] = {&p};
    hipError_t e = hipLaunchCooperativeKernel((const void*)fwd_mega, dim3(grid), dim3(NTHR), args, LDS_BYTES, stream);
    if (e != hipSuccess) fprintf(stderr, "cooperative launch failed: %s (grid %d)\n", hipGetErrorString(e), grid);
}
```

```cpp
#include <hip/hip_runtime.h>
#include <hip/hip_cooperative_groups.h>
#include <cstdio>
#include <cstdint>
namespace cg = cooperative_groups;

namespace pg8 {
#define PG8_LAS __attribute__((address_space(3)))
typedef unsigned short bf16_t;
typedef short bf16x8 __attribute__((ext_vector_type(8)));
typedef float f32x4 __attribute__((ext_vector_type(4)));
typedef unsigned u32x4 __attribute__((ext_vector_type(4)));
constexpr int BM = 256, BK = 64, HALF = 128, HTB = HALF * BK * 2  , STAGE_BYTES = 8 * HTB, NXCD = 8, WGM = 8;

__host__ __device__ __forceinline__ int lds_byte(int r, int c) { const int st = (r >> 4) * 2 + (c >> 5), rr = r & 15, cc = c & 31, ob = rr * 64 + cc * 2; return st * 1024 + (ob ^ (((ob >> 9) & 1) << 5)); }
__host__ __device__ __forceinline__ void stage_rc(int b, int& R, int& C) { const int st = b / 1024, sb = b % 1024, swz = sb ^ (((sb >> 9) & 1) << 5); R = (st >> 1) * 16 + swz / 64; C = (st & 1) * 32 + (swz % 64) / 2; }
__host__ __device__ __forceinline__ int perm32(int rho) { const int n = rho >> 4, i = rho & 15; return 8 * (i >> 2) + 4 * n + (i & 3); }

struct Unit { int pm, pn, k0, nt, part; };
struct Gemm { const bf16_t* A; const bf16_t* Bt; int M, N, K; };

struct StaticOrder {
    int nM, nN, nwg, G, c, ntfull;
    __host__ __device__ void init(int M, int N, int K, int G_, int c_) { nM = M / BM; nN = N / BM; nwg = nM * nN; G = G_; c = c_; ntfull = K / BK; }
    __host__ __device__ __forceinline__ bool next(int i, Unit& u) const {
        const long L = (long)i * G + c; if (L >= nwg) return false;
        int wgid = (int)L; { const int q = nwg / NXCD, r = nwg % NXCD, xcd = wgid % NXCD, off = wgid / NXCD; wgid = (xcd < r ? xcd * (q + 1) : r * (q + 1) + (xcd - r) * q) + off; }
        const int nig = WGM * nN, gid = wgid / nig, fm = gid * WGM, gsz = (nM - fm) < WGM ? (nM - fm) : WGM;
        u.pm = fm + ((wgid % nig) % gsz); u.pn = (wgid % nig) / gsz; u.k0 = 0; u.nt = ntfull; u.part = -1; return true;
    }
    __device__ __forceinline__ void a_ready(const Unit&) const {}
    __device__ __forceinline__ void done(const Unit&) const {}
};


struct TailOrder {
    int nN, G, c, ntfull;
    __host__ __device__ void init(int N, int K, int G_, int c_) { nN = N / BM; G = G_; c = c_; ntfull = K / BK; }
    __host__ __device__ __forceinline__ bool next(int i, Unit& u) const {
        const int L = i * G + c, nfull = 32 * nN;
        if (L >= nfull + 4 * nN * 8) return false;
        const bool full = L < nfull;
        int wgid = full ? L : 0; { const int q = nfull / NXCD, r = nfull % NXCD, xcd = wgid % NXCD, off = wgid / NXCD; wgid = (xcd < r ? xcd * (q + 1) : r * (q + 1) + (xcd - r) * q) + off; }
        const int nig = WGM * nN, gid = wgid / nig, fm = gid * WGM;
        const int fpm = fm + ((wgid % nig) % WGM), fpn = (wgid % nig) / WGM;
        const int ut = full ? 0 : L - nfull, tile = ut >> 3, ks = ut & 7, base = (ntfull / 8) & ~1, extra = (ntfull - 8 * base) / 2;
        const int tpm = 32 + tile / nN, tpn = tile % nN, tnt = base + (ks < extra ? 2 : 0), tk0 = ks * base + 2 * (ks < extra ? ks : extra);
        Unit r_; r_.pm = full ? fpm : tpm; r_.pn = full ? fpn : tpn; r_.k0 = full ? 0 : tk0; r_.nt = full ? ntfull : tnt; r_.part = full ? -1 : ks;
        u = r_; return true;
    }
    __device__ __forceinline__ void a_ready(const Unit&) const {}
    __device__ __forceinline__ void done(const Unit&) const {}
};

__device__ __forceinline__ unsigned cvt_pk_bf16(float lo, float hi) { unsigned r; asm volatile("v_cvt_pk_bf16_f32 %0, %1, %2" : "=v"(r) : "v"(lo), "v"(hi)); return r; }

struct EpiStoreF32 {
    static constexpr bool PERM = true, AFTER_DRAIN = false;
    float* O; int ldc;
    __device__ __forceinline__ void operator()(const f32x4 (&acc)[2][2][4][2], const Unit& u, int wr, int wc, int fr, int fq) const {
        const int row0 = u.pm * BM + wr * 64 + fr, col0 = u.pn * BM + wc * 32 + 8 * fq;
#pragma unroll
        for (int ai = 0; ai < 2; ++ai)
#pragma unroll
            for (int m = 0; m < 4; ++m) { float* rowp = O + (size_t)(row0 + ai * HALF + m * 16) * ldc + col0;
#pragma unroll
                for (int bj = 0; bj < 2; ++bj) { *(f32x4*)(rowp + bj * HALF) = acc[ai][bj][m][0]; *(f32x4*)(rowp + bj * HALF + 4) = acc[ai][bj][m][1]; } }
    }
};
struct EpiResAdd {
    static constexpr bool PERM = true, AFTER_DRAIN = false;
    float* O; int ldc; float* P;
    __device__ __forceinline__ void operator()(const f32x4 (&acc)[2][2][4][2], const Unit& u, int wr, int wc, int fr, int fq) const {
        const int row0 = u.pm * BM + wr * 64 + fr, col0 = u.pn * BM + wc * 32 + 8 * fq;
        if (u.part < 0) {
#pragma unroll
            for (int ai = 0; ai < 2; ++ai)
#pragma unroll
                for (int m = 0; m < 4; ++m) { float* rowp = O + (size_t)(row0 + ai * HALF + m * 16) * ldc + col0;
#pragma unroll
                    for (int bj = 0; bj < 2; ++bj) {
                        f32x4 a = *(const f32x4*)(rowp + bj * HALF), b = *(const f32x4*)(rowp + bj * HALF + 4);
                        *(f32x4*)(rowp + bj * HALF) = a + acc[ai][bj][m][0]; *(f32x4*)(rowp + bj * HALF + 4) = b + acc[ai][bj][m][1]; } }
        } else {
            float* base = P + (size_t)u.part * 1024 * ldc;
#pragma unroll
            for (int ai = 0; ai < 2; ++ai)
#pragma unroll
                for (int m = 0; m < 4; ++m) { float* rowp = base + (size_t)(row0 - 8192 + ai * HALF + m * 16) * ldc + col0;
#pragma unroll
                    for (int bj = 0; bj < 2; ++bj) { *(f32x4*)(rowp + bj * HALF) = acc[ai][bj][m][0]; *(f32x4*)(rowp + bj * HALF + 4) = acc[ai][bj][m][1]; } }
        }
    }
};
struct EpiSwiGLU {
    static constexpr bool PERM = true, AFTER_DRAIN = false;
    bf16_t* O; int ldc;
    __device__ __forceinline__ void operator()(const f32x4 (&acc)[2][2][4][2], const Unit& u, int wr, int wc, int fr, int fq) const {
        const int row0 = u.pm * BM + wr * 64 + fr, col0 = u.pn * HALF + wc * 32 + 8 * fq;
#pragma unroll
        for (int ai = 0; ai < 2; ++ai)
#pragma unroll
            for (int m = 0; m < 4; ++m) { bf16_t* rowp = O + (size_t)(row0 + ai * HALF + m * 16) * ldc + col0;
                float o[8];
#pragma unroll
                for (int n = 0; n < 2; ++n)
#pragma unroll
                    for (int j = 0; j < 4; ++j) { const float g = acc[ai][0][m][n][j], up = acc[ai][1][m][n][j]; o[n * 4 + j] = g * up * __builtin_amdgcn_rcpf(1.0f + __expf(-g)); }
                u32x4 w; w.x = cvt_pk_bf16(o[0], o[1]); w.y = cvt_pk_bf16(o[2], o[3]); w.z = cvt_pk_bf16(o[4], o[5]); w.w = cvt_pk_bf16(o[6], o[7]);
                *(u32x4*)rowp = w; }
    }
};

template <class Epi, class Sched, bool ALIGN_EPI = false, bool SP2 = false>
__device__ __forceinline__ void gemm_phase(PG8_LAS unsigned char* lds, const Gemm g, const Sched& S, const Epi& E, const int tid) {
    const int wid = __builtin_amdgcn_readfirstlane(tid >> 6), lane = tid & 63, wr = wid >> 2, wc = wid & 3, fr = lane & 15, fq = lane >> 4;
    const int K = g.K;
    unsigned voffA[2], voffB[2];
#pragma unroll
    for (int i = 0; i < 2; ++i) { int R, C; stage_rc(tid * 16 + i * 8192, R, C); const int Rb = Epi::PERM ? ((R & ~31) + perm32(R & 31)) : R;
        voffA[i] = (unsigned)(R * K + C) * 2u; voffB[i] = (unsigned)(Rb * K + C) * 2u; }
    const size_t kstep = (size_t)(BK * 2);
    const size_t hstep = (size_t)HALF * K * 2;
    const size_t tstep = 2 * hstep;
    const unsigned ldsw = (unsigned)wid * 1024u;
    const int aoff = lds_byte(wr * 64 + fr, fq * 8), boff = lds_byte(wc * 32 + fr, fq * 8);
#define PG8_SA(b, h) (((b) * 2 + (h)) * HTB)
#define PG8_SB(b, h) ((4 + (b) * 2 + (h)) * HTB)
#define PG8_STAGE(bufoff, gbase, voff) do { _Pragma("unroll") for (int _i = 0; _i < 2; ++_i) \
        __builtin_amdgcn_global_load_lds((const unsigned*)((const char*)(gbase) + (voff)[_i]), (PG8_LAS unsigned*)(lds + (bufoff) + ldsw + _i * 8192), 16, 0, 0); } while (0)
#define PG8_LDA(dst, b, h) do { _Pragma("unroll") for (int m = 0; m < 4; ++m) _Pragma("unroll") for (int k = 0; k < 2; ++k) dst[m][k] = *(const PG8_LAS bf16x8*)(lds + PG8_SA(b, h) + aoff + m * 2048 + k * 1024); } while (0)
#define PG8_LDB(dst, b, h) do { _Pragma("unroll") for (int n = 0; n < 2; ++n) _Pragma("unroll") for (int k = 0; k < 2; ++k) dst[n][k] = *(const PG8_LAS bf16x8*)(lds + PG8_SB(b, h) + boff + n * 2048 + k * 1024); } while (0)
#define PG8_MMA(ai, bj, At, Bt) do { __builtin_amdgcn_s_setprio(1); _Pragma("unroll") for (int m = 0; m < 4; ++m) _Pragma("unroll") for (int n = 0; n < 2; ++n) _Pragma("unroll") for (int k = 0; k < 2; ++k) \
        acc[ai][bj][m][n] = __builtin_amdgcn_mfma_f32_16x16x32_bf16(Bt[n][k], At[m][k], acc[ai][bj][m][n], 0, 0, 0); __builtin_amdgcn_s_setprio(0); } while (0)
#define PG8_WAIT_V(n) asm volatile("s_waitcnt vmcnt(" #n ")" ::: "memory")
#define PG8_WAIT_L(n) asm volatile("s_waitcnt lgkmcnt(" #n ")" ::: "memory")
#define PG8_BAR __builtin_amdgcn_s_barrier()
#define PG8_SCHED __builtin_amdgcn_sched_barrier(0)
    Unit cur, nxt; int ui = 0;
    if (!S.next(0, cur)) return;
    f32x4 acc[2][2][4][2];
#pragma unroll
    for (int a = 0; a < 2; ++a)
#pragma unroll
        for (int b = 0; b < 2; ++b)
#pragma unroll
            for (int m = 0; m < 4; ++m)
#pragma unroll
                for (int n = 0; n < 2; ++n) acc[a][b][m][n] = (f32x4){0.f, 0.f, 0.f, 0.f};
    bf16x8 At[4][2], B0[2][2], B1[2][2];
    const char* cA = (const char*)g.A + (size_t)cur.pm * tstep + (size_t)cur.k0 * kstep; const char* cB = (const char*)g.Bt + (size_t)cur.pn * tstep + (size_t)cur.k0 * kstep;
    S.a_ready(cur);
    if constexpr (SP2) {
        PG8_STAGE(PG8_SB(0, 0), cB, voffB); PG8_STAGE(PG8_SB(0, 1), cB + hstep, voffB); PG8_STAGE(PG8_SA(0, 0), cA, voffA); PG8_STAGE(PG8_SA(0, 1), cA + hstep, voffA);
        if (wr == 1) PG8_BAR;
        PG8_WAIT_V(2); PG8_BAR;
        PG8_STAGE(PG8_SB(1, 0), cB + kstep, voffB); PG8_STAGE(PG8_SA(1, 0), cA + kstep, voffA); PG8_STAGE(PG8_SB(1, 1), cB + hstep + kstep, voffB);
        PG8_WAIT_V(6); PG8_BAR;
    } else {
        PG8_STAGE(PG8_SB(0, 0), cB, voffB); PG8_STAGE(PG8_SA(0, 0), cA, voffA); PG8_STAGE(PG8_SB(0, 1), cB + hstep, voffB); PG8_STAGE(PG8_SA(0, 1), cA + hstep, voffA);
        if (wr == 1) PG8_BAR;
        PG8_WAIT_V(4); PG8_BAR;
        PG8_STAGE(PG8_SB(1, 0), cB + kstep, voffB); PG8_STAGE(PG8_SA(1, 0), cA + kstep, voffA); PG8_STAGE(PG8_SB(1, 1), cB + hstep + kstep, voffB);
        PG8_WAIT_V(6); PG8_BAR;
    }
    for (;;) {
        const bool has_next = S.next(ui + 1, nxt);
        const char* nA = has_next ? (const char*)g.A + (size_t)nxt.pm * tstep + (size_t)nxt.k0 * kstep : cA; const char* nB = has_next ? (const char*)g.Bt + (size_t)nxt.pn * tstep + (size_t)nxt.k0 * kstep : cB;
        const int nt = cur.nt;
        for (int t = 0; t < nt; t += 2) {
            const bool last = (t == nt - 2);
            const char* a1 = cA + (size_t)(t + 1) * kstep;
            const char* a2 = last ? nA : cA + (size_t)(t + 2) * kstep; const char* b2 = last ? nB : cB + (size_t)(t + 2) * kstep;
            const char* a3 = a2 + kstep; const char* b3 = b2 + kstep;
            if (last && has_next) S.a_ready(nxt);
            if constexpr (SP2) {
            PG8_LDB(B0, 0, 0); PG8_LDB(B1, 0, 1); PG8_SCHED; PG8_LDA(At, 0, 0); PG8_STAGE(PG8_SA(1, 1), a1 + hstep, voffA);
            PG8_WAIT_V(8); PG8_WAIT_L(0); PG8_BAR; PG8_MMA(0, 0, At, B0); PG8_MMA(0, 1, At, B1); PG8_BAR; PG8_SCHED;
            PG8_LDA(At, 0, 1); PG8_STAGE(PG8_SB(0, 0), b2, voffB); PG8_STAGE(PG8_SB(0, 1), b2 + hstep, voffB); PG8_STAGE(PG8_SA(0, 0), a2, voffA);
            PG8_WAIT_V(8); PG8_WAIT_L(0); PG8_BAR; PG8_MMA(1, 0, At, B0); PG8_MMA(1, 1, At, B1); PG8_BAR; PG8_SCHED;
            PG8_LDB(B0, 1, 0); PG8_LDB(B1, 1, 1); PG8_SCHED; PG8_LDA(At, 1, 0); PG8_STAGE(PG8_SA(0, 1), a2 + hstep, voffA);
            PG8_WAIT_V(8); PG8_WAIT_L(0); PG8_BAR; PG8_MMA(0, 0, At, B0); PG8_MMA(0, 1, At, B1); PG8_BAR; PG8_SCHED;
            PG8_LDA(At, 1, 1); PG8_STAGE(PG8_SB(1, 0), b3, voffB); PG8_STAGE(PG8_SB(1, 1), b3 + hstep, voffB); PG8_STAGE(PG8_SA(1, 0), a3, voffA);
            PG8_WAIT_V(8); PG8_WAIT_L(0); PG8_BAR; PG8_MMA(1, 0, At, B0); PG8_MMA(1, 1, At, B1); PG8_BAR; PG8_SCHED;
            } else {
            PG8_LDB(B0, 0, 0); PG8_SCHED; PG8_LDA(At, 0, 0); PG8_STAGE(PG8_SA(1, 1), a1 + hstep, voffA);
            PG8_WAIT_L(8); PG8_BAR; PG8_WAIT_L(0); PG8_MMA(0, 0, At, B0); PG8_BAR; PG8_SCHED;
            PG8_LDB(B1, 0, 1); PG8_STAGE(PG8_SB(0, 0), b2, voffB);
            PG8_BAR; PG8_WAIT_L(0); PG8_MMA(0, 1, At, B1); PG8_BAR;
            PG8_LDA(At, 0, 1); PG8_STAGE(PG8_SA(0, 0), a2, voffA);
            PG8_BAR; PG8_WAIT_L(0); PG8_MMA(1, 0, At, B0); PG8_BAR; PG8_SCHED;
            PG8_STAGE(PG8_SB(0, 1), b2 + hstep, voffB);
            PG8_WAIT_V(6); PG8_BAR; PG8_MMA(1, 1, At, B1); PG8_BAR;
            PG8_LDB(B0, 1, 0); PG8_SCHED; PG8_LDA(At, 1, 0); PG8_STAGE(PG8_SA(0, 1), a2 + hstep, voffA);
            PG8_WAIT_L(8); PG8_BAR; PG8_WAIT_L(0); PG8_MMA(0, 0, At, B0); PG8_BAR; PG8_SCHED;
            PG8_LDB(B1, 1, 1); PG8_STAGE(PG8_SB(1, 0), b3, voffB);
            PG8_BAR; PG8_WAIT_L(0); PG8_MMA(0, 1, At, B1); PG8_BAR;
            PG8_LDA(At, 1, 1); PG8_STAGE(PG8_SA(1, 0), a3, voffA);
            PG8_BAR; PG8_WAIT_L(0); PG8_MMA(1, 0, At, B0); PG8_BAR; PG8_SCHED;
            PG8_STAGE(PG8_SB(1, 1), b3 + hstep, voffB);
            PG8_WAIT_V(6); PG8_BAR; PG8_MMA(1, 1, At, B1); PG8_BAR;
            }
        }
        if constexpr (ALIGN_EPI) { if (wr == 0) PG8_BAR; }
        if constexpr (!Epi::AFTER_DRAIN) { E(acc, cur, wr, wc, fr, fq); S.done(cur); }
        if (!has_next) break;
#pragma unroll
        for (int a = 0; a < 2; ++a)
#pragma unroll
            for (int b = 0; b < 2; ++b)
#pragma unroll
                for (int m = 0; m < 4; ++m)
#pragma unroll
                    for (int n = 0; n < 2; ++n) acc[a][b][m][n] = (f32x4){0.f, 0.f, 0.f, 0.f};
        cur = nxt; cA = nA; cB = nB; ++ui;
        if constexpr (ALIGN_EPI) { if (wr == 1) PG8_BAR; }
    }
    PG8_WAIT_V(0);
    if constexpr (!ALIGN_EPI) { if (wr == 0) PG8_BAR; }
    PG8_BAR;
    if constexpr (Epi::AFTER_DRAIN) { E.fused(acc, cur, wr, wc, fr, fq, lds, wid, lane); S.done(cur); }
#undef PG8_SA
#undef PG8_SB
#undef PG8_STAGE
#undef PG8_LDA
#undef PG8_LDB
#undef PG8_MMA
#undef PG8_WAIT_V
#undef PG8_WAIT_L
#undef PG8_BAR
#undef PG8_SCHED
}
}

#define LAS __attribute__((address_space(3)))
typedef unsigned short bf16;
typedef float f32x4 __attribute__((ext_vector_type(4)));
typedef float f32x2 __attribute__((ext_vector_type(2)));
typedef unsigned u32x4 __attribute__((ext_vector_type(4)));
typedef unsigned u32x2 __attribute__((ext_vector_type(2)));
typedef short bfx8 __attribute__((ext_vector_type(8)));
#define XB_TMO      128
#define XB_XCNT(j)  (256  + 64 * (j))
#define XB_XSUB(j)  (1280 + 64 * (j))
#define XB_XGEN(j)  (2304 + 64 * (j))
#define XB_TOP      3328
#define XB_TOPGEN   3392
#define XCD_BAR_WORDS 3456
#define XB_SPIN_CAP (1u << 18)

__device__ __forceinline__ unsigned xb_ld(unsigned* p)              { return __hip_atomic_load(p, __ATOMIC_RELAXED, __HIP_MEMORY_SCOPE_AGENT); }
__device__ __forceinline__ unsigned xb_add(unsigned* p, unsigned v) { return __hip_atomic_fetch_add(p, v, __ATOMIC_RELAXED, __HIP_MEMORY_SCOPE_AGENT); }
__device__ __forceinline__ unsigned xb_xcc_id() { return (unsigned)__builtin_amdgcn_s_getreg((3 << 11) | 20) & 0xFu; }
#define XB_SPIN(cond, bar) do { unsigned _sp = 0; while (cond) { __builtin_amdgcn_s_sleep(1); \
    if ((++_sp & 255u) == 0u) { if (xb_ld(&(bar)[XB_TMO])) break; if (_sp > XB_SPIN_CAP) { atomicAdd(&(bar)[XB_TMO], 1u); break; } } } } while (0)

struct XcdBarrier {
    unsigned* bar; unsigned x;
    volatile LAS unsigned* st;
};

__device__ __forceinline__ XcdBarrier xcd_barrier_post(unsigned* bar, volatile LAS unsigned* st, int tid) {
    XcdBarrier b; b.bar = bar; b.x = xb_xcc_id(); b.st = st;
    if (tid == 0) (void)xb_add(&bar[XB_XCNT(b.x)], 1u);
    return b;
}
__device__ __forceinline__ void xcd_barrier_complete(unsigned* bar, unsigned x, unsigned& nloc, unsigned& nx) {
    const unsigned G = gridDim.x * gridDim.y * gridDim.z;
    unsigned sum, cnt, mine, sp = 0u;
    for (;;) {
        sum = 0u; cnt = 0u; mine = 0u;
#pragma unroll
        for (unsigned j = 0; j < 16; ++j) { const unsigned c = xb_ld(&bar[XB_XCNT(j)]); sum += c; cnt += (c > 0u) ? 1u : 0u; mine = (j == x) ? c : mine; }
        if (sum == G) break;
        __builtin_amdgcn_s_sleep(1);
        if ((++sp & 255u) == 0u) { if (xb_ld(&bar[XB_TMO])) break; if (sp > XB_SPIN_CAP) { atomicAdd(&bar[XB_TMO], 1u); break; } }
    }
    nloc = mine > 0u ? mine : 1u; nx = cnt > 0u ? cnt : 1u;
}

__device__ __forceinline__ void xcd_barrier(const XcdBarrier& b, int tid) {
    asm volatile("s_waitcnt vmcnt(0)" ::: "memory");
    __syncthreads();
    if (tid == 0) {
        unsigned* bar = b.bar;
        __builtin_amdgcn_s_waitcnt(0);
        unsigned nloc = b.st[0], nx = b.st[1];
        if (nloc == 0u) { xcd_barrier_complete(bar, b.x, nloc, nx); b.st[0] = nloc; b.st[1] = nx; }
        const unsigned old = xb_add(&bar[XB_XSUB(b.x)], 1u);
        const unsigned gen = old / nloc;
        if (old + 1u == (gen + 1u) * nloc) {
            __builtin_amdgcn_fence(__ATOMIC_RELEASE, "agent");
            asm volatile("s_waitcnt vmcnt(0)" ::: "memory");
            const unsigned og = xb_add(&bar[XB_TOP], 1u);
            const unsigned tg = og / nx;
            if (og + 1u == (tg + 1u) * nx) xb_add(&bar[XB_TOPGEN], 1u);
            else XB_SPIN(xb_ld(&bar[XB_TOPGEN]) == tg, bar);
            __builtin_amdgcn_fence(__ATOMIC_ACQUIRE, "agent");
            xb_add(&bar[XB_XGEN(b.x)], 1u);
            asm volatile("s_waitcnt vmcnt(0)" ::: "memory");
        } else {
            XB_SPIN(xb_ld(&bar[XB_XGEN(b.x)]) == gen, bar);
            __builtin_amdgcn_fence(__ATOMIC_ACQUIRE, "agent");
            asm volatile("s_waitcnt vmcnt(0)" ::: "memory");
        }
    }
    __syncthreads();
}

constexpr int NWAVES = 8, NTHR = 512;
constexpr int TP = 8192, TS = 1024, T = 9216, D = 2048, NIN = 4800, NZ = 4864, FF = 5632, NGU = 11264;
constexpr int NH = 16, HS = 64, RD = 1024, RP = 3264, DEPTH = 4;
constexpr int ZQ = 1536;
constexpr float RMS_EPS = 1e-6f, LN_EPS = 1e-5f, GN_EPS = 64e-5f;
constexpr int SCR = 384;
constexpr size_t O_Y = 0;
constexpr size_t O_CONV_P = (size_t)T * D;
constexpr size_t O_POOL_P = O_CONV_P + (size_t)DEPTH * 4 * 30 * 512;
constexpr size_t O_SHIFT_P = O_POOL_P + (size_t)DEPTH * 4 * 15 * 512;
constexpr size_t O_WKV_P = O_SHIFT_P + (size_t)DEPTH * 4 * RP;
constexpr size_t O_CONV_S = O_WKV_P + (size_t)DEPTH * 4 * NH * 4096;
constexpr size_t O_POOL_S = O_CONV_S + (size_t)DEPTH * 16 * 30 * 512;
constexpr size_t O_SHIFT_S = O_POOL_S + (size_t)DEPTH * 16 * 15 * 512;
constexpr size_t O_WKV_S = O_SHIFT_S + (size_t)DEPTH * 16 * RP;
constexpr size_t O_END = O_WKV_S + (size_t)DEPTH * 16 * NH * 4096;
constexpr size_t WS_POOLW = 131072;
constexpr size_t WS_UPS = 262144;
constexpr size_t WS_WIN = 1u << 20;
constexpr size_t WS_WOUT = WS_WIN + (size_t)NZ * D * 2;
constexpr size_t WS_WGU = WS_WOUT + (size_t)D * D * 2;
constexpr size_t WS_WDN = WS_WGU + (size_t)NGU * D * 2;
constexpr size_t WS_X = WS_WDN + (size_t)D * FF * 2;
constexpr size_t WS_XN = WS_X + (size_t)T * D * 4;
constexpr size_t WS_MIX = WS_XN + (size_t)T * D * 2;
constexpr size_t WS_Z = WS_MIX + (size_t)T * D * 2;
constexpr size_t WS_ACT = WS_Z;
constexpr size_t WS_SC = WS_Z + (size_t)T * NZ * 4;
constexpr size_t WS_PART = WS_SC;
constexpr size_t WS_Y = WS_SC + (size_t)T * NH * SCR * 4;
constexpr size_t WS_G = WS_Y + (size_t)T * RD * 4;
constexpr size_t WS_RK = WS_G + (size_t)T * RD * 4;
constexpr int NC = 16, CL = 128;
constexpr size_t WS_PQ = WS_RK + (size_t)T * NH * 4;
constexpr size_t WS_S0 = WS_PQ + (size_t)64 * NC * 2 * 4096 * 4;
constexpr size_t WS_GB = WS_S0 + (size_t)64 * NC * 4096 * 4;
constexpr size_t WS_END = WS_GB + (size_t)TP * RD * 4;
static_assert((size_t)T * FF * 2 <= (size_t)T * NZ * 4, "act overlay fits in z");
constexpr int LDS_BYTES = 147456;

#ifndef REP_PREP
#define REP_PREP 1
#endif
#ifndef REP_POOL
#define REP_POOL 1
#endif
#ifndef REP_CONV
#define REP_CONV 1
#endif
#ifndef REP_P1
#define REP_P1 1
#endif
#ifndef REP_CB
#define REP_CB 1
#endif
#ifndef REP_MIXA
#define REP_MIXA 1
#endif
#ifndef REP_SCAN
#define REP_SCAN 1
#endif
#ifndef REP_POST
#define REP_POST 1
#endif
#ifndef REP_CVT
#define REP_CVT 1
#endif
#ifdef NO_SYNC
#define GSYNC() __syncthreads()
#else
#define GSYNC() do { int w_ = wave0; asm volatile("" : "+s"(w_)); xcd_barrier(xbar, w_ * 64 + (int)__builtin_amdgcn_mbcnt_hi(~0u, __builtin_amdgcn_mbcnt_lo(~0u, (unsigned)launder_v(0)))); } while (0)
#endif
struct Params { const float* in[31]; float* out; unsigned char* ws; };
typedef const __attribute__((address_space(4))) Params* KP;
__device__ __forceinline__ KP kargs() { KP k = (KP)__builtin_amdgcn_kernarg_segment_ptr(); asm volatile("" : "+s"(k)); return k; }
__device__ __forceinline__ int launder_v(int v) { asm volatile("" : "+v"(v)); return v; }
#define PH_BEGIN() KP kp = kargs(); int wave_ = wave0; asm volatile("" : "+s"(wave_)); const int wave = wave_; const int lane = (int)__builtin_amdgcn_mbcnt_hi(~0u, __builtin_amdgcn_mbcnt_lo(~0u, (unsigned)launder_v(0))); const int tid = wave * 64 + lane; \
    const int nb = gridDim.x, bid = blockIdx.x, gw = bid * NWAVES + wave, ngw = nb * NWAVES; unsigned char* const ws = kp->ws; (void)lane; (void)wave; (void)gw; (void)ngw; (void)ws; (void)nb; (void)bid

__device__ __forceinline__ float wave_sum(float v) {
#pragma unroll
    for (int o = 1; o < 64; o <<= 1) v += __shfl_xor(v, o);
    return v;
}
__device__ __forceinline__ unsigned f2bf(float f) { unsigned u = __builtin_bit_cast(unsigned, f); return (u + 0x7fffu + ((u >> 16) & 1u)) >> 16; }
__device__ __forceinline__ unsigned pk2(float lo, float hi) { return f2bf(lo) | (f2bf(hi) << 16); }
__device__ __forceinline__ float sigm(float x) { return 1.0f / (1.0f + __expf(-x)); }

__device__ __forceinline__ void transpose_item(const float* W, int K, int N, bf16* WT, int mode, LAS float* scr, int item, int lane) {
    const int nblk = N / 32, kb = item / nblk, nb = item % nblk, k0 = 64 * kb, n0 = 32 * nb;
    const int drow0 = (mode == 0) ? n0 : ((n0 >> 7) * 256 + (n0 & 127) + (mode == 2 ? 128 : 0));
#pragma unroll 8
    for (int i = 0; i < 32; ++i) { const int kk = 2 * i + (lane >> 5); scr[kk * 33 + (lane & 31)] = W[(size_t)(k0 + kk) * N + n0 + (lane & 31)]; }
    asm volatile("s_waitcnt lgkmcnt(0)" ::: "memory");
    const int c = lane & 7;
#pragma unroll
    for (int j = 0; j < 4; ++j) { const int n = (lane >> 3) + 8 * j; const LAS float* s = scr + (8 * c) * 33 + n;
        u32x4 o; o.x = pk2(s[0 * 33], s[1 * 33]); o.y = pk2(s[2 * 33], s[3 * 33]); o.z = pk2(s[4 * 33], s[5 * 33]); o.w = pk2(s[6 * 33], s[7 * 33]);
        *(u32x4*)(WT + (size_t)(drow0 + n) * K + k0 + 8 * c) = o; }
    asm volatile("s_waitcnt lgkmcnt(0)" ::: "memory");
}
__device__ __forceinline__ void convert_weights(KP kp, int l, LAS unsigned char* lds, int gw, int ngw, int wave, int lane) {
    LAS float* scr = (LAS float*)(lds + wave * 16384);
    unsigned char* ws = kp->ws;
    bf16* WIN = (bf16*)(ws + WS_WIN); bf16* WOUT = (bf16*)(ws + WS_WOUT); bf16* WGU = (bf16*)(ws + WS_WGU); bf16* WDN = (bf16*)(ws + WS_WDN);
    constexpr int I_IN = (D / 64) * (NIN / 32), I_OUT = (D / 64) * (D / 32), I_G = (D / 64) * (FF / 32), I_D = (FF / 64) * (D / 32);
    constexpr int I_P = 4 * 8, I_U = 3 * 32;
    constexpr int NITEMS = I_IN + I_OUT + 2 * I_G + I_D + I_P + I_U;
    for (int it = gw; it < NITEMS; it += ngw) {
        int r = it;
        if (r < I_IN) { transpose_item(kp->in[7] + (size_t)l * D * NIN, D, NIN, WIN, 0, scr, r, lane); continue; } r -= I_IN;
        if (r < I_OUT) { transpose_item(kp->in[25] + (size_t)l * D * D, D, D, WOUT, 0, scr, r, lane); continue; } r -= I_OUT;
        if (r < I_G) { transpose_item(kp->in[27] + (size_t)l * D * FF, D, FF, WGU, 1, scr, r, lane); continue; } r -= I_G;
        if (r < I_G) { transpose_item(kp->in[28] + (size_t)l * D * FF, D, FF, WGU, 2, scr, r, lane); continue; } r -= I_G;
        if (r < I_D) { transpose_item(kp->in[29] + (size_t)l * FF * D, FF, D, WDN, 0, scr, r, lane); continue; } r -= I_D;
        if (r < I_P) { const int g = r >> 3; transpose_item(kp->in[12] + (size_t)((l * 4 + g) * 128) * 128, 128, 128, (bf16*)(ws + WS_POOLW) + (size_t)g * 128 * 128, 0, scr, r & 7, lane); continue; } r -= I_P;
        { const int m = r >> 5; const float* src = (m == 0 ? kp->in[16] : (m == 1 ? kp->in[18] : kp->in[19])) + (size_t)l * 64 * RD;
          transpose_item(src, 64, RD, (bf16*)(ws + WS_UPS) + (size_t)m * RD * 64, 0, scr, r & 31, lane); }
    }
    { const unsigned z = (unsigned)launder_v(0); for (int e = gw * 64 + lane; e < 16384; e += ngw * 64) ((u32x4*)(WIN + (size_t)NIN * D))[e] = (u32x4){z, z, z, z}; }
}
__device__ __forceinline__ void norm_rows(const float* sa, const float* sb, const float* g, float* xcopy, bf16* xn, float* fout, const float* part, int gw, int ngw, int lane) {
    for (int m = gw; m < T; m += ngw) {
        const float* row = (m < TP) ? sa + (size_t)m * D : sb + (size_t)(m - TP) * D;
        f32x4 v[8]; float ss = 0.f;
#pragma unroll
        for (int j = 0; j < 8; ++j) v[j] = ((const f32x4*)row)[lane + 64 * j];
        if (part && m >= TP) {
#pragma unroll
            for (int k = 0; k < 8; ++k)
#pragma unroll
                for (int j = 0; j < 8; ++j) v[j] += ((const f32x4*)(part + ((size_t)k * 1024 + (m - TP)) * D))[lane + 64 * j];
#pragma unroll
            for (int j = 0; j < 8; ++j) ((f32x4*)(const_cast<float*>(sb) + (size_t)(m - TP) * D))[lane + 64 * j] = v[j];
        }
#pragma unroll
        for (int j = 0; j < 8; ++j) ss += (v[j].x * v[j].x + v[j].y * v[j].y) + (v[j].z * v[j].z + v[j].w * v[j].w);
        const float rinv = 1.0f / sqrtf(wave_sum(ss) * (1.0f / D) + RMS_EPS);
#pragma unroll
        for (int j = 0; j < 8; ++j) {
            if (xcopy) ((f32x4*)(xcopy + (size_t)m * D))[lane + 64 * j] = v[j];
            const f32x4 gj = ((const f32x4*)g)[lane + 64 * j];
            const f32x4 y = v[j] * rinv * gj;
            if (xn) { u32x2 o; o.x = pk2(y.x, y.y); o.y = pk2(y.z, y.w); ((u32x2*)(xn + (size_t)m * D))[lane + 64 * j] = o; }
            if (fout) ((f32x4*)(fout + (size_t)m * D))[lane + 64 * j] = y;
        }
    }
}

__device__ __forceinline__ void conv_item(KP kp, int l, int item, LAS float* lds, int tid_in) {
    const int tid = launder_v(tid_in);
    const float* Z = (const float*)(kp->ws + WS_Z); bf16* MIX = (bf16*)(kp->ws + WS_MIX);
    const int t0 = item * 32;
    int s, tau0, Ls; bool prompt;
    if (t0 < TP) { s = t0 >> 11; tau0 = t0 & 2047; Ls = 2048; prompt = true; } else { s = (t0 - TP) >> 6; tau0 = (t0 - TP) & 63; Ls = 64; prompt = false; }
    const int c = tid;
    const float* cw = kp->in[8] + (size_t)l * 31 * 512;
    float w[31];
#pragma unroll
    for (int j = 0; j < 31; ++j) w[j] = cw[j * 512 + c];
    const float bias = kp->in[9][l * 512 + c];
    float acc[32];
#pragma unroll
    for (int i = 0; i < 32; ++i) acc[i] = bias;
    const bool first = (tau0 == 0), lastit = (tau0 + 32 == Ls);
    float* oc = prompt ? kp->out + O_CONV_P + (size_t)((l * 4 + s) * 30) * 512 : kp->out + O_CONV_S + (size_t)((l * 16 + s) * 30) * 512;
    const float* cc = kp->in[2] + (size_t)((l * 16 + s) * 30) * 512;
#pragma unroll
    for (int ii = 0; ii < 62; ++ii) {
        float u;
        if (ii < 30 && first) { u = prompt ? 0.f : cc[ii * 512 + c]; }
        else { const float* zr = Z + (size_t)(t0 + ii - 30) * NZ; const float val = zr[c], gate = zr[512 + c]; u = val * sigm(gate); }
        if (ii >= 32 && lastit) oc[(ii - 32) * 512 + c] = u;
#pragma unroll
        for (int oi = 0; oi < 32; ++oi) { const int j = ii - oi; if (j >= 0 && j <= 30) acc[oi] += w[j] * u; }
    }
#pragma unroll
    for (int oi = 0; oi < 32; ++oi) lds[oi * 512 + c] = acc[oi];
    __syncthreads();
    const int wave = tid >> 6, lane = tid & 63;
    const f32x4 g0 = *(const f32x4*)(kp->in[10] + l * 512 + lane * 8), g1 = *(const f32x4*)(kp->in[10] + l * 512 + lane * 8 + 4);
    const f32x4 b0 = *(const f32x4*)(kp->in[11] + l * 512 + lane * 8), b1 = *(const f32x4*)(kp->in[11] + l * 512 + lane * 8 + 4);
#pragma unroll
    for (int q = 0; q < 4; ++q) {
        const int oi = wave * 4 + q;
        f32x4 a = *(const LAS f32x4*)(lds + oi * 512 + lane * 8), b = *(const LAS f32x4*)(lds + oi * 512 + lane * 8 + 4);
        const float mean = wave_sum((a.x + a.y) + (a.z + a.w) + (b.x + b.y) + (b.z + b.w)) * (1.0f / 512.0f);
        a = a - mean; b = b - mean;
        const float var = wave_sum((a.x * a.x + a.y * a.y) + (a.z * a.z + a.w * a.w) + (b.x * b.x + b.y * b.y) + (b.z * b.z + b.w * b.w)) * (1.0f / 512.0f);
        const float rstd = 1.0f / sqrtf(var + LN_EPS);
        a = a * rstd * g0 + b0; b = b * rstd * g1 + b1;
        float o[8] = {a.x, a.y, a.z, a.w, b.x, b.y, b.z, b.w};
#pragma unroll
        for (int k = 0; k < 8; ++k) o[k] = o[k] * sigm(o[k]);
        u32x4 wv; wv.x = pk2(o[0], o[1]); wv.y = pk2(o[2], o[3]); wv.z = pk2(o[4], o[5]); wv.w = pk2(o[6], o[7]);
        *(u32x4*)(MIX + (size_t)(t0 + oi) * D + lane * 8) = wv;
    }
    __syncthreads();
}
__device__ __forceinline__ void pool_item(KP kp, int l, int item, LAS unsigned char* ldsb, int tid_in) {
    const int tid = launder_v(tid_in);
    const float* Z = (const float*)(kp->ws + WS_Z); bf16* MIX = (bf16*)(kp->ws + WS_MIX);
    LAS float* pp = (LAS float*)ldsb;
    LAS bf16* db = (LAS bf16*)(ldsb + 47 * 512 * 4);
    const int t0 = item * 32;
    int s, tau0, Ls; bool prompt;
    if (t0 < TP) { s = t0 >> 11; tau0 = t0 & 2047; Ls = 2048; prompt = true; } else { s = (t0 - TP) >> 6; tau0 = (t0 - TP) & 63; Ls = 64; prompt = false; }
    const int c = tid;
    const bool first = (tau0 == 0), lastit = (tau0 + 32 == Ls);
    float* op = prompt ? kp->out + O_POOL_P + (size_t)((l * 4 + s) * 15) * 512 : kp->out + O_POOL_S + (size_t)((l * 16 + s) * 15) * 512;
    const float* cp = kp->in[3] + (size_t)((l * 16 + s) * 15) * 512;
#pragma unroll 16
    for (int ii = 0; ii < 47; ++ii) {
        float val;
        if (ii < 15 && first) val = prompt ? 0.f : cp[ii * 512 + c];
        else val = Z[(size_t)(t0 + ii - 15) * NZ + 1024 + c];
        pp[ii * 512 + c] = val;
        if (ii >= 32 && lastit) op[(ii - 32) * 512 + c] = val;
    }
    const int gi = c >> 7, w = 2 << gi;
    for (int oi = 0; oi < 32; ++oi) {
        float sum = 0.f;
        for (int k = 0; k < w; ++k) sum += pp[(oi + 15 - k) * 512 + c];
        const int cnt = prompt ? min(w, tau0 + oi + 1) : w;
        const float d = sum / (float)cnt - pp[(oi + 15) * 512 + c];
        db[oi * 520 + c] = (bf16)f2bf(d);
    }
    __syncthreads();
    const int lane = tid & 63, wave = tid >> 6, n16 = lane & 15, q = lane >> 4, g = wave >> 1, nh = wave & 1;
    const bf16* WT = (const bf16*)(kp->ws + WS_POOLW) + (size_t)g * 128 * 128;
    bfx8 Bf[4][4];
#pragma unroll
    for (int nt = 0; nt < 4; ++nt)
#pragma unroll
        for (int ks = 0; ks < 4; ++ks) Bf[nt][ks] = *(const bfx8*)(WT + (size_t)(nh * 64 + nt * 16 + n16) * 128 + ks * 32 + q * 8);
    float scale[4];
#pragma unroll
    for (int nt = 0; nt < 4; ++nt) scale[nt] = kp->in[13][l * 512 + g * 128 + nh * 64 + nt * 16 + n16];
#pragma unroll
    for (int mt = 0; mt < 2; ++mt) {
        bfx8 Af[4];
#pragma unroll
        for (int ks = 0; ks < 4; ++ks) Af[ks] = *(const LAS bfx8*)(db + (mt * 16 + n16) * 520 + g * 128 + ks * 32 + q * 8);
        f32x4 acc[4];
#pragma unroll
        for (int nt = 0; nt < 4; ++nt) { acc[nt] = (f32x4){0.f, 0.f, 0.f, 0.f};
#pragma unroll
            for (int ks = 0; ks < 4; ++ks) acc[nt] = __builtin_amdgcn_mfma_f32_16x16x32_bf16(Af[ks], Bf[nt][ks], acc[nt], 0, 0, 0); }
#pragma unroll
        for (int nt = 0; nt < 4; ++nt)
#pragma unroll
            for (int r = 0; r < 4; ++r) MIX[(size_t)(t0 + mt * 16 + 4 * q + r) * D + 512 + g * 128 + nh * 64 + nt * 16 + n16] = (bf16)f2bf(acc[nt][r] * scale[nt]);
    }
    __syncthreads();
}
__device__ __forceinline__ float rowsum16(float v) { v += __shfl_xor(v, 1); v += __shfl_xor(v, 2); v += __shfl_xor(v, 4); v += __shfl_xor(v, 8); return v; }
__device__ __forceinline__ void prep_item(KP kp, int l, int item, LAS unsigned char* ldsb, int tid_in) {
    const int tid = launder_v(tid_in);
    const float* Z = (const float*)(kp->ws + WS_Z);
    float* SC = (float*)(kp->ws + WS_SC); float* G = (float*)(kp->ws + WS_G); float* RK = (float*)(kp->ws + WS_RK);
    const bf16* UPT = (const bf16*)(kp->ws + WS_UPS);
    LAS bf16* lo = (LAS bf16*)ldsb;
    const int t0 = item * 16;
    int s, tau0, Ls; bool prompt;
    if (t0 < TP) { s = t0 >> 11; tau0 = t0 & 2047; Ls = 2048; prompt = true; } else { s = (t0 - TP) >> 6; tau0 = (t0 - TP) & 63; Ls = 64; prompt = false; }
    const float* mu = kp->in[14] + (size_t)l * RP;
    const float* ssh = kp->in[4] + (size_t)(l * 16 + s) * RP;
    for (int e = tid; e < 16 * 192; e += NTHR) {
        const int tok = e / 192, col = e % 192, zc = 3072 + col, t = t0 + tok, tau = tau0 + tok;
        const float qv = Z[(size_t)t * NZ + ZQ + zc];
        const float qp = tau > 0 ? Z[(size_t)(t - 1) * NZ + ZQ + zc] : (prompt ? 0.f : ssh[zc]);
        const float qs = qv + (qp - qv) * mu[zc];
        const float val = col < 64 ? tanhf(qs) : (col < 128 ? qs : sigm(qs));
        lo[((col >> 6) * 16 + tok) * 72 + (col & 63)] = (bf16)f2bf(val);
    }
    __syncthreads();
    const int lane = tid & 63, wave = tid >> 6, n16 = lane & 15, q = lane >> 4;
#pragma unroll 1
    for (int hh = 0; hh < 2; ++hh) {
        const int h = wave * 2 + hh;
        f32x4 acc[3][4];
#pragma unroll
        for (int m = 0; m < 3; ++m) {
            bfx8 Af[2], Bf[4][2];
#pragma unroll
            for (int ks = 0; ks < 2; ++ks) Af[ks] = *(const LAS bfx8*)(lo + (m * 16 + n16) * 72 + ks * 32 + q * 8);
#pragma unroll
            for (int i = 0; i < 4; ++i)
#pragma unroll
                for (int ks = 0; ks < 2; ++ks) Bf[i][ks] = *(const bfx8*)(UPT + (size_t)(m * RD + h * 64 + i * 16 + n16) * 64 + ks * 32 + q * 8);
#pragma unroll
            for (int i = 0; i < 4; ++i) { acc[m][i] = (f32x4){0.f, 0.f, 0.f, 0.f};
#pragma unroll
                for (int ks = 0; ks < 2; ++ks) acc[m][i] = __builtin_amdgcn_mfma_f32_16x16x32_bf16(Af[ks], Bf[i][ks], acc[m][i], 0, 0, 0); }
        }
        float mur[4], muk[4], muv[4], w0c[4], a0c[4], kkc[4], kac[4], rkc[4], sr[4], sk[4], sv[4];
#pragma unroll
        for (int i = 0; i < 4; ++i) { const int c = h * 64 + i * 16 + n16;
            mur[i] = mu[c]; muk[i] = mu[RD + c]; muv[i] = mu[2 * RD + c];
            w0c[i] = kp->in[15][l * RD + c]; a0c[i] = kp->in[17][l * RD + c]; kkc[i] = kp->in[20][l * RD + c]; kac[i] = kp->in[21][l * RD + c]; rkc[i] = kp->in[22][l * RD + c];
            sr[i] = prompt ? 0.f : ssh[c]; sk[i] = prompt ? 0.f : ssh[RD + c]; sv[i] = prompt ? 0.f : ssh[2 * RD + c]; }
#pragma unroll
        for (int r = 0; r < 4; ++r) {
            const int tok = 4 * q + r, t = t0 + tok, tau = tau0 + tok;
            const float* zr = Z + (size_t)t * NZ + ZQ;
            float rv[4], kv[4], vv[4], av[4], dv[4], kk[4];
            float skk = 0.f;
#pragma unroll
            for (int i = 0; i < 4; ++i) { const int c = h * 64 + i * 16 + n16;
                float rr = zr[c], k = zr[RD + c], v = zr[2 * RD + c];
                float pr, pk, pv;
                if (tau > 0) { pr = zr[c - NZ]; pk = zr[RD + c - NZ]; pv = zr[2 * RD + c - NZ]; } else { pr = sr[i]; pk = sk[i]; pv = sv[i]; }
                rr += (pr - rr) * mur[i]; k += (pk - k) * muk[i]; v += (pv - v) * muv[i];
                const float xw = -(w0c[i] + acc[0][i][r]);
                const float sp = fmaxf(xw, 0.f) + log1pf(expf(-fabsf(xw)));
                dv[i] = expf(-expf(-sp - 0.5f));
                av[i] = sigm(a0c[i] + acc[1][i][r]);
                rv[i] = rr; kv[i] = k; vv[i] = v; kk[i] = k * kkc[i]; skk += kk[i] * kk[i];
                G[(size_t)t * RD + c] = acc[2][i][r];
                }
            skk = rowsum16(skk);
            const float rinv = 1.0f / sqrtf(fmaxf(skk, 1e-24f));
            float srk = 0.f;
#pragma unroll
            for (int i = 0; i < 4; ++i) {
                const float kkn = kk[i] * rinv, kpv = kv[i] * (1.0f + (av[i] - 1.0f) * kac[i]), bb = kkn * av[i];
                srk += rv[i] * kpv * rkc[i];
                float* sc = SC + ((size_t)t * NH + h) * SCR + i * 16 + n16;
                sc[0] = dv[i]; sc[64] = kkn; sc[128] = bb; sc[192] = kpv; sc[256] = rv[i]; sc[320] = vv[i];
            }
            srk = rowsum16(srk);
            if (n16 == 0) RK[t * NH + h] = srk;
            __builtin_amdgcn_sched_barrier(0);
        }
    }
    if (tau0 + 16 == Ls) {
        float* osh = prompt ? kp->out + O_SHIFT_P + (size_t)(l * 4 + s) * RP : kp->out + O_SHIFT_S + (size_t)(l * 16 + s) * RP;
        const float* zr = Z + (size_t)(t0 + 15) * NZ + ZQ;
        for (int e = tid; e < RP; e += NTHR) osh[e] = zr[e];
    }
    __syncthreads();
}

__device__ __forceinline__ void sc_issue(f32x4 (&r)[4], const LAS f32x4* o, int c) {
    if (c < 4) {
#pragma unroll
        for (int i = 0; i < 4; ++i) r[i] = o[16 + 4 * c + i];
    } else { const int j = c - 4; r[0] = o[j]; r[1] = o[32 + j]; r[2] = o[48 + j]; r[3] = o[64 + j]; }
}
template <int MODE>
__device__ __forceinline__ void scan_run(const float* SC, int tg0, int nsteps, int h, LAS float* wl  , int lane,
                                         const float* Sinit, float* Y, float* GB, float* Sout, float* PQout) {
    constexpr int GS = 4, NCH = 20;
    f32x2 S[32];
    f32x2 P[(MODE == 3) ? 32 : 1];
    if (MODE == 3) {
        const int ln = launder_v(lane);
#pragma unroll
        for (int j = 0; j < 32; ++j) { S[j] = (f32x2){0.f, 0.f}; P[j] = (f32x2){(2 * j == ln) ? 1.f : 0.f, (2 * j + 1 == ln) ? 1.f : 0.f}; }
    } else {
#pragma unroll
        for (int j = 0; j < 16; ++j) { const f32x4 v = ((const f32x4*)(Sinit + lane * 64))[j]; S[2 * j] = (f32x2){v.x, v.y}; S[2 * j + 1] = (f32x2){v.z, v.w}; }
    }
#define SC_STAGE(g, buf) do { _Pragma("unroll") for (int s_ = 0; s_ < GS; ++s_) { const float* rec_ = SC + ((size_t)(tg0 + (g) * GS + s_) * NH + h) * SCR + lane; \
        _Pragma("unroll") for (int k_ = 0; k_ < 6; ++k_) __builtin_amdgcn_global_load_lds((const unsigned*)(rec_ + k_ * 64), (LAS unsigned*)(wl + ((buf) * GS + s_) * SCR + k_ * 64), 4, 0, 0); } } while (0)
    SC_STAGE(0, 0);
    const int ngroups = nsteps / GS;
    for (int g = 0; g < ngroups; ++g) {
        asm volatile("s_waitcnt vmcnt(0)" ::: "memory");
        if (g + 1 < ngroups) SC_STAGE(g + 1, (g + 1) & 1);
        const LAS float* wb = wl + (g & 1) * GS * SCR;
        f32x4 R[4][4];
#pragma unroll
        for (int q = 0; q < 3; ++q) sc_issue(R[q & 3], (const LAS f32x4*)(wb + (q / NCH) * SCR), q % NCH);
        __builtin_amdgcn_sched_barrier(0);
#pragma unroll
        for (int s = 0; s < GS; ++s) {
            f32x2 d2a = (f32x2){0.f, 0.f}, y2a = (f32x2){0.f, 0.f};
            f32x2 e2a = (f32x2){0.f, 0.f}, g2a = (f32x2){0.f, 0.f};
            f32x2 sa2 = (f32x2){0.f, 0.f}, sp2 = (f32x2){0.f, 0.f};
            const float vs = wb[s * SCR + 320 + lane];
            const f32x2 v2 = (f32x2){vs, vs};
#pragma unroll
            for (int c = 0; c < NCH; ++c) {
                const int q = s * NCH + c, qn = q + 3;
                if (qn < GS * NCH) sc_issue(R[qn & 3], (const LAS f32x4*)(wb + (qn / NCH) * SCR), qn % NCH);
                __builtin_amdgcn_sched_barrier(0);
                f32x4 (&r)[4] = R[q & 3];
                if (c < 4) {
#pragma unroll
                    for (int i = 0; i < 4; ++i) { const int j = 4 * c + i; d2a += S[2 * j] * (f32x2){r[i].x, r[i].y}; d2a += S[2 * j + 1] * (f32x2){r[i].z, r[i].w};
                        if (MODE == 3) { e2a += P[2 * j] * (f32x2){r[i].x, r[i].y}; e2a += P[2 * j + 1] * (f32x2){r[i].z, r[i].w}; } }
                    if (c == 3) { const f32x2 d2 = d2a; const float sa = -(d2.x + d2.y); sa2 = (f32x2){sa, sa};
                        if (MODE == 3) { const f32x2 e2 = e2a; const float sp = -(e2.x + e2.y); sp2 = (f32x2){sp, sp}; } }
                } else {
                    const int j = c - 4;
                    f32x2 t0 = v2 * (f32x2){r[2].x, r[2].y}; t0 = sa2 * (f32x2){r[1].x, r[1].y} + t0; S[2 * j] = S[2 * j] * (f32x2){r[0].x, r[0].y} + t0;
                    f32x2 t1 = v2 * (f32x2){r[2].z, r[2].w}; t1 = sa2 * (f32x2){r[1].z, r[1].w} + t1; S[2 * j + 1] = S[2 * j + 1] * (f32x2){r[0].z, r[0].w} + t1;
                    y2a += S[2 * j] * (f32x2){r[3].x, r[3].y}; y2a += S[2 * j + 1] * (f32x2){r[3].z, r[3].w};
                    if (MODE == 3) {
                        const f32x2 u0 = sp2 * (f32x2){r[1].x, r[1].y}, u1 = sp2 * (f32x2){r[1].z, r[1].w};
                        P[2 * j] = P[2 * j] * (f32x2){r[0].x, r[0].y} + u0; P[2 * j + 1] = P[2 * j + 1] * (f32x2){r[0].z, r[0].w} + u1;
                        g2a += P[2 * j] * (f32x2){r[3].x, r[3].y}; g2a += P[2 * j + 1] * (f32x2){r[3].z, r[3].w};
                    }
                }
                __builtin_amdgcn_sched_barrier(0);
            }
            { const f32x2 y2 = y2a; Y[(size_t)(tg0 + g * GS + s) * RD + h * 64 + lane] = y2.x + y2.y; }
            if (MODE == 3) { const f32x2 g2 = g2a; GB[(size_t)(tg0 + g * GS + s) * RD + h * 64 + lane] = g2.x + g2.y; }
        }
        asm volatile("s_waitcnt lgkmcnt(0)" ::: "memory");
    }
#undef SC_STAGE
    if (MODE == 3) {
#pragma unroll
        for (int j = 0; j < 16; ++j) { ((f32x4*)PQout)[j * 64 + lane] = (f32x4){P[2 * j].x, P[2 * j].y, P[2 * j + 1].x, P[2 * j + 1].y};
                                       ((f32x4*)(PQout + 4096))[j * 64 + lane] = (f32x4){S[2 * j].x, S[2 * j].y, S[2 * j + 1].x, S[2 * j + 1].y}; }
    } else {
#pragma unroll
        for (int j = 0; j < 16; ++j) ((f32x4*)(Sout + lane * 64))[j] = (f32x4){S[2 * j].x, S[2 * j].y, S[2 * j + 1].x, S[2 * j + 1].y};
    }
}
__device__ __forceinline__ void ycorr_task(const float* GB, float* Y, const float* S0q  , int tg0, int h, int lane) {
    const int n = lane & 15, kq = lane >> 4;
    float Bv[4][16];
#pragma unroll
    for (int nt = 0; nt < 4; ++nt)
#pragma unroll
        for (int ks = 0; ks < 16; ++ks) Bv[nt][ks] = S0q[(size_t)(ks * 64 + nt * 16 + n) * 4 + kq];
#pragma unroll 1
    for (int mt = 0; mt < CL / 16; ++mt) {
        const float* grow = GB + (size_t)(tg0 + mt * 16 + n) * RD + h * 64 + kq;
        float Av[16];
#pragma unroll
        for (int ks = 0; ks < 16; ++ks) Av[ks] = grow[ks * 4];
        f32x4 acc[4];
#pragma unroll
        for (int nt = 0; nt < 4; ++nt) acc[nt] = (f32x4){0.f, 0.f, 0.f, 0.f};
#pragma unroll
        for (int ks = 0; ks < 16; ++ks)
#pragma unroll
            for (int nt = 0; nt < 4; ++nt) acc[nt] = __builtin_amdgcn_mfma_f32_16x16x4f32(Av[ks], Bv[nt][ks], acc[nt], 0, 0, 0);
#pragma unroll
        for (int nt = 0; nt < 4; ++nt)
#pragma unroll
            for (int r = 0; r < 4; ++r) { float* yp = Y + (size_t)(tg0 + mt * 16 + 4 * kq + r) * RD + h * 64 + nt * 16 + n; *yp += acc[nt][r]; }
    }
}
__device__ __forceinline__ void combine_chain(const float* PQ, float* S0, float* Sfin, LAS unsigned char* lds, int tid, int wave, int lane) {
    LAS f32x4* pl = (LAS f32x4*)lds;
    LAS f32x4* xch = (LAS f32x4*)(lds + 16384);
    f32x2 S[32];
#pragma unroll
    for (int j = 0; j < 32; ++j) S[j] = (f32x2){0.f, 0.f};
    const int n4a = 2 * wave, n4b = 2 * wave + 1;
    const f32x4* Pc = (const f32x4*)PQ;
    f32x4 p0 = Pc[tid], p1 = Pc[tid + 512];
    for (int c = 0; c < NC; ++c) {
        const f32x4* Qc = (const f32x4*)(PQ + (size_t)(c * 2 + 1) * 4096);
        pl[tid] = p0; pl[tid + 512] = p1;
        f32x4 na = Qc[n4a * 64 + lane], nb = Qc[n4b * 64 + lane];
        if (c + 1 < NC) { const f32x4* Pn = (const f32x4*)(PQ + (size_t)((c + 1) * 2) * 4096); p0 = Pn[tid]; p1 = Pn[tid + 512]; }
        __syncthreads();
        f32x2 a0 = (f32x2){na.x, na.y}, a1 = (f32x2){na.z, na.w}, b0 = (f32x2){nb.x, nb.y}, b1 = (f32x2){nb.z, nb.w};
#pragma unroll
        for (int j = 0; j < 32; ++j) {
            const f32x4 pa0 = pl[n4a * 64 + 2 * j], pb0 = pl[n4b * 64 + 2 * j], pa1 = pl[n4a * 64 + 2 * j + 1], pb1 = pl[n4b * 64 + 2 * j + 1];
            const f32x2 s0 = (f32x2){S[j].x, S[j].x}, s1 = (f32x2){S[j].y, S[j].y};
            a0 += s0 * (f32x2){pa0.x, pa0.y}; a1 += s0 * (f32x2){pa0.z, pa0.w}; b0 += s0 * (f32x2){pb0.x, pb0.y}; b1 += s0 * (f32x2){pb0.z, pb0.w};
            a0 += s1 * (f32x2){pa1.x, pa1.y}; a1 += s1 * (f32x2){pa1.z, pa1.w}; b0 += s1 * (f32x2){pb1.x, pb1.y}; b1 += s1 * (f32x2){pb1.z, pb1.w};
            if ((j & 1) == 1) __builtin_amdgcn_sched_barrier(0);
        }
        na = (f32x4){a0.x, a0.y, a1.x, a1.y}; nb = (f32x4){b0.x, b0.y, b1.x, b1.y};
        if (c + 1 < NC) {
            xch[n4a * 64 + lane] = na; xch[n4b * 64 + lane] = nb;
            f32x4* So = (f32x4*)(S0 + (size_t)(c + 1) * 4096);
            So[n4a * 64 + lane] = na; So[n4b * 64 + lane] = nb;
            __syncthreads();
#pragma unroll
            for (int j = 0; j < 16; ++j) { const f32x4 v = xch[j * 64 + lane]; S[2 * j] = (f32x2){v.x, v.y}; S[2 * j + 1] = (f32x2){v.z, v.w}; }
        } else {
            *(f32x4*)(Sfin + lane * 64 + 8 * wave) = na; *(f32x4*)(Sfin + lane * 64 + 8 * wave + 4) = nb;
        }
        __syncthreads();
    }
}
__device__ __forceinline__ void post_rows(KP kp, int l, int gw, int ngw, int lane) {
    const float* SC = (const float*)(kp->ws + WS_SC); const float* Y = (const float*)(kp->ws + WS_Y); const float* G = (const float*)(kp->ws + WS_G); const float* RK = (const float*)(kp->ws + WS_RK);
    bf16* MIX = (bf16*)(kp->ws + WS_MIX);
    for (int it = gw; it < T * NH; it += ngw) {
        const int t = it >> 4, h = it & 15, c = h * 64 + lane;
        const float y = Y[(size_t)t * RD + c];
        const float mean = wave_sum(y) * (1.0f / 64.0f);
        const float d = y - mean;
        const float var = wave_sum(d * d) * (1.0f / 64.0f);
        const float yn = d * (1.0f / sqrtf(var + GN_EPS)) * kp->in[23][l * RD + c] + kp->in[24][l * RD + c];
        const float v = SC[((size_t)t * NH + h) * SCR + 320 + lane];
        const float o = (yn + RK[it] * v) * G[(size_t)t * RD + c];
        MIX[(size_t)t * D + 1024 + c] = (bf16)f2bf(o);
    }
}

__global__ void __launch_bounds__(NTHR, 2) fwd_mega(Params p) {
    extern __shared__ __attribute__((aligned(16))) unsigned char lds_raw[];
    LAS unsigned char* lds = (LAS unsigned char*)lds_raw;
    const int wave0 = __builtin_amdgcn_readfirstlane((int)threadIdx.x >> 6);
    volatile LAS unsigned* MISC = (volatile LAS unsigned*)(lds + 131072);
    if (threadIdx.x < 16) MISC[threadIdx.x] = 0u;
    __syncthreads();
    const XcdBarrier xbar = xcd_barrier_post((unsigned*)p.ws + 4096, MISC, (int)threadIdx.x);
    cg::this_grid().sync();

#pragma unroll 1
    for (int l = 0; l < DEPTH; ++l) {
        for (int rep = 0; rep < REP_CVT; ++rep) { PH_BEGIN();
#ifndef NO_CVT
          convert_weights(kp, l, lds, gw, ngw, wave, lane);
#endif
#ifndef NO_NORM
          float* X = (float*)(ws + WS_X); bf16* XN = (bf16*)(ws + WS_XN);
          if (l == 0) norm_rows(kp->in[0], kp->in[1], kp->in[6], X, XN, nullptr, nullptr, gw, ngw, lane);
          else norm_rows(X, X + (size_t)TP * D, kp->in[6] + l * D, nullptr, XN, nullptr, (const float*)(ws + WS_PART), gw, ngw, lane);
#endif
        }
        GSYNC();
#ifndef NO_GEMM1
        { PH_BEGIN(); pg8::Gemm g{(const bf16*)(ws + WS_XN), (const bf16*)(ws + WS_WIN), T, NZ, D}; pg8::StaticOrder S; S.init(T, NZ, D, nb, bid); pg8::EpiStoreF32 E{(float*)(ws + WS_Z), NZ};
          pg8::gemm_phase<pg8::EpiStoreF32, pg8::StaticOrder, true, true>(lds, g, S, E, tid); }
#endif
        GSYNC();
        for (int rep = 0; rep < REP_MIXA; ++rep) { PH_BEGIN();
          if (rep) __syncthreads();
          for (int it = bid; it < 1152; it += nb) {
#ifndef NO_PREP
            if (it < 576) _Pragma("unroll 1") for (int r_ = 0; r_ < REP_PREP; ++r_) prep_item(kp, l, it, lds, tid);
#endif
#ifndef NO_POOL
            if (it >= 576 && it < 864) _Pragma("unroll 1") for (int r_ = 0; r_ < REP_POOL; ++r_) pool_item(kp, l, it - 576, lds, tid);
#endif
#ifndef NO_CONV
            if (it >= 864) _Pragma("unroll 1") for (int r_ = 0; r_ < REP_CONV; ++r_) conv_item(kp, l, it - 864, (LAS float*)lds, tid);
#endif
          }
        }
        GSYNC();
#ifndef NO_SCAN
        for (int rep = 0; rep < REP_SCAN; ++rep) {
        if (rep) GSYNC();
        for (int rp = 0; rp < REP_P1; ++rp) { PH_BEGIN();
            const float* SC = (const float*)(ws + WS_SC); float* Y = (float*)(ws + WS_Y); float* PQ = (float*)(ws + WS_PQ); float* GB = (float*)(ws + WS_GB);
            LAS float* wl = (LAS float*)(lds + wave * 12288);
            for (int task = wave * nb + bid; task < 64 * NC + 256; task += NWAVES * nb) {
                if (task < 64 * NC) {
                    const int ch = task / NC, c = task % NC, s = ch >> 4, h = ch & 15;
                    scan_run<3>(SC, s * 2048 + c * CL, CL, h, wl, lane, nullptr, Y, GB, nullptr, PQ + (size_t)((ch * NC + c) * 2) * 4096);
                } else {
                    const int ch = task - 64 * NC, b = ch >> 4, h = ch & 15;
                    scan_run<1>(SC, TP + b * 64, 64, h, wl, lane, kp->in[5] + (size_t)((l * 16 + b) * NH + h) * 4096, Y, nullptr, kp->out + O_WKV_S + (size_t)((l * 16 + b) * NH + h) * 4096, nullptr);
                }
            }
        }
        GSYNC();
        for (int rp = 0; rp < REP_CB; ++rp) { PH_BEGIN();
            for (int ch = bid; ch < 64; ch += nb) { const int s = ch >> 4, h = ch & 15;
                combine_chain((const float*)(ws + WS_PQ) + (size_t)ch * NC * 2 * 4096, (float*)(ws + WS_S0) + (size_t)ch * NC * 4096, kp->out + O_WKV_P + (size_t)((l * 4 + s) * NH + h) * 4096, lds, tid, wave, lane); }
        }
        GSYNC();
        { PH_BEGIN();
            const float* GB = (const float*)(ws + WS_GB); float* Y = (float*)(ws + WS_Y); const float* S0 = (const float*)(ws + WS_S0);
            for (int task = wave * nb + bid; task < 64 * (NC - 1); task += NWAVES * nb) {
                const int ch = task / (NC - 1), c = 1 + task % (NC - 1), s = ch >> 4, h = ch & 15;
                ycorr_task(GB, Y, S0 + (size_t)(ch * NC + c) * 4096, s * 2048 + c * CL, h, lane);
            }
        }
        }
#endif
        GSYNC();
#ifndef NO_POST
        for (int rep = 0; rep < REP_POST; ++rep) { PH_BEGIN(); post_rows(kp, l, gw, ngw, lane); }
#endif
        GSYNC();
#ifndef NO_GEMM2
        { PH_BEGIN(); pg8::Gemm g{(const bf16*)(ws + WS_MIX), (const bf16*)(ws + WS_WOUT), T, D, D}; pg8::TailOrder S; S.init(D, D, nb, bid); pg8::EpiResAdd E{(float*)(ws + WS_X), D, (float*)(ws + WS_PART)};
          pg8::gemm_phase<pg8::EpiResAdd, pg8::TailOrder, true, true>(lds, g, S, E, tid); }
#endif
        GSYNC();
#ifndef NO_NORM
        { PH_BEGIN(); float* X = (float*)(ws + WS_X); norm_rows(X, X + (size_t)TP * D, kp->in[26] + l * D, nullptr, (bf16*)(ws + WS_XN), nullptr, (const float*)(ws + WS_PART), gw, ngw, lane); }
#endif
        GSYNC();
#ifndef NO_GEMM3
        { PH_BEGIN(); pg8::Gemm g{(const bf16*)(ws + WS_XN), (const bf16*)(ws + WS_WGU), T, NGU, D}; pg8::StaticOrder S; S.init(T, NGU, D, nb, bid); pg8::EpiSwiGLU E{(bf16*)(ws + WS_ACT), FF};
          pg8::gemm_phase<pg8::EpiSwiGLU, pg8::StaticOrder, true, true>(lds, g, S, E, tid); }
#endif
        GSYNC();
#ifndef NO_GEMM4
        { PH_BEGIN(); pg8::Gemm g{(const bf16*)(ws + WS_ACT), (const bf16*)(ws + WS_WDN), T, D, FF}; pg8::TailOrder S; S.init(D, FF, nb, bid); pg8::EpiResAdd E{(float*)(ws + WS_X), D, (float*)(ws + WS_PART)};
          pg8::gemm_phase<pg8::EpiResAdd, pg8::TailOrder, true, true>(lds, g, S, E, tid); }
#endif
        GSYNC();
    }
#ifndef NO_NORM
    { PH_BEGIN(); float* X = (float*)(ws + WS_X); norm_rows(X, X + (size_t)TP * D, kp->in[30], nullptr, nullptr, kp->out + O_Y, (const float*)(ws + WS_PART), gw, ngw, lane); }
#endif
}

extern "C" void kernel_launch(void* const* d_in, const int* in_sizes, int n_in, void* d_out, int out_size, void* d_ws, size_t ws_size, hipStream_t stream) {
    static int grid = 0;
    if (grid == 0) {
        if (n_in != 31 || (size_t)out_size != O_END || ws_size < WS_END) { fprintf(stderr, "kernel_launch: unexpected shapes: n_in %d out %d ws %zu (need %zu)\n", n_in, out_size, ws_size, (size_t)WS_END); grid = -1; return; }
        int dev = 0, cus = 0, per_cu = 0;
        hipGetDevice(&dev);
        hipDeviceGetAttribute(&cus, hipDeviceAttributeMultiprocessorCount, dev);
        if (hipFuncSetAttribute((const void*)fwd_mega, hipFuncAttributeMaxDynamicSharedMemorySize, LDS_BYTES) != hipSuccess) { fprintf(stderr, "kernel_launch: hipFuncSetAttribute failed\n"); grid = -1; return; }
        hipOccupancyMaxActiveBlocksPerMultiprocessor(&per_cu, (const void*)fwd_mega, NTHR, LDS_BYTES);
        (void)hipGetLastError();
        if (per_cu < 1) { fprintf(stderr, "kernel_launch: occupancy query says %d blocks per CU\n", per_cu); per_cu = 1; }
        grid = cus * 1;
    }
    if (grid < 0) return;
    Params p{};
    for (int i = 0; i < 31; ++i) p.in[i] = (const float*)d_in[i];
    p.out = (float*)d_out; p.ws = (unsigned char*)d_ws;
    if (hipMemsetAsync(d_ws, 0, 65536, stream) != hipSuccess) { fprintf(stderr, "kernel_launch: memset failed\n"); return; }
    void* args[] = {&p};
    hipError_t e = hipLaunchCooperativeKernel((const void*)fwd_mega, dim3(grid), dim3(NTHR), args, LDS_BYTES, stream);
    if (e != hipSuccess) fprintf(stderr, "cooperative launch failed: %s (grid %d)\n", hipGetErrorString(e), grid);
}
```

```cpp
#include <hip/hip_runtime.h>
#include <hip/hip_cooperative_groups.h>
#include <cstdio>
#include <cstdint>
namespace cg = cooperative_groups;

namespace pg8 {
#define PG8_LAS __attribute__((address_space(3)))
typedef unsigned short bf16_t;
typedef short bf16x8 __attribute__((ext_vector_type(8)));
typedef float f32x4 __attribute__((ext_vector_type(4)));
typedef unsigned u32x4 __attribute__((ext_vector_type(4)));
constexpr int BM = 256, BK = 64, HALF = 128, HTB = HALF * BK * 2  , STAGE_BYTES = 8 * HTB, NXCD = 8, WGM = 8;

__host__ __device__ __forceinline__ int lds_byte(int r, int c) { const int st = (r >> 4) * 2 + (c >> 5), rr = r & 15, cc = c & 31, ob = rr * 64 + cc * 2; return st * 1024 + (ob ^ (((ob >> 9) & 1) << 5)); }
__host__ __device__ __forceinline__ void stage_rc(int b, int& R, int& C) { const int st = b / 1024, sb = b % 1024, swz = sb ^ (((sb >> 9) & 1) << 5); R = (st >> 1) * 16 + swz / 64; C = (st & 1) * 32 + (swz % 64) / 2; }
__host__ __device__ __forceinline__ int perm32(int rho) { const int n = rho >> 4, i = rho & 15; return 8 * (i >> 2) + 4 * n + (i & 3); }

struct Unit { int pm, pn, k0, nt, part; };
struct Gemm { const bf16_t* A; const bf16_t* Bt; int M, N, K; };

struct StaticOrder {
    int nM, nN, nwg, G, c, ntfull;
    __host__ __device__ void init(int M, int N, int K, int G_, int c_) { nM = M / BM; nN = N / BM; nwg = nM * nN; G = G_; c = c_; ntfull = K / BK; }
    __host__ __device__ __forceinline__ bool next(int i, Unit& u) const {
        const long L = (long)i * G + c; if (L >= nwg) return false;
        int wgid = (int)L; { const int q = nwg / NXCD, r = nwg % NXCD, xcd = wgid % NXCD, off = wgid / NXCD; wgid = (xcd < r ? xcd * (q + 1) : r * (q + 1) + (xcd - r) * q) + off; }
        const int nig = WGM * nN, gid = wgid / nig, fm = gid * WGM, gsz = (nM - fm) < WGM ? (nM - fm) : WGM;
        u.pm = fm + ((wgid % nig) % gsz); u.pn = (wgid % nig) / gsz; u.k0 = 0; u.nt = ntfull; u.part = -1; return true;
    }
    __device__ __forceinline__ void a_ready(const Unit&) const {}
    __device__ __forceinline__ void done(const Unit&) const {}
};


struct TailOrder {
    int nN, G, c, ntfull;
    __host__ __device__ void init(int N, int K, int G_, int c_) { nN = N / BM; G = G_; c = c_; ntfull = K / BK; }
    __host__ __device__ __forceinline__ bool next(int i, Unit& u) const {
        const int L = i * G + c, nfull = 32 * nN;
        if (L >= nfull + 4 * nN * 8) return false;
        const bool full = L < nfull;
        int wgid = full ? L : 0; { const int q = nfull / NXCD, r = nfull % NXCD, xcd = wgid % NXCD, off = wgid / NXCD; wgid = (xcd < r ? xcd * (q + 1) : r * (q + 1) + (xcd - r) * q) + off; }
        const int nig = WGM * nN, gid = wgid / nig, fm = gid * WGM;
        const int fpm = fm + ((wgid % nig) % WGM), fpn = (wgid % nig) / WGM;
        const int ut = full ? 0 : L - nfull, tile = ut >> 3, ks = ut & 7, base = (ntfull / 8) & ~1, extra = (ntfull - 8 * base) / 2;
        const int tpm = 32 + tile / nN, tpn = tile % nN, tnt = base + (ks < extra ? 2 : 0), tk0 = ks * base + 2 * (ks < extra ? ks : extra);
        Unit r_; r_.pm = full ? fpm : tpm; r_.pn = full ? fpn : tpn; r_.k0 = full ? 0 : tk0; r_.nt = full ? ntfull : tnt; r_.part = full ? -1 : ks;
        u = r_; return true;
    }
    __device__ __forceinline__ void a_ready(const Unit&) const {}
    __device__ __forceinline__ void done(const Unit&) const {}
};

__device__ __forceinline__ unsigned cvt_pk_bf16(float lo, float hi) { unsigned r; asm volatile("v_cvt_pk_bf16_f32 %0, %1, %2" : "=v"(r) : "v"(lo), "v"(hi)); return r; }

struct EpiStoreF32 {
    static constexpr bool PERM = true, AFTER_DRAIN = false;
    float* O; int ldc;
    __device__ __forceinline__ void operator()(const f32x4 (&acc)[2][2][4][2], const Unit& u, int wr, int wc, int fr, int fq) const {
        const int row0 = u.pm * BM + wr * 64 + fr, col0 = u.pn * BM + wc * 32 + 8 * fq;
#pragma unroll
        for (int ai = 0; ai < 2; ++ai)
#pragma unroll
            for (int m = 0; m < 4; ++m) { float* rowp = O + (size_t)(row0 + ai * HALF + m * 16) * ldc + col0;
#pragma unroll
                for (int bj = 0; bj < 2; ++bj) { *(f32x4*)(rowp + bj * HALF) = acc[ai][bj][m][0]; *(f32x4*)(rowp + bj * HALF + 4) = acc[ai][bj][m][1]; } }
    }
};
struct EpiResAdd {
    static constexpr bool PERM = true, AFTER_DRAIN = false;
    float* O; int ldc; float* P;
    __device__ __forceinline__ void operator()(const f32x4 (&acc)[2][2][4][2], const Unit& u, int wr, int wc, int fr, int fq) const {
        const int row0 = u.pm * BM + wr * 64 + fr, col0 = u.pn * BM + wc * 32 + 8 * fq;
        if (u.part < 0) {
#pragma unroll
            for (int ai = 0; ai < 2; ++ai)
#pragma unroll
                for (int m = 0; m < 4; ++m) { float* rowp = O + (size_t)(row0 + ai * HALF + m * 16) * ldc + col0;
#pragma unroll
                    for (int bj = 0; bj < 2; ++bj) {
                        f32x4 a = *(const f32x4*)(rowp + bj * HALF), b = *(const f32x4*)(rowp + bj * HALF + 4);
                        *(f32x4*)(rowp + bj * HALF) = a + acc[ai][bj][m][0]; *(f32x4*)(rowp + bj * HALF + 4) = b + acc[ai][bj][m][1]; } }
        } else {
            float* base = P + (size_t)u.part * 1024 * ldc;
#pragma unroll
            for (int ai = 0; ai < 2; ++ai)
#pragma unroll
                for (int m = 0; m < 4; ++m) { float* rowp = base + (size_t)(row0 - 8192 + ai * HALF + m * 16) * ldc + col0;
#pragma unroll
                    for (int bj = 0; bj < 2; ++bj) { *(f32x4*)(rowp + bj * HALF) = acc[ai][bj][m][0]; *(f32x4*)(rowp + bj * HALF + 4) = acc[ai][bj][m][1]; } }
        }
    }
};
struct EpiSwiGLU {
    static constexpr bool PERM = true, AFTER_DRAIN = false;
    bf16_t* O; int ldc;
    __device__ __forceinline__ void operator()(const f32x4 (&acc)[2][2][4][2], const Unit& u, int wr, int wc, int fr, int fq) const {
        const int row0 = u.pm * BM + wr * 64 + fr, col0 = u.pn * HALF + wc * 32 + 8 * fq;
#pragma unroll
        for (int ai = 0; ai < 2; ++ai)
#pragma unroll
            for (int m = 0; m < 4; ++m) { bf16_t* rowp = O + (size_t)(row0 + ai * HALF + m * 16) * ldc + col0;
                float o[8];
#pragma unroll
                for (int n = 0; n < 2; ++n)
#pragma unroll
                    for (int j = 0; j < 4; ++j) { const float g = acc[ai][0][m][n][j], up = acc[ai][1][m][n][j]; o[n * 4 + j] = g * up * __builtin_amdgcn_rcpf(1.0f + __expf(-g)); }
                u32x4 w; w.x = cvt_pk_bf16(o[0], o[1]); w.y = cvt_pk_bf16(o[2], o[3]); w.z = cvt_pk_bf16(o[4], o[5]); w.w = cvt_pk_bf16(o[6], o[7]);
                *(u32x4*)rowp = w; }
    }
};

template <class Epi, class Sched, bool ALIGN_EPI = false, bool SP2 = false>
__device__ __forceinline__ void gemm_phase(PG8_LAS unsigned char* lds, const Gemm g, const Sched& S, const Epi& E, const int tid) {
    const int wid = __builtin_amdgcn_readfirstlane(tid >> 6), lane = tid & 63, wr = wid >> 2, wc = wid & 3, fr = lane & 15, fq = lane >> 4;
    const int K = g.K;
    unsigned voffA[2], voffB[2];
#pragma unroll
    for (int i = 0; i < 2; ++i) { int R, C; stage_rc(tid * 16 + i * 8192, R, C); const int Rb = Epi::PERM ? ((R & ~31) + perm32(R & 31)) : R;
        voffA[i] = (unsigned)(R * K + C) * 2u; voffB[i] = (unsigned)(Rb * K + C) * 2u; }
    const size_t kstep = (size_t)(BK * 2);
    const size_t hstep = (size_t)HALF * K * 2;
    const size_t tstep = 2 * hstep;
    const unsigned ldsw = (unsigned)wid * 1024u;
    const int aoff = lds_byte(wr * 64 + fr, fq * 8), boff = lds_byte(wc * 32 + fr, fq * 8);
#define PG8_SA(b, h) (((b) * 2 + (h)) * HTB)
#define PG8_SB(b, h) ((4 + (b) * 2 + (h)) * HTB)
#define PG8_STAGE(bufoff, gbase, voff) do { _Pragma("unroll") for (int _i = 0; _i < 2; ++_i) \
        __builtin_amdgcn_global_load_lds((const unsigned*)((const char*)(gbase) + (voff)[_i]), (PG8_LAS unsigned*)(lds + (bufoff) + ldsw + _i * 8192), 16, 0, 0); } while (0)
#define PG8_LDA(dst, b, h) do { _Pragma("unroll") for (int m = 0; m < 4; ++m) _Pragma("unroll") for (int k = 0; k < 2; ++k) dst[m][k] = *(const PG8_LAS bf16x8*)(lds + PG8_SA(b, h) + aoff + m * 2048 + k * 1024); } while (0)
#define PG8_LDB(dst, b, h) do { _Pragma("unroll") for (int n = 0; n < 2; ++n) _Pragma("unroll") for (int k = 0; k < 2; ++k) dst[n][k] = *(const PG8_LAS bf16x8*)(lds + PG8_SB(b, h) + boff + n * 2048 + k * 1024); } while (0)
#define PG8_MMA(ai, bj, At, Bt) do { __builtin_amdgcn_s_setprio(1); _Pragma("unroll") for (int m = 0; m < 4; ++m) _Pragma("unroll") for (int n = 0; n < 2; ++n) _Pragma("unroll") for (int k = 0; k < 2; ++k) \
        acc[ai][bj][m][n] = __builtin_amdgcn_mfma_f32_16x16x32_bf16(Bt[n][k], At[m][k], acc[ai][bj][m][n], 0, 0, 0); __builtin_amdgcn_s_setprio(0); } while (0)
#define PG8_WAIT_V(n) asm volatile("s_waitcnt vmcnt(" #n ")" ::: "memory")
#define PG8_WAIT_L(n) asm volatile("s_waitcnt lgkmcnt(" #n ")" ::: "memory")
#define PG8_BAR __builtin_amdgcn_s_barrier()
#define PG8_SCHED __builtin_amdgcn_sched_barrier(0)
    Unit cur, nxt; int ui = 0;
    if (!S.next(0, cur)) return;
    f32x4 acc[2][2][4][2];
#pragma unroll
    for (int a = 0; a < 2; ++a)
#pragma unroll
        for (int b = 0; b < 2; ++b)
#pragma unroll
            for (int m = 0; m < 4; ++m)
#pragma unroll
                for (int n = 0; n < 2; ++n) acc[a][b][m][n] = (f32x4){0.f, 0.f, 0.f, 0.f};
    bf16x8 At[4][2], B0[2][2], B1[2][2];
    const char* cA = (const char*)g.A + (size_t)cur.pm * tstep + (size_t)cur.k0 * kstep; const char* cB = (const char*)g.Bt + (size_t)cur.pn * tstep + (size_t)cur.k0 * kstep;
    S.a_ready(cur);
    if constexpr (SP2) {
        PG8_STAGE(PG8_SB(0, 0), cB, voffB); PG8_STAGE(PG8_SB(0, 1), cB + hstep, voffB); PG8_STAGE(PG8_SA(0, 0), cA, voffA); PG8_STAGE(PG8_SA(0, 1), cA + hstep, voffA);
        if (wr == 1) PG8_BAR;
        PG8_WAIT_V(2); PG8_BAR;
        PG8_STAGE(PG8_SB(1, 0), cB + kstep, voffB); PG8_STAGE(PG8_SA(1, 0), cA + kstep, voffA); PG8_STAGE(PG8_SB(1, 1), cB + hstep + kstep, voffB);
        PG8_WAIT_V(6); PG8_BAR;
    } else {
        PG8_STAGE(PG8_SB(0, 0), cB, voffB); PG8_STAGE(PG8_SA(0, 0), cA, voffA); PG8_STAGE(PG8_SB(0, 1), cB + hstep, voffB); PG8_STAGE(PG8_SA(0, 1), cA + hstep, voffA);
        if (wr == 1) PG8_BAR;
        PG8_WAIT_V(4); PG8_BAR;
        PG8_STAGE(PG8_SB(1, 0), cB + kstep, voffB); PG8_STAGE(PG8_SA(1, 0), cA + kstep, voffA); PG8_STAGE(PG8_SB(1, 1), cB + hstep + kstep, voffB);
        PG8_WAIT_V(6); PG8_BAR;
    }
    for (;;) {
        const bool has_next = S.next(ui + 1, nxt);
        const char* nA = has_next ? (const char*)g.A + (size_t)nxt.pm * tstep + (size_t)nxt.k0 * kstep : cA; const char* nB = has_next ? (const char*)g.Bt + (size_t)nxt.pn * tstep + (size_t)nxt.k0 * kstep : cB;
        const int nt = cur.nt;
        for (int t = 0; t < nt; t += 2) {
            const bool last = (t == nt - 2);
            const char* a1 = cA + (size_t)(t + 1) * kstep;
            const char* a2 = last ? nA : cA + (size_t)(t + 2) * kstep; const char* b2 = last ? nB : cB + (size_t)(t + 2) * kstep;
            const char* a3 = a2 + kstep; const char* b3 = b2 + kstep;
            if (last && has_next) S.a_ready(nxt);
            if constexpr (SP2) {
            PG8_LDB(B0, 0, 0); PG8_LDB(B1, 0, 1); PG8_SCHED; PG8_LDA(At, 0, 0); PG8_STAGE(PG8_SA(1, 1), a1 + hstep, voffA);
            PG8_WAIT_V(8); PG8_WAIT_L(0); PG8_BAR; PG8_MMA(0, 0, At, B0); PG8_MMA(0, 1, At, B1); PG8_BAR; PG8_SCHED;
            PG8_LDA(At, 0, 1); PG8_STAGE(PG8_SB(0, 0), b2, voffB); PG8_STAGE(PG8_SB(0, 1), b2 + hstep, voffB); PG8_STAGE(PG8_SA(0, 0), a2, voffA);
            PG8_WAIT_V(8); PG8_WAIT_L(0); PG8_BAR; PG8_MMA(1, 0, At, B0); PG8_MMA(1, 1, At, B1); PG8_BAR; PG8_SCHED;
            PG8_LDB(B0, 1, 0); PG8_LDB(B1, 1, 1); PG8_SCHED; PG8_LDA(At, 1, 0); PG8_STAGE(PG8_SA(0, 1), a2 + hstep, voffA);
            PG8_WAIT_V(8); PG8_WAIT_L(0); PG8_BAR; PG8_MMA(0, 0, At, B0); PG8_MMA(0, 1, At, B1); PG8_BAR; PG8_SCHED;
            PG8_LDA(At, 1, 1); PG8_STAGE(PG8_SB(1, 0), b3, voffB); PG8_STAGE(PG8_SB(1, 1), b3 + hstep, voffB); PG8_STAGE(PG8_SA(1, 0), a3, voffA);
            PG8_WAIT_V(8); PG8_WAIT_L(0); PG8_BAR; PG8_MMA(1, 0, At, B0); PG8_MMA(1, 1, At, B1); PG8_BAR; PG8_SCHED;
            } else {
            PG8_LDB(B0, 0, 0); PG8_SCHED; PG8_LDA(At, 0, 0); PG8_STAGE(PG8_SA(1, 1), a1 + hstep, voffA);
            PG8_WAIT_L(8); PG8_BAR; PG8_WAIT_L(0); PG8_MMA(0, 0, At, B0); PG8_BAR; PG8_SCHED;
            PG8_LDB(B1, 0, 1); PG8_STAGE(PG8_SB(0, 0), b2, voffB);
            PG8_BAR; PG8_WAIT_L(0); PG8_MMA(0, 1, At, B1); PG8_BAR;
            PG8_LDA(At, 0, 1); PG8_STAGE(PG8_SA(0, 0), a2, voffA);
            PG8_BAR; PG8_WAIT_L(0); PG8_MMA(1, 0, At, B0); PG8_BAR; PG8_SCHED;
            PG8_STAGE(PG8_SB(0, 1), b2 + hstep, voffB);
            PG8_WAIT_V(6); PG8_BAR; PG8_MMA(1, 1, At, B1); PG8_BAR;
            PG8_LDB(B0, 1, 0); PG8_SCHED; PG8_LDA(At, 1, 0); PG8_STAGE(PG8_SA(0, 1), a2 + hstep, voffA);
            PG8_WAIT_L(8); PG8_BAR; PG8_WAIT_L(0); PG8_MMA(0, 0, At, B0); PG8_BAR; PG8_SCHED;
            PG8_LDB(B1, 1, 1); PG8_STAGE(PG8_SB(1, 0), b3, voffB);
            PG8_BAR; PG8_WAIT_L(0); PG8_MMA(0, 1, At, B1); PG8_BAR;
            PG8_LDA(At, 1, 1); PG8_STAGE(PG8_SA(1, 0), a3, voffA);
            PG8_BAR; PG8_WAIT_L(0); PG8_MMA(1, 0, At, B0); PG8_BAR; PG8_SCHED;
            PG8_STAGE(PG8_SB(1, 1), b3 + hstep, voffB);
            PG8_WAIT_V(6); PG8_BAR; PG8_MMA(1, 1, At, B1); PG8_BAR;
            }
        }
        if constexpr (ALIGN_EPI) { if (wr == 0) PG8_BAR; }
        if constexpr (!Epi::AFTER_DRAIN) { E(acc, cur, wr, wc, fr, fq); S.done(cur); }
        if (!has_next) break;
#pragma unroll
        for (int a = 0; a < 2; ++a)
#pragma unroll
            for (int b = 0; b < 2; ++b)
#pragma unroll
                for (int m = 0; m < 4; ++m)
#pragma unroll
                    for (int n = 0; n < 2; ++n) acc[a][b][m][n] = (f32x4){0.f, 0.f, 0.f, 0.f};
        cur = nxt; cA = nA; cB = nB; ++ui;
        if constexpr (ALIGN_EPI) { if (wr == 1) PG8_BAR; }
    }
    PG8_WAIT_V(0);
    if constexpr (!ALIGN_EPI) { if (wr == 0) PG8_BAR; }
    PG8_BAR;
    if constexpr (Epi::AFTER_DRAIN) { E.fused(acc, cur, wr, wc, fr, fq, lds, wid, lane); S.done(cur); }
#undef PG8_SA
#undef PG8_SB
#undef PG8_STAGE
#undef PG8_LDA
#undef PG8_LDB
#undef PG8_MMA
#undef PG8_WAIT_V
#undef PG8_WAIT_L
#undef PG8_BAR
#undef PG8_SCHED
}
}

#define LAS __attribute__((address_space(3)))
typedef unsigned short bf16;
typedef float f32x4 __attribute__((ext_vector_type(4)));
typedef float f32x2 __attribute__((ext_vector_type(2)));
typedef unsigned u32x4 __attribute__((ext_vector_type(4)));
typedef unsigned u32x2 __attribute__((ext_vector_type(2)));
typedef short bfx8 __attribute__((ext_vector_type(8)));
#define XB_TMO      128
#define XB_XCNT(j)  (256  + 64 * (j))
#define XB_XSUB(j)  (1280 + 64 * (j))
#define XB_XGEN(j)  (2304 + 64 * (j))
#define XB_TOP      3328
#define XB_TOPGEN   3392
#define XCD_BAR_WORDS 3456
#define XB_SPIN_CAP (1u << 18)

__device__ __forceinline__ unsigned xb_ld(unsigned* p)              { return __hip_atomic_load(p, __ATOMIC_RELAXED, __HIP_MEMORY_SCOPE_AGENT); }
__device__ __forceinline__ unsigned xb_add(unsigned* p, unsigned v) { return __hip_atomic_fetch_add(p, v, __ATOMIC_RELAXED, __HIP_MEMORY_SCOPE_AGENT); }
__device__ __forceinline__ unsigned xb_xcc_id() { return (unsigned)__builtin_amdgcn_s_getreg((3 << 11) | 20) & 0xFu; }
#define XB_SPIN(cond, bar) do { unsigned _sp = 0; while (cond) { __builtin_amdgcn_s_sleep(1); \
    if ((++_sp & 255u) == 0u) { if (xb_ld(&(bar)[XB_TMO])) break; if (_sp > XB_SPIN_CAP) { atomicAdd(&(bar)[XB_TMO], 1u); break; } } } } while (0)

struct XcdBarrier {
    unsigned* bar; unsigned x;
    volatile LAS unsigned* st;
};

__device__ __forceinline__ XcdBarrier xcd_barrier_post(unsigned* bar, volatile LAS unsigned* st, int tid) {
    XcdBarrier b; b.bar = bar; b.x = xb_xcc_id(); b.st = st;
    if (tid == 0) (void)xb_add(&bar[XB_XCNT(b.x)], 1u);
    return b;
}
__device__ __forceinline__ void xcd_barrier_complete(unsigned* bar, unsigned x, unsigned& nloc, unsigned& nx) {
    const unsigned G = gridDim.x * gridDim.y * gridDim.z;
    unsigned sum, cnt, mine, sp = 0u;
    for (;;) {
        sum = 0u; cnt = 0u; mine = 0u;
#pragma unroll
        for (unsigned j = 0; j < 16; ++j) { const unsigned c = xb_ld(&bar[XB_XCNT(j)]); sum += c; cnt += (c > 0u) ? 1u : 0u; mine = (j == x) ? c : mine; }
        if (sum == G) break;
        __builtin_amdgcn_s_sleep(1);
        if ((++sp & 255u) == 0u) { if (xb_ld(&bar[XB_TMO])) break; if (sp > XB_SPIN_CAP) { atomicAdd(&bar[XB_TMO], 1u); break; } }
    }
    nloc = mine > 0u ? mine : 1u; nx = cnt > 0u ? cnt : 1u;
}

__device__ __forceinline__ void xcd_barrier(const XcdBarrier& b, int tid) {
    asm volatile("s_waitcnt vmcnt(0)" ::: "memory");
    __syncthreads();
    if (tid == 0) {
        unsigned* bar = b.bar;
        __builtin_amdgcn_s_waitcnt(0);
        unsigned nloc = b.st[0], nx = b.st[1];
        if (nloc == 0u) { xcd_barrier_complete(bar, b.x, nloc, nx); b.st[0] = nloc; b.st[1] = nx; }
        const unsigned old = xb_add(&bar[XB_XSUB(b.x)], 1u);
        const unsigned gen = old / nloc;
        if (old + 1u == (gen + 1u) * nloc) {
            __builtin_amdgcn_fence(__ATOMIC_RELEASE, "agent");
            asm volatile("s_waitcnt vmcnt(0)" ::: "memory");
            const unsigned og = xb_add(&bar[XB_TOP], 1u);
            const unsigned tg = og / nx;
            if (og + 1u == (tg + 1u) * nx) xb_add(&bar[XB_TOPGEN], 1u);
            else XB_SPIN(xb_ld(&bar[XB_TOPGEN]) == tg, bar);
            __builtin_amdgcn_fence(__ATOMIC_ACQUIRE, "agent");
            xb_add(&bar[XB_XGEN(b.x)], 1u);
            asm volatile("s_waitcnt vmcnt(0)" ::: "memory");
        } else {
            XB_SPIN(xb_ld(&bar[XB_XGEN(b.x)]) == gen, bar);
            __builtin_amdgcn_fence(__ATOMIC_ACQUIRE, "agent");
            asm volatile("s_waitcnt vmcnt(0)" ::: "memory");
        }
    }
    __syncthreads();
}

constexpr int NWAVES = 8, NTHR = 512;
constexpr int TP = 8192, TS = 1024, T = 9216, D = 2048, NIN = 4800, NZ = 4864, FF = 5632, NGU = 11264;
constexpr int NH = 16, HS = 64, RD = 1024, RP = 3264, DEPTH = 4;
constexpr int ZQ = 1536;
constexpr float RMS_EPS = 1e-6f, LN_EPS = 1e-5f, GN_EPS = 64e-5f;
constexpr int SCR = 384;
constexpr size_t O_Y = 0;
constexpr size_t O_CONV_P = (size_t)T * D;
constexpr size_t O_POOL_P = O_CONV_P + (size_t)DEPTH * 4 * 30 * 512;
constexpr size_t O_SHIFT_P = O_POOL_P + (size_t)DEPTH * 4 * 15 * 512;
constexpr size_t O_WKV_P = O_SHIFT_P + (size_t)DEPTH * 4 * RP;
constexpr size_t O_CONV_S = O_WKV_P + (size_t)DEPTH * 4 * NH * 4096;
constexpr size_t O_POOL_S = O_CONV_S + (size_t)DEPTH * 16 * 30 * 512;
constexpr size_t O_SHIFT_S = O_POOL_S + (size_t)DEPTH * 16 * 15 * 512;
constexpr size_t O_WKV_S = O_SHIFT_S + (size_t)DEPTH * 16 * RP;
constexpr size_t O_END = O_WKV_S + (size_t)DEPTH * 16 * NH * 4096;
constexpr size_t WS_POOLW = 131072;
constexpr size_t WS_UPS = 262144;
constexpr size_t WS_WIN = 1u << 20;
constexpr size_t WS_WOUT = WS_WIN + (size_t)NZ * D * 2;
constexpr size_t WS_WGU = WS_WOUT + (size_t)D * D * 2;
constexpr size_t WS_WDN = WS_WGU + (size_t)NGU * D * 2;
constexpr size_t WS_X = WS_WDN + (size_t)D * FF * 2;
constexpr size_t WS_XN = WS_X + (size_t)T * D * 4;
constexpr size_t WS_MIX = WS_XN + (size_t)T * D * 2;
constexpr size_t WS_Z = WS_MIX + (size_t)T * D * 2;
constexpr size_t WS_ACT = WS_Z;
constexpr size_t WS_SC = WS_Z + (size_t)T * NZ * 4;
constexpr size_t WS_PART = WS_SC;
constexpr size_t WS_Y = WS_SC + (size_t)T * NH * SCR * 4;
constexpr size_t WS_G = WS_Y + (size_t)T * RD * 4;
constexpr size_t WS_RK = WS_G + (size_t)T * RD * 4;
constexpr int NC = 16, CL = 128;
constexpr size_t WS_PQ = WS_RK + (size_t)T * NH * 4;
constexpr size_t WS_S0 = WS_PQ + (size_t)64 * NC * 2 * 4096 * 4;
constexpr size_t WS_GB = WS_S0 + (size_t)64 * NC * 4096 * 4;
constexpr size_t WS_END = WS_GB + (size_t)TP * RD * 4;
static_assert((size_t)T * FF * 2 <= (size_t)T * NZ * 4, "act overlay fits in z");
constexpr int LDS_BYTES = 147456;

#ifndef REP_PREP
#define REP_PREP 1
#endif
#ifndef REP_POOL
#define REP_POOL 1
#endif
#ifndef REP_CONV
#define REP_CONV 1
#endif
#ifndef REP_P1
#define REP_P1 1
#endif
#ifndef REP_CB
#define REP_CB 1
#endif
#ifndef REP_MIXA
#define REP_MIXA 1
#endif
#ifndef REP_SCAN
#define REP_SCAN 1
#endif
#ifndef REP_POST
#define REP_POST 1
#endif
#ifndef REP_CVT
#define REP_CVT 1
#endif
#ifdef NO_SYNC
#define GSYNC() __syncthreads()
#else
#define GSYNC() do { int w_ = wave0; asm volatile("" : "+s"(w_)); xcd_barrier(xbar, w_ * 64 + (int)__builtin_amdgcn_mbcnt_hi(~0u, __builtin_amdgcn_mbcnt_lo(~0u, (unsigned)launder_v(0)))); } while (0)
#endif
struct Params { const float* in[31]; float* out; unsigned char* ws; };
typedef const __attribute__((address_space(4))) Params* KP;
__device__ __forceinline__ KP kargs() { KP k = (KP)__builtin_amdgcn_kernarg_segment_ptr(); asm volatile("" : "+s"(k)); return k; }
__device__ __forceinline__ int launder_v(int v) { asm volatile("" : "+v"(v)); return v; }
#define PH_BEGIN() KP kp = kargs(); int wave_ = wave0; asm volatile("" : "+s"(wave_)); const int wave = wave_; const int lane = (int)__builtin_amdgcn_mbcnt_hi(~0u, __builtin_amdgcn_mbcnt_lo(~0u, (unsigned)launder_v(0))); const int tid = wave * 64 + lane; \
    const int nb = gridDim.x, bid = blockIdx.x, gw = bid * NWAVES + wave, ngw = nb * NWAVES; unsigned char* const ws = kp->ws; (void)lane; (void)wave; (void)gw; (void)ngw; (void)ws; (void)nb; (void)bid

__device__ __forceinline__ float wave_sum(float v) {
#pragma unroll
    for (int o = 1; o < 64; o <<= 1) v += __shfl_xor(v, o);
    return v;
}
__device__ __forceinline__ unsigned f2bf(float f) { unsigned u = __builtin_bit_cast(unsigned, f); return (u + 0x7fffu + ((u >> 16) & 1u)) >> 16; }
__device__ __forceinline__ unsigned pk2(float lo, float hi) { return f2bf(lo) | (f2bf(hi) << 16); }
__device__ __forceinline__ float sigm(float x) { return 1.0f / (1.0f + __expf(-x)); }

__device__ __forceinline__ void transpose_item(const float* W, int K, int N, bf16* WT, int mode, LAS float* scr, int item, int lane) {
    const int nblk = N / 32, kb = item / nblk, nb = item % nblk, k0 = 64 * kb, n0 = 32 * nb;
    const int drow0 = (mode == 0) ? n0 : ((n0 >> 7) * 256 + (n0 & 127) + (mode == 2 ? 128 : 0));
    float wv[32];
#pragma unroll
    for (int i = 0; i < 32; ++i) { const int kk = 2 * i + (lane >> 5); wv[i] = W[(size_t)(k0 + kk) * N + n0 + (lane & 31)]; }
#pragma unroll
    for (int i = 0; i < 32; ++i) { const int kk = 2 * i + (lane >> 5); scr[kk * 33 + (lane & 31)] = wv[i]; }
    asm volatile("s_waitcnt lgkmcnt(0)" ::: "memory");
    const int c = lane & 7;
#pragma unroll
    for (int j = 0; j < 4; ++j) { const int n = (lane >> 3) + 8 * j; const LAS float* s = scr + (8 * c) * 33 + n;
        u32x4 o; o.x = pk2(s[0 * 33], s[1 * 33]); o.y = pk2(s[2 * 33], s[3 * 33]); o.z = pk2(s[4 * 33], s[5 * 33]); o.w = pk2(s[6 * 33], s[7 * 33]);
        *(u32x4*)(WT + (size_t)(drow0 + n) * K + k0 + 8 * c) = o; }
    asm volatile("s_waitcnt lgkmcnt(0)" ::: "memory");
}
__device__ __forceinline__ void convert_weights(KP kp, int l, LAS unsigned char* lds, int gw, int ngw, int wave, int lane) {
    LAS float* scr = (LAS float*)(lds + wave * 16384);
    unsigned char* ws = kp->ws;
    bf16* WIN = (bf16*)(ws + WS_WIN); bf16* WOUT = (bf16*)(ws + WS_WOUT); bf16* WGU = (bf16*)(ws + WS_WGU); bf16* WDN = (bf16*)(ws + WS_WDN);
    constexpr int I_IN = (D / 64) * (NIN / 32), I_OUT = (D / 64) * (D / 32), I_G = (D / 64) * (FF / 32), I_D = (FF / 64) * (D / 32);
    constexpr int I_P = 4 * 8, I_U = 3 * 32;
    constexpr int NITEMS = I_IN + I_OUT + 2 * I_G + I_D + I_P + I_U;
    for (int it = gw; it < NITEMS; it += ngw) {
        int r = it;
        if (r < I_IN) { transpose_item(kp->in[7] + (size_t)l * D * NIN, D, NIN, WIN, 0, scr, r, lane); continue; } r -= I_IN;
        if (r < I_OUT) { transpose_item(kp->in[25] + (size_t)l * D * D, D, D, WOUT, 0, scr, r, lane); continue; } r -= I_OUT;
        if (r < I_G) { transpose_item(kp->in[27] + (size_t)l * D * FF, D, FF, WGU, 1, scr, r, lane); continue; } r -= I_G;
        if (r < I_G) { transpose_item(kp->in[28] + (size_t)l * D * FF, D, FF, WGU, 2, scr, r, lane); continue; } r -= I_G;
        if (r < I_D) { transpose_item(kp->in[29] + (size_t)l * FF * D, FF, D, WDN, 0, scr, r, lane); continue; } r -= I_D;
        if (r < I_P) { const int g = r >> 3; transpose_item(kp->in[12] + (size_t)((l * 4 + g) * 128) * 128, 128, 128, (bf16*)(ws + WS_POOLW) + (size_t)g * 128 * 128, 0, scr, r & 7, lane); continue; } r -= I_P;
        { const int m = r >> 5; const float* src = (m == 0 ? kp->in[16] : (m == 1 ? kp->in[18] : kp->in[19])) + (size_t)l * 64 * RD;
          transpose_item(src, 64, RD, (bf16*)(ws + WS_UPS) + (size_t)m * RD * 64, 0, scr, r & 31, lane); }
    }
    { const unsigned z = (unsigned)launder_v(0); for (int e = gw * 64 + lane; e < 16384; e += ngw * 64) ((u32x4*)(WIN + (size_t)NIN * D))[e] = (u32x4){z, z, z, z}; }
}
__device__ __forceinline__ void norm_rows(const float* sa, const float* sb, const float* g, float* xcopy, bf16* xn, float* fout, const float* part, int gw, int ngw, int lane) {
    for (int m = gw; m < T; m += ngw) {
        const float* row = (m < TP) ? sa + (size_t)m * D : sb + (size_t)(m - TP) * D;
        f32x4 v[8]; float ss = 0.f;
#pragma unroll
        for (int j = 0; j < 8; ++j) v[j] = ((const f32x4*)row)[lane + 64 * j];
        if (part && m >= TP) {
#pragma unroll
            for (int k = 0; k < 8; ++k)
#pragma unroll
                for (int j = 0; j < 8; ++j) v[j] += ((const f32x4*)(part + ((size_t)k * 1024 + (m - TP)) * D))[lane + 64 * j];
#pragma unroll
            for (int j = 0; j < 8; ++j) ((f32x4*)(const_cast<float*>(sb) + (size_t)(m - TP) * D))[lane + 64 * j] = v[j];
        }
#pragma unroll
        for (int j = 0; j < 8; ++j) ss += (v[j].x * v[j].x + v[j].y * v[j].y) + (v[j].z * v[j].z + v[j].w * v[j].w);
        const float rinv = 1.0f / sqrtf(wave_sum(ss) * (1.0f / D) + RMS_EPS);
#pragma unroll
        for (int j = 0; j < 8; ++j) {
            if (xcopy) ((f32x4*)(xcopy + (size_t)m * D))[lane + 64 * j] = v[j];
            const f32x4 gj = ((const f32x4*)g)[lane + 64 * j];
            const f32x4 y = v[j] * rinv * gj;
            if (xn) { u32x2 o; o.x = pk2(y.x, y.y); o.y = pk2(y.z, y.w); ((u32x2*)(xn + (size_t)m * D))[lane + 64 * j] = o; }
            if (fout) ((f32x4*)(fout + (size_t)m * D))[lane + 64 * j] = y;
        }
    }
}

__device__ __forceinline__ void conv_item(KP kp, int l, int item, LAS float* lds, int tid_in) {
    const int tid = launder_v(tid_in);
    const float* Z = (const float*)(kp->ws + WS_Z); bf16* MIX = (bf16*)(kp->ws + WS_MIX);
    const int t0 = item * 32;
    int s, tau0, Ls; bool prompt;
    if (t0 < TP) { s = t0 >> 11; tau0 = t0 & 2047; Ls = 2048; prompt = true; } else { s = (t0 - TP) >> 6; tau0 = (t0 - TP) & 63; Ls = 64; prompt = false; }
    const int c = tid;
    const float* cw = kp->in[8] + (size_t)l * 31 * 512;
    float w[31];
#pragma unroll
    for (int j = 0; j < 31; ++j) w[j] = cw[j * 512 + c];
    const float bias = kp->in[9][l * 512 + c];
    float acc[32];
#pragma unroll
    for (int i = 0; i < 32; ++i) acc[i] = bias;
    const bool first = (tau0 == 0), lastit = (tau0 + 32 == Ls);
    float* oc = prompt ? kp->out + O_CONV_P + (size_t)((l * 4 + s) * 30) * 512 : kp->out + O_CONV_S + (size_t)((l * 16 + s) * 30) * 512;
    const float* cc = kp->in[2] + (size_t)((l * 16 + s) * 30) * 512;
#pragma unroll
    for (int hf = 0; hf < 2; ++hf) {
        float pv[31], pg[31];
#pragma unroll
        for (int k = 0; k < 31; ++k) { const int ii = hf * 31 + k;
            if (ii < 30 && first) { pv[k] = prompt ? 0.f : cc[ii * 512 + c]; pg[k] = 0.f; }
            else { const float* zr = Z + (size_t)(t0 + ii - 30) * NZ; pv[k] = zr[c]; pg[k] = zr[512 + c]; } }
#pragma unroll
        for (int k = 0; k < 31; ++k) { const int ii = hf * 31 + k;
            const float u = (ii < 30 && first) ? pv[k] : pv[k] * sigm(pg[k]);
            if (ii >= 32 && lastit) oc[(ii - 32) * 512 + c] = u;
#pragma unroll
            for (int oi = 0; oi < 32; ++oi) { const int j = ii - oi; if (j >= 0 && j <= 30) acc[oi] += w[j] * u; }
        }
    }
#pragma unroll
    for (int oi = 0; oi < 32; ++oi) lds[oi * 512 + c] = acc[oi];
    __syncthreads();
    const int wave = tid >> 6, lane = tid & 63;
    const f32x4 g0 = *(const f32x4*)(kp->in[10] + l * 512 + lane * 8), g1 = *(const f32x4*)(kp->in[10] + l * 512 + lane * 8 + 4);
    const f32x4 b0 = *(const f32x4*)(kp->in[11] + l * 512 + lane * 8), b1 = *(const f32x4*)(kp->in[11] + l * 512 + lane * 8 + 4);
#pragma unroll
    for (int q = 0; q < 4; ++q) {
        const int oi = wave * 4 + q;
        f32x4 a = *(const LAS f32x4*)(lds + oi * 512 + lane * 8), b = *(const LAS f32x4*)(lds + oi * 512 + lane * 8 + 4);
        const float mean = wave_sum((a.x + a.y) + (a.z + a.w) + (b.x + b.y) + (b.z + b.w)) * (1.0f / 512.0f);
        a = a - mean; b = b - mean;
        const float var = wave_sum((a.x * a.x + a.y * a.y) + (a.z * a.z + a.w * a.w) + (b.x * b.x + b.y * b.y) + (b.z * b.z + b.w * b.w)) * (1.0f / 512.0f);
        const float rstd = 1.0f / sqrtf(var + LN_EPS);
        a = a * rstd * g0 + b0; b = b * rstd * g1 + b1;
        float o[8] = {a.x, a.y, a.z, a.w, b.x, b.y, b.z, b.w};
#pragma unroll
        for (int k = 0; k < 8; ++k) o[k] = o[k] * sigm(o[k]);
        u32x4 wv; wv.x = pk2(o[0], o[1]); wv.y = pk2(o[2], o[3]); wv.z = pk2(o[4], o[5]); wv.w = pk2(o[6], o[7]);
        *(u32x4*)(MIX + (size_t)(t0 + oi) * D + lane * 8) = wv;
    }
    __syncthreads();
}
__device__ __forceinline__ void pool_item(KP kp, int l, int item, LAS unsigned char* ldsb, int tid_in) {
    const int tid = launder_v(tid_in);
    const float* Z = (const float*)(kp->ws + WS_Z); bf16* MIX = (bf16*)(kp->ws + WS_MIX);
    LAS float* pp = (LAS float*)ldsb;
    LAS bf16* db = (LAS bf16*)(ldsb + 47 * 512 * 4);
    const int t0 = item * 32;
    int s, tau0, Ls; bool prompt;
    if (t0 < TP) { s = t0 >> 11; tau0 = t0 & 2047; Ls = 2048; prompt = true; } else { s = (t0 - TP) >> 6; tau0 = (t0 - TP) & 63; Ls = 64; prompt = false; }
    const int c = tid;
    const bool first = (tau0 == 0), lastit = (tau0 + 32 == Ls);
    float* op = prompt ? kp->out + O_POOL_P + (size_t)((l * 4 + s) * 15) * 512 : kp->out + O_POOL_S + (size_t)((l * 16 + s) * 15) * 512;
    const float* cp = kp->in[3] + (size_t)((l * 16 + s) * 15) * 512;
#pragma unroll 16
    for (int ii = 0; ii < 47; ++ii) {
        float val;
        if (ii < 15 && first) val = prompt ? 0.f : cp[ii * 512 + c];
        else val = Z[(size_t)(t0 + ii - 15) * NZ + 1024 + c];
        pp[ii * 512 + c] = val;
        if (ii >= 32 && lastit) op[(ii - 32) * 512 + c] = val;
    }
    const int gi = c >> 7, w = 2 << gi;
    for (int oi = 0; oi < 32; ++oi) {
        float sum = 0.f;
        for (int k = 0; k < w; ++k) sum += pp[(oi + 15 - k) * 512 + c];
        const int cnt = prompt ? min(w, tau0 + oi + 1) : w;
        const float d = sum / (float)cnt - pp[(oi + 15) * 512 + c];
        db[oi * 520 + c] = (bf16)f2bf(d);
    }
    __syncthreads();
    const int lane = tid & 63, wave = tid >> 6, n16 = lane & 15, q = lane >> 4, g = wave >> 1, nh = wave & 1;
    const bf16* WT = (const bf16*)(kp->ws + WS_POOLW) + (size_t)g * 128 * 128;
    bfx8 Bf[4][4];
#pragma unroll
    for (int nt = 0; nt < 4; ++nt)
#pragma unroll
        for (int ks = 0; ks < 4; ++ks) Bf[nt][ks] = *(const bfx8*)(WT + (size_t)(nh * 64 + nt * 16 + n16) * 128 + ks * 32 + q * 8);
    float scale[4];
#pragma unroll
    for (int nt = 0; nt < 4; ++nt) scale[nt] = kp->in[13][l * 512 + g * 128 + nh * 64 + nt * 16 + n16];
#pragma unroll
    for (int mt = 0; mt < 2; ++mt) {
        bfx8 Af[4];
#pragma unroll
        for (int ks = 0; ks < 4; ++ks) Af[ks] = *(const LAS bfx8*)(db + (mt * 16 + n16) * 520 + g * 128 + ks * 32 + q * 8);
        f32x4 acc[4];
#pragma unroll
        for (int nt = 0; nt < 4; ++nt) { acc[nt] = (f32x4){0.f, 0.f, 0.f, 0.f};
#pragma unroll
            for (int ks = 0; ks < 4; ++ks) acc[nt] = __builtin_amdgcn_mfma_f32_16x16x32_bf16(Af[ks], Bf[nt][ks], acc[nt], 0, 0, 0); }
#pragma unroll
        for (int nt = 0; nt < 4; ++nt)
#pragma unroll
            for (int r = 0; r < 4; ++r) MIX[(size_t)(t0 + mt * 16 + 4 * q + r) * D + 512 + g * 128 + nh * 64 + nt * 16 + n16] = (bf16)f2bf(acc[nt][r] * scale[nt]);
    }
    __syncthreads();
}
__device__ __forceinline__ float rowsum16(float v) { v += __shfl_xor(v, 1); v += __shfl_xor(v, 2); v += __shfl_xor(v, 4); v += __shfl_xor(v, 8); return v; }
__device__ __forceinline__ void prep_item(KP kp, int l, int item, LAS unsigned char* ldsb, int tid_in) {
    const int tid = launder_v(tid_in);
    const float* Z = (const float*)(kp->ws + WS_Z);
    float* SC = (float*)(kp->ws + WS_SC); float* G = (float*)(kp->ws + WS_G); float* RK = (float*)(kp->ws + WS_RK);
    const bf16* UPT = (const bf16*)(kp->ws + WS_UPS);
    LAS bf16* lo = (LAS bf16*)ldsb;
    const int t0 = item * 16;
    int s, tau0, Ls; bool prompt;
    if (t0 < TP) { s = t0 >> 11; tau0 = t0 & 2047; Ls = 2048; prompt = true; } else { s = (t0 - TP) >> 6; tau0 = (t0 - TP) & 63; Ls = 64; prompt = false; }
    const float* mu = kp->in[14] + (size_t)l * RP;
    const float* ssh = kp->in[4] + (size_t)(l * 16 + s) * RP;
    for (int e = tid; e < 16 * 192; e += NTHR) {
        const int tok = e / 192, col = e % 192, zc = 3072 + col, t = t0 + tok, tau = tau0 + tok;
        const float qv = Z[(size_t)t * NZ + ZQ + zc];
        const float qp = tau > 0 ? Z[(size_t)(t - 1) * NZ + ZQ + zc] : (prompt ? 0.f : ssh[zc]);
        const float qs = qv + (qp - qv) * mu[zc];
        const float val = col < 64 ? tanhf(qs) : (col < 128 ? qs : sigm(qs));
        lo[((col >> 6) * 16 + tok) * 72 + (col & 63)] = (bf16)f2bf(val);
    }
    __syncthreads();
    const int lane = tid & 63, wave = tid >> 6, n16 = lane & 15, q = lane >> 4;
#pragma unroll 1
    for (int hh = 0; hh < 2; ++hh) {
        const int h = wave * 2 + hh;
        f32x4 acc[3][4];
#pragma unroll
        for (int m = 0; m < 3; ++m) {
            bfx8 Af[2], Bf[4][2];
#pragma unroll
            for (int ks = 0; ks < 2; ++ks) Af[ks] = *(const LAS bfx8*)(lo + (m * 16 + n16) * 72 + ks * 32 + q * 8);
#pragma unroll
            for (int i = 0; i < 4; ++i)
#pragma unroll
                for (int ks = 0; ks < 2; ++ks) Bf[i][ks] = *(const bfx8*)(UPT + (size_t)(m * RD + h * 64 + i * 16 + n16) * 64 + ks * 32 + q * 8);
#pragma unroll
            for (int i = 0; i < 4; ++i) { acc[m][i] = (f32x4){0.f, 0.f, 0.f, 0.f};
#pragma unroll
                for (int ks = 0; ks < 2; ++ks) acc[m][i] = __builtin_amdgcn_mfma_f32_16x16x32_bf16(Af[ks], Bf[i][ks], acc[m][i], 0, 0, 0); }
        }
        float mur[4], muk[4], muv[4], w0c[4], a0c[4], kkc[4], kac[4], rkc[4], sr[4], sk[4], sv[4];
#pragma unroll
        for (int i = 0; i < 4; ++i) { const int c = h * 64 + i * 16 + n16;
            mur[i] = mu[c]; muk[i] = mu[RD + c]; muv[i] = mu[2 * RD + c];
            w0c[i] = kp->in[15][l * RD + c]; a0c[i] = kp->in[17][l * RD + c]; kkc[i] = kp->in[20][l * RD + c]; kac[i] = kp->in[21][l * RD + c]; rkc[i] = kp->in[22][l * RD + c];
            sr[i] = prompt ? 0.f : ssh[c]; sk[i] = prompt ? 0.f : ssh[RD + c]; sv[i] = prompt ? 0.f : ssh[2 * RD + c]; }
#pragma unroll
        for (int r = 0; r < 4; ++r) {
            const int tok = 4 * q + r, t = t0 + tok, tau = tau0 + tok;
            const float* zr = Z + (size_t)t * NZ + ZQ;
            float rv[4], kv[4], vv[4], av[4], dv[4], kk[4];
            float skk = 0.f;
#pragma unroll
            for (int i = 0; i < 4; ++i) { const int c = h * 64 + i * 16 + n16;
                float rr = zr[c], k = zr[RD + c], v = zr[2 * RD + c];
                float pr, pk, pv;
                if (tau > 0) { pr = zr[c - NZ]; pk = zr[RD + c - NZ]; pv = zr[2 * RD + c - NZ]; } else { pr = sr[i]; pk = sk[i]; pv = sv[i]; }
                rr += (pr - rr) * mur[i]; k += (pk - k) * muk[i]; v += (pv - v) * muv[i];
                const float xw = -(w0c[i] + acc[0][i][r]);
                const float sp = fmaxf(xw, 0.f) + log1pf(expf(-fabsf(xw)));
                dv[i] = expf(-expf(-sp - 0.5f));
                av[i] = sigm(a0c[i] + acc[1][i][r]);
                rv[i] = rr; kv[i] = k; vv[i] = v; kk[i] = k * kkc[i]; skk += kk[i] * kk[i];
                G[(size_t)t * RD + c] = acc[2][i][r];
                }
            skk = rowsum16(skk);
            const float rinv = 1.0f / sqrtf(fmaxf(skk, 1e-24f));
            float srk = 0.f;
#pragma unroll
            for (int i = 0; i < 4; ++i) {
                const float kkn = kk[i] * rinv, kpv = kv[i] * (1.0f + (av[i] - 1.0f) * kac[i]), bb = kkn * av[i];
                srk += rv[i] * kpv * rkc[i];
                float* sc = SC + ((size_t)t * NH + h) * SCR + i * 16 + n16;
                sc[0] = dv[i]; sc[64] = kkn; sc[128] = bb; sc[192] = kpv; sc[256] = rv[i]; sc[320] = vv[i];
            }
            srk = rowsum16(srk);
            if (n16 == 0) RK[t * NH + h] = srk;
            __builtin_amdgcn_sched_barrier(0);
        }
    }
    if (tau0 + 16 == Ls) {
        float* osh = prompt ? kp->out + O_SHIFT_P + (size_t)(l * 4 + s) * RP : kp->out + O_SHIFT_S + (size_t)(l * 16 + s) * RP;
        const float* zr = Z + (size_t)(t0 + 15) * NZ + ZQ;
        for (int e = tid; e < RP; e += NTHR) osh[e] = zr[e];
    }
    __syncthreads();
}

__device__ __forceinline__ void sc_issue(f32x4 (&r)[4], const LAS f32x4* o, int c) {
    if (c < 4) {
#pragma unroll
        for (int i = 0; i < 4; ++i) r[i] = o[16 + 4 * c + i];
    } else { const int j = c - 4; r[0] = o[j]; r[1] = o[32 + j]; r[2] = o[48 + j]; r[3] = o[64 + j]; }
}
template <int MODE>
__device__ __forceinline__ void scan_run(const float* SC, int tg0, int nsteps, int h, LAS float* wl  , int lane,
                                         const float* Sinit, float* Y, float* GB, float* Sout, float* PQout) {
    constexpr int GS = 4, NCH = 20;
    f32x2 S[32];
    f32x2 P[(MODE == 3) ? 32 : 1];
    if (MODE == 3) {
        const int ln = launder_v(lane);
#pragma unroll
        for (int j = 0; j < 32; ++j) { S[j] = (f32x2){0.f, 0.f}; P[j] = (f32x2){(2 * j == ln) ? 1.f : 0.f, (2 * j + 1 == ln) ? 1.f : 0.f}; }
    } else {
#pragma unroll
        for (int j = 0; j < 16; ++j) { const f32x4 v = ((const f32x4*)(Sinit + lane * 64))[j]; S[2 * j] = (f32x2){v.x, v.y}; S[2 * j + 1] = (f32x2){v.z, v.w}; }
    }
#define SC_STAGE(g, buf) do { _Pragma("unroll") for (int s_ = 0; s_ < GS; ++s_) { const float* rec_ = SC + ((size_t)(tg0 + (g) * GS + s_) * NH + h) * SCR + lane; \
        _Pragma("unroll") for (int k_ = 0; k_ < 6; ++k_) __builtin_amdgcn_global_load_lds((const unsigned*)(rec_ + k_ * 64), (LAS unsigned*)(wl + ((buf) * GS + s_) * SCR + k_ * 64), 4, 0, 0); } } while (0)
    SC_STAGE(0, 0);
    const int ngroups = nsteps / GS;
    for (int g = 0; g < ngroups; ++g) {
        asm volatile("s_waitcnt vmcnt(0)" ::: "memory");
        if (g + 1 < ngroups) SC_STAGE(g + 1, (g + 1) & 1);
        const LAS float* wb = wl + (g & 1) * GS * SCR;
        f32x4 R[4][4];
#pragma unroll
        for (int q = 0; q < 3; ++q) sc_issue(R[q & 3], (const LAS f32x4*)(wb + (q / NCH) * SCR), q % NCH);
        __builtin_amdgcn_sched_barrier(0);
#pragma unroll
        for (int s = 0; s < GS; ++s) {
            f32x2 d2a = (f32x2){0.f, 0.f}, y2a = (f32x2){0.f, 0.f};
            f32x2 e2a = (f32x2){0.f, 0.f}, g2a = (f32x2){0.f, 0.f};
            f32x2 sa2 = (f32x2){0.f, 0.f}, sp2 = (f32x2){0.f, 0.f};
            const float vs = wb[s * SCR + 320 + lane];
            const f32x2 v2 = (f32x2){vs, vs};
#pragma unroll
            for (int c = 0; c < NCH; ++c) {
                const int q = s * NCH + c, qn = q + 3;
                if (qn < GS * NCH) sc_issue(R[qn & 3], (const LAS f32x4*)(wb + (qn / NCH) * SCR), qn % NCH);
                __builtin_amdgcn_sched_barrier(0);
                f32x4 (&r)[4] = R[q & 3];
                if (c < 4) {
#pragma unroll
                    for (int i = 0; i < 4; ++i) { const int j = 4 * c + i; d2a += S[2 * j] * (f32x2){r[i].x, r[i].y}; d2a += S[2 * j + 1] * (f32x2){r[i].z, r[i].w};
                        if (MODE == 3) { e2a += P[2 * j] * (f32x2){r[i].x, r[i].y}; e2a += P[2 * j + 1] * (f32x2){r[i].z, r[i].w}; } }
                    if (c == 3) { const f32x2 d2 = d2a; const float sa = -(d2.x + d2.y); sa2 = (f32x2){sa, sa};
                        if (MODE == 3) { const f32x2 e2 = e2a; const float sp = -(e2.x + e2.y); sp2 = (f32x2){sp, sp}; } }
                } else {
                    const int j = c - 4;
                    f32x2 t0 = v2 * (f32x2){r[2].x, r[2].y}; t0 = sa2 * (f32x2){r[1].x, r[1].y} + t0; S[2 * j] = S[2 * j] * (f32x2){r[0].x, r[0].y} + t0;
                    f32x2 t1 = v2 * (f32x2){r[2].z, r[2].w}; t1 = sa2 * (f32x2){r[1].z, r[1].w} + t1; S[2 * j + 1] = S[2 * j + 1] * (f32x2){r[0].z, r[0].w} + t1;
                    y2a += S[2 * j] * (f32x2){r[3].x, r[3].y}; y2a += S[2 * j + 1] * (f32x2){r[3].z, r[3].w};
                    if (MODE == 3) {
                        const f32x2 u0 = sp2 * (f32x2){r[1].x, r[1].y}, u1 = sp2 * (f32x2){r[1].z, r[1].w};
                        P[2 * j] = P[2 * j] * (f32x2){r[0].x, r[0].y} + u0; P[2 * j + 1] = P[2 * j + 1] * (f32x2){r[0].z, r[0].w} + u1;
                        g2a += P[2 * j] * (f32x2){r[3].x, r[3].y}; g2a += P[2 * j + 1] * (f32x2){r[3].z, r[3].w};
                    }
                }
                __builtin_amdgcn_sched_barrier(0);
            }
            { const f32x2 y2 = y2a; Y[(size_t)(tg0 + g * GS + s) * RD + h * 64 + lane] = y2.x + y2.y; }
            if (MODE == 3) { const f32x2 g2 = g2a; GB[(size_t)(tg0 + g * GS + s) * RD + h * 64 + lane] = g2.x + g2.y; }
        }
        asm volatile("s_waitcnt lgkmcnt(0)" ::: "memory");
    }
#undef SC_STAGE
    if (MODE == 3) {
#pragma unroll
        for (int j = 0; j < 16; ++j) { ((f32x4*)PQout)[j * 64 + lane] = (f32x4){P[2 * j].x, P[2 * j].y, P[2 * j + 1].x, P[2 * j + 1].y};
                                       ((f32x4*)(PQout + 4096))[j * 64 + lane] = (f32x4){S[2 * j].x, S[2 * j].y, S[2 * j + 1].x, S[2 * j + 1].y}; }
    } else {
#pragma unroll
        for (int j = 0; j < 16; ++j) ((f32x4*)(Sout + lane * 64))[j] = (f32x4){S[2 * j].x, S[2 * j].y, S[2 * j + 1].x, S[2 * j + 1].y};
    }
}
template <int NMT>
__device__ __forceinline__ void ypost_task(KP kp, int l, const float* S0q  , int tg0, int h, int lane) {
    const float* GB = (const float*)(kp->ws + WS_GB); const float* Y = (const float*)(kp->ws + WS_Y); const float* SC = (const float*)(kp->ws + WS_SC);
    const float* G = (const float*)(kp->ws + WS_G); const float* RK = (const float*)(kp->ws + WS_RK); bf16* MIX = (bf16*)(kp->ws + WS_MIX);
    const int n = lane & 15, kq = lane >> 4;
    float Bv[4][16];
    if (S0q) {
#pragma unroll
        for (int nt = 0; nt < 4; ++nt)
#pragma unroll
            for (int ks = 0; ks < 16; ++ks) Bv[nt][ks] = S0q[(size_t)(ks * 64 + nt * 16 + n) * 4 + kq];
    }
    float gng[4], gnb[4];
#pragma unroll
    for (int nt = 0; nt < 4; ++nt) { gng[nt] = kp->in[23][l * RD + h * 64 + nt * 16 + n]; gnb[nt] = kp->in[24][l * RD + h * 64 + nt * 16 + n]; }
#pragma unroll 1
    for (int mt = 0; mt < NMT; ++mt) {
        const int tb = tg0 + mt * 16;
        float Av[16];
        if (S0q) { const float* grow = GB + (size_t)(tb + n) * RD + h * 64 + kq;
#pragma unroll
            for (int ks = 0; ks < 16; ++ks) Av[ks] = grow[ks * 4]; }
        f32x4 acc[4]; float vv[4][4], gg[4][4], rk[4];
#pragma unroll
        for (int r = 0; r < 4; ++r) { const int t = tb + 4 * kq + r; rk[r] = RK[t * NH + h];
#pragma unroll
            for (int nt = 0; nt < 4; ++nt) { acc[nt][r] = Y[(size_t)t * RD + h * 64 + nt * 16 + n]; vv[nt][r] = SC[((size_t)t * NH + h) * SCR + 320 + nt * 16 + n]; gg[nt][r] = G[(size_t)t * RD + h * 64 + nt * 16 + n]; } }
        if (S0q) {
#pragma unroll
            for (int ks = 0; ks < 16; ++ks)
#pragma unroll
                for (int nt = 0; nt < 4; ++nt) acc[nt] = __builtin_amdgcn_mfma_f32_16x16x4f32(Av[ks], Bv[nt][ks], acc[nt], 0, 0, 0);
        }
#pragma unroll
        for (int r = 0; r < 4; ++r) {
            const int t = tb + 4 * kq + r;
            const float mean = rowsum16((acc[0][r] + acc[1][r]) + (acc[2][r] + acc[3][r])) * (1.0f / 64.0f);
            float d[4], qq = 0.f;
#pragma unroll
            for (int nt = 0; nt < 4; ++nt) { d[nt] = acc[nt][r] - mean; qq += d[nt] * d[nt]; }
            const float rstd = 1.0f / sqrtf(rowsum16(qq) * (1.0f / 64.0f) + GN_EPS);
#pragma unroll
            for (int nt = 0; nt < 4; ++nt) { const float o = ((d[nt] * rstd * gng[nt] + gnb[nt]) + rk[r] * vv[nt][r]) * gg[nt][r];
                MIX[(size_t)t * D + 1024 + h * 64 + nt * 16 + n] = (bf16)f2bf(o); }
        }
    }
}
__device__ __forceinline__ void combine_chain(const float* PQ, float* S0, float* Sfin, LAS unsigned char* lds, int tid, int wave, int lane) {
    LAS f32x4* pl = (LAS f32x4*)lds;
    LAS f32x4* xch = (LAS f32x4*)(lds + 16384);
    f32x2 S[32];
#pragma unroll
    for (int j = 0; j < 32; ++j) S[j] = (f32x2){0.f, 0.f};
    const int n4a = 2 * wave, n4b = 2 * wave + 1;
    const f32x4* Pc = (const f32x4*)PQ;
    f32x4 p0 = Pc[tid], p1 = Pc[tid + 512];
    for (int c = 0; c < NC; ++c) {
        const f32x4* Qc = (const f32x4*)(PQ + (size_t)(c * 2 + 1) * 4096);
        pl[tid] = p0; pl[tid + 512] = p1;
        f32x4 na = Qc[n4a * 64 + lane], nb = Qc[n4b * 64 + lane];
        if (c + 1 < NC) { const f32x4* Pn = (const f32x4*)(PQ + (size_t)((c + 1) * 2) * 4096); p0 = Pn[tid]; p1 = Pn[tid + 512]; }
        __syncthreads();
        f32x2 a0 = (f32x2){na.x, na.y}, a1 = (f32x2){na.z, na.w}, b0 = (f32x2){nb.x, nb.y}, b1 = (f32x2){nb.z, nb.w};
#pragma unroll
        for (int j = 0; j < 32; ++j) {
            const f32x4 pa0 = pl[n4a * 64 + 2 * j], pb0 = pl[n4b * 64 + 2 * j], pa1 = pl[n4a * 64 + 2 * j + 1], pb1 = pl[n4b * 64 + 2 * j + 1];
            const f32x2 s0 = (f32x2){S[j].x, S[j].x}, s1 = (f32x2){S[j].y, S[j].y};
            a0 += s0 * (f32x2){pa0.x, pa0.y}; a1 += s0 * (f32x2){pa0.z, pa0.w}; b0 += s0 * (f32x2){pb0.x, pb0.y}; b1 += s0 * (f32x2){pb0.z, pb0.w};
            a0 += s1 * (f32x2){pa1.x, pa1.y}; a1 += s1 * (f32x2){pa1.z, pa1.w}; b0 += s1 * (f32x2){pb1.x, pb1.y}; b1 += s1 * (f32x2){pb1.z, pb1.w};
            if ((j & 1) == 1) __builtin_amdgcn_sched_barrier(0);
        }
        na = (f32x4){a0.x, a0.y, a1.x, a1.y}; nb = (f32x4){b0.x, b0.y, b1.x, b1.y};
        if (c + 1 < NC) {
            xch[n4a * 64 + lane] = na; xch[n4b * 64 + lane] = nb;
            f32x4* So = (f32x4*)(S0 + (size_t)(c + 1) * 4096);
            So[n4a * 64 + lane] = na; So[n4b * 64 + lane] = nb;
            __syncthreads();
#pragma unroll
            for (int j = 0; j < 16; ++j) { const f32x4 v = xch[j * 64 + lane]; S[2 * j] = (f32x2){v.x, v.y}; S[2 * j + 1] = (f32x2){v.z, v.w}; }
        } else {
            *(f32x4*)(Sfin + lane * 64 + 8 * wave) = na; *(f32x4*)(Sfin + lane * 64 + 8 * wave + 4) = nb;
        }
        __syncthreads();
    }
}
__device__ __forceinline__ void post_rows(KP kp, int l, int gw, int ngw, int lane) {
    const float* SC = (const float*)(kp->ws + WS_SC); const float* Y = (const float*)(kp->ws + WS_Y); const float* G = (const float*)(kp->ws + WS_G); const float* RK = (const float*)(kp->ws + WS_RK);
    bf16* MIX = (bf16*)(kp->ws + WS_MIX);
    for (int it = gw; it < T * NH; it += ngw) {
        const int t = it >> 4, h = it & 15, c = h * 64 + lane;
        const float y = Y[(size_t)t * RD + c];
        const float mean = wave_sum(y) * (1.0f / 64.0f);
        const float d = y - mean;
        const float var = wave_sum(d * d) * (1.0f / 64.0f);
        const float yn = d * (1.0f / sqrtf(var + GN_EPS)) * kp->in[23][l * RD + c] + kp->in[24][l * RD + c];
        const float v = SC[((size_t)t * NH + h) * SCR + 320 + lane];
        const float o = (yn + RK[it] * v) * G[(size_t)t * RD + c];
        MIX[(size_t)t * D + 1024 + c] = (bf16)f2bf(o);
    }
}

__global__ void __launch_bounds__(NTHR, 2) fwd_mega(Params p) {
    extern __shared__ __attribute__((aligned(16))) unsigned char lds_raw[];
    LAS unsigned char* lds = (LAS unsigned char*)lds_raw;
    const int wave0 = __builtin_amdgcn_readfirstlane((int)threadIdx.x >> 6);
    volatile LAS unsigned* MISC = (volatile LAS unsigned*)(lds + 131072);
    if (threadIdx.x < 16) MISC[threadIdx.x] = 0u;
    __syncthreads();
    const XcdBarrier xbar = xcd_barrier_post((unsigned*)p.ws + 4096, MISC, (int)threadIdx.x);
    cg::this_grid().sync();

#pragma unroll 1
    for (int l = 0; l < DEPTH; ++l) {
        for (int rep = 0; rep < REP_CVT; ++rep) { PH_BEGIN();
#ifndef NO_CVT
          convert_weights(kp, l, lds, gw, ngw, wave, lane);
#endif
#ifndef NO_NORM
          float* X = (float*)(ws + WS_X); bf16* XN = (bf16*)(ws + WS_XN);
          if (l == 0) norm_rows(kp->in[0], kp->in[1], kp->in[6], X, XN, nullptr, nullptr, gw, ngw, lane);
          else norm_rows(X, X + (size_t)TP * D, kp->in[6] + l * D, nullptr, XN, nullptr, (const float*)(ws + WS_PART), gw, ngw, lane);
#endif
        }
        GSYNC();
#ifndef NO_GEMM1
        { PH_BEGIN(); pg8::Gemm g{(const bf16*)(ws + WS_XN), (const bf16*)(ws + WS_WIN), T, NZ, D}; pg8::StaticOrder S; S.init(T, NZ, D, nb, bid); pg8::EpiStoreF32 E{(float*)(ws + WS_Z), NZ};
          pg8::gemm_phase<pg8::EpiStoreF32, pg8::StaticOrder, true, true>(lds, g, S, E, tid); }
#endif
        GSYNC();
        for (int rep = 0; rep < REP_MIXA; ++rep) { PH_BEGIN();
          if (rep) __syncthreads();
          for (int it = bid; it < 1152; it += nb) {
#ifndef NO_PREP
            if (it < 576) _Pragma("unroll 1") for (int r_ = 0; r_ < REP_PREP; ++r_) prep_item(kp, l, it, lds, tid);
#endif
#ifndef NO_POOL
            if (it >= 576 && it < 864) _Pragma("unroll 1") for (int r_ = 0; r_ < REP_POOL; ++r_) pool_item(kp, l, it - 576, lds, tid);
#endif
#ifndef NO_CONV
            if (it >= 864) _Pragma("unroll 1") for (int r_ = 0; r_ < REP_CONV; ++r_) conv_item(kp, l, it - 864, (LAS float*)lds, tid);
#endif
          }
        }
        GSYNC();
#ifndef NO_SCAN
        for (int rep = 0; rep < REP_SCAN; ++rep) {
        if (rep) GSYNC();
        for (int rp = 0; rp < REP_P1; ++rp) { PH_BEGIN();
            const float* SC = (const float*)(ws + WS_SC); float* Y = (float*)(ws + WS_Y); float* PQ = (float*)(ws + WS_PQ); float* GB = (float*)(ws + WS_GB);
            LAS float* wl = (LAS float*)(lds + wave * 12288);
            for (int task = wave * nb + bid; task < 64 * NC + 256; task += NWAVES * nb) {
                if (task < 64 * NC) {
                    const int ch = task / NC, c = task % NC, s = ch >> 4, h = ch & 15;
                    scan_run<3>(SC, s * 2048 + c * CL, CL, h, wl, lane, nullptr, Y, GB, nullptr, PQ + (size_t)((ch * NC + c) * 2) * 4096);
                } else {
                    const int ch = task - 64 * NC, b = ch >> 4, h = ch & 15;
                    scan_run<1>(SC, TP + b * 64, 64, h, wl, lane, kp->in[5] + (size_t)((l * 16 + b) * NH + h) * 4096, Y, nullptr, kp->out + O_WKV_S + (size_t)((l * 16 + b) * NH + h) * 4096, nullptr);
                }
            }
        }
        GSYNC();
        for (int rp = 0; rp < REP_CB; ++rp) { PH_BEGIN();
            for (int ch = bid; ch < 64; ch += nb) { const int s = ch >> 4, h = ch & 15;
                combine_chain((const float*)(ws + WS_PQ) + (size_t)ch * NC * 2 * 4096, (float*)(ws + WS_S0) + (size_t)ch * NC * 4096, kp->out + O_WKV_P + (size_t)((l * 4 + s) * NH + h) * 4096, lds, tid, wave, lane); }
        }
        GSYNC();
        { PH_BEGIN();
            const float* S0 = (const float*)(ws + WS_S0);
            for (int u = wave * nb + bid; u < 2048 + 256; u += NWAVES * nb) {
                if (u < 2048) { const int task = u >> 1, hf = u & 1, ch = task / NC, c = task % NC, s = ch >> 4, h = ch & 15;
                    ypost_task<4>(kp, l, c == 0 ? nullptr : S0 + (size_t)(ch * NC + c) * 4096, s * 2048 + c * CL + hf * 64, h, lane); }
                else { const int ch = u - 2048, b = ch >> 4, h = ch & 15; ypost_task<4>(kp, l, nullptr, TP + b * 64, h, lane); }
            }
        }
        }
#endif
        GSYNC();
#ifndef NO_GEMM2
        { PH_BEGIN(); pg8::Gemm g{(const bf16*)(ws + WS_MIX), (const bf16*)(ws + WS_WOUT), T, D, D}; pg8::TailOrder S; S.init(D, D, nb, bid); pg8::EpiResAdd E{(float*)(ws + WS_X), D, (float*)(ws + WS_PART)};
          pg8::gemm_phase<pg8::EpiResAdd, pg8::TailOrder, true, true>(lds, g, S, E, tid); }
#endif
        GSYNC();
#ifndef NO_NORM
        { PH_BEGIN(); float* X = (float*)(ws + WS_X); norm_rows(X, X + (size_t)TP * D, kp->in[26] + l * D, nullptr, (bf16*)(ws + WS_XN), nullptr, (const float*)(ws + WS_PART), gw, ngw, lane); }
#endif
        GSYNC();
#ifndef NO_GEMM3
        { PH_BEGIN(); pg8::Gemm g{(const bf16*)(ws + WS_XN), (const bf16*)(ws + WS_WGU), T, NGU, D}; pg8::StaticOrder S; S.init(T, NGU, D, nb, bid); pg8::EpiSwiGLU E{(bf16*)(ws + WS_ACT), FF};
          pg8::gemm_phase<pg8::EpiSwiGLU, pg8::StaticOrder, true, true>(lds, g, S, E, tid); }
#endif
        GSYNC();
#ifndef NO_GEMM4
        { PH_BEGIN(); pg8::Gemm g{(const bf16*)(ws + WS_ACT), (const bf16*)(ws + WS_WDN), T, D, FF}; pg8::TailOrder S; S.init(D, FF, nb, bid); pg8::EpiResAdd E{(float*)(ws + WS_X), D, (float*)(ws + WS_PART)};
          pg8::gemm_phase<pg8::EpiResAdd, pg8::TailOrder, true, true>(lds, g, S, E, tid); }
#endif
        GSYNC();
    }
#ifndef NO_NORM
    { PH_BEGIN(); float* X = (float*)(ws + WS_X); norm_rows(X, X + (size_t)TP * D, kp->in[30], nullptr, nullptr, kp->out + O_Y, (const float*)(ws + WS_PART), gw, ngw, lane); }
#endif
}

extern "C" void kernel_launch(void* const* d_in, const int* in_sizes, int n_in, void* d_out, int out_size, void* d_ws, size_t ws_size, hipStream_t stream) {
    static int grid = 0;
    if (grid == 0) {
        if (n_in != 31 || (size_t)out_size != O_END || ws_size < WS_END) { fprintf(stderr, "kernel_launch: unexpected shapes: n_in %d out %d ws %zu (need %zu)\n", n_in, out_size, ws_size, (size_t)WS_END); grid = -1; return; }
        int dev = 0, cus = 0, per_cu = 0;
        hipGetDevice(&dev);
        hipDeviceGetAttribute(&cus, hipDeviceAttributeMultiprocessorCount, dev);
        if (hipFuncSetAttribute((const void*)fwd_mega, hipFuncAttributeMaxDynamicSharedMemorySize, LDS_BYTES) != hipSuccess) { fprintf(stderr, "kernel_launch: hipFuncSetAttribute failed\n"); grid = -1; return; }
        hipOccupancyMaxActiveBlocksPerMultiprocessor(&per_cu, (const void*)fwd_mega, NTHR, LDS_BYTES);
        (void)hipGetLastError();
        if (per_cu < 1) { fprintf(stderr, "kernel_launch: occupancy query says %d blocks per CU\n", per_cu); per_cu = 1; }
        grid = cus * 1;
    }
    if (grid < 0) return;
    Params p{};
    for (int i = 0; i < 31; ++i) p.in[i] = (const float*)d_in[i];
    p.out = (float*)d_out; p.ws = (unsigned char*)d_ws;
    if (hipMemsetAsync(d_ws, 0, 65536, stream) != hipSuccess) { fprintf(stderr, "kernel_launch: memset failed\n"); return; }
    void* args[] = {&p};
    hipError_t e = hipLaunchCooperativeKernel((const void*)fwd_mega, dim3(grid), dim3(NTHR), args, LDS_BYTES, stream);
    if (e != hipSuccess) fprintf(stderr, "cooperative launch failed: %s (grid %d)\n", hipGetErrorString(e), grid);
}
```

```cpp
#include <hip/hip_runtime.h>
#include <hip/hip_cooperative_groups.h>
#include <cstdio>
#include <cstdint>
namespace cg = cooperative_groups;

namespace pg8 {
#define PG8_LAS __attribute__((address_space(3)))
typedef unsigned short bf16_t;
typedef short bf16x8 __attribute__((ext_vector_type(8)));
typedef float f32x4 __attribute__((ext_vector_type(4)));
typedef unsigned u32x4 __attribute__((ext_vector_type(4)));
constexpr int BM = 256, BK = 64, HALF = 128, HTB = HALF * BK * 2  , STAGE_BYTES = 8 * HTB, NXCD = 8, WGM = 8;

__host__ __device__ __forceinline__ int lds_byte(int r, int c) { const int st = (r >> 4) * 2 + (c >> 5), rr = r & 15, cc = c & 31, ob = rr * 64 + cc * 2; return st * 1024 + (ob ^ (((ob >> 9) & 1) << 5)); }
__host__ __device__ __forceinline__ void stage_rc(int b, int& R, int& C) { const int st = b / 1024, sb = b % 1024, swz = sb ^ (((sb >> 9) & 1) << 5); R = (st >> 1) * 16 + swz / 64; C = (st & 1) * 32 + (swz % 64) / 2; }
__host__ __device__ __forceinline__ int perm32(int rho) { const int n = rho >> 4, i = rho & 15; return 8 * (i >> 2) + 4 * n + (i & 3); }

struct Unit { int pm, pn, k0, nt, part; };
struct Gemm { const bf16_t* A; const bf16_t* Bt; int M, N, K; };

struct StaticOrder {
    int nM, nN, nwg, G, c, ntfull;
    __host__ __device__ void init(int M, int N, int K, int G_, int c_) { nM = M / BM; nN = N / BM; nwg = nM * nN; G = G_; c = c_; ntfull = K / BK; }
    __host__ __device__ __forceinline__ bool next(int i, Unit& u) const {
        const long L = (long)i * G + c; if (L >= nwg) return false;
        int wgid = (int)L; { const int q = nwg / NXCD, r = nwg % NXCD, xcd = wgid % NXCD, off = wgid / NXCD; wgid = (xcd < r ? xcd * (q + 1) : r * (q + 1) + (xcd - r) * q) + off; }
        const int nig = WGM * nN, gid = wgid / nig, fm = gid * WGM, gsz = (nM - fm) < WGM ? (nM - fm) : WGM;
        u.pm = fm + ((wgid % nig) % gsz); u.pn = (wgid % nig) / gsz; u.k0 = 0; u.nt = ntfull; u.part = -1; return true;
    }
    __device__ __forceinline__ void a_ready(const Unit&) const {}
    __device__ __forceinline__ void done(const Unit&) const {}
};


struct TailOrder {
    int nN, G, c, ntfull, skip;
    __host__ __device__ void init(int N, int K, int G_, int c_, int skip_ = 0) { nN = N / BM; G = G_; c = c_; ntfull = K / BK; skip = skip_; }
    __host__ __device__ __forceinline__ bool next(int i, Unit& u) const {
        const int nfull = 32 * nN, L = i * G + c + skip * nfull;
        if (L >= nfull + 4 * nN * 8) return false;
        const bool full = L < nfull;
        int wgid = full ? L : 0; { const int q = nfull / NXCD, r = nfull % NXCD, xcd = wgid % NXCD, off = wgid / NXCD; wgid = (xcd < r ? xcd * (q + 1) : r * (q + 1) + (xcd - r) * q) + off; }
        const int nig = WGM * nN, gid = wgid / nig, fm = gid * WGM;
        const int fpm = fm + ((wgid % nig) % WGM), fpn = (wgid % nig) / WGM;
        const int ut = full ? 0 : L - nfull, tile = ut >> 3, ks = ut & 7, base = (ntfull / 8) & ~1, extra = (ntfull - 8 * base) / 2;
        const int tpm = 32 + tile / nN, tpn = tile % nN, tnt = base + (ks < extra ? 2 : 0), tk0 = ks * base + 2 * (ks < extra ? ks : extra);
        Unit r_; r_.pm = full ? fpm : tpm; r_.pn = full ? fpn : tpn; r_.k0 = full ? 0 : tk0; r_.nt = full ? ntfull : tnt; r_.part = full ? -1 : ks;
        u = r_; return true;
    }
    __device__ __forceinline__ void a_ready(const Unit&) const {}
    __device__ __forceinline__ void done(const Unit&) const {}
};

__device__ __forceinline__ unsigned cvt_pk_bf16(float lo, float hi) { unsigned r; asm volatile("v_cvt_pk_bf16_f32 %0, %1, %2" : "=v"(r) : "v"(lo), "v"(hi)); return r; }

struct EpiStoreBf16 {
    static constexpr bool PERM = true, AFTER_DRAIN = false;
    bf16_t* O; int ldc;
    __device__ __forceinline__ void operator()(const f32x4 (&acc)[2][2][4][2], const Unit& u, int wr, int wc, int fr, int fq) const {
        const int row0 = u.pm * BM + wr * 64 + fr, col0 = u.pn * BM + wc * 32 + 8 * fq;
#pragma unroll
        for (int ai = 0; ai < 2; ++ai)
#pragma unroll
            for (int m = 0; m < 4; ++m) { bf16_t* rowp = O + (size_t)(row0 + ai * HALF + m * 16) * ldc + col0;
#pragma unroll
                for (int bj = 0; bj < 2; ++bj) { const f32x4 v0 = acc[ai][bj][m][0], v1 = acc[ai][bj][m][1];
                    u32x4 w; w.x = cvt_pk_bf16(v0[0], v0[1]); w.y = cvt_pk_bf16(v0[2], v0[3]); w.z = cvt_pk_bf16(v1[0], v1[1]); w.w = cvt_pk_bf16(v1[2], v1[3]);
                    *(u32x4*)(rowp + bj * HALF) = w; } }
    }
};
struct EpiResAdd {
    static constexpr bool PERM = true, AFTER_DRAIN = false;
    float* O; int ldc; float* P;
    __device__ __forceinline__ void operator()(const f32x4 (&acc)[2][2][4][2], const Unit& u, int wr, int wc, int fr, int fq) const {
        const int row0 = u.pm * BM + wr * 64 + fr, col0 = u.pn * BM + wc * 32 + 8 * fq;
        if (u.part < 0) {
#pragma unroll
            for (int ai = 0; ai < 2; ++ai)
#pragma unroll
                for (int m = 0; m < 4; ++m) { float* rowp = O + (size_t)(row0 + ai * HALF + m * 16) * ldc + col0;
#pragma unroll
                    for (int bj = 0; bj < 2; ++bj) {
                        f32x4 a = *(const f32x4*)(rowp + bj * HALF), b = *(const f32x4*)(rowp + bj * HALF + 4);
                        *(f32x4*)(rowp + bj * HALF) = a + acc[ai][bj][m][0]; *(f32x4*)(rowp + bj * HALF + 4) = b + acc[ai][bj][m][1]; } }
        } else {
            float* base = P + (size_t)u.part * 1024 * ldc;
#pragma unroll
            for (int ai = 0; ai < 2; ++ai)
#pragma unroll
                for (int m = 0; m < 4; ++m) { float* rowp = base + (size_t)(row0 - 8192 + ai * HALF + m * 16) * ldc + col0;
#pragma unroll
                    for (int bj = 0; bj < 2; ++bj) { *(f32x4*)(rowp + bj * HALF) = acc[ai][bj][m][0]; *(f32x4*)(rowp + bj * HALF + 4) = acc[ai][bj][m][1]; } }
        }
    }
};
struct EpiSwiGLU {
    static constexpr bool PERM = true, AFTER_DRAIN = false;
    bf16_t* O; int ldc;
    __device__ __forceinline__ void operator()(const f32x4 (&acc)[2][2][4][2], const Unit& u, int wr, int wc, int fr, int fq) const {
        const int row0 = u.pm * BM + wr * 64 + fr, col0 = u.pn * HALF + wc * 32 + 8 * fq;
#pragma unroll
        for (int ai = 0; ai < 2; ++ai)
#pragma unroll
            for (int m = 0; m < 4; ++m) { bf16_t* rowp = O + (size_t)(row0 + ai * HALF + m * 16) * ldc + col0;
                float o[8];
#pragma unroll
                for (int n = 0; n < 2; ++n)
#pragma unroll
                    for (int j = 0; j < 4; ++j) { const float g = acc[ai][0][m][n][j], up = acc[ai][1][m][n][j]; o[n * 4 + j] = g * up * __builtin_amdgcn_rcpf(1.0f + __expf(-g)); }
                u32x4 w; w.x = cvt_pk_bf16(o[0], o[1]); w.y = cvt_pk_bf16(o[2], o[3]); w.z = cvt_pk_bf16(o[4], o[5]); w.w = cvt_pk_bf16(o[6], o[7]);
                *(u32x4*)rowp = w; }
    }
};

template <class Epi, class Sched, bool ALIGN_EPI = false, bool SP2 = false>
__device__ __forceinline__ void gemm_phase(PG8_LAS unsigned char* lds, const Gemm g, const Sched& S, const Epi& E, const int tid) {
    const int wid = __builtin_amdgcn_readfirstlane(tid >> 6), lane = tid & 63, wr = wid >> 2, wc = wid & 3, fr = lane & 15, fq = lane >> 4;
    const int K = g.K;
    unsigned voffA[2], voffB[2];
#pragma unroll
    for (int i = 0; i < 2; ++i) { int R, C; stage_rc(tid * 16 + i * 8192, R, C); const int Rb = Epi::PERM ? ((R & ~31) + perm32(R & 31)) : R;
        voffA[i] = (unsigned)(R * K + C) * 2u; voffB[i] = (unsigned)(Rb * K + C) * 2u; }
    const size_t kstep = (size_t)(BK * 2);
    const size_t hstep = (size_t)HALF * K * 2;
    const size_t tstep = 2 * hstep;
    const unsigned ldsw = (unsigned)wid * 1024u;
    const int aoff = lds_byte(wr * 64 + fr, fq * 8), boff = lds_byte(wc * 32 + fr, fq * 8);
#define PG8_SA(b, h) (((b) * 2 + (h)) * HTB)
#define PG8_SB(b, h) ((4 + (b) * 2 + (h)) * HTB)
#define PG8_STAGE(bufoff, gbase, voff) do { _Pragma("unroll") for (int _i = 0; _i < 2; ++_i) \
        __builtin_amdgcn_global_load_lds((const unsigned*)((const char*)(gbase) + (voff)[_i]), (PG8_LAS unsigned*)(lds + (bufoff) + ldsw + _i * 8192), 16, 0, 0); } while (0)
#define PG8_LDA(dst, b, h) do { _Pragma("unroll") for (int m = 0; m < 4; ++m) _Pragma("unroll") for (int k = 0; k < 2; ++k) dst[m][k] = *(const PG8_LAS bf16x8*)(lds + PG8_SA(b, h) + aoff + m * 2048 + k * 1024); } while (0)
#define PG8_LDB(dst, b, h) do { _Pragma("unroll") for (int n = 0; n < 2; ++n) _Pragma("unroll") for (int k = 0; k < 2; ++k) dst[n][k] = *(const PG8_LAS bf16x8*)(lds + PG8_SB(b, h) + boff + n * 2048 + k * 1024); } while (0)
#define PG8_MMA(ai, bj, At, Bt) do { __builtin_amdgcn_s_setprio(1); _Pragma("unroll") for (int m = 0; m < 4; ++m) _Pragma("unroll") for (int n = 0; n < 2; ++n) _Pragma("unroll") for (int k = 0; k < 2; ++k) \
        acc[ai][bj][m][n] = __builtin_amdgcn_mfma_f32_16x16x32_bf16(Bt[n][k], At[m][k], acc[ai][bj][m][n], 0, 0, 0); __builtin_amdgcn_s_setprio(0); } while (0)
#define PG8_WAIT_V(n) asm volatile("s_waitcnt vmcnt(" #n ")" ::: "memory")
#define PG8_WAIT_L(n) asm volatile("s_waitcnt lgkmcnt(" #n ")" ::: "memory")
#define PG8_BAR __builtin_amdgcn_s_barrier()
#define PG8_SCHED __builtin_amdgcn_sched_barrier(0)
    Unit cur, nxt; int ui = 0;
    if (!S.next(0, cur)) return;
    f32x4 acc[2][2][4][2];
#pragma unroll
    for (int a = 0; a < 2; ++a)
#pragma unroll
        for (int b = 0; b < 2; ++b)
#pragma unroll
            for (int m = 0; m < 4; ++m)
#pragma unroll
                for (int n = 0; n < 2; ++n) acc[a][b][m][n] = (f32x4){0.f, 0.f, 0.f, 0.f};
    bf16x8 At[4][2], B0[2][2], B1[2][2];
    const char* cA = (const char*)g.A + (size_t)cur.pm * tstep + (size_t)cur.k0 * kstep; const char* cB = (const char*)g.Bt + (size_t)cur.pn * tstep + (size_t)cur.k0 * kstep;
    S.a_ready(cur);
    if constexpr (SP2) {
        PG8_STAGE(PG8_SB(0, 0), cB, voffB); PG8_STAGE(PG8_SB(0, 1), cB + hstep, voffB); PG8_STAGE(PG8_SA(0, 0), cA, voffA); PG8_STAGE(PG8_SA(0, 1), cA + hstep, voffA);
        if (wr == 1) PG8_BAR;
        PG8_WAIT_V(2); PG8_BAR;
        PG8_STAGE(PG8_SB(1, 0), cB + kstep, voffB); PG8_STAGE(PG8_SA(1, 0), cA + kstep, voffA); PG8_STAGE(PG8_SB(1, 1), cB + hstep + kstep, voffB);
        PG8_WAIT_V(6); PG8_BAR;
    } else {
        PG8_STAGE(PG8_SB(0, 0), cB, voffB); PG8_STAGE(PG8_SA(0, 0), cA, voffA); PG8_STAGE(PG8_SB(0, 1), cB + hstep, voffB); PG8_STAGE(PG8_SA(0, 1), cA + hstep, voffA);
        if (wr == 1) PG8_BAR;
        PG8_WAIT_V(4); PG8_BAR;
        PG8_STAGE(PG8_SB(1, 0), cB + kstep, voffB); PG8_STAGE(PG8_SA(1, 0), cA + kstep, voffA); PG8_STAGE(PG8_SB(1, 1), cB + hstep + kstep, voffB);
        PG8_WAIT_V(6); PG8_BAR;
    }
    for (;;) {
        const bool has_next = S.next(ui + 1, nxt);
        const char* nA = has_next ? (const char*)g.A + (size_t)nxt.pm * tstep + (size_t)nxt.k0 * kstep : cA; const char* nB = has_next ? (const char*)g.Bt + (size_t)nxt.pn * tstep + (size_t)nxt.k0 * kstep : cB;
        const int nt = cur.nt;
        for (int t = 0; t < nt; t += 2) {
            const bool last = (t == nt - 2);
            const char* a1 = cA + (size_t)(t + 1) * kstep;
            const char* a2 = last ? nA : cA + (size_t)(t + 2) * kstep; const char* b2 = last ? nB : cB + (size_t)(t + 2) * kstep;
            const char* a3 = a2 + kstep; const char* b3 = b2 + kstep;
            if (last && has_next) S.a_ready(nxt);
            if constexpr (SP2) {
            PG8_LDB(B0, 0, 0); PG8_LDB(B1, 0, 1); PG8_SCHED; PG8_LDA(At, 0, 0); PG8_STAGE(PG8_SA(1, 1), a1 + hstep, voffA);
            PG8_WAIT_V(8); PG8_WAIT_L(0); PG8_BAR; PG8_MMA(0, 0, At, B0); PG8_MMA(0, 1, At, B1); PG8_BAR; PG8_SCHED;
            PG8_LDA(At, 0, 1); PG8_STAGE(PG8_SB(0, 0), b2, voffB); PG8_STAGE(PG8_SB(0, 1), b2 + hstep, voffB); PG8_STAGE(PG8_SA(0, 0), a2, voffA);
            PG8_WAIT_V(8); PG8_WAIT_L(0); PG8_BAR; PG8_MMA(1, 0, At, B0); PG8_MMA(1, 1, At, B1); PG8_BAR; PG8_SCHED;
            PG8_LDB(B0, 1, 0); PG8_LDB(B1, 1, 1); PG8_SCHED; PG8_LDA(At, 1, 0); PG8_STAGE(PG8_SA(0, 1), a2 + hstep, voffA);
            PG8_WAIT_V(8); PG8_WAIT_L(0); PG8_BAR; PG8_MMA(0, 0, At, B0); PG8_MMA(0, 1, At, B1); PG8_BAR; PG8_SCHED;
            PG8_LDA(At, 1, 1); PG8_STAGE(PG8_SB(1, 0), b3, voffB); PG8_STAGE(PG8_SB(1, 1), b3 + hstep, voffB); PG8_STAGE(PG8_SA(1, 0), a3, voffA);
            PG8_WAIT_V(8); PG8_WAIT_L(0); PG8_BAR; PG8_MMA(1, 0, At, B0); PG8_MMA(1, 1, At, B1); PG8_BAR; PG8_SCHED;
            } else {
            PG8_LDB(B0, 0, 0); PG8_SCHED; PG8_LDA(At, 0, 0); PG8_STAGE(PG8_SA(1, 1), a1 + hstep, voffA);
            PG8_WAIT_L(8); PG8_BAR; PG8_WAIT_L(0); PG8_MMA(0, 0, At, B0); PG8_BAR; PG8_SCHED;
            PG8_LDB(B1, 0, 1); PG8_STAGE(PG8_SB(0, 0), b2, voffB);
            PG8_BAR; PG8_WAIT_L(0); PG8_MMA(0, 1, At, B1); PG8_BAR;
            PG8_LDA(At, 0, 1); PG8_STAGE(PG8_SA(0, 0), a2, voffA);
            PG8_BAR; PG8_WAIT_L(0); PG8_MMA(1, 0, At, B0); PG8_BAR; PG8_SCHED;
            PG8_STAGE(PG8_SB(0, 1), b2 + hstep, voffB);
            PG8_WAIT_V(6); PG8_BAR; PG8_MMA(1, 1, At, B1); PG8_BAR;
            PG8_LDB(B0, 1, 0); PG8_SCHED; PG8_LDA(At, 1, 0); PG8_STAGE(PG8_SA(0, 1), a2 + hstep, voffA);
            PG8_WAIT_L(8); PG8_BAR; PG8_WAIT_L(0); PG8_MMA(0, 0, At, B0); PG8_BAR; PG8_SCHED;
            PG8_LDB(B1, 1, 1); PG8_STAGE(PG8_SB(1, 0), b3, voffB);
            PG8_BAR; PG8_WAIT_L(0); PG8_MMA(0, 1, At, B1); PG8_BAR;
            PG8_LDA(At, 1, 1); PG8_STAGE(PG8_SA(1, 0), a3, voffA);
            PG8_BAR; PG8_WAIT_L(0); PG8_MMA(1, 0, At, B0); PG8_BAR; PG8_SCHED;
            PG8_STAGE(PG8_SB(1, 1), b3 + hstep, voffB);
            PG8_WAIT_V(6); PG8_BAR; PG8_MMA(1, 1, At, B1); PG8_BAR;
            }
        }
        if constexpr (ALIGN_EPI) { if (wr == 0) PG8_BAR; }
        if constexpr (!Epi::AFTER_DRAIN) { E(acc, cur, wr, wc, fr, fq); S.done(cur); }
        if (!has_next) break;
#pragma unroll
        for (int a = 0; a < 2; ++a)
#pragma unroll
            for (int b = 0; b < 2; ++b)
#pragma unroll
                for (int m = 0; m < 4; ++m)
#pragma unroll
                    for (int n = 0; n < 2; ++n) acc[a][b][m][n] = (f32x4){0.f, 0.f, 0.f, 0.f};
        cur = nxt; cA = nA; cB = nB; ++ui;
        if constexpr (ALIGN_EPI) { if (wr == 1) PG8_BAR; }
    }
    PG8_WAIT_V(0);
    if constexpr (!ALIGN_EPI) { if (wr == 0) PG8_BAR; }
    PG8_BAR;
    if constexpr (Epi::AFTER_DRAIN) { E.fused(acc, cur, wr, wc, fr, fq, lds, wid, lane); S.done(cur); }
#undef PG8_SA
#undef PG8_SB
#undef PG8_STAGE
#undef PG8_LDA
#undef PG8_LDB
#undef PG8_MMA
#undef PG8_WAIT_V
#undef PG8_WAIT_L
#undef PG8_BAR
#undef PG8_SCHED
}
}

#define LAS __attribute__((address_space(3)))
typedef unsigned short bf16;
typedef float f32x4 __attribute__((ext_vector_type(4)));
typedef float f32x2 __attribute__((ext_vector_type(2)));
typedef unsigned u32x4 __attribute__((ext_vector_type(4)));
typedef unsigned u32x2 __attribute__((ext_vector_type(2)));
typedef short bfx8 __attribute__((ext_vector_type(8)));
#define XB_TMO      128
#define XB_XCNT(j)  (256  + 64 * (j))
#define XB_XSUB(j)  (1280 + 64 * (j))
#define XB_XGEN(j)  (2304 + 64 * (j))
#define XB_TOP      3328
#define XB_TOPGEN   3392
#define XCD_BAR_WORDS 3456
#define XB_SPIN_CAP (1u << 18)

__device__ __forceinline__ unsigned xb_ld(unsigned* p)              { return __hip_atomic_load(p, __ATOMIC_RELAXED, __HIP_MEMORY_SCOPE_AGENT); }
__device__ __forceinline__ unsigned xb_add(unsigned* p, unsigned v) { return __hip_atomic_fetch_add(p, v, __ATOMIC_RELAXED, __HIP_MEMORY_SCOPE_AGENT); }
__device__ __forceinline__ unsigned xb_xcc_id() { return (unsigned)__builtin_amdgcn_s_getreg((3 << 11) | 20) & 0xFu; }
#define XB_SPIN(cond, bar) do { unsigned _sp = 0; while (cond) { __builtin_amdgcn_s_sleep(1); \
    if ((++_sp & 255u) == 0u) { if (xb_ld(&(bar)[XB_TMO])) break; if (_sp > XB_SPIN_CAP) { atomicAdd(&(bar)[XB_TMO], 1u); break; } } } } while (0)

struct XcdBarrier {
    unsigned* bar; unsigned x;
    volatile LAS unsigned* st;
};

__device__ __forceinline__ XcdBarrier xcd_barrier_post(unsigned* bar, volatile LAS unsigned* st, int tid) {
    XcdBarrier b; b.bar = bar; b.x = xb_xcc_id(); b.st = st;
    if (tid == 0) (void)xb_add(&bar[XB_XCNT(b.x)], 1u);
    return b;
}
__device__ __forceinline__ void xcd_barrier_complete(unsigned* bar, unsigned x, unsigned& nloc, unsigned& nx) {
    const unsigned G = gridDim.x * gridDim.y * gridDim.z;
    unsigned sum, cnt, mine, sp = 0u;
    for (;;) {
        sum = 0u; cnt = 0u; mine = 0u;
#pragma unroll
        for (unsigned j = 0; j < 16; ++j) { const unsigned c = xb_ld(&bar[XB_XCNT(j)]); sum += c; cnt += (c > 0u) ? 1u : 0u; mine = (j == x) ? c : mine; }
        if (sum == G) break;
        __builtin_amdgcn_s_sleep(1);
        if ((++sp & 255u) == 0u) { if (xb_ld(&bar[XB_TMO])) break; if (sp > XB_SPIN_CAP) { atomicAdd(&bar[XB_TMO], 1u); break; } }
    }
    nloc = mine > 0u ? mine : 1u; nx = cnt > 0u ? cnt : 1u;
}

__device__ __forceinline__ void xcd_barrier(const XcdBarrier& b, int tid) {
    asm volatile("s_waitcnt vmcnt(0)" ::: "memory");
    __syncthreads();
    if (tid == 0) {
        unsigned* bar = b.bar;
        __builtin_amdgcn_s_waitcnt(0);
        unsigned nloc = b.st[0], nx = b.st[1];
        if (nloc == 0u) { xcd_barrier_complete(bar, b.x, nloc, nx); b.st[0] = nloc; b.st[1] = nx; }
        const unsigned old = xb_add(&bar[XB_XSUB(b.x)], 1u);
        const unsigned gen = old / nloc;
        if (old + 1u == (gen + 1u) * nloc) {
            __builtin_amdgcn_fence(__ATOMIC_RELEASE, "agent");
            asm volatile("s_waitcnt vmcnt(0)" ::: "memory");
            const unsigned og = xb_add(&bar[XB_TOP], 1u);
            const unsigned tg = og / nx;
            if (og + 1u == (tg + 1u) * nx) xb_add(&bar[XB_TOPGEN], 1u);
            else XB_SPIN(xb_ld(&bar[XB_TOPGEN]) == tg, bar);
            __builtin_amdgcn_fence(__ATOMIC_ACQUIRE, "agent");
            xb_add(&bar[XB_XGEN(b.x)], 1u);
            asm volatile("s_waitcnt vmcnt(0)" ::: "memory");
        } else {
            XB_SPIN(xb_ld(&bar[XB_XGEN(b.x)]) == gen, bar);
            __builtin_amdgcn_fence(__ATOMIC_ACQUIRE, "agent");
            asm volatile("s_waitcnt vmcnt(0)" ::: "memory");
        }
    }
    __syncthreads();
}

constexpr int NWAVES = 8, NTHR = 512;
constexpr int TP = 8192, TS = 1024, T = 9216, D = 2048, NIN = 4800, NZ = 4864, FF = 5632, NGU = 11264;
constexpr int NH = 16, HS = 64, RD = 1024, RP = 3264, DEPTH = 4;
constexpr int ZQ = 1536;
constexpr float RMS_EPS = 1e-6f, LN_EPS = 1e-5f, GN_EPS = 64e-5f;
constexpr int SCR = 384;
constexpr size_t O_Y = 0;
constexpr size_t O_CONV_P = (size_t)T * D;
constexpr size_t O_POOL_P = O_CONV_P + (size_t)DEPTH * 4 * 30 * 512;
constexpr size_t O_SHIFT_P = O_POOL_P + (size_t)DEPTH * 4 * 15 * 512;
constexpr size_t O_WKV_P = O_SHIFT_P + (size_t)DEPTH * 4 * RP;
constexpr size_t O_CONV_S = O_WKV_P + (size_t)DEPTH * 4 * NH * 4096;
constexpr size_t O_POOL_S = O_CONV_S + (size_t)DEPTH * 16 * 30 * 512;
constexpr size_t O_SHIFT_S = O_POOL_S + (size_t)DEPTH * 16 * 15 * 512;
constexpr size_t O_WKV_S = O_SHIFT_S + (size_t)DEPTH * 16 * RP;
constexpr size_t O_END = O_WKV_S + (size_t)DEPTH * 16 * NH * 4096;
constexpr size_t WS_POOLW = 131072;
constexpr size_t WS_UPS = 262144;
constexpr size_t WS_WIN = 1u << 20;
constexpr size_t WS_WOUT = WS_WIN + (size_t)NZ * D * 2;
constexpr size_t WS_WGU = WS_WOUT + (size_t)D * D * 2;
constexpr size_t WS_WDN = WS_WGU + (size_t)NGU * D * 2;
constexpr size_t WS_X = WS_WDN + (size_t)D * FF * 2;
constexpr size_t WS_XN = WS_X + (size_t)T * D * 4;
constexpr size_t WS_MIX = WS_XN + (size_t)T * D * 2;
constexpr size_t WS_Z = WS_MIX + (size_t)T * D * 2;
constexpr size_t WS_ACT = WS_Z;
constexpr size_t WS_SC = WS_Z + (size_t)T * NZ * 2;
constexpr size_t WS_PART = WS_SC + (32u << 20);
constexpr size_t WS_Y = WS_SC + (size_t)T * NH * SCR * 4;
constexpr size_t WS_G = WS_Y + (size_t)T * RD * 4;
constexpr size_t WS_RK = WS_G + (size_t)T * RD * 4;
constexpr int NC = 16, CL = 128;
constexpr size_t WS_PQ = WS_RK + (size_t)T * NH * 4;
constexpr size_t WS_S0 = WS_PQ + (size_t)64 * NC * 2 * 4096 * 4;
constexpr size_t WS_GB = WS_S0 + (size_t)64 * NC * 4096 * 4;
constexpr size_t WS_END = WS_GB + (size_t)TP * RD * 4;
static_assert(WS_ACT + (size_t)T * FF * 2 <= WS_PART && WS_PART + (size_t)8 * 1024 * D * 4 <= WS_Y, "act / partial overlays");
constexpr int LDS_BYTES = 147456;

#ifndef REP_CVTW
#define REP_CVTW 1
#endif
#ifndef REP_YP
#define REP_YP 1
#endif
#ifndef REP_G1
#define REP_G1 1
#endif
#ifndef REP_N2
#define REP_N2 1
#endif
#ifndef REP_T4
#define REP_T4 1
#endif
#ifndef REP_G3
#define REP_G3 1
#endif
#ifndef REP_PREP
#define REP_PREP 1
#endif
#ifndef REP_POOL
#define REP_POOL 1
#endif
#ifndef REP_CONV
#define REP_CONV 1
#endif
#ifndef REP_P1
#define REP_P1 1
#endif
#ifndef REP_CB
#define REP_CB 1
#endif
#ifndef REP_MIXA
#define REP_MIXA 1
#endif
#ifndef REP_SCAN
#define REP_SCAN 1
#endif
#ifndef REP_POST
#define REP_POST 1
#endif
#ifndef REP_CVT
#define REP_CVT 1
#endif
#ifdef NO_SYNC
#define GSYNC() __syncthreads()
#else
#define GSYNC() do { int w_ = wave0; asm volatile("" : "+s"(w_)); xcd_barrier(xbar, w_ * 64 + (int)__builtin_amdgcn_mbcnt_hi(~0u, __builtin_amdgcn_mbcnt_lo(~0u, (unsigned)launder_v(0)))); } while (0)
#endif
__host__ __device__ __forceinline__ size_t sc_off(int t, int h) { return ((size_t)(((t >> 2) * NH + h) * 4 + (t & 3))) * SCR; }
struct Params { const float* in[31]; float* out; unsigned char* ws; };
typedef const __attribute__((address_space(4))) Params* KP;
__device__ __forceinline__ KP kargs() { KP k = (KP)__builtin_amdgcn_kernarg_segment_ptr(); asm volatile("" : "+s"(k)); return k; }
__device__ __forceinline__ int launder_v(int v) { asm volatile("" : "+v"(v)); return v; }
#define PH_BEGIN() KP kp = kargs(); int wave_ = wave0; asm volatile("" : "+s"(wave_)); const int wave = wave_; const int lane = (int)__builtin_amdgcn_mbcnt_hi(~0u, __builtin_amdgcn_mbcnt_lo(~0u, (unsigned)launder_v(0))); const int tid = wave * 64 + lane; \
    const int nb = gridDim.x, bid = blockIdx.x, gw = bid * NWAVES + wave, ngw = nb * NWAVES; unsigned char* const ws = kp->ws; (void)lane; (void)wave; (void)gw; (void)ngw; (void)ws; (void)nb; (void)bid

__device__ __forceinline__ float wave_sum(float v) {
#pragma unroll
    for (int o = 1; o < 64; o <<= 1) v += __shfl_xor(v, o);
    return v;
}
__device__ __forceinline__ unsigned f2bf(float f) { unsigned u = __builtin_bit_cast(unsigned, f); return (u + 0x7fffu + ((u >> 16) & 1u)) >> 16; }
__device__ __forceinline__ unsigned pk2(float lo, float hi) { return f2bf(lo) | (f2bf(hi) << 16); }
__device__ __forceinline__ float bf2f(bf16 v) { return __builtin_bit_cast(float, (unsigned)v << 16); }
__device__ __forceinline__ float sigm(float x) { return 1.0f / (1.0f + __expf(-x)); }

__device__ __forceinline__ void transpose_item(const float* W, int K, int N, bf16* WT, int mode, LAS float* scr, int item, int lane) {
    const int nblk = N / 32, kb = item / nblk, nb = item % nblk, k0 = 64 * kb, n0 = 32 * nb;
    const int drow0 = (mode == 0) ? n0 : ((n0 >> 7) * 256 + (n0 & 127) + (mode == 2 ? 128 : 0));
    float wv[32];
#pragma unroll
    for (int i = 0; i < 32; ++i) { const int kk = 2 * i + (lane >> 5); wv[i] = W[(size_t)(k0 + kk) * N + n0 + (lane & 31)]; }
#pragma unroll
    for (int i = 0; i < 32; ++i) { const int kk = 2 * i + (lane >> 5); scr[kk * 33 + (lane & 31)] = wv[i]; }
    asm volatile("s_waitcnt lgkmcnt(0)" ::: "memory");
    const int c = lane & 7;
#pragma unroll
    for (int j = 0; j < 4; ++j) { const int n = (lane >> 3) + 8 * j; const LAS float* s = scr + (8 * c) * 33 + n;
        u32x4 o; o.x = pk2(s[0 * 33], s[1 * 33]); o.y = pk2(s[2 * 33], s[3 * 33]); o.z = pk2(s[4 * 33], s[5 * 33]); o.w = pk2(s[6 * 33], s[7 * 33]);
        *(u32x4*)(WT + (size_t)(drow0 + n) * K + k0 + 8 * c) = o; }
    asm volatile("s_waitcnt lgkmcnt(0)" ::: "memory");
}
__device__ __forceinline__ void convert_weights(KP kp, int l, LAS unsigned char* lds, int gw, int ngw, int wave, int lane) {
    LAS float* scr = (LAS float*)(lds + wave * 16384);
    unsigned char* ws = kp->ws;
    bf16* WIN = (bf16*)(ws + WS_WIN); bf16* WOUT = (bf16*)(ws + WS_WOUT); bf16* WGU = (bf16*)(ws + WS_WGU); bf16* WDN = (bf16*)(ws + WS_WDN);
    constexpr int I_IN = (D / 64) * (NIN / 32), I_OUT = (D / 64) * (D / 32), I_G = (D / 64) * (FF / 32), I_D = (FF / 64) * (D / 32);
    constexpr int I_P = 4 * 8, I_U = 3 * 32;
    constexpr int NITEMS = I_IN + I_OUT + 2 * I_G + I_D + I_P + I_U;
    for (int it = gw; it < NITEMS; it += ngw) {
        int r = it;
        if (r < I_IN) { transpose_item(kp->in[7] + (size_t)l * D * NIN, D, NIN, WIN, 0, scr, r, lane); continue; } r -= I_IN;
        if (r < I_OUT) { transpose_item(kp->in[25] + (size_t)l * D * D, D, D, WOUT, 0, scr, r, lane); continue; } r -= I_OUT;
        if (r < I_G) { transpose_item(kp->in[27] + (size_t)l * D * FF, D, FF, WGU, 1, scr, r, lane); continue; } r -= I_G;
        if (r < I_G) { transpose_item(kp->in[28] + (size_t)l * D * FF, D, FF, WGU, 2, scr, r, lane); continue; } r -= I_G;
        if (r < I_D) { transpose_item(kp->in[29] + (size_t)l * FF * D, FF, D, WDN, 0, scr, r, lane); continue; } r -= I_D;
        if (r < I_P) { const int g = r >> 3; transpose_item(kp->in[12] + (size_t)((l * 4 + g) * 128) * 128, 128, 128, (bf16*)(ws + WS_POOLW) + (size_t)g * 128 * 128, 0, scr, r & 7, lane); continue; } r -= I_P;
        { const int m = r >> 5; const float* src = (m == 0 ? kp->in[16] : (m == 1 ? kp->in[18] : kp->in[19])) + (size_t)l * 64 * RD;
          transpose_item(src, 64, RD, (bf16*)(ws + WS_UPS) + (size_t)m * RD * 64, 0, scr, r & 31, lane); }
    }
    { const unsigned z = (unsigned)launder_v(0); for (int e = gw * 64 + lane; e < 16384; e += ngw * 64) ((u32x4*)(WIN + (size_t)NIN * D))[e] = (u32x4){z, z, z, z}; }
}
__device__ __forceinline__ void norm_rows(const float* sa, const float* sb, const float* g, float* xcopy, bf16* xn, float* fout, const float* part, int gw, int ngw, int lane) {
    for (int m = gw; m < T; m += ngw) {
        const float* row = (m < TP) ? sa + (size_t)m * D : sb + (size_t)(m - TP) * D;
        f32x4 v[8]; float ss = 0.f;
#pragma unroll
        for (int j = 0; j < 8; ++j) v[j] = ((const f32x4*)row)[lane + 64 * j];
        if (part && m >= TP) {
#pragma unroll
            for (int k = 0; k < 8; ++k)
#pragma unroll
                for (int j = 0; j < 8; ++j) v[j] += ((const f32x4*)(part + ((size_t)k * 1024 + (m - TP)) * D))[lane + 64 * j];
#pragma unroll
            for (int j = 0; j < 8; ++j) ((f32x4*)(const_cast<float*>(sb) + (size_t)(m - TP) * D))[lane + 64 * j] = v[j];
        }
#pragma unroll
        for (int j = 0; j < 8; ++j) ss += (v[j].x * v[j].x + v[j].y * v[j].y) + (v[j].z * v[j].z + v[j].w * v[j].w);
        const float rinv = 1.0f / sqrtf(wave_sum(ss) * (1.0f / D) + RMS_EPS);
#pragma unroll
        for (int j = 0; j < 8; ++j) {
            if (xcopy) ((f32x4*)(xcopy + (size_t)m * D))[lane + 64 * j] = v[j];
            const f32x4 gj = ((const f32x4*)g)[lane + 64 * j];
            const f32x4 y = v[j] * rinv * gj;
            if (xn) { u32x2 o; o.x = pk2(y.x, y.y); o.y = pk2(y.z, y.w); ((u32x2*)(xn + (size_t)m * D))[lane + 64 * j] = o; }
            if (fout) ((f32x4*)(fout + (size_t)m * D))[lane + 64 * j] = y;
        }
    }
}

__device__ __forceinline__ void conv_item(KP kp, int l, int item, LAS float* lds, int tid_in) {
    const int tid = launder_v(tid_in);
    const bf16* Z = (const bf16*)(kp->ws + WS_Z); bf16* MIX = (bf16*)(kp->ws + WS_MIX);
    const int t0 = item * 32;
    int s, tau0, Ls; bool prompt;
    if (t0 < TP) { s = t0 >> 11; tau0 = t0 & 2047; Ls = 2048; prompt = true; } else { s = (t0 - TP) >> 6; tau0 = (t0 - TP) & 63; Ls = 64; prompt = false; }
    const int c = tid;
    const float* cw = kp->in[8] + (size_t)l * 31 * 512;
    float w[31];
#pragma unroll
    for (int j = 0; j < 31; ++j) w[j] = cw[j * 512 + c];
    const float bias = kp->in[9][l * 512 + c];
    float acc[32];
#pragma unroll
    for (int i = 0; i < 32; ++i) acc[i] = bias;
    const bool first = (tau0 == 0), lastit = (tau0 + 32 == Ls);
    float* oc = prompt ? kp->out + O_CONV_P + (size_t)((l * 4 + s) * 30) * 512 : kp->out + O_CONV_S + (size_t)((l * 16 + s) * 30) * 512;
    const float* cc = kp->in[2] + (size_t)((l * 16 + s) * 30) * 512;
#pragma unroll
    for (int hf = 0; hf < 2; ++hf) {
        float pv[31], pg[31];
#pragma unroll
        for (int k = 0; k < 31; ++k) { const int ii = hf * 31 + k;
            if (ii < 30 && first) { pv[k] = prompt ? 0.f : cc[ii * 512 + c]; pg[k] = 0.f; }
            else { const bf16* zr = Z + (size_t)(t0 + ii - 30) * NZ; pv[k] = bf2f(zr[c]); pg[k] = bf2f(zr[512 + c]); } }
#pragma unroll
        for (int k = 0; k < 31; ++k) { const int ii = hf * 31 + k;
            const float u = (ii < 30 && first) ? pv[k] : pv[k] * sigm(pg[k]);
            if (ii >= 32 && lastit) oc[(ii - 32) * 512 + c] = u;
#pragma unroll
            for (int oi = 0; oi < 32; ++oi) { const int j = ii - oi; if (j >= 0 && j <= 30) acc[oi] += w[j] * u; }
        }
    }
#pragma unroll
    for (int oi = 0; oi < 32; ++oi) lds[oi * 512 + c] = acc[oi];
    __syncthreads();
    const int wave = tid >> 6, lane = tid & 63;
    const f32x4 g0 = *(const f32x4*)(kp->in[10] + l * 512 + lane * 8), g1 = *(const f32x4*)(kp->in[10] + l * 512 + lane * 8 + 4);
    const f32x4 b0 = *(const f32x4*)(kp->in[11] + l * 512 + lane * 8), b1 = *(const f32x4*)(kp->in[11] + l * 512 + lane * 8 + 4);
#pragma unroll
    for (int q = 0; q < 4; ++q) {
        const int oi = wave * 4 + q;
        f32x4 a = *(const LAS f32x4*)(lds + oi * 512 + lane * 8), b = *(const LAS f32x4*)(lds + oi * 512 + lane * 8 + 4);
        const float mean = wave_sum((a.x + a.y) + (a.z + a.w) + (b.x + b.y) + (b.z + b.w)) * (1.0f / 512.0f);
        a = a - mean; b = b - mean;
        const float var = wave_sum((a.x * a.x + a.y * a.y) + (a.z * a.z + a.w * a.w) + (b.x * b.x + b.y * b.y) + (b.z * b.z + b.w * b.w)) * (1.0f / 512.0f);
        const float rstd = 1.0f / sqrtf(var + LN_EPS);
        a = a * rstd * g0 + b0; b = b * rstd * g1 + b1;
        float o[8] = {a.x, a.y, a.z, a.w, b.x, b.y, b.z, b.w};
#pragma unroll
        for (int k = 0; k < 8; ++k) o[k] = o[k] * sigm(o[k]);
        u32x4 wv; wv.x = pk2(o[0], o[1]); wv.y = pk2(o[2], o[3]); wv.z = pk2(o[4], o[5]); wv.w = pk2(o[6], o[7]);
        *(u32x4*)(MIX + (size_t)(t0 + oi) * D + lane * 8) = wv;
    }
    __syncthreads();
}
__device__ __forceinline__ void pool_item(KP kp, int l, int item, LAS unsigned char* ldsb, int tid_in) {
    const int tid = launder_v(tid_in);
    const bf16* Z = (const bf16*)(kp->ws + WS_Z); bf16* MIX = (bf16*)(kp->ws + WS_MIX);
    LAS float* pp = (LAS float*)ldsb;
    LAS bf16* db = (LAS bf16*)(ldsb + 47 * 512 * 4);
    const int t0 = item * 32;
    int s, tau0, Ls; bool prompt;
    if (t0 < TP) { s = t0 >> 11; tau0 = t0 & 2047; Ls = 2048; prompt = true; } else { s = (t0 - TP) >> 6; tau0 = (t0 - TP) & 63; Ls = 64; prompt = false; }
    const int c = tid;
    const bool first = (tau0 == 0), lastit = (tau0 + 32 == Ls);
    float* op = prompt ? kp->out + O_POOL_P + (size_t)((l * 4 + s) * 15) * 512 : kp->out + O_POOL_S + (size_t)((l * 16 + s) * 15) * 512;
    const float* cp = kp->in[3] + (size_t)((l * 16 + s) * 15) * 512;
    {
        float pvl[47];
#pragma unroll
        for (int ii = 0; ii < 47; ++ii) {
            if (ii < 15 && first) pvl[ii] = prompt ? 0.f : cp[ii * 512 + c];
            else pvl[ii] = bf2f(Z[(size_t)(t0 + ii - 15) * NZ + 1024 + c]);
        }
#pragma unroll
        for (int ii = 0; ii < 47; ++ii) {
            pp[ii * 512 + c] = pvl[ii];
            if (ii >= 32 && lastit) op[(ii - 32) * 512 + c] = pvl[ii];
        }
    }
    const int gi = c >> 7, w = 2 << gi;
    for (int oi = 0; oi < 32; ++oi) {
        float sum = 0.f;
        for (int k = 0; k < w; ++k) sum += pp[(oi + 15 - k) * 512 + c];
        const int cnt = prompt ? min(w, tau0 + oi + 1) : w;
        const float d = sum / (float)cnt - pp[(oi + 15) * 512 + c];
        db[oi * 520 + c] = (bf16)f2bf(d);
    }
    __syncthreads();
    const int lane = tid & 63, wave = tid >> 6, n16 = lane & 15, q = lane >> 4, g = wave >> 1, nh = wave & 1;
    const bf16* WT = (const bf16*)(kp->ws + WS_POOLW) + (size_t)g * 128 * 128;
    bfx8 Bf[4][4];
#pragma unroll
    for (int nt = 0; nt < 4; ++nt)
#pragma unroll
        for (int ks = 0; ks < 4; ++ks) Bf[nt][ks] = *(const bfx8*)(WT + (size_t)(nh * 64 + nt * 16 + n16) * 128 + ks * 32 + q * 8);
    float scale[4];
#pragma unroll
    for (int nt = 0; nt < 4; ++nt) scale[nt] = kp->in[13][l * 512 + g * 128 + nh * 64 + nt * 16 + n16];
#pragma unroll
    for (int mt = 0; mt < 2; ++mt) {
        bfx8 Af[4];
#pragma unroll
        for (int ks = 0; ks < 4; ++ks) Af[ks] = *(const LAS bfx8*)(db + (mt * 16 + n16) * 520 + g * 128 + ks * 32 + q * 8);
        f32x4 acc[4];
#pragma unroll
        for (int nt = 0; nt < 4; ++nt) { acc[nt] = (f32x4){0.f, 0.f, 0.f, 0.f};
#pragma unroll
            for (int ks = 0; ks < 4; ++ks) acc[nt] = __builtin_amdgcn_mfma_f32_16x16x32_bf16(Af[ks], Bf[nt][ks], acc[nt], 0, 0, 0); }
#pragma unroll
        for (int nt = 0; nt < 4; ++nt)
#pragma unroll
            for (int r = 0; r < 4; ++r) MIX[(size_t)(t0 + mt * 16 + 4 * q + r) * D + 512 + g * 128 + nh * 64 + nt * 16 + n16] = (bf16)f2bf(acc[nt][r] * scale[nt]);
    }
    __syncthreads();
}
__device__ __forceinline__ float rowsum16(float v) { v += __shfl_xor(v, 1); v += __shfl_xor(v, 2); v += __shfl_xor(v, 4); v += __shfl_xor(v, 8); return v; }
__device__ __forceinline__ void prep_item(KP kp, int l, int item, LAS unsigned char* ldsb, int tid_in) {
    const int tid = launder_v(tid_in);
    const bf16* Z = (const bf16*)(kp->ws + WS_Z);
    float* SC = (float*)(kp->ws + WS_SC); float* G = (float*)(kp->ws + WS_G); float* RK = (float*)(kp->ws + WS_RK);
    const bf16* UPT = (const bf16*)(kp->ws + WS_UPS);
    LAS bf16* lo = (LAS bf16*)ldsb;
    const int t0 = item * 16;
    int s, tau0, Ls; bool prompt;
    if (t0 < TP) { s = t0 >> 11; tau0 = t0 & 2047; Ls = 2048; prompt = true; } else { s = (t0 - TP) >> 6; tau0 = (t0 - TP) & 63; Ls = 64; prompt = false; }
    const float* mu = kp->in[14] + (size_t)l * RP;
    const float* ssh = kp->in[4] + (size_t)(l * 16 + s) * RP;
    {
        float qv[6], qp[6], mq[6];
#pragma unroll
        for (int k = 0; k < 6; ++k) { const int e = tid + k * NTHR, tok = e / 192, col = e % 192, zc = 3072 + col, t = t0 + tok, tau = tau0 + tok;
            qv[k] = bf2f(Z[(size_t)t * NZ + ZQ + zc]);
            qp[k] = tau > 0 ? bf2f(Z[(size_t)(t - 1) * NZ + ZQ + zc]) : (prompt ? 0.f : ssh[zc]);
            mq[k] = mu[zc]; }
#pragma unroll
        for (int k = 0; k < 6; ++k) { const int e = tid + k * NTHR, tok = e / 192, col = e % 192;
            const float qs = qv[k] + (qp[k] - qv[k]) * mq[k];
            const float val = col < 64 ? tanhf(qs) : (col < 128 ? qs : sigm(qs));
            lo[((col >> 6) * 16 + tok) * 72 + (col & 63)] = (bf16)f2bf(val); }
    }
    __syncthreads();
    const int lane = tid & 63, wave = tid >> 6, n16 = lane & 15, q = lane >> 4;
#pragma unroll 1
    for (int hh = 0; hh < 2; ++hh) {
        const int h = wave * 2 + hh;
        f32x4 acc[3][4];
#pragma unroll
        for (int m = 0; m < 3; ++m) {
            bfx8 Af[2], Bf[4][2];
#pragma unroll
            for (int ks = 0; ks < 2; ++ks) Af[ks] = *(const LAS bfx8*)(lo + (m * 16 + n16) * 72 + ks * 32 + q * 8);
#pragma unroll
            for (int i = 0; i < 4; ++i)
#pragma unroll
                for (int ks = 0; ks < 2; ++ks) Bf[i][ks] = *(const bfx8*)(UPT + (size_t)(m * RD + h * 64 + i * 16 + n16) * 64 + ks * 32 + q * 8);
#pragma unroll
            for (int i = 0; i < 4; ++i) { acc[m][i] = (f32x4){0.f, 0.f, 0.f, 0.f};
#pragma unroll
                for (int ks = 0; ks < 2; ++ks) acc[m][i] = __builtin_amdgcn_mfma_f32_16x16x32_bf16(Af[ks], Bf[i][ks], acc[m][i], 0, 0, 0); }
        }
        float mur[4], muk[4], muv[4], w0c[4], a0c[4], kkc[4], kac[4], rkc[4], sr[4], sk[4], sv[4];
#pragma unroll
        for (int i = 0; i < 4; ++i) { const int c = h * 64 + i * 16 + n16;
            mur[i] = mu[c]; muk[i] = mu[RD + c]; muv[i] = mu[2 * RD + c];
            w0c[i] = kp->in[15][l * RD + c]; a0c[i] = kp->in[17][l * RD + c]; kkc[i] = kp->in[20][l * RD + c]; kac[i] = kp->in[21][l * RD + c]; rkc[i] = kp->in[22][l * RD + c];
            sr[i] = prompt ? 0.f : ssh[c]; sk[i] = prompt ? 0.f : ssh[RD + c]; sv[i] = prompt ? 0.f : ssh[2 * RD + c]; }
        float zc_[4][4][3], zp_[4][4][3];
#pragma unroll
        for (int r = 0; r < 4; ++r) {
            const int tok = 4 * q + r, t = t0 + tok, tau = tau0 + tok;
            const bf16* zr = Z + (size_t)t * NZ + ZQ;
#pragma unroll
            for (int i = 0; i < 4; ++i) { const int c = h * 64 + i * 16 + n16;
                zc_[r][i][0] = bf2f(zr[c]); zc_[r][i][1] = bf2f(zr[RD + c]); zc_[r][i][2] = bf2f(zr[2 * RD + c]);
                if (tau > 0) { zp_[r][i][0] = bf2f(zr[c - NZ]); zp_[r][i][1] = bf2f(zr[RD + c - NZ]); zp_[r][i][2] = bf2f(zr[2 * RD + c - NZ]); } else { zp_[r][i][0] = sr[i]; zp_[r][i][1] = sk[i]; zp_[r][i][2] = sv[i]; } }
        }
#pragma unroll
        for (int r = 0; r < 4; ++r) {
            const int tok = 4 * q + r, t = t0 + tok;
            float rv[4], kv[4], vv[4], av[4], dv[4], kk[4];
            float skk = 0.f;
#pragma unroll
            for (int i = 0; i < 4; ++i) { const int c = h * 64 + i * 16 + n16;
                float rr = zc_[r][i][0], k = zc_[r][i][1], v = zc_[r][i][2];
                rr += (zp_[r][i][0] - rr) * mur[i]; k += (zp_[r][i][1] - k) * muk[i]; v += (zp_[r][i][2] - v) * muv[i];
                const float xw = -(w0c[i] + acc[0][i][r]);
                const float sp = fmaxf(xw, 0.f) + log1pf(expf(-fabsf(xw)));
                dv[i] = expf(-expf(-sp - 0.5f));
                av[i] = sigm(a0c[i] + acc[1][i][r]);
                rv[i] = rr; kv[i] = k; vv[i] = v; kk[i] = k * kkc[i]; skk += kk[i] * kk[i];
                G[(size_t)t * RD + c] = acc[2][i][r];
                }
            skk = rowsum16(skk);
            const float rinv = 1.0f / sqrtf(fmaxf(skk, 1e-24f));
            float srk = 0.f;
#pragma unroll
            for (int i = 0; i < 4; ++i) {
                const float kkn = kk[i] * rinv, kpv = kv[i] * (1.0f + (av[i] - 1.0f) * kac[i]), bb = kkn * av[i];
                srk += rv[i] * kpv * rkc[i];
                float* sc = SC + sc_off(t, h) + i * 16 + n16;
                sc[0] = dv[i]; sc[64] = kkn; sc[128] = bb; sc[192] = kpv; sc[256] = rv[i]; sc[320] = vv[i];
            }
            srk = rowsum16(srk);
            if (n16 == 0) RK[t * NH + h] = srk;
        }
    }
    if (tau0 + 16 == Ls) {
        float* osh = prompt ? kp->out + O_SHIFT_P + (size_t)(l * 4 + s) * RP : kp->out + O_SHIFT_S + (size_t)(l * 16 + s) * RP;
        const bf16* zr = Z + (size_t)(t0 + 15) * NZ + ZQ;
        for (int e = tid; e < RP; e += NTHR) osh[e] = bf2f(zr[e]);
    }
    __syncthreads();
}

__device__ __forceinline__ void sc_issue(f32x4 (&r)[4], const LAS f32x4* o, int c) {
    if (c < 4) {
#pragma unroll
        for (int i = 0; i < 4; ++i) r[i] = o[16 + 4 * c + i];
    } else { const int j = c - 4; r[0] = o[j]; r[1] = o[32 + j]; r[2] = o[48 + j]; r[3] = o[64 + j]; }
}
template <int MODE>
__device__ __forceinline__ void scan_run(const float* SC, int tg0, int nsteps, int h, LAS float* wl  , int lane,
                                         const float* Sinit, float* Y, float* GB, float* Sout, float* PQout) {
    constexpr int GS = 4, NCH = 20;
    f32x2 S[32];
    f32x2 P[(MODE == 3) ? 32 : 1];
    if (MODE == 3) {
        const int ln = launder_v(lane);
#pragma unroll
        for (int j = 0; j < 32; ++j) { S[j] = (f32x2){0.f, 0.f}; P[j] = (f32x2){(2 * j == ln) ? 1.f : 0.f, (2 * j + 1 == ln) ? 1.f : 0.f}; }
    } else {
#pragma unroll
        for (int j = 0; j < 16; ++j) { const f32x4 v = ((const f32x4*)(Sinit + lane * 64))[j]; S[2 * j] = (f32x2){v.x, v.y}; S[2 * j + 1] = (f32x2){v.z, v.w}; }
    }
#define SC_STAGE(g, buf) do { const float* rec_ = SC + sc_off(tg0 + (g) * GS, h) + lane * 4; \
        _Pragma("unroll") for (int k_ = 0; k_ < 6; ++k_) __builtin_amdgcn_global_load_lds((const unsigned*)(rec_ + k_ * 256), (LAS unsigned*)(wl + (buf) * GS * SCR + k_ * 256), 16, 0, 0); } while (0)
    SC_STAGE(0, 0);
    const int ngroups = nsteps / GS;
    for (int g = 0; g < ngroups; ++g) {
        asm volatile("s_waitcnt vmcnt(0)" ::: "memory");
        if (g + 1 < ngroups) SC_STAGE(g + 1, (g + 1) & 1);
        const LAS float* wb = wl + (g & 1) * GS * SCR;
        f32x4 R[4][4];
#pragma unroll
        for (int q = 0; q < 3; ++q) sc_issue(R[q & 3], (const LAS f32x4*)(wb + (q / NCH) * SCR), q % NCH);
        __builtin_amdgcn_sched_barrier(0);
#pragma unroll
        for (int s = 0; s < GS; ++s) {
            f32x2 d2a = (f32x2){0.f, 0.f}, y2a = (f32x2){0.f, 0.f};
            f32x2 e2a = (f32x2){0.f, 0.f}, g2a = (f32x2){0.f, 0.f};
            f32x2 sa2 = (f32x2){0.f, 0.f}, sp2 = (f32x2){0.f, 0.f};
            const float vs = wb[s * SCR + 320 + lane];
            const f32x2 v2 = (f32x2){vs, vs};
#pragma unroll
            for (int c = 0; c < NCH; ++c) {
                const int q = s * NCH + c, qn = q + 3;
                if (qn < GS * NCH) sc_issue(R[qn & 3], (const LAS f32x4*)(wb + (qn / NCH) * SCR), qn % NCH);
                __builtin_amdgcn_sched_barrier(0);
                f32x4 (&r)[4] = R[q & 3];
                if (c < 4) {
#pragma unroll
                    for (int i = 0; i < 4; ++i) { const int j = 4 * c + i; d2a += S[2 * j] * (f32x2){r[i].x, r[i].y}; d2a += S[2 * j + 1] * (f32x2){r[i].z, r[i].w};
                        if (MODE == 3) { e2a += P[2 * j] * (f32x2){r[i].x, r[i].y}; e2a += P[2 * j + 1] * (f32x2){r[i].z, r[i].w}; } }
                    if (c == 3) { const f32x2 d2 = d2a; const float sa = -(d2.x + d2.y); sa2 = (f32x2){sa, sa};
                        if (MODE == 3) { const f32x2 e2 = e2a; const float sp = -(e2.x + e2.y); sp2 = (f32x2){sp, sp}; } }
                } else {
                    const int j = c - 4;
                    f32x2 t0 = v2 * (f32x2){r[2].x, r[2].y}; t0 = sa2 * (f32x2){r[1].x, r[1].y} + t0; S[2 * j] = S[2 * j] * (f32x2){r[0].x, r[0].y} + t0;
                    f32x2 t1 = v2 * (f32x2){r[2].z, r[2].w}; t1 = sa2 * (f32x2){r[1].z, r[1].w} + t1; S[2 * j + 1] = S[2 * j + 1] * (f32x2){r[0].z, r[0].w} + t1;
                    y2a += S[2 * j] * (f32x2){r[3].x, r[3].y}; y2a += S[2 * j + 1] * (f32x2){r[3].z, r[3].w};
                    if (MODE == 3) {
                        const f32x2 u0 = sp2 * (f32x2){r[1].x, r[1].y}, u1 = sp2 * (f32x2){r[1].z, r[1].w};
                        P[2 * j] = P[2 * j] * (f32x2){r[0].x, r[0].y} + u0; P[2 * j + 1] = P[2 * j + 1] * (f32x2){r[0].z, r[0].w} + u1;
                        g2a += P[2 * j] * (f32x2){r[3].x, r[3].y}; g2a += P[2 * j + 1] * (f32x2){r[3].z, r[3].w};
                    }
                }
                __builtin_amdgcn_sched_barrier(0);
            }
            { const f32x2 y2 = y2a; Y[(size_t)(tg0 + g * GS + s) * RD + h * 64 + lane] = y2.x + y2.y; }
            if (MODE == 3) { const f32x2 g2 = g2a; GB[(size_t)(tg0 + g * GS + s) * RD + h * 64 + lane] = g2.x + g2.y; }
        }
        asm volatile("s_waitcnt lgkmcnt(0)" ::: "memory");
    }
#undef SC_STAGE
    if (MODE == 3) {
#pragma unroll
        for (int j = 0; j < 16; ++j) { ((f32x4*)PQout)[j * 64 + lane] = (f32x4){P[2 * j].x, P[2 * j].y, P[2 * j + 1].x, P[2 * j + 1].y};
                                       ((f32x4*)(PQout + 4096))[j * 64 + lane] = (f32x4){S[2 * j].x, S[2 * j].y, S[2 * j + 1].x, S[2 * j + 1].y}; }
    } else {
#pragma unroll
        for (int j = 0; j < 16; ++j) ((f32x4*)(Sout + lane * 64))[j] = (f32x4){S[2 * j].x, S[2 * j].y, S[2 * j + 1].x, S[2 * j + 1].y};
    }
}
template <int NMT>
__device__ __forceinline__ void ypost_task(KP kp, int l, const float* S0q  , int tg0, int h, int lane) {
    const float* GB = (const float*)(kp->ws + WS_GB); const float* Y = (const float*)(kp->ws + WS_Y); const float* SC = (const float*)(kp->ws + WS_SC);
    const float* G = (const float*)(kp->ws + WS_G); const float* RK = (const float*)(kp->ws + WS_RK); bf16* MIX = (bf16*)(kp->ws + WS_MIX);
    const int n = lane & 15, kq = lane >> 4;
    float Bv[4][16];
    if (S0q) {
#pragma unroll
        for (int nt = 0; nt < 4; ++nt)
#pragma unroll
            for (int ks = 0; ks < 16; ++ks) Bv[nt][ks] = S0q[(size_t)(ks * 64 + nt * 16 + n) * 4 + kq];
    }
    float gng[4], gnb[4];
#pragma unroll
    for (int nt = 0; nt < 4; ++nt) { gng[nt] = kp->in[23][l * RD + h * 64 + nt * 16 + n]; gnb[nt] = kp->in[24][l * RD + h * 64 + nt * 16 + n]; }
#pragma unroll 1
    for (int mt = 0; mt < NMT; ++mt) {
        const int tb = tg0 + mt * 16;
        float Av[16];
        if (S0q) { const float* grow = GB + (size_t)(tb + n) * RD + h * 64 + kq;
#pragma unroll
            for (int ks = 0; ks < 16; ++ks) Av[ks] = grow[ks * 4]; }
        f32x4 acc[4]; float vv[4][4], gg[4][4], rk[4];
#pragma unroll
        for (int r = 0; r < 4; ++r) { const int t = tb + 4 * kq + r; rk[r] = RK[t * NH + h];
#pragma unroll
            for (int nt = 0; nt < 4; ++nt) { acc[nt][r] = Y[(size_t)t * RD + h * 64 + nt * 16 + n]; vv[nt][r] = SC[sc_off(t, h) + 320 + nt * 16 + n]; gg[nt][r] = G[(size_t)t * RD + h * 64 + nt * 16 + n]; } }
        if (S0q) {
#pragma unroll
            for (int ks = 0; ks < 16; ++ks)
#pragma unroll
                for (int nt = 0; nt < 4; ++nt) acc[nt] = __builtin_amdgcn_mfma_f32_16x16x4f32(Av[ks], Bv[nt][ks], acc[nt], 0, 0, 0);
        }
#pragma unroll
        for (int r = 0; r < 4; ++r) {
            const int t = tb + 4 * kq + r;
            const float mean = rowsum16((acc[0][r] + acc[1][r]) + (acc[2][r] + acc[3][r])) * (1.0f / 64.0f);
            float d[4], qq = 0.f;
#pragma unroll
            for (int nt = 0; nt < 4; ++nt) { d[nt] = acc[nt][r] - mean; qq += d[nt] * d[nt]; }
            const float rstd = 1.0f / sqrtf(rowsum16(qq) * (1.0f / 64.0f) + GN_EPS);
#pragma unroll
            for (int nt = 0; nt < 4; ++nt) { const float o = ((d[nt] * rstd * gng[nt] + gnb[nt]) + rk[r] * vv[nt][r]) * gg[nt][r];
                MIX[(size_t)t * D + 1024 + h * 64 + nt * 16 + n] = (bf16)f2bf(o); }
        }
    }
}
__device__ __forceinline__ void combine_chain(const float* PQ, float* S0, float* Sfin, LAS unsigned char* lds, int tid, int wave, int lane) {
    LAS f32x4* pl = (LAS f32x4*)lds;
    LAS f32x4* xch = (LAS f32x4*)(lds + 16384);
    f32x2 S[32];
#pragma unroll
    for (int j = 0; j < 32; ++j) S[j] = (f32x2){0.f, 0.f};
    const int n4a = 2 * wave, n4b = 2 * wave + 1;
    const f32x4* Pc = (const f32x4*)PQ;
    f32x4 p0 = Pc[tid], p1 = Pc[tid + 512];
    for (int c = 0; c < NC; ++c) {
        const f32x4* Qc = (const f32x4*)(PQ + (size_t)(c * 2 + 1) * 4096);
        pl[tid] = p0; pl[tid + 512] = p1;
        f32x4 na = Qc[n4a * 64 + lane], nb = Qc[n4b * 64 + lane];
        if (c + 1 < NC) { const f32x4* Pn = (const f32x4*)(PQ + (size_t)((c + 1) * 2) * 4096); p0 = Pn[tid]; p1 = Pn[tid + 512]; }
        __syncthreads();
        f32x2 a0 = (f32x2){na.x, na.y}, a1 = (f32x2){na.z, na.w}, b0 = (f32x2){nb.x, nb.y}, b1 = (f32x2){nb.z, nb.w};
#pragma unroll
        for (int j = 0; j < 32; ++j) {
            const f32x4 pa0 = pl[n4a * 64 + 2 * j], pb0 = pl[n4b * 64 + 2 * j], pa1 = pl[n4a * 64 + 2 * j + 1], pb1 = pl[n4b * 64 + 2 * j + 1];
            const f32x2 s0 = (f32x2){S[j].x, S[j].x}, s1 = (f32x2){S[j].y, S[j].y};
            a0 += s0 * (f32x2){pa0.x, pa0.y}; a1 += s0 * (f32x2){pa0.z, pa0.w}; b0 += s0 * (f32x2){pb0.x, pb0.y}; b1 += s0 * (f32x2){pb0.z, pb0.w};
            a0 += s1 * (f32x2){pa1.x, pa1.y}; a1 += s1 * (f32x2){pa1.z, pa1.w}; b0 += s1 * (f32x2){pb1.x, pb1.y}; b1 += s1 * (f32x2){pb1.z, pb1.w};
            if ((j & 1) == 1) __builtin_amdgcn_sched_barrier(0);
        }
        na = (f32x4){a0.x, a0.y, a1.x, a1.y}; nb = (f32x4){b0.x, b0.y, b1.x, b1.y};
        if (c + 1 < NC) {
            xch[n4a * 64 + lane] = na; xch[n4b * 64 + lane] = nb;
            f32x4* So = (f32x4*)(S0 + (size_t)(c + 1) * 4096);
            So[n4a * 64 + lane] = na; So[n4b * 64 + lane] = nb;
            __syncthreads();
#pragma unroll
            for (int j = 0; j < 16; ++j) { const f32x4 v = xch[j * 64 + lane]; S[2 * j] = (f32x2){v.x, v.y}; S[2 * j + 1] = (f32x2){v.z, v.w}; }
        } else {
            *(f32x4*)(Sfin + lane * 64 + 8 * wave) = na; *(f32x4*)(Sfin + lane * 64 + 8 * wave + 4) = nb;
        }
        __syncthreads();
    }
}
__global__ void __launch_bounds__(NTHR, 2) fwd_mega(Params p) {
    extern __shared__ __attribute__((aligned(16))) unsigned char lds_raw[];
    LAS unsigned char* lds = (LAS unsigned char*)lds_raw;
    const int wave0 = __builtin_amdgcn_readfirstlane((int)threadIdx.x >> 6);
    volatile LAS unsigned* MISC = (volatile LAS unsigned*)(lds + 131072);
    if (threadIdx.x < 16) MISC[threadIdx.x] = 0u;
    __syncthreads();
    const XcdBarrier xbar = xcd_barrier_post((unsigned*)p.ws + 4096, MISC, (int)threadIdx.x);
    cg::this_grid().sync();

#pragma unroll 1
    for (int l = 0; l < DEPTH; ++l) {
        for (int rep = 0; rep < REP_CVT; ++rep) { PH_BEGIN();
#ifndef NO_CVT
          _Pragma("unroll 1") for (int rc = 0; rc < REP_CVTW; ++rc) convert_weights(kp, l, lds, gw, ngw, wave, lane);
#endif
#ifndef NO_NORM
          float* X = (float*)(ws + WS_X); bf16* XN = (bf16*)(ws + WS_XN);
          if (l == 0) norm_rows(kp->in[0], kp->in[1], kp->in[6], X, XN, nullptr, nullptr, gw, ngw, lane);
          else norm_rows(X, X + (size_t)TP * D, kp->in[6] + l * D, nullptr, XN, nullptr, (const float*)(ws + WS_PART), gw, ngw, lane);
#endif
        }
        GSYNC();
#ifndef NO_GEMM1
        _Pragma("unroll 1") for (int rg = 0; rg < REP_G1; ++rg) { PH_BEGIN(); pg8::Gemm g{(const bf16*)(ws + WS_XN), (const bf16*)(ws + WS_WIN), T, NZ, D}; pg8::StaticOrder S; S.init(T, NZ, D, nb, bid); pg8::EpiStoreBf16 E{(bf16*)(ws + WS_Z), NZ};
          pg8::gemm_phase<pg8::EpiStoreBf16, pg8::StaticOrder, true, true>(lds, g, S, E, tid); }
#endif
        GSYNC();
        for (int rep = 0; rep < REP_MIXA; ++rep) { PH_BEGIN();
          if (rep) __syncthreads();
          for (int it = bid; it < 1152; it += nb) {
#ifndef NO_PREP
            if (it < 576) _Pragma("unroll 1") for (int r_ = 0; r_ < REP_PREP; ++r_) prep_item(kp, l, it, lds, tid);
#endif
#ifndef NO_POOL
            if (it >= 576 && it < 864) _Pragma("unroll 1") for (int r_ = 0; r_ < REP_POOL; ++r_) pool_item(kp, l, it - 576, lds, tid);
#endif
#ifndef NO_CONV
            if (it >= 864) _Pragma("unroll 1") for (int r_ = 0; r_ < REP_CONV; ++r_) conv_item(kp, l, it - 864, (LAS float*)lds, tid);
#endif
          }
        }
        GSYNC();
#ifndef NO_SCAN
        for (int rep = 0; rep < REP_SCAN; ++rep) {
        if (rep) GSYNC();
        for (int rp = 0; rp < REP_P1; ++rp) { PH_BEGIN();
            const float* SC = (const float*)(ws + WS_SC); float* Y = (float*)(ws + WS_Y); float* PQ = (float*)(ws + WS_PQ); float* GB = (float*)(ws + WS_GB);
            LAS float* wl = (LAS float*)(lds + wave * 12288);
            for (int task = wave * nb + bid; task < 64 * NC + 256; task += NWAVES * nb) {
                if (task < 64 * NC) {
                    const int ch = task / NC, c = task % NC, s = ch >> 4, h = ch & 15;
                    scan_run<3>(SC, s * 2048 + c * CL, CL, h, wl, lane, nullptr, Y, GB, nullptr, PQ + (size_t)((ch * NC + c) * 2) * 4096);
                } else {
                    const int ch = task - 64 * NC, b = ch >> 4, h = ch & 15;
                    scan_run<1>(SC, TP + b * 64, 64, h, wl, lane, kp->in[5] + (size_t)((l * 16 + b) * NH + h) * 4096, Y, nullptr, kp->out + O_WKV_S + (size_t)((l * 16 + b) * NH + h) * 4096, nullptr);
                }
            }
        }
        GSYNC();
        for (int rp = 0; rp < REP_CB; ++rp) { PH_BEGIN();
            for (int ch = bid; ch < 64; ch += nb) { const int s = ch >> 4, h = ch & 15;
                combine_chain((const float*)(ws + WS_PQ) + (size_t)ch * NC * 2 * 4096, (float*)(ws + WS_S0) + (size_t)ch * NC * 4096, kp->out + O_WKV_P + (size_t)((l * 4 + s) * NH + h) * 4096, lds, tid, wave, lane); }
        }
        GSYNC();
        _Pragma("unroll 1") for (int ry = 0; ry < REP_YP; ++ry) { PH_BEGIN();
            const float* S0 = (const float*)(ws + WS_S0);
            constexpr int UPC = CL / 64, NPU = 64 * NC * UPC;
            for (int u = wave * nb + bid; u < NPU + 256; u += NWAVES * nb) {
                if (u < NPU) { const int task = u / UPC, hf = u % UPC, ch = task / NC, c = task % NC, s = ch >> 4, h = ch & 15;
                    ypost_task<4>(kp, l, c == 0 ? nullptr : S0 + (size_t)(ch * NC + c) * 4096, s * 2048 + c * CL + hf * 64, h, lane); }
                else { const int ch = u - NPU, b = ch >> 4, h = ch & 15; ypost_task<4>(kp, l, nullptr, TP + b * 64, h, lane); }
            }
        }
        }
#endif
        GSYNC();
#ifndef NO_GEMM2
        { PH_BEGIN(); pg8::Gemm g{(const bf16*)(ws + WS_MIX), (const bf16*)(ws + WS_WOUT), T, D, D}; pg8::TailOrder S; S.init(D, D, nb, bid); pg8::EpiResAdd E{(float*)(ws + WS_X), D, (float*)(ws + WS_PART)};
          pg8::gemm_phase<pg8::EpiResAdd, pg8::TailOrder, true, true>(lds, g, S, E, tid); }
#endif
        GSYNC();
#ifndef NO_NORM
        _Pragma("unroll 1") for (int rn = 0; rn < REP_N2; ++rn) { PH_BEGIN(); float* X = (float*)(ws + WS_X); norm_rows(X, X + (size_t)TP * D, kp->in[26] + l * D, nullptr, (bf16*)(ws + WS_XN), nullptr, rn == 0 ? (const float*)(ws + WS_PART) : nullptr, gw, ngw, lane); }
#endif
        GSYNC();
#ifndef NO_GEMM3
        _Pragma("unroll 1") for (int rg = 0; rg < REP_G3; ++rg) { PH_BEGIN(); pg8::Gemm g{(const bf16*)(ws + WS_XN), (const bf16*)(ws + WS_WGU), T, NGU, D}; pg8::StaticOrder S; S.init(T, NGU, D, nb, bid); pg8::EpiSwiGLU E{(bf16*)(ws + WS_ACT), FF};
          pg8::gemm_phase<pg8::EpiSwiGLU, pg8::StaticOrder, true, true>(lds, g, S, E, tid); }
#endif
        GSYNC();
#ifndef NO_GEMM4
        _Pragma("unroll 1") for (int rt = 0; rt < REP_T4; ++rt) { PH_BEGIN(); pg8::Gemm g{(const bf16*)(ws + WS_ACT), (const bf16*)(ws + WS_WDN), T, D, FF}; pg8::TailOrder S; S.init(D, FF, nb, bid, rt); pg8::EpiResAdd E{(float*)(ws + WS_X), D, (float*)(ws + WS_PART)};
          pg8::gemm_phase<pg8::EpiResAdd, pg8::TailOrder, true, true>(lds, g, S, E, tid); }
#endif
        GSYNC();
    }
#ifndef NO_NORM
    { PH_BEGIN(); float* X = (float*)(ws + WS_X); norm_rows(X, X + (size_t)TP * D, kp->in[30], nullptr, nullptr, kp->out + O_Y, (const float*)(ws + WS_PART), gw, ngw, lane); }
#endif
}

extern "C" void kernel_launch(void* const* d_in, const int* in_sizes, int n_in, void* d_out, int out_size, void* d_ws, size_t ws_size, hipStream_t stream) {
    static int grid = 0;
    if (grid == 0) {
        if (n_in != 31 || (size_t)out_size != O_END || ws_size < WS_END) { fprintf(stderr, "kernel_launch: unexpected shapes: n_in %d out %d ws %zu (need %zu)\n", n_in, out_size, ws_size, (size_t)WS_END); grid = -1; return; }
        int dev = 0, cus = 0, per_cu = 0;
        hipGetDevice(&dev);
        hipDeviceGetAttribute(&cus, hipDeviceAttributeMultiprocessorCount, dev);
        if (hipFuncSetAttribute((const void*)fwd_mega, hipFuncAttributeMaxDynamicSharedMemorySize, LDS_BYTES) != hipSuccess) { fprintf(stderr, "kernel_launch: hipFuncSetAttribute failed\n"); grid = -1; return; }
        hipOccupancyMaxActiveBlocksPerMultiprocessor(&per_cu, (const void*)fwd_mega, NTHR, LDS_BYTES);
        (void)hipGetLastError();
        if (per_cu < 1) { fprintf(stderr, "kernel_launch: occupancy query says %d blocks per CU\n", per_cu); per_cu = 1; }
        grid = cus * 1;
    }
    if (grid < 0) return;
    Params p{};
    for (int i = 0; i < 31; ++i) p.in[i] = (const float*)d_in[i];
    p.out = (float*)d_out; p.ws = (unsigned char*)d_ws;
    if (hipMemsetAsync(d_ws, 0, 65536, stream) != hipSuccess) { fprintf(stderr, "kernel_launch: memset failed\n"); return; }
    void* args[] = {&p};
    hipError_t e = hipLaunchCooperativeKernel((const void*)fwd_mega, dim3(grid), dim3(NTHR), args, LDS_BYTES, stream);
    if (e != hipSuccess) fprintf(stderr, "cooperative launch failed: %s (grid %d)\n", hipGetErrorString(e), grid);
}
```

```cpp
#include <hip/hip_runtime.h>
#include <hip/hip_cooperative_groups.h>
#include <cstdio>
#include <cstdint>
namespace cg = cooperative_groups;

namespace pg8 {
#define PG8_LAS __attribute__((address_space(3)))
typedef unsigned short bf16_t;
typedef short bf16x8 __attribute__((ext_vector_type(8)));
typedef float f32x4 __attribute__((ext_vector_type(4)));
typedef unsigned u32x4 __attribute__((ext_vector_type(4)));
constexpr int BM = 256, BK = 64, HALF = 128, HTB = HALF * BK * 2  , STAGE_BYTES = 8 * HTB, NXCD = 8, WGM = 8;

__host__ __device__ __forceinline__ int lds_byte(int r, int c) { const int st = (r >> 4) * 2 + (c >> 5), rr = r & 15, cc = c & 31, ob = rr * 64 + cc * 2; return st * 1024 + (ob ^ (((ob >> 9) & 1) << 5)); }
__host__ __device__ __forceinline__ void stage_rc(int b, int& R, int& C) { const int st = b / 1024, sb = b % 1024, swz = sb ^ (((sb >> 9) & 1) << 5); R = (st >> 1) * 16 + swz / 64; C = (st & 1) * 32 + (swz % 64) / 2; }
__host__ __device__ __forceinline__ int perm32(int rho) { const int n = rho >> 4, i = rho & 15; return 8 * (i >> 2) + 4 * n + (i & 3); }

struct Unit { int pm, pn, k0, nt, part; };
struct Gemm { const bf16_t* A; const bf16_t* Bt; int M, N, K; };

struct StaticOrder {
    int nM, nN, nwg, G, c, ntfull;
    __host__ __device__ void init(int M, int N, int K, int G_, int c_) { nM = M / BM; nN = N / BM; nwg = nM * nN; G = G_; c = c_; ntfull = K / BK; }
    __host__ __device__ __forceinline__ bool next(int i, Unit& u) const {
        const long L = (long)i * G + c; if (L >= nwg) return false;
        int wgid = (int)L; { const int q = nwg / NXCD, r = nwg % NXCD, xcd = wgid % NXCD, off = wgid / NXCD; wgid = (xcd < r ? xcd * (q + 1) : r * (q + 1) + (xcd - r) * q) + off; }
        const int nig = WGM * nN, gid = wgid / nig, fm = gid * WGM, gsz = (nM - fm) < WGM ? (nM - fm) : WGM;
        u.pm = fm + ((wgid % nig) % gsz); u.pn = (wgid % nig) / gsz; u.k0 = 0; u.nt = ntfull; u.part = -1; return true;
    }
    __device__ __forceinline__ void a_ready(const Unit&) const {}
    __device__ __forceinline__ void done(const Unit&) const {}
};


struct TailOrder {
    int nN, G, c, ntfull, skip;
    __host__ __device__ void init(int N, int K, int G_, int c_, int skip_ = 0) { nN = N / BM; G = G_; c = c_; ntfull = K / BK; skip = skip_; }
    __host__ __device__ __forceinline__ bool next(int i, Unit& u) const {
        const int nfull = 32 * nN, L = i * G + c + skip * nfull;
        if (L >= nfull + 4 * nN * 8) return false;
        const bool full = L < nfull;
        int wgid = full ? L : 0; { const int q = nfull / NXCD, r = nfull % NXCD, xcd = wgid % NXCD, off = wgid / NXCD; wgid = (xcd < r ? xcd * (q + 1) : r * (q + 1) + (xcd - r) * q) + off; }
        const int nig = WGM * nN, gid = wgid / nig, fm = gid * WGM;
        const int fpm = fm + ((wgid % nig) % WGM), fpn = (wgid % nig) / WGM;
        const int ut = full ? 0 : L - nfull, tile = ut >> 3, ks = ut & 7, base = (ntfull / 8) & ~1, extra = (ntfull - 8 * base) / 2;
        const int tpm = 32 + tile / nN, tpn = tile % nN, tnt = base + (ks < extra ? 2 : 0), tk0 = ks * base + 2 * (ks < extra ? ks : extra);
        Unit r_; r_.pm = full ? fpm : tpm; r_.pn = full ? fpn : tpn; r_.k0 = full ? 0 : tk0; r_.nt = full ? ntfull : tnt; r_.part = full ? -1 : ks;
        u = r_; return true;
    }
    __device__ __forceinline__ void a_ready(const Unit&) const {}
    __device__ __forceinline__ void done(const Unit&) const {}
};

__device__ __forceinline__ unsigned cvt_pk_bf16(float lo, float hi) { unsigned r; asm volatile("v_cvt_pk_bf16_f32 %0, %1, %2" : "=v"(r) : "v"(lo), "v"(hi)); return r; }

struct EpiStoreBf16 {
    static constexpr bool PERM = true, AFTER_DRAIN = false;
    bf16_t* O; int ldc;
    __device__ __forceinline__ void operator()(const f32x4 (&acc)[2][2][4][2], const Unit& u, int wr, int wc, int fr, int fq) const {
        const int row0 = u.pm * BM + wr * 64 + fr, col0 = u.pn * BM + wc * 32 + 8 * fq;
#pragma unroll
        for (int ai = 0; ai < 2; ++ai)
#pragma unroll
            for (int m = 0; m < 4; ++m) { bf16_t* rowp = O + (size_t)(row0 + ai * HALF + m * 16) * ldc + col0;
#pragma unroll
                for (int bj = 0; bj < 2; ++bj) { const f32x4 v0 = acc[ai][bj][m][0], v1 = acc[ai][bj][m][1];
                    u32x4 w; w.x = cvt_pk_bf16(v0[0], v0[1]); w.y = cvt_pk_bf16(v0[2], v0[3]); w.z = cvt_pk_bf16(v1[0], v1[1]); w.w = cvt_pk_bf16(v1[2], v1[3]);
                    *(u32x4*)(rowp + bj * HALF) = w; } }
    }
};
struct EpiResAdd {
    static constexpr bool PERM = true, AFTER_DRAIN = false;
    float* O; int ldc; float* P;
    __device__ __forceinline__ void operator()(const f32x4 (&acc)[2][2][4][2], const Unit& u, int wr, int wc, int fr, int fq) const {
        const int row0 = u.pm * BM + wr * 64 + fr, col0 = u.pn * BM + wc * 32 + 8 * fq;
        if (u.part < 0) {
#pragma unroll
            for (int ai = 0; ai < 2; ++ai)
#pragma unroll
                for (int m = 0; m < 4; ++m) { float* rowp = O + (size_t)(row0 + ai * HALF + m * 16) * ldc + col0;
#pragma unroll
                    for (int bj = 0; bj < 2; ++bj) {
                        f32x4 a = *(const f32x4*)(rowp + bj * HALF), b = *(const f32x4*)(rowp + bj * HALF + 4);
                        *(f32x4*)(rowp + bj * HALF) = a + acc[ai][bj][m][0]; *(f32x4*)(rowp + bj * HALF + 4) = b + acc[ai][bj][m][1]; } }
        } else {
            float* base = P + (size_t)u.part * 1024 * ldc;
#pragma unroll
            for (int ai = 0; ai < 2; ++ai)
#pragma unroll
                for (int m = 0; m < 4; ++m) { float* rowp = base + (size_t)(row0 - 8192 + ai * HALF + m * 16) * ldc + col0;
#pragma unroll
                    for (int bj = 0; bj < 2; ++bj) { *(f32x4*)(rowp + bj * HALF) = acc[ai][bj][m][0]; *(f32x4*)(rowp + bj * HALF + 4) = acc[ai][bj][m][1]; } }
        }
    }
};
struct EpiSwiGLU {
    static constexpr bool PERM = true, AFTER_DRAIN = false;
    bf16_t* O; int ldc;
    __device__ __forceinline__ void operator()(const f32x4 (&acc)[2][2][4][2], const Unit& u, int wr, int wc, int fr, int fq) const {
        const int row0 = u.pm * BM + wr * 64 + fr, col0 = u.pn * HALF + wc * 32 + 8 * fq;
#pragma unroll
        for (int ai = 0; ai < 2; ++ai)
#pragma unroll
            for (int m = 0; m < 4; ++m) { bf16_t* rowp = O + (size_t)(row0 + ai * HALF + m * 16) * ldc + col0;
                float o[8];
#pragma unroll
                for (int n = 0; n < 2; ++n)
#pragma unroll
                    for (int j = 0; j < 4; ++j) { const float g = acc[ai][0][m][n][j], up = acc[ai][1][m][n][j]; o[n * 4 + j] = g * up * __builtin_amdgcn_rcpf(1.0f + __expf(-g)); }
                u32x4 w; w.x = cvt_pk_bf16(o[0], o[1]); w.y = cvt_pk_bf16(o[2], o[3]); w.z = cvt_pk_bf16(o[4], o[5]); w.w = cvt_pk_bf16(o[6], o[7]);
                *(u32x4*)rowp = w; }
    }
};

template <class Epi, class Sched, bool ALIGN_EPI = false, bool SP2 = false>
__device__ __forceinline__ void gemm_phase(PG8_LAS unsigned char* lds, const Gemm g, const Sched& S, const Epi& E, const int tid) {
    const int wid = __builtin_amdgcn_readfirstlane(tid >> 6), lane = tid & 63, wr = wid >> 2, wc = wid & 3, fr = lane & 15, fq = lane >> 4;
    const int K = g.K;
    unsigned voffA[2], voffB[2];
#pragma unroll
    for (int i = 0; i < 2; ++i) { int R, C; stage_rc(tid * 16 + i * 8192, R, C); const int Rb = Epi::PERM ? ((R & ~31) + perm32(R & 31)) : R;
        voffA[i] = (unsigned)(R * K + C) * 2u; voffB[i] = (unsigned)(Rb * K + C) * 2u; }
    const size_t kstep = (size_t)(BK * 2);
    const size_t hstep = (size_t)HALF * K * 2;
    const size_t tstep = 2 * hstep;
    const unsigned ldsw = (unsigned)wid * 1024u;
    const int aoff = lds_byte(wr * 64 + fr, fq * 8), boff = lds_byte(wc * 32 + fr, fq * 8);
#define PG8_SA(b, h) (((b) * 2 + (h)) * HTB)
#define PG8_SB(b, h) ((4 + (b) * 2 + (h)) * HTB)
#define PG8_STAGE(bufoff, gbase, voff) do { _Pragma("unroll") for (int _i = 0; _i < 2; ++_i) \
        __builtin_amdgcn_global_load_lds((const unsigned*)((const char*)(gbase) + (voff)[_i]), (PG8_LAS unsigned*)(lds + (bufoff) + ldsw + _i * 8192), 16, 0, 0); } while (0)
#define PG8_LDA(dst, b, h) do { _Pragma("unroll") for (int m = 0; m < 4; ++m) _Pragma("unroll") for (int k = 0; k < 2; ++k) dst[m][k] = *(const PG8_LAS bf16x8*)(lds + PG8_SA(b, h) + aoff + m * 2048 + k * 1024); } while (0)
#define PG8_LDB(dst, b, h) do { _Pragma("unroll") for (int n = 0; n < 2; ++n) _Pragma("unroll") for (int k = 0; k < 2; ++k) dst[n][k] = *(const PG8_LAS bf16x8*)(lds + PG8_SB(b, h) + boff + n * 2048 + k * 1024); } while (0)
#define PG8_MMA(ai, bj, At, Bt) do { __builtin_amdgcn_s_setprio(1); _Pragma("unroll") for (int m = 0; m < 4; ++m) _Pragma("unroll") for (int n = 0; n < 2; ++n) _Pragma("unroll") for (int k = 0; k < 2; ++k) \
        acc[ai][bj][m][n] = __builtin_amdgcn_mfma_f32_16x16x32_bf16(Bt[n][k], At[m][k], acc[ai][bj][m][n], 0, 0, 0); __builtin_amdgcn_s_setprio(0); } while (0)
#define PG8_WAIT_V(n) asm volatile("s_waitcnt vmcnt(" #n ")" ::: "memory")
#define PG8_WAIT_L(n) asm volatile("s_waitcnt lgkmcnt(" #n ")" ::: "memory")
#define PG8_BAR __builtin_amdgcn_s_barrier()
#define PG8_SCHED __builtin_amdgcn_sched_barrier(0)
    Unit cur, nxt; int ui = 0;
    if (!S.next(0, cur)) return;
    f32x4 acc[2][2][4][2];
#pragma unroll
    for (int a = 0; a < 2; ++a)
#pragma unroll
        for (int b = 0; b < 2; ++b)
#pragma unroll
            for (int m = 0; m < 4; ++m)
#pragma unroll
                for (int n = 0; n < 2; ++n) acc[a][b][m][n] = (f32x4){0.f, 0.f, 0.f, 0.f};
    bf16x8 At[4][2], B0[2][2], B1[2][2];
    const char* cA = (const char*)g.A + (size_t)cur.pm * tstep + (size_t)cur.k0 * kstep; const char* cB = (const char*)g.Bt + (size_t)cur.pn * tstep + (size_t)cur.k0 * kstep;
    S.a_ready(cur);
    if constexpr (SP2) {
        PG8_STAGE(PG8_SB(0, 0), cB, voffB); PG8_STAGE(PG8_SB(0, 1), cB + hstep, voffB); PG8_STAGE(PG8_SA(0, 0), cA, voffA); PG8_STAGE(PG8_SA(0, 1), cA + hstep, voffA);
        if (wr == 1) PG8_BAR;
        PG8_WAIT_V(2); PG8_BAR;
        PG8_STAGE(PG8_SB(1, 0), cB + kstep, voffB); PG8_STAGE(PG8_SA(1, 0), cA + kstep, voffA); PG8_STAGE(PG8_SB(1, 1), cB + hstep + kstep, voffB);
        PG8_WAIT_V(6); PG8_BAR;
    } else {
        PG8_STAGE(PG8_SB(0, 0), cB, voffB); PG8_STAGE(PG8_SA(0, 0), cA, voffA); PG8_STAGE(PG8_SB(0, 1), cB + hstep, voffB); PG8_STAGE(PG8_SA(0, 1), cA + hstep, voffA);
        if (wr == 1) PG8_BAR;
        PG8_WAIT_V(4); PG8_BAR;
        PG8_STAGE(PG8_SB(1, 0), cB + kstep, voffB); PG8_STAGE(PG8_SA(1, 0), cA + kstep, voffA); PG8_STAGE(PG8_SB(1, 1), cB + hstep + kstep, voffB);
        PG8_WAIT_V(6); PG8_BAR;
    }
    for (;;) {
        const bool has_next = S.next(ui + 1, nxt);
        const char* nA = has_next ? (const char*)g.A + (size_t)nxt.pm * tstep + (size_t)nxt.k0 * kstep : cA; const char* nB = has_next ? (const char*)g.Bt + (size_t)nxt.pn * tstep + (size_t)nxt.k0 * kstep : cB;
        const int nt = cur.nt;
        for (int t = 0; t < nt; t += 2) {
            const bool last = (t == nt - 2);
            const char* a1 = cA + (size_t)(t + 1) * kstep;
            const char* a2 = last ? nA : cA + (size_t)(t + 2) * kstep; const char* b2 = last ? nB : cB + (size_t)(t + 2) * kstep;
            const char* a3 = a2 + kstep; const char* b3 = b2 + kstep;
            if (last && has_next) S.a_ready(nxt);
            if constexpr (SP2) {
            PG8_LDB(B0, 0, 0); PG8_LDB(B1, 0, 1); PG8_SCHED; PG8_LDA(At, 0, 0); PG8_STAGE(PG8_SA(1, 1), a1 + hstep, voffA);
            PG8_WAIT_V(8); PG8_WAIT_L(0); PG8_BAR; PG8_MMA(0, 0, At, B0); PG8_MMA(0, 1, At, B1); PG8_BAR; PG8_SCHED;
            PG8_LDA(At, 0, 1); PG8_STAGE(PG8_SB(0, 0), b2, voffB); PG8_STAGE(PG8_SB(0, 1), b2 + hstep, voffB); PG8_STAGE(PG8_SA(0, 0), a2, voffA);
            PG8_WAIT_V(8); PG8_WAIT_L(0); PG8_BAR; PG8_MMA(1, 0, At, B0); PG8_MMA(1, 1, At, B1); PG8_BAR; PG8_SCHED;
            PG8_LDB(B0, 1, 0); PG8_LDB(B1, 1, 1); PG8_SCHED; PG8_LDA(At, 1, 0); PG8_STAGE(PG8_SA(0, 1), a2 + hstep, voffA);
            PG8_WAIT_V(8); PG8_WAIT_L(0); PG8_BAR; PG8_MMA(0, 0, At, B0); PG8_MMA(0, 1, At, B1); PG8_BAR; PG8_SCHED;
            PG8_LDA(At, 1, 1); PG8_STAGE(PG8_SB(1, 0), b3, voffB); PG8_STAGE(PG8_SB(1, 1), b3 + hstep, voffB); PG8_STAGE(PG8_SA(1, 0), a3, voffA);
            PG8_WAIT_V(8); PG8_WAIT_L(0); PG8_BAR; PG8_MMA(1, 0, At, B0); PG8_MMA(1, 1, At, B1); PG8_BAR; PG8_SCHED;
            } else {
            PG8_LDB(B0, 0, 0); PG8_SCHED; PG8_LDA(At, 0, 0); PG8_STAGE(PG8_SA(1, 1), a1 + hstep, voffA);
            PG8_WAIT_L(8); PG8_BAR; PG8_WAIT_L(0); PG8_MMA(0, 0, At, B0); PG8_BAR; PG8_SCHED;
            PG8_LDB(B1, 0, 1); PG8_STAGE(PG8_SB(0, 0), b2, voffB);
            PG8_BAR; PG8_WAIT_L(0); PG8_MMA(0, 1, At, B1); PG8_BAR;
            PG8_LDA(At, 0, 1); PG8_STAGE(PG8_SA(0, 0), a2, voffA);
            PG8_BAR; PG8_WAIT_L(0); PG8_MMA(1, 0, At, B0); PG8_BAR; PG8_SCHED;
            PG8_STAGE(PG8_SB(0, 1), b2 + hstep, voffB);
            PG8_WAIT_V(6); PG8_BAR; PG8_MMA(1, 1, At, B1); PG8_BAR;
            PG8_LDB(B0, 1, 0); PG8_SCHED; PG8_LDA(At, 1, 0); PG8_STAGE(PG8_SA(0, 1), a2 + hstep, voffA);
            PG8_WAIT_L(8); PG8_BAR; PG8_WAIT_L(0); PG8_MMA(0, 0, At, B0); PG8_BAR; PG8_SCHED;
            PG8_LDB(B1, 1, 1); PG8_STAGE(PG8_SB(1, 0), b3, voffB);
            PG8_BAR; PG8_WAIT_L(0); PG8_MMA(0, 1, At, B1); PG8_BAR;
            PG8_LDA(At, 1, 1); PG8_STAGE(PG8_SA(1, 0), a3, voffA);
            PG8_BAR; PG8_WAIT_L(0); PG8_MMA(1, 0, At, B0); PG8_BAR; PG8_SCHED;
            PG8_STAGE(PG8_SB(1, 1), b3 + hstep, voffB);
            PG8_WAIT_V(6); PG8_BAR; PG8_MMA(1, 1, At, B1); PG8_BAR;
            }
        }
        if constexpr (ALIGN_EPI) { if (wr == 0) PG8_BAR; }
        if constexpr (!Epi::AFTER_DRAIN) { E(acc, cur, wr, wc, fr, fq); S.done(cur); }
        if (!has_next) break;
#pragma unroll
        for (int a = 0; a < 2; ++a)
#pragma unroll
            for (int b = 0; b < 2; ++b)
#pragma unroll
                for (int m = 0; m < 4; ++m)
#pragma unroll
                    for (int n = 0; n < 2; ++n) acc[a][b][m][n] = (f32x4){0.f, 0.f, 0.f, 0.f};
        cur = nxt; cA = nA; cB = nB; ++ui;
        if constexpr (ALIGN_EPI) { if (wr == 1) PG8_BAR; }
    }
    PG8_WAIT_V(0);
    if constexpr (!ALIGN_EPI) { if (wr == 0) PG8_BAR; }
    PG8_BAR;
    if constexpr (Epi::AFTER_DRAIN) { E.fused(acc, cur, wr, wc, fr, fq, lds, wid, lane); S.done(cur); }
#undef PG8_SA
#undef PG8_SB
#undef PG8_STAGE
#undef PG8_LDA
#undef PG8_LDB
#undef PG8_MMA
#undef PG8_WAIT_V
#undef PG8_WAIT_L
#undef PG8_BAR
#undef PG8_SCHED
}
}

#define LAS __attribute__((address_space(3)))
typedef unsigned short bf16;
typedef float f32x4 __attribute__((ext_vector_type(4)));
typedef float f32x2 __attribute__((ext_vector_type(2)));
typedef unsigned u32x4 __attribute__((ext_vector_type(4)));
typedef unsigned u32x2 __attribute__((ext_vector_type(2)));
typedef short bfx8 __attribute__((ext_vector_type(8)));
#define XB_TMO      128
#define XB_XCNT(j)  (256  + 64 * (j))
#define XB_XSUB(j)  (1280 + 64 * (j))
#define XB_XGEN(j)  (2304 + 64 * (j))
#define XB_TOP      3328
#define XB_TOPGEN   3392
#define XCD_BAR_WORDS 3456
#define XB_SPIN_CAP (1u << 18)

__device__ __forceinline__ unsigned xb_ld(unsigned* p)              { return __hip_atomic_load(p, __ATOMIC_RELAXED, __HIP_MEMORY_SCOPE_AGENT); }
__device__ __forceinline__ unsigned xb_add(unsigned* p, unsigned v) { return __hip_atomic_fetch_add(p, v, __ATOMIC_RELAXED, __HIP_MEMORY_SCOPE_AGENT); }
__device__ __forceinline__ unsigned xb_xcc_id() { return (unsigned)__builtin_amdgcn_s_getreg((3 << 11) | 20) & 0xFu; }
#define XB_SPIN(cond, bar) do { unsigned _sp = 0; while (cond) { __builtin_amdgcn_s_sleep(1); \
    if ((++_sp & 255u) == 0u) { if (xb_ld(&(bar)[XB_TMO])) break; if (_sp > XB_SPIN_CAP) { atomicAdd(&(bar)[XB_TMO], 1u); break; } } } } while (0)

struct XcdBarrier {
    unsigned* bar; unsigned x;
    volatile LAS unsigned* st;
};

__device__ __forceinline__ XcdBarrier xcd_barrier_post(unsigned* bar, volatile LAS unsigned* st, int tid) {
    XcdBarrier b; b.bar = bar; b.x = xb_xcc_id(); b.st = st;
    if (tid == 0) (void)xb_add(&bar[XB_XCNT(b.x)], 1u);
    return b;
}
__device__ __forceinline__ void xcd_barrier_complete(unsigned* bar, unsigned x, unsigned& nloc, unsigned& nx) {
    const unsigned G = gridDim.x * gridDim.y * gridDim.z;
    unsigned sum, cnt, mine, sp = 0u;
    for (;;) {
        sum = 0u; cnt = 0u; mine = 0u;
#pragma unroll
        for (unsigned j = 0; j < 16; ++j) { const unsigned c = xb_ld(&bar[XB_XCNT(j)]); sum += c; cnt += (c > 0u) ? 1u : 0u; mine = (j == x) ? c : mine; }
        if (sum == G) break;
        __builtin_amdgcn_s_sleep(1);
        if ((++sp & 255u) == 0u) { if (xb_ld(&bar[XB_TMO])) break; if (sp > XB_SPIN_CAP) { atomicAdd(&bar[XB_TMO], 1u); break; } }
    }
    nloc = mine > 0u ? mine : 1u; nx = cnt > 0u ? cnt : 1u;
}

__device__ __forceinline__ void xcd_barrier(const XcdBarrier& b, int tid) {
    asm volatile("s_waitcnt vmcnt(0)" ::: "memory");
    __syncthreads();
    if (tid == 0) {
        unsigned* bar = b.bar;
        __builtin_amdgcn_s_waitcnt(0);
        unsigned nloc = b.st[0], nx = b.st[1];
        if (nloc == 0u) { xcd_barrier_complete(bar, b.x, nloc, nx); b.st[0] = nloc; b.st[1] = nx; }
        const unsigned old = xb_add(&bar[XB_XSUB(b.x)], 1u);
        const unsigned gen = old / nloc;
        if (old + 1u == (gen + 1u) * nloc) {
            __builtin_amdgcn_fence(__ATOMIC_RELEASE, "agent");
            asm volatile("s_waitcnt vmcnt(0)" ::: "memory");
            const unsigned og = xb_add(&bar[XB_TOP], 1u);
            const unsigned tg = og / nx;
            if (og + 1u == (tg + 1u) * nx) xb_add(&bar[XB_TOPGEN], 1u);
            else XB_SPIN(xb_ld(&bar[XB_TOPGEN]) == tg, bar);
            __builtin_amdgcn_fence(__ATOMIC_ACQUIRE, "agent");
            xb_add(&bar[XB_XGEN(b.x)], 1u);
            asm volatile("s_waitcnt vmcnt(0)" ::: "memory");
        } else {
            XB_SPIN(xb_ld(&bar[XB_XGEN(b.x)]) == gen, bar);
            __builtin_amdgcn_fence(__ATOMIC_ACQUIRE, "agent");
            asm volatile("s_waitcnt vmcnt(0)" ::: "memory");
        }
    }
    __syncthreads();
}

constexpr int NWAVES = 8, NTHR = 512;
constexpr int TP = 8192, TS = 1024, T = 9216, D = 2048, NIN = 4800, NZ = 4864, FF = 5632, NGU = 11264;
constexpr int NH = 16, HS = 64, RD = 1024, RP = 3264, DEPTH = 4;
constexpr int ZQ = 1536;
constexpr float RMS_EPS = 1e-6f, LN_EPS = 1e-5f, GN_EPS = 64e-5f;
constexpr int SCR = 384;
constexpr size_t O_Y = 0;
constexpr size_t O_CONV_P = (size_t)T * D;
constexpr size_t O_POOL_P = O_CONV_P + (size_t)DEPTH * 4 * 30 * 512;
constexpr size_t O_SHIFT_P = O_POOL_P + (size_t)DEPTH * 4 * 15 * 512;
constexpr size_t O_WKV_P = O_SHIFT_P + (size_t)DEPTH * 4 * RP;
constexpr size_t O_CONV_S = O_WKV_P + (size_t)DEPTH * 4 * NH * 4096;
constexpr size_t O_POOL_S = O_CONV_S + (size_t)DEPTH * 16 * 30 * 512;
constexpr size_t O_SHIFT_S = O_POOL_S + (size_t)DEPTH * 16 * 15 * 512;
constexpr size_t O_WKV_S = O_SHIFT_S + (size_t)DEPTH * 16 * RP;
constexpr size_t O_END = O_WKV_S + (size_t)DEPTH * 16 * NH * 4096;
constexpr size_t WS_POOLW = 131072;
constexpr size_t WS_UPS = 262144;
constexpr size_t WS_WIN = 1u << 20;
constexpr size_t WS_WOUT = WS_WIN + (size_t)NZ * D * 2;
constexpr size_t WS_WGU = WS_WOUT + (size_t)D * D * 2;
constexpr size_t WS_WDN = WS_WGU + (size_t)NGU * D * 2;
constexpr size_t WS_X = WS_WDN + (size_t)D * FF * 2;
constexpr size_t WS_XN = WS_X + (size_t)T * D * 4;
constexpr size_t WS_MIX = WS_XN + (size_t)T * D * 2;
constexpr size_t WS_Z = WS_MIX + (size_t)T * D * 2;
constexpr size_t WS_ACT = WS_Z;
constexpr size_t WS_SC = WS_Z + (size_t)T * NZ * 2;
constexpr size_t WS_PART = WS_SC + (32u << 20);
constexpr size_t WS_Y = WS_SC + (size_t)T * NH * SCR * 4;
constexpr size_t WS_G = WS_Y + (size_t)T * RD * 4;
constexpr size_t WS_RK = WS_G + (size_t)T * RD * 4;
constexpr int NC = 16, CL = 128;
constexpr size_t WS_PQ = WS_RK + (size_t)T * NH * 4;
constexpr size_t WS_S0 = WS_PQ + (size_t)64 * NC * 2 * 4096 * 4;
constexpr size_t WS_GB = WS_S0 + (size_t)64 * NC * 4096 * 4;
constexpr size_t WS_W2 = WS_GB + (size_t)TP * RD * 4;
constexpr size_t WSET = WS_X - WS_WIN;
constexpr size_t WS_END = WS_W2 + WSET;
static_assert(WS_ACT + (size_t)T * FF * 2 <= WS_PART && WS_PART + (size_t)8 * 1024 * D * 4 <= WS_Y, "act / partial overlays");
constexpr int LDS_BYTES = 147456;

#ifndef REP_CVTW
#define REP_CVTW 1
#endif
#ifndef REP_YP
#define REP_YP 1
#endif
#ifndef REP_G1
#define REP_G1 1
#endif
#ifndef REP_N2
#define REP_N2 1
#endif
#ifndef REP_T4
#define REP_T4 1
#endif
#ifndef REP_G3
#define REP_G3 1
#endif
#ifndef REP_PREP
#define REP_PREP 1
#endif
#ifndef REP_POOL
#define REP_POOL 1
#endif
#ifndef REP_CONV
#define REP_CONV 1
#endif
#ifndef REP_P1
#define REP_P1 1
#endif
#ifndef REP_CB
#define REP_CB 1
#endif
#ifndef REP_MIXA
#define REP_MIXA 1
#endif
#ifndef REP_SCAN
#define REP_SCAN 1
#endif
#ifndef REP_POST
#define REP_POST 1
#endif
#ifndef REP_CVT
#define REP_CVT 1
#endif
#ifdef NO_SYNC
#define GSYNC() __syncthreads()
#else
#define GSYNC() do { int w_ = wave0; asm volatile("" : "+s"(w_)); xcd_barrier(xbar, w_ * 64 + (int)__builtin_amdgcn_mbcnt_hi(~0u, __builtin_amdgcn_mbcnt_lo(~0u, (unsigned)launder_v(0)))); } while (0)
#endif
__host__ __device__ __forceinline__ size_t sc_off(int t, int h) { return ((size_t)(((t >> 2) * NH + h) * 4 + (t & 3))) * SCR; }
struct Params { const float* in[31]; float* out; unsigned char* ws; };
typedef const __attribute__((address_space(4))) Params* KP;
__device__ __forceinline__ KP kargs() { KP k = (KP)__builtin_amdgcn_kernarg_segment_ptr(); asm volatile("" : "+s"(k)); return k; }
__device__ __forceinline__ int launder_v(int v) { asm volatile("" : "+v"(v)); return v; }
#define PH_BEGIN() KP kp = kargs(); int wave_ = wave0; asm volatile("" : "+s"(wave_)); const int wave = wave_; const int lane = (int)__builtin_amdgcn_mbcnt_hi(~0u, __builtin_amdgcn_mbcnt_lo(~0u, (unsigned)launder_v(0))); const int tid = wave * 64 + lane; \
    const int nb = gridDim.x, bid = blockIdx.x, gw = bid * NWAVES + wave, ngw = nb * NWAVES; unsigned char* const ws = kp->ws; (void)lane; (void)wave; (void)gw; (void)ngw; (void)ws; (void)nb; (void)bid

template <int M> __device__ __forceinline__ float swz_xor(float v) { return __builtin_bit_cast(float, __builtin_amdgcn_ds_swizzle(__builtin_bit_cast(int, v), 0x1f | (M << 10))); }
__device__ __forceinline__ float rowsum16(float v) { v += swz_xor<1>(v); v += swz_xor<2>(v); v += swz_xor<4>(v); v += swz_xor<8>(v); return v; }
__device__ __forceinline__ float wave_sum(float v) {
    v = rowsum16(v); v += swz_xor<16>(v);
    const int ln = (int)__builtin_amdgcn_mbcnt_hi(~0u, __builtin_amdgcn_mbcnt_lo(~0u, (unsigned)launder_v(0)));
    v += __builtin_bit_cast(float, __builtin_amdgcn_ds_bpermute((ln ^ 32) << 2, __builtin_bit_cast(int, v)));
    return v;
}
__device__ __forceinline__ unsigned f2bf(float f) { unsigned u = __builtin_bit_cast(unsigned, f); return (u + 0x7fffu + ((u >> 16) & 1u)) >> 16; }
__device__ __forceinline__ unsigned pk2(float lo, float hi) { return f2bf(lo) | (f2bf(hi) << 16); }
__device__ __forceinline__ float bf2f(bf16 v) { return __builtin_bit_cast(float, (unsigned)v << 16); }
__device__ __forceinline__ float sigm(float x) { return __builtin_amdgcn_rcpf(1.0f + __expf(-x)); }

__device__ __forceinline__ void transpose_item(const float* W, int K, int N, bf16* WT, int mode, LAS float* scr, int item, int lane) {
    const int nblk = N / 32, kb = item / nblk, nb = item % nblk, k0 = 64 * kb, n0 = 32 * nb;
    const int drow0 = (mode == 0) ? n0 : ((n0 >> 7) * 256 + (n0 & 127) + (mode == 2 ? 128 : 0));
    float wv[32];
#pragma unroll
    for (int i = 0; i < 32; ++i) { const int kk = 2 * i + (lane >> 5); wv[i] = W[(size_t)(k0 + kk) * N + n0 + (lane & 31)]; }
#pragma unroll
    for (int i = 0; i < 32; ++i) { const int kk = 2 * i + (lane >> 5); scr[kk * 33 + (lane & 31)] = wv[i]; }
    asm volatile("s_waitcnt lgkmcnt(0)" ::: "memory");
    const int c = lane & 7;
#pragma unroll
    for (int j = 0; j < 4; ++j) { const int n = (lane >> 3) + 8 * j; const LAS float* s = scr + (8 * c) * 33 + n;
        u32x4 o; o.x = pk2(s[0 * 33], s[1 * 33]); o.y = pk2(s[2 * 33], s[3 * 33]); o.z = pk2(s[4 * 33], s[5 * 33]); o.w = pk2(s[6 * 33], s[7 * 33]);
        *(u32x4*)(WT + (size_t)(drow0 + n) * K + k0 + 8 * c) = o; }
    asm volatile("s_waitcnt lgkmcnt(0)" ::: "memory");
}
__device__ __forceinline__ void convert_weights(KP kp, int l, LAS float* scr, int gw, int ngw, int lane) {
    unsigned char* ws = kp->ws;
    unsigned char* wsw = kp->ws + ((l & 1) ? (WS_W2 - WS_WIN) : 0);
    bf16* WIN = (bf16*)(wsw + WS_WIN); bf16* WOUT = (bf16*)(wsw + WS_WOUT); bf16* WGU = (bf16*)(wsw + WS_WGU); bf16* WDN = (bf16*)(wsw + WS_WDN);
    constexpr int I_IN = (D / 64) * (NIN / 32), I_OUT = (D / 64) * (D / 32), I_G = (D / 64) * (FF / 32), I_D = (FF / 64) * (D / 32);
    constexpr int I_P = 4 * 8, I_U = 3 * 32;
    constexpr int NITEMS = I_IN + I_OUT + 2 * I_G + I_D + I_P + I_U;
    for (int it = gw; it < NITEMS; it += ngw) {
        int r = it;
        if (r < I_IN) { transpose_item(kp->in[7] + (size_t)l * D * NIN, D, NIN, WIN, 0, scr, r, lane); continue; } r -= I_IN;
        if (r < I_OUT) { transpose_item(kp->in[25] + (size_t)l * D * D, D, D, WOUT, 0, scr, r, lane); continue; } r -= I_OUT;
        if (r < I_G) { transpose_item(kp->in[27] + (size_t)l * D * FF, D, FF, WGU, 1, scr, r, lane); continue; } r -= I_G;
        if (r < I_G) { transpose_item(kp->in[28] + (size_t)l * D * FF, D, FF, WGU, 2, scr, r, lane); continue; } r -= I_G;
        if (r < I_D) { transpose_item(kp->in[29] + (size_t)l * FF * D, FF, D, WDN, 0, scr, r, lane); continue; } r -= I_D;
        if (r < I_P) { const int g = r >> 3; transpose_item(kp->in[12] + (size_t)((l * 4 + g) * 128) * 128, 128, 128, (bf16*)(ws + WS_POOLW) + (size_t)g * 128 * 128, 0, scr, r & 7, lane); continue; } r -= I_P;
        { const int m = r >> 5; const float* src = (m == 0 ? kp->in[16] : (m == 1 ? kp->in[18] : kp->in[19])) + (size_t)l * 64 * RD;
          transpose_item(src, 64, RD, (bf16*)(ws + WS_UPS) + (size_t)m * RD * 64, 0, scr, r & 31, lane); }
    }
    { const unsigned z = (unsigned)launder_v(0); for (int e = gw * 64 + lane; e < 16384; e += ngw * 64) ((u32x4*)(WIN + (size_t)NIN * D))[e] = (u32x4){z, z, z, z}; }
}
__device__ __forceinline__ void norm_rows(const float* sa, const float* sb, const float* g, float* xcopy, bf16* xn, float* fout, const float* part, int gw, int ngw, int lane) {
    for (int m = gw; m < T; m += ngw) {
        const float* row = (m < TP) ? sa + (size_t)m * D : sb + (size_t)(m - TP) * D;
        f32x4 v[8]; float ss = 0.f;
#pragma unroll
        for (int j = 0; j < 8; ++j) v[j] = ((const f32x4*)row)[lane + 64 * j];
        if (part && m >= TP) {
#pragma unroll
            for (int k = 0; k < 8; ++k)
#pragma unroll
                for (int j = 0; j < 8; ++j) v[j] += ((const f32x4*)(part + ((size_t)k * 1024 + (m - TP)) * D))[lane + 64 * j];
#pragma unroll
            for (int j = 0; j < 8; ++j) ((f32x4*)(const_cast<float*>(sb) + (size_t)(m - TP) * D))[lane + 64 * j] = v[j];
        }
#pragma unroll
        for (int j = 0; j < 8; ++j) ss += (v[j].x * v[j].x + v[j].y * v[j].y) + (v[j].z * v[j].z + v[j].w * v[j].w);
        const float rinv = 1.0f / sqrtf(wave_sum(ss) * (1.0f / D) + RMS_EPS);
#pragma unroll
        for (int j = 0; j < 8; ++j) {
            if (xcopy) ((f32x4*)(xcopy + (size_t)m * D))[lane + 64 * j] = v[j];
            const f32x4 gj = ((const f32x4*)g)[lane + 64 * j];
            const f32x4 y = v[j] * rinv * gj;
            if (xn) { u32x2 o; o.x = pk2(y.x, y.y); o.y = pk2(y.z, y.w); ((u32x2*)(xn + (size_t)m * D))[lane + 64 * j] = o; }
            if (fout) ((f32x4*)(fout + (size_t)m * D))[lane + 64 * j] = y;
        }
    }
}

__device__ __forceinline__ void conv_item(KP kp, int l, int item, LAS float* lds, int tid_in) {
    const int tid = launder_v(tid_in);
    const bf16* Z = (const bf16*)(kp->ws + WS_Z); bf16* MIX = (bf16*)(kp->ws + WS_MIX);
    const int t0 = item * 32;
    int s, tau0, Ls; bool prompt;
    if (t0 < TP) { s = t0 >> 11; tau0 = t0 & 2047; Ls = 2048; prompt = true; } else { s = (t0 - TP) >> 6; tau0 = (t0 - TP) & 63; Ls = 64; prompt = false; }
    const int c = tid;
    const float* cw = kp->in[8] + (size_t)l * 31 * 512;
    float w[31];
#pragma unroll
    for (int j = 0; j < 31; ++j) w[j] = cw[j * 512 + c];
    const float bias = kp->in[9][l * 512 + c];
    float acc[32];
#pragma unroll
    for (int i = 0; i < 32; ++i) acc[i] = bias;
    const bool first = (tau0 == 0), lastit = (tau0 + 32 == Ls);
    float* oc = prompt ? kp->out + O_CONV_P + (size_t)((l * 4 + s) * 30) * 512 : kp->out + O_CONV_S + (size_t)((l * 16 + s) * 30) * 512;
    const float* cc = kp->in[2] + (size_t)((l * 16 + s) * 30) * 512;
#pragma unroll
    for (int hf = 0; hf < 2; ++hf) {
        float pv[31], pg[31];
#pragma unroll
        for (int k = 0; k < 31; ++k) { const int ii = hf * 31 + k;
            if (ii < 30 && first) { pv[k] = prompt ? 0.f : cc[ii * 512 + c]; pg[k] = 0.f; }
            else { const bf16* zr = Z + (size_t)(t0 + ii - 30) * NZ; pv[k] = bf2f(zr[c]); pg[k] = bf2f(zr[512 + c]); } }
#pragma unroll
        for (int k = 0; k < 31; ++k) { const int ii = hf * 31 + k;
            const float u = (ii < 30 && first) ? pv[k] : pv[k] * sigm(pg[k]);
            if (ii >= 32 && lastit) oc[(ii - 32) * 512 + c] = u;
#pragma unroll
            for (int oi = 0; oi < 32; ++oi) { const int j = ii - oi; if (j >= 0 && j <= 30) acc[oi] += w[j] * u; }
        }
    }
#pragma unroll
    for (int oi = 0; oi < 32; ++oi) lds[oi * 512 + c] = acc[oi];
    __syncthreads();
    const int wave = tid >> 6, lane = tid & 63;
    const f32x4 g0 = *(const f32x4*)(kp->in[10] + l * 512 + lane * 8), g1 = *(const f32x4*)(kp->in[10] + l * 512 + lane * 8 + 4);
    const f32x4 b0 = *(const f32x4*)(kp->in[11] + l * 512 + lane * 8), b1 = *(const f32x4*)(kp->in[11] + l * 512 + lane * 8 + 4);
#pragma unroll
    for (int q = 0; q < 4; ++q) {
        const int oi = wave * 4 + q;
        f32x4 a = *(const LAS f32x4*)(lds + oi * 512 + lane * 8), b = *(const LAS f32x4*)(lds + oi * 512 + lane * 8 + 4);
        const float mean = wave_sum((a.x + a.y) + (a.z + a.w) + (b.x + b.y) + (b.z + b.w)) * (1.0f / 512.0f);
        a = a - mean; b = b - mean;
        const float var = wave_sum((a.x * a.x + a.y * a.y) + (a.z * a.z + a.w * a.w) + (b.x * b.x + b.y * b.y) + (b.z * b.z + b.w * b.w)) * (1.0f / 512.0f);
        const float rstd = __builtin_amdgcn_rsqf(var + LN_EPS);
        a = a * rstd * g0 + b0; b = b * rstd * g1 + b1;
        float o[8] = {a.x, a.y, a.z, a.w, b.x, b.y, b.z, b.w};
#pragma unroll
        for (int k = 0; k < 8; ++k) o[k] = o[k] * sigm(o[k]);
        u32x4 wv; wv.x = pk2(o[0], o[1]); wv.y = pk2(o[2], o[3]); wv.z = pk2(o[4], o[5]); wv.w = pk2(o[6], o[7]);
        *(u32x4*)(MIX + (size_t)(t0 + oi) * D + lane * 8) = wv;
    }
    __syncthreads();
}
__device__ __forceinline__ void pool_item(KP kp, int l, int item, LAS unsigned char* ldsb, int tid_in) {
    const int tid = launder_v(tid_in);
    const bf16* Z = (const bf16*)(kp->ws + WS_Z); bf16* MIX = (bf16*)(kp->ws + WS_MIX);
    LAS float* pp = (LAS float*)ldsb;
    LAS bf16* db = (LAS bf16*)(ldsb + 47 * 512 * 4);
    const int t0 = item * 32;
    int s, tau0, Ls; bool prompt;
    if (t0 < TP) { s = t0 >> 11; tau0 = t0 & 2047; Ls = 2048; prompt = true; } else { s = (t0 - TP) >> 6; tau0 = (t0 - TP) & 63; Ls = 64; prompt = false; }
    const int c = tid;
    const bool first = (tau0 == 0), lastit = (tau0 + 32 == Ls);
    float* op = prompt ? kp->out + O_POOL_P + (size_t)((l * 4 + s) * 15) * 512 : kp->out + O_POOL_S + (size_t)((l * 16 + s) * 15) * 512;
    const float* cp = kp->in[3] + (size_t)((l * 16 + s) * 15) * 512;
    {
        float pvl[47];
#pragma unroll
        for (int ii = 0; ii < 47; ++ii) {
            if (ii < 15 && first) pvl[ii] = prompt ? 0.f : cp[ii * 512 + c];
            else pvl[ii] = bf2f(Z[(size_t)(t0 + ii - 15) * NZ + 1024 + c]);
        }
#pragma unroll
        for (int ii = 0; ii < 47; ++ii) {
            pp[ii * 512 + c] = pvl[ii];
            if (ii >= 32 && lastit) op[(ii - 32) * 512 + c] = pvl[ii];
        }
    }
    const int gi = c >> 7, w = 2 << gi;
    for (int oi = 0; oi < 32; ++oi) {
        float sum = 0.f;
        for (int k = 0; k < w; ++k) sum += pp[(oi + 15 - k) * 512 + c];
        const int cnt = prompt ? min(w, tau0 + oi + 1) : w;
        const float d = sum * __builtin_amdgcn_rcpf((float)cnt) - pp[(oi + 15) * 512 + c];
        db[oi * 520 + c] = (bf16)f2bf(d);
    }
    __syncthreads();
    const int lane = tid & 63, wave = tid >> 6, n16 = lane & 15, q = lane >> 4, g = wave >> 1, nh = wave & 1;
    const bf16* WT = (const bf16*)(kp->ws + WS_POOLW) + (size_t)g * 128 * 128;
    bfx8 Bf[4][4];
#pragma unroll
    for (int nt = 0; nt < 4; ++nt)
#pragma unroll
        for (int ks = 0; ks < 4; ++ks) Bf[nt][ks] = *(const bfx8*)(WT + (size_t)(nh * 64 + nt * 16 + n16) * 128 + ks * 32 + q * 8);
    float scale[4];
#pragma unroll
    for (int nt = 0; nt < 4; ++nt) scale[nt] = kp->in[13][l * 512 + g * 128 + nh * 64 + nt * 16 + n16];
#pragma unroll
    for (int mt = 0; mt < 2; ++mt) {
        bfx8 Af[4];
#pragma unroll
        for (int ks = 0; ks < 4; ++ks) Af[ks] = *(const LAS bfx8*)(db + (mt * 16 + n16) * 520 + g * 128 + ks * 32 + q * 8);
        f32x4 acc[4];
#pragma unroll
        for (int nt = 0; nt < 4; ++nt) { acc[nt] = (f32x4){0.f, 0.f, 0.f, 0.f};
#pragma unroll
            for (int ks = 0; ks < 4; ++ks) acc[nt] = __builtin_amdgcn_mfma_f32_16x16x32_bf16(Af[ks], Bf[nt][ks], acc[nt], 0, 0, 0); }
#pragma unroll
        for (int nt = 0; nt < 4; ++nt)
#pragma unroll
            for (int r = 0; r < 4; ++r) MIX[(size_t)(t0 + mt * 16 + 4 * q + r) * D + 512 + g * 128 + nh * 64 + nt * 16 + n16] = (bf16)f2bf(acc[nt][r] * scale[nt]);
    }
    __syncthreads();
}
__device__ __forceinline__ void prep_item(KP kp, int l, int item, LAS unsigned char* ldsb, int tid_in) {
    const int tid = launder_v(tid_in);
    const bf16* Z = (const bf16*)(kp->ws + WS_Z);
    float* SC = (float*)(kp->ws + WS_SC); float* G = (float*)(kp->ws + WS_G); float* RK = (float*)(kp->ws + WS_RK);
    const bf16* UPT = (const bf16*)(kp->ws + WS_UPS);
    LAS bf16* lo = (LAS bf16*)ldsb;
    const int t0 = item * 16;
    int s, tau0, Ls; bool prompt;
    if (t0 < TP) { s = t0 >> 11; tau0 = t0 & 2047; Ls = 2048; prompt = true; } else { s = (t0 - TP) >> 6; tau0 = (t0 - TP) & 63; Ls = 64; prompt = false; }
    const float* mu = kp->in[14] + (size_t)l * RP;
    const float* ssh = kp->in[4] + (size_t)(l * 16 + s) * RP;
    {
        float qv[6], qp[6], mq[6];
#pragma unroll
        for (int k = 0; k < 6; ++k) { const int e = tid + k * NTHR, tok = e / 192, col = e % 192, zc = 3072 + col, t = t0 + tok, tau = tau0 + tok;
            qv[k] = bf2f(Z[(size_t)t * NZ + ZQ + zc]);
            qp[k] = tau > 0 ? bf2f(Z[(size_t)(t - 1) * NZ + ZQ + zc]) : (prompt ? 0.f : ssh[zc]);
            mq[k] = mu[zc]; }
#pragma unroll
        for (int k = 0; k < 6; ++k) { const int e = tid + k * NTHR, tok = e / 192, col = e % 192;
            const float qs = qv[k] + (qp[k] - qv[k]) * mq[k];
            const float val = col < 64 ? (1.0f - 2.0f * __builtin_amdgcn_rcpf(1.0f + __expf(2.0f * qs))) : (col < 128 ? qs : sigm(qs));
            lo[((col >> 6) * 16 + tok) * 72 + (col & 63)] = (bf16)f2bf(val); }
    }
    __syncthreads();
    const int lane = tid & 63, wave = tid >> 6, n16 = lane & 15, q = lane >> 4;
#pragma unroll 1
    for (int hh = 0; hh < 2; ++hh) {
        const int h = wave * 2 + hh;
        f32x4 acc[3][4];
#pragma unroll
        for (int m = 0; m < 3; ++m) {
            bfx8 Af[2], Bf[4][2];
#pragma unroll
            for (int ks = 0; ks < 2; ++ks) Af[ks] = *(const LAS bfx8*)(lo + (m * 16 + n16) * 72 + ks * 32 + q * 8);
#pragma unroll
            for (int i = 0; i < 4; ++i)
#pragma unroll
                for (int ks = 0; ks < 2; ++ks) Bf[i][ks] = *(const bfx8*)(UPT + (size_t)(m * RD + h * 64 + i * 16 + n16) * 64 + ks * 32 + q * 8);
#pragma unroll
            for (int i = 0; i < 4; ++i) { acc[m][i] = (f32x4){0.f, 0.f, 0.f, 0.f};
#pragma unroll
                for (int ks = 0; ks < 2; ++ks) acc[m][i] = __builtin_amdgcn_mfma_f32_16x16x32_bf16(Af[ks], Bf[i][ks], acc[m][i], 0, 0, 0); }
        }
        float mur[4], muk[4], muv[4], w0c[4], a0c[4], kkc[4], kac[4], rkc[4], sr[4], sk[4], sv[4];
#pragma unroll
        for (int i = 0; i < 4; ++i) { const int c = h * 64 + i * 16 + n16;
            mur[i] = mu[c]; muk[i] = mu[RD + c]; muv[i] = mu[2 * RD + c];
            w0c[i] = kp->in[15][l * RD + c]; a0c[i] = kp->in[17][l * RD + c]; kkc[i] = kp->in[20][l * RD + c]; kac[i] = kp->in[21][l * RD + c]; rkc[i] = kp->in[22][l * RD + c];
            sr[i] = prompt ? 0.f : ssh[c]; sk[i] = prompt ? 0.f : ssh[RD + c]; sv[i] = prompt ? 0.f : ssh[2 * RD + c]; }
        float zc_[4][4][3], zp_[4][4][3];
#pragma unroll
        for (int r = 0; r < 4; ++r) {
            const int tok = 4 * q + r, t = t0 + tok, tau = tau0 + tok;
            const bf16* zr = Z + (size_t)t * NZ + ZQ;
#pragma unroll
            for (int i = 0; i < 4; ++i) { const int c = h * 64 + i * 16 + n16;
                zc_[r][i][0] = bf2f(zr[c]); zc_[r][i][1] = bf2f(zr[RD + c]); zc_[r][i][2] = bf2f(zr[2 * RD + c]);
                if (tau > 0) { zp_[r][i][0] = bf2f(zr[c - NZ]); zp_[r][i][1] = bf2f(zr[RD + c - NZ]); zp_[r][i][2] = bf2f(zr[2 * RD + c - NZ]); } else { zp_[r][i][0] = sr[i]; zp_[r][i][1] = sk[i]; zp_[r][i][2] = sv[i]; } }
        }
#pragma unroll
        for (int r = 0; r < 4; ++r) {
            const int tok = 4 * q + r, t = t0 + tok;
            float rv[4], kv[4], vv[4], av[4], dv[4], kk[4];
            float skk = 0.f;
#pragma unroll
            for (int i = 0; i < 4; ++i) { const int c = h * 64 + i * 16 + n16;
                float rr = zc_[r][i][0], k = zc_[r][i][1], v = zc_[r][i][2];
                rr += (zp_[r][i][0] - rr) * mur[i]; k += (zp_[r][i][1] - k) * muk[i]; v += (zp_[r][i][2] - v) * muv[i];
                const float xw = -(w0c[i] + acc[0][i][r]);
                const float sp = fmaxf(xw, 0.f) + __logf(1.0f + __expf(-fabsf(xw)));
                dv[i] = __expf(-__expf(-sp - 0.5f));
                av[i] = sigm(a0c[i] + acc[1][i][r]);
                rv[i] = rr; kv[i] = k; vv[i] = v; kk[i] = k * kkc[i]; skk += kk[i] * kk[i];
                G[(size_t)t * RD + c] = acc[2][i][r];
                }
            skk = rowsum16(skk);
            const float rinv = __builtin_amdgcn_rsqf(fmaxf(skk, 1e-24f));
            float srk = 0.f;
#pragma unroll
            for (int i = 0; i < 4; ++i) {
                const float kkn = kk[i] * rinv, kpv = kv[i] * (1.0f + (av[i] - 1.0f) * kac[i]), bb = kkn * av[i];
                srk += rv[i] * kpv * rkc[i];
                float* sc = SC + sc_off(t, h) + i * 16 + n16;
                sc[0] = dv[i]; sc[64] = kkn; sc[128] = bb; sc[192] = kpv; sc[256] = rv[i]; sc[320] = vv[i];
            }
            srk = rowsum16(srk);
            if (n16 == 0) RK[t * NH + h] = srk;
        }
    }
    if (tau0 + 16 == Ls) {
        float* osh = prompt ? kp->out + O_SHIFT_P + (size_t)(l * 4 + s) * RP : kp->out + O_SHIFT_S + (size_t)(l * 16 + s) * RP;
        const bf16* zr = Z + (size_t)(t0 + 15) * NZ + ZQ;
        for (int e = tid; e < RP; e += NTHR) osh[e] = bf2f(zr[e]);
    }
    __syncthreads();
}

__device__ __forceinline__ void sc_issue(f32x4 (&r)[4], const LAS f32x4* o, int c) {
    if (c < 4) {
#pragma unroll
        for (int i = 0; i < 4; ++i) r[i] = o[16 + 4 * c + i];
    } else { const int j = c - 4; r[0] = o[j]; r[1] = o[32 + j]; r[2] = o[48 + j]; r[3] = o[64 + j]; }
}
template <int MODE>
__device__ __forceinline__ void scan_run(const float* SC, int tg0, int nsteps, int h, LAS float* wl  , int lane,
                                         const float* Sinit, float* Y, float* GB, float* Sout, float* PQout) {
    constexpr int GS = 4, NCH = 20;
    f32x2 S[32];
    f32x2 P[(MODE == 3) ? 32 : 1];
    if (MODE == 3) {
        const int ln = launder_v(lane);
#pragma unroll
        for (int j = 0; j < 32; ++j) { S[j] = (f32x2){0.f, 0.f}; P[j] = (f32x2){(2 * j == ln) ? 1.f : 0.f, (2 * j + 1 == ln) ? 1.f : 0.f}; }
    } else {
#pragma unroll
        for (int j = 0; j < 16; ++j) { const f32x4 v = ((const f32x4*)(Sinit + lane * 64))[j]; S[2 * j] = (f32x2){v.x, v.y}; S[2 * j + 1] = (f32x2){v.z, v.w}; }
    }
#define SC_STAGE(g, buf) do { const float* rec_ = SC + sc_off(tg0 + (g) * GS, h) + lane * 4; \
        _Pragma("unroll") for (int k_ = 0; k_ < 6; ++k_) __builtin_amdgcn_global_load_lds((const unsigned*)(rec_ + k_ * 256), (LAS unsigned*)(wl + (buf) * GS * SCR + k_ * 256), 16, 0, 0); } while (0)
    SC_STAGE(0, 0);
    const int ngroups = nsteps / GS;
    for (int g = 0; g < ngroups; ++g) {
        asm volatile("s_waitcnt vmcnt(0)" ::: "memory");
        if (g + 1 < ngroups) SC_STAGE(g + 1, (g + 1) & 1);
        const LAS float* wb = wl + (g & 1) * GS * SCR;
        f32x4 R[4][4];
#pragma unroll
        for (int q = 0; q < 3; ++q) sc_issue(R[q & 3], (const LAS f32x4*)(wb + (q / NCH) * SCR), q % NCH);
        __builtin_amdgcn_sched_barrier(0);
#pragma unroll
        for (int s = 0; s < GS; ++s) {
            f32x2 d2a = (f32x2){0.f, 0.f}, y2a = (f32x2){0.f, 0.f};
            f32x2 e2a = (f32x2){0.f, 0.f}, g2a = (f32x2){0.f, 0.f};
            f32x2 sa2 = (f32x2){0.f, 0.f}, sp2 = (f32x2){0.f, 0.f};
            const float vs = wb[s * SCR + 320 + lane];
            const f32x2 v2 = (f32x2){vs, vs};
#pragma unroll
            for (int c = 0; c < NCH; ++c) {
                const int q = s * NCH + c, qn = q + 3;
                if (qn < GS * NCH) sc_issue(R[qn & 3], (const LAS f32x4*)(wb + (qn / NCH) * SCR), qn % NCH);
                __builtin_amdgcn_sched_barrier(0);
                f32x4 (&r)[4] = R[q & 3];
                if (c < 4) {
#pragma unroll
                    for (int i = 0; i < 4; ++i) { const int j = 4 * c + i; d2a += S[2 * j] * (f32x2){r[i].x, r[i].y}; d2a += S[2 * j + 1] * (f32x2){r[i].z, r[i].w};
                        if (MODE == 3) { e2a += P[2 * j] * (f32x2){r[i].x, r[i].y}; e2a += P[2 * j + 1] * (f32x2){r[i].z, r[i].w}; } }
                    if (c == 3) { const f32x2 d2 = d2a; const float sa = -(d2.x + d2.y); sa2 = (f32x2){sa, sa};
                        if (MODE == 3) { const f32x2 e2 = e2a; const float sp = -(e2.x + e2.y); sp2 = (f32x2){sp, sp}; } }
                } else {
                    const int j = c - 4;
                    f32x2 t0 = v2 * (f32x2){r[2].x, r[2].y}; t0 = sa2 * (f32x2){r[1].x, r[1].y} + t0; S[2 * j] = S[2 * j] * (f32x2){r[0].x, r[0].y} + t0;
                    f32x2 t1 = v2 * (f32x2){r[2].z, r[2].w}; t1 = sa2 * (f32x2){r[1].z, r[1].w} + t1; S[2 * j + 1] = S[2 * j + 1] * (f32x2){r[0].z, r[0].w} + t1;
                    y2a += S[2 * j] * (f32x2){r[3].x, r[3].y}; y2a += S[2 * j + 1] * (f32x2){r[3].z, r[3].w};
                    if (MODE == 3) {
                        const f32x2 u0 = sp2 * (f32x2){r[1].x, r[1].y}, u1 = sp2 * (f32x2){r[1].z, r[1].w};
                        P[2 * j] = P[2 * j] * (f32x2){r[0].x, r[0].y} + u0; P[2 * j + 1] = P[2 * j + 1] * (f32x2){r[0].z, r[0].w} + u1;
                        g2a += P[2 * j] * (f32x2){r[3].x, r[3].y}; g2a += P[2 * j + 1] * (f32x2){r[3].z, r[3].w};
                    }
                }
                __builtin_amdgcn_sched_barrier(0);
            }
            { const f32x2 y2 = y2a; Y[(size_t)(tg0 + g * GS + s) * RD + h * 64 + lane] = y2.x + y2.y; }
            if (MODE == 3) { const f32x2 g2 = g2a; GB[(size_t)(tg0 + g * GS + s) * RD + h * 64 + lane] = g2.x + g2.y; }
        }
        asm volatile("s_waitcnt lgkmcnt(0)" ::: "memory");
    }
#undef SC_STAGE
    if (MODE == 3) {
#pragma unroll
        for (int j = 0; j < 16; ++j) { ((f32x4*)PQout)[j * 64 + lane] = (f32x4){P[2 * j].x, P[2 * j].y, P[2 * j + 1].x, P[2 * j + 1].y};
                                       ((f32x4*)(PQout + 4096))[j * 64 + lane] = (f32x4){S[2 * j].x, S[2 * j].y, S[2 * j + 1].x, S[2 * j + 1].y}; }
    } else {
#pragma unroll
        for (int j = 0; j < 16; ++j) ((f32x4*)(Sout + lane * 64))[j] = (f32x4){S[2 * j].x, S[2 * j].y, S[2 * j + 1].x, S[2 * j + 1].y};
    }
}
template <int NMT>
__device__ __forceinline__ void ypost_task(KP kp, int l, const float* S0q  , int tg0, int h, int lane) {
    const float* GB = (const float*)(kp->ws + WS_GB); const float* Y = (const float*)(kp->ws + WS_Y); const float* SC = (const float*)(kp->ws + WS_SC);
    const float* G = (const float*)(kp->ws + WS_G); const float* RK = (const float*)(kp->ws + WS_RK); bf16* MIX = (bf16*)(kp->ws + WS_MIX);
    const int n = lane & 15, kq = lane >> 4;
    float Bv[4][16];
    if (S0q) {
#pragma unroll
        for (int nt = 0; nt < 4; ++nt)
#pragma unroll
            for (int ks = 0; ks < 16; ++ks) Bv[nt][ks] = S0q[(size_t)(ks * 64 + nt * 16 + n) * 4 + kq];
    }
    float gng[4], gnb[4];
#pragma unroll
    for (int nt = 0; nt < 4; ++nt) { gng[nt] = kp->in[23][l * RD + h * 64 + nt * 16 + n]; gnb[nt] = kp->in[24][l * RD + h * 64 + nt * 16 + n]; }
#pragma unroll 1
    for (int mt = 0; mt < NMT; ++mt) {
        const int tb = tg0 + mt * 16;
        float Av[16];
        if (S0q) { const float* grow = GB + (size_t)(tb + n) * RD + h * 64 + kq;
#pragma unroll
            for (int ks = 0; ks < 16; ++ks) Av[ks] = grow[ks * 4]; }
        f32x4 acc[4]; float vv[4][4], gg[4][4], rk[4];
#pragma unroll
        for (int r = 0; r < 4; ++r) { const int t = tb + 4 * kq + r; rk[r] = RK[t * NH + h];
#pragma unroll
            for (int nt = 0; nt < 4; ++nt) { acc[nt][r] = Y[(size_t)t * RD + h * 64 + nt * 16 + n]; vv[nt][r] = SC[sc_off(t, h) + 320 + nt * 16 + n]; gg[nt][r] = G[(size_t)t * RD + h * 64 + nt * 16 + n]; } }
        if (S0q) {
#pragma unroll
            for (int ks = 0; ks < 16; ++ks)
#pragma unroll
                for (int nt = 0; nt < 4; ++nt) acc[nt] = __builtin_amdgcn_mfma_f32_16x16x4f32(Av[ks], Bv[nt][ks], acc[nt], 0, 0, 0);
        }
#pragma unroll
        for (int r = 0; r < 4; ++r) {
            const int t = tb + 4 * kq + r;
            const float mean = rowsum16((acc[0][r] + acc[1][r]) + (acc[2][r] + acc[3][r])) * (1.0f / 64.0f);
            float d[4], qq = 0.f;
#pragma unroll
            for (int nt = 0; nt < 4; ++nt) { d[nt] = acc[nt][r] - mean; qq += d[nt] * d[nt]; }
            const float rstd = __builtin_amdgcn_rsqf(rowsum16(qq) * (1.0f / 64.0f) + GN_EPS);
#pragma unroll
            for (int nt = 0; nt < 4; ++nt) { const float o = ((d[nt] * rstd * gng[nt] + gnb[nt]) + rk[r] * vv[nt][r]) * gg[nt][r];
                MIX[(size_t)t * D + 1024 + h * 64 + nt * 16 + n] = (bf16)f2bf(o); }
        }
    }
}
__device__ __forceinline__ void combine_chain(const float* PQ, float* S0, float* Sfin, LAS unsigned char* lds, int tid, int wave, int lane) {
    LAS f32x4* pl = (LAS f32x4*)lds;
    LAS f32x4* xch = (LAS f32x4*)(lds + 16384);
    f32x2 S[32];
#pragma unroll
    for (int j = 0; j < 32; ++j) S[j] = (f32x2){0.f, 0.f};
    const int n4a = 2 * wave, n4b = 2 * wave + 1;
    const f32x4* Pc = (const f32x4*)PQ;
    f32x4 p0 = Pc[tid], p1 = Pc[tid + 512];
    for (int c = 0; c < NC; ++c) {
        const f32x4* Qc = (const f32x4*)(PQ + (size_t)(c * 2 + 1) * 4096);
        pl[tid] = p0; pl[tid + 512] = p1;
        f32x4 na = Qc[n4a * 64 + lane], nb = Qc[n4b * 64 + lane];
        if (c + 1 < NC) { const f32x4* Pn = (const f32x4*)(PQ + (size_t)((c + 1) * 2) * 4096); p0 = Pn[tid]; p1 = Pn[tid + 512]; }
        __syncthreads();
        f32x2 a0 = (f32x2){na.x, na.y}, a1 = (f32x2){na.z, na.w}, b0 = (f32x2){nb.x, nb.y}, b1 = (f32x2){nb.z, nb.w};
#pragma unroll
        for (int j = 0; j < 32; ++j) {
            const f32x4 pa0 = pl[n4a * 64 + 2 * j], pb0 = pl[n4b * 64 + 2 * j], pa1 = pl[n4a * 64 + 2 * j + 1], pb1 = pl[n4b * 64 + 2 * j + 1];
            const f32x2 s0 = (f32x2){S[j].x, S[j].x}, s1 = (f32x2){S[j].y, S[j].y};
            a0 += s0 * (f32x2){pa0.x, pa0.y}; a1 += s0 * (f32x2){pa0.z, pa0.w}; b0 += s0 * (f32x2){pb0.x, pb0.y}; b1 += s0 * (f32x2){pb0.z, pb0.w};
            a0 += s1 * (f32x2){pa1.x, pa1.y}; a1 += s1 * (f32x2){pa1.z, pa1.w}; b0 += s1 * (f32x2){pb1.x, pb1.y}; b1 += s1 * (f32x2){pb1.z, pb1.w};
            if ((j & 1) == 1) __builtin_amdgcn_sched_barrier(0);
        }
        na = (f32x4){a0.x, a0.y, a1.x, a1.y}; nb = (f32x4){b0.x, b0.y, b1.x, b1.y};
        if (c + 1 < NC) {
            xch[n4a * 64 + lane] = na; xch[n4b * 64 + lane] = nb;
            f32x4* So = (f32x4*)(S0 + (size_t)(c + 1) * 4096);
            So[n4a * 64 + lane] = na; So[n4b * 64 + lane] = nb;
            __syncthreads();
#pragma unroll
            for (int j = 0; j < 16; ++j) { const f32x4 v = xch[j * 64 + lane]; S[2 * j] = (f32x2){v.x, v.y}; S[2 * j + 1] = (f32x2){v.z, v.w}; }
        } else {
            *(f32x4*)(Sfin + lane * 64 + 8 * wave) = na; *(f32x4*)(Sfin + lane * 64 + 8 * wave + 4) = nb;
        }
        __syncthreads();
    }
}
__global__ void __launch_bounds__(NTHR, 2) fwd_mega(Params p) {
    extern __shared__ __attribute__((aligned(16))) unsigned char lds_raw[];
    LAS unsigned char* lds = (LAS unsigned char*)lds_raw;
    const int wave0 = __builtin_amdgcn_readfirstlane((int)threadIdx.x >> 6);
    volatile LAS unsigned* MISC = (volatile LAS unsigned*)(lds + 131072);
    if (threadIdx.x < 16) MISC[threadIdx.x] = 0u;
    __syncthreads();
    const XcdBarrier xbar = xcd_barrier_post((unsigned*)p.ws + 4096, MISC, (int)threadIdx.x);
    cg::this_grid().sync();

#pragma unroll 1
    for (int l = 0; l < DEPTH; ++l) {
        for (int rep = 0; rep < REP_CVT; ++rep) { PH_BEGIN();
#ifndef NO_CVT
          if (l == 0) convert_weights(kp, 0, (LAS float*)(lds + wave * 16384), gw, ngw, lane);
#endif
#ifndef NO_NORM
          float* X = (float*)(ws + WS_X); bf16* XN = (bf16*)(ws + WS_XN);
          if (l == 0) norm_rows(kp->in[0], kp->in[1], kp->in[6], X, XN, nullptr, nullptr, gw, ngw, lane);
          else norm_rows(X, X + (size_t)TP * D, kp->in[6] + l * D, nullptr, XN, nullptr, (const float*)(ws + WS_PART), gw, ngw, lane);
#endif
        }
        GSYNC();
#ifndef NO_GEMM1
        _Pragma("unroll 1") for (int rg = 0; rg < REP_G1; ++rg) { PH_BEGIN(); pg8::Gemm g{(const bf16*)(ws + WS_XN), (const bf16*)(ws + WS_WIN + ((l & 1) ? (WS_W2 - WS_WIN) : 0)), T, NZ, D}; pg8::StaticOrder S; S.init(T, NZ, D, nb, bid); pg8::EpiStoreBf16 E{(bf16*)(ws + WS_Z), NZ};
          pg8::gemm_phase<pg8::EpiStoreBf16, pg8::StaticOrder, true, true>(lds, g, S, E, tid); }
#endif
        GSYNC();
        for (int rep = 0; rep < REP_MIXA; ++rep) { PH_BEGIN();
          if (rep) __syncthreads();
          for (int it = bid; it < 1152; it += nb) {
#ifndef NO_PREP
            if (it < 576) _Pragma("unroll 1") for (int r_ = 0; r_ < REP_PREP; ++r_) prep_item(kp, l, it, lds, tid);
#endif
#ifndef NO_POOL
            if (it >= 576 && it < 864) _Pragma("unroll 1") for (int r_ = 0; r_ < REP_POOL; ++r_) pool_item(kp, l, it - 576, lds, tid);
#endif
#ifndef NO_CONV
            if (it >= 864) _Pragma("unroll 1") for (int r_ = 0; r_ < REP_CONV; ++r_) conv_item(kp, l, it - 864, (LAS float*)lds, tid);
#endif
          }
        }
        GSYNC();
#ifndef NO_SCAN
        for (int rep = 0; rep < REP_SCAN; ++rep) {
        if (rep) GSYNC();
        for (int rp = 0; rp < REP_P1; ++rp) { PH_BEGIN();
            const float* SC = (const float*)(ws + WS_SC); float* Y = (float*)(ws + WS_Y); float* PQ = (float*)(ws + WS_PQ); float* GB = (float*)(ws + WS_GB);
            LAS float* wl = (LAS float*)(lds + wave * 12288);
            if (wave >= 5 && l + 1 < DEPTH) convert_weights(kp, l + 1, (LAS float*)(lds + 98304 + (wave - 5) * 8448), bid * 3 + (wave - 5), nb * 3, lane);
            for (int task = wave * nb + bid; task < 64 * NC + 256; task += NWAVES * nb) {
                if (task < 64 * NC) {
                    const int ch = task / NC, c = task % NC, s = ch >> 4, h = ch & 15;
                    scan_run<3>(SC, s * 2048 + c * CL, CL, h, wl, lane, nullptr, Y, GB, nullptr, PQ + (size_t)((ch * NC + c) * 2) * 4096);
                } else {
                    const int ch = task - 64 * NC, b = ch >> 4, h = ch & 15;
                    scan_run<1>(SC, TP + b * 64, 64, h, wl, lane, kp->in[5] + (size_t)((l * 16 + b) * NH + h) * 4096, Y, nullptr, kp->out + O_WKV_S + (size_t)((l * 16 + b) * NH + h) * 4096, nullptr);
                }
            }
        }
        GSYNC();
        for (int rp = 0; rp < REP_CB; ++rp) { PH_BEGIN();
            for (int ch = bid; ch < 64; ch += nb) { const int s = ch >> 4, h = ch & 15;
                combine_chain((const float*)(ws + WS_PQ) + (size_t)ch * NC * 2 * 4096, (float*)(ws + WS_S0) + (size_t)ch * NC * 4096, kp->out + O_WKV_P + (size_t)((l * 4 + s) * NH + h) * 4096, lds, tid, wave, lane); }
        }
        GSYNC();
        _Pragma("unroll 1") for (int ry = 0; ry < REP_YP; ++ry) { PH_BEGIN();
            const float* S0 = (const float*)(ws + WS_S0);
            constexpr int UPC = CL / 64, NPU = 64 * NC * UPC;
            for (int u = wave * nb + bid; u < NPU + 256; u += NWAVES * nb) {
                if (u < NPU) { const int task = u / UPC, hf = u % UPC, ch = task / NC, c = task % NC, s = ch >> 4, h = ch & 15;
                    ypost_task<4>(kp, l, c == 0 ? nullptr : S0 + (size_t)(ch * NC + c) * 4096, s * 2048 + c * CL + hf * 64, h, lane); }
                else { const int ch = u - NPU, b = ch >> 4, h = ch & 15; ypost_task<4>(kp, l, nullptr, TP + b * 64, h, lane); }
            }
        }
        }
#endif
        GSYNC();
#ifndef NO_GEMM2
        { PH_BEGIN(); pg8::Gemm g{(const bf16*)(ws + WS_MIX), (const bf16*)(ws + WS_WOUT + ((l & 1) ? (WS_W2 - WS_WIN) : 0)), T, D, D}; pg8::TailOrder S; S.init(D, D, nb, bid); pg8::EpiResAdd E{(float*)(ws + WS_X), D, (float*)(ws + WS_PART)};
          pg8::gemm_phase<pg8::EpiResAdd, pg8::TailOrder, true, true>(lds, g, S, E, tid); }
#endif
        GSYNC();
#ifndef NO_NORM
        _Pragma("unroll 1") for (int rn = 0; rn < REP_N2; ++rn) { PH_BEGIN(); float* X = (float*)(ws + WS_X); norm_rows(X, X + (size_t)TP * D, kp->in[26] + l * D, nullptr, (bf16*)(ws + WS_XN), nullptr, rn == 0 ? (const float*)(ws + WS_PART) : nullptr, gw, ngw, lane); }
#endif
        GSYNC();
#ifndef NO_GEMM3
        _Pragma("unroll 1") for (int rg = 0; rg < REP_G3; ++rg) { PH_BEGIN(); pg8::Gemm g{(const bf16*)(ws + WS_XN), (const bf16*)(ws + WS_WGU + ((l & 1) ? (WS_W2 - WS_WIN) : 0)), T, NGU, D}; pg8::StaticOrder S; S.init(T, NGU, D, nb, bid); pg8::EpiSwiGLU E{(bf16*)(ws + WS_ACT), FF};
          pg8::gemm_phase<pg8::EpiSwiGLU, pg8::StaticOrder, true, true>(lds, g, S, E, tid); }
#endif
        GSYNC();
#ifndef NO_GEMM4
        _Pragma("unroll 1") for (int rt = 0; rt < REP_T4; ++rt) { PH_BEGIN(); pg8::Gemm g{(const bf16*)(ws + WS_ACT), (const bf16*)(ws + WS_WDN + ((l & 1) ? (WS_W2 - WS_WIN) : 0)), T, D, FF}; pg8::TailOrder S; S.init(D, FF, nb, bid, rt); pg8::EpiResAdd E{(float*)(ws + WS_X), D, (float*)(ws + WS_PART)};
          pg8::gemm_phase<pg8::EpiResAdd, pg8::TailOrder, true, true>(lds, g, S, E, tid); }
#endif
        GSYNC();
    }
#ifndef NO_NORM
    { PH_BEGIN(); float* X = (float*)(ws + WS_X); norm_rows(X, X + (size_t)TP * D, kp->in[30], nullptr, nullptr, kp->out + O_Y, (const float*)(ws + WS_PART), gw, ngw, lane); }
#endif
}

extern "C" void kernel_launch(void* const* d_in, const int* in_sizes, int n_in, void* d_out, int out_size, void* d_ws, size_t ws_size, hipStream_t stream) {
    static int grid = 0;
    if (grid == 0) {
        if (n_in != 31 || (size_t)out_size != O_END || ws_size < WS_END) { fprintf(stderr, "kernel_launch: unexpected shapes: n_in %d out %d ws %zu (need %zu)\n", n_in, out_size, ws_size, (size_t)WS_END); grid = -1; return; }
        int dev = 0, cus = 0, per_cu = 0;
        hipGetDevice(&dev);
        hipDeviceGetAttribute(&cus, hipDeviceAttributeMultiprocessorCount, dev);
        if (hipFuncSetAttribute((const void*)fwd_mega, hipFuncAttributeMaxDynamicSharedMemorySize, LDS_BYTES) != hipSuccess) { fprintf(stderr, "kernel_launch: hipFuncSetAttribute failed\n"); grid = -1; return; }
        hipOccupancyMaxActiveBlocksPerMultiprocessor(&per_cu, (const void*)fwd_mega, NTHR, LDS_BYTES);
        (void)hipGetLastError();
        if (per_cu < 1) { fprintf(stderr, "kernel_launch: occupancy query says %d blocks per CU\n", per_cu); per_cu = 1; }
        grid = cus * 1;
    }
    if (grid < 0) return;
    Params p{};
    for (int i = 0; i < 31; ++i) p.in[i] = (const float*)d_in[i];
    p.out = (float*)d_out; p.ws = (unsigned char*)d_ws;
    if (hipMemsetAsync(d_ws, 0, 65536, stream) != hipSuccess) { fprintf(stderr, "kernel_launch: memset failed\n"); return; }
    void* args[] = {&p};
    hipError_t e = hipLaunchCooperativeKernel((const void*)fwd_mega, dim3(grid), dim3(NTHR), args, LDS_BYTES, stream);
    if (e != hipSuccess) fprintf(stderr, "cooperative launch failed: %s (grid %d)\n", hipGetErrorString(e), grid);
}
```

```cpp
#include <hip/hip_runtime.h>
#include <hip/hip_cooperative_groups.h>
#include <cstdio>
#include <cstdint>
namespace cg = cooperative_groups;

namespace pg8 {
#define PG8_LAS __attribute__((address_space(3)))
typedef unsigned short bf16_t;
typedef short bf16x8 __attribute__((ext_vector_type(8)));
typedef float f32x4 __attribute__((ext_vector_type(4)));
typedef unsigned u32x4 __attribute__((ext_vector_type(4)));
constexpr int BM = 256, BK = 64, HALF = 128, HTB = HALF * BK * 2  , STAGE_BYTES = 8 * HTB, NXCD = 8, WGM = 8;

__host__ __device__ __forceinline__ int lds_byte(int r, int c) { const int st = (r >> 4) * 2 + (c >> 5), rr = r & 15, cc = c & 31, ob = rr * 64 + cc * 2; return st * 1024 + (ob ^ (((ob >> 9) & 1) << 5)); }
__host__ __device__ __forceinline__ void stage_rc(int b, int& R, int& C) { const int st = b / 1024, sb = b % 1024, swz = sb ^ (((sb >> 9) & 1) << 5); R = (st >> 1) * 16 + swz / 64; C = (st & 1) * 32 + (swz % 64) / 2; }
__host__ __device__ __forceinline__ int perm32(int rho) { const int n = rho >> 4, i = rho & 15; return 8 * (i >> 2) + 4 * n + (i & 3); }

struct Unit { int pm, pn, k0, nt, part; };
struct Gemm { const bf16_t* A; const bf16_t* Bt; int M, N, K; };

struct StaticOrder {
    int nM, nN, nwg, G, c, ntfull;
    __host__ __device__ void init(int M, int N, int K, int G_, int c_) { nM = M / BM; nN = N / BM; nwg = nM * nN; G = G_; c = c_; ntfull = K / BK; }
    __host__ __device__ __forceinline__ bool next(int i, Unit& u) const {
        const long L = (long)i * G + c; if (L >= nwg) return false;
        int wgid = (int)L; { const int q = nwg / NXCD, r = nwg % NXCD, xcd = wgid % NXCD, off = wgid / NXCD; wgid = (xcd < r ? xcd * (q + 1) : r * (q + 1) + (xcd - r) * q) + off; }
        const int nig = WGM * nN, gid = wgid / nig, fm = gid * WGM, gsz = (nM - fm) < WGM ? (nM - fm) : WGM;
        u.pm = fm + ((wgid % nig) % gsz); u.pn = (wgid % nig) / gsz; u.k0 = 0; u.nt = ntfull; u.part = -1; return true;
    }
    __device__ __forceinline__ void a_ready(const Unit&) const {}
    __device__ __forceinline__ void done(const Unit&) const {}
};


struct TailOrder {
    int nN, G, c, ntfull, skip;
    __host__ __device__ void init(int N, int K, int G_, int c_, int skip_ = 0) { nN = N / BM; G = G_; c = c_; ntfull = K / BK; skip = skip_; }
    __host__ __device__ __forceinline__ bool next(int i, Unit& u) const {
        const int nfull = 32 * nN, L = i * G + c + skip * nfull;
        if (L >= nfull + 4 * nN * 8) return false;
        const bool full = L < nfull;
        int wgid = full ? L : 0; { const int q = nfull / NXCD, r = nfull % NXCD, xcd = wgid % NXCD, off = wgid / NXCD; wgid = (xcd < r ? xcd * (q + 1) : r * (q + 1) + (xcd - r) * q) + off; }
        const int nig = WGM * nN, gid = wgid / nig, fm = gid * WGM;
        const int fpm = fm + ((wgid % nig) % WGM), fpn = (wgid % nig) / WGM;
        const int ut = full ? 0 : L - nfull, tile = ut >> 3, ks = ut & 7, base = (ntfull / 8) & ~1, extra = (ntfull - 8 * base) / 2;
        const int tpm = 32 + tile / nN, tpn = tile % nN, tnt = base + (ks < extra ? 2 : 0), tk0 = ks * base + 2 * (ks < extra ? ks : extra);
        Unit r_; r_.pm = full ? fpm : tpm; r_.pn = full ? fpn : tpn; r_.k0 = full ? 0 : tk0; r_.nt = full ? ntfull : tnt; r_.part = full ? -1 : ks;
        u = r_; return true;
    }
    __device__ __forceinline__ void a_ready(const Unit&) const {}
    __device__ __forceinline__ void done(const Unit&) const {}
};

__device__ __forceinline__ unsigned cvt_pk_bf16(float lo, float hi) { unsigned r; asm volatile("v_cvt_pk_bf16_f32 %0, %1, %2" : "=v"(r) : "v"(lo), "v"(hi)); return r; }

struct EpiStoreBf16 {
    static constexpr bool PERM = true, AFTER_DRAIN = false;
    bf16_t* O; int ldc;
    __device__ __forceinline__ void operator()(const f32x4 (&acc)[2][2][4][2], const Unit& u, int wr, int wc, int fr, int fq) const {
        const int row0 = u.pm * BM + wr * 64 + fr, col0 = u.pn * BM + wc * 32 + 8 * fq;
#pragma unroll
        for (int ai = 0; ai < 2; ++ai)
#pragma unroll
            for (int m = 0; m < 4; ++m) { bf16_t* rowp = O + (size_t)(row0 + ai * HALF + m * 16) * ldc + col0;
#pragma unroll
                for (int bj = 0; bj < 2; ++bj) { const f32x4 v0 = acc[ai][bj][m][0], v1 = acc[ai][bj][m][1];
                    u32x4 w; w.x = cvt_pk_bf16(v0[0], v0[1]); w.y = cvt_pk_bf16(v0[2], v0[3]); w.z = cvt_pk_bf16(v1[0], v1[1]); w.w = cvt_pk_bf16(v1[2], v1[3]);
                    *(u32x4*)(rowp + bj * HALF) = w; } }
    }
};
struct EpiResAdd {
    static constexpr bool PERM = true, AFTER_DRAIN = false;
    float* O; int ldc; float* P;
    __device__ __forceinline__ void operator()(const f32x4 (&acc)[2][2][4][2], const Unit& u, int wr, int wc, int fr, int fq) const {
        const int row0 = u.pm * BM + wr * 64 + fr, col0 = u.pn * BM + wc * 32 + 8 * fq;
        if (u.part < 0) {
#pragma unroll
            for (int ai = 0; ai < 2; ++ai)
#pragma unroll
                for (int m = 0; m < 4; ++m) { float* rowp = O + (size_t)(row0 + ai * HALF + m * 16) * ldc + col0;
#pragma unroll
                    for (int bj = 0; bj < 2; ++bj) {
                        f32x4 a = *(const f32x4*)(rowp + bj * HALF), b = *(const f32x4*)(rowp + bj * HALF + 4);
                        *(f32x4*)(rowp + bj * HALF) = a + acc[ai][bj][m][0]; *(f32x4*)(rowp + bj * HALF + 4) = b + acc[ai][bj][m][1]; } }
        } else {
            float* base = P + (size_t)u.part * 1024 * ldc;
#pragma unroll
            for (int ai = 0; ai < 2; ++ai)
#pragma unroll
                for (int m = 0; m < 4; ++m) { float* rowp = base + (size_t)(row0 - 8192 + ai * HALF + m * 16) * ldc + col0;
#pragma unroll
                    for (int bj = 0; bj < 2; ++bj) { *(f32x4*)(rowp + bj * HALF) = acc[ai][bj][m][0]; *(f32x4*)(rowp + bj * HALF + 4) = acc[ai][bj][m][1]; } }
        }
    }
};
struct EpiSwiGLU {
    static constexpr bool PERM = true, AFTER_DRAIN = false;
    bf16_t* O; int ldc;
    __device__ __forceinline__ void operator()(const f32x4 (&acc)[2][2][4][2], const Unit& u, int wr, int wc, int fr, int fq) const {
        const int row0 = u.pm * BM + wr * 64 + fr, col0 = u.pn * HALF + wc * 32 + 8 * fq;
#pragma unroll
        for (int ai = 0; ai < 2; ++ai)
#pragma unroll
            for (int m = 0; m < 4; ++m) { bf16_t* rowp = O + (size_t)(row0 + ai * HALF + m * 16) * ldc + col0;
                float o[8];
#pragma unroll
                for (int n = 0; n < 2; ++n)
#pragma unroll
                    for (int j = 0; j < 4; ++j) { const float g = acc[ai][0][m][n][j], up = acc[ai][1][m][n][j]; o[n * 4 + j] = g * up * __builtin_amdgcn_rcpf(1.0f + __expf(-g)); }
                u32x4 w; w.x = cvt_pk_bf16(o[0], o[1]); w.y = cvt_pk_bf16(o[2], o[3]); w.z = cvt_pk_bf16(o[4], o[5]); w.w = cvt_pk_bf16(o[6], o[7]);
                *(u32x4*)rowp = w; }
    }
};

template <class Epi, class Sched, bool ALIGN_EPI = false, bool SP2 = false>
__device__ __forceinline__ void gemm_phase(PG8_LAS unsigned char* lds, const Gemm g, const Sched& S, const Epi& E, const int tid) {
    const int wid = __builtin_amdgcn_readfirstlane(tid >> 6), lane = tid & 63, wr = wid >> 2, wc = wid & 3, fr = lane & 15, fq = lane >> 4;
    const int K = g.K;
    unsigned voffA[2], voffB[2];
#pragma unroll
    for (int i = 0; i < 2; ++i) { int R, C; stage_rc(tid * 16 + i * 8192, R, C); const int Rb = Epi::PERM ? ((R & ~31) + perm32(R & 31)) : R;
        voffA[i] = (unsigned)(R * K + C) * 2u; voffB[i] = (unsigned)(Rb * K + C) * 2u; }
    const size_t kstep = (size_t)(BK * 2);
    const size_t hstep = (size_t)HALF * K * 2;
    const size_t tstep = 2 * hstep;
    const unsigned ldsw = (unsigned)wid * 1024u;
    const int aoff = lds_byte(wr * 64 + fr, fq * 8), boff = lds_byte(wc * 32 + fr, fq * 8);
#define PG8_SA(b, h) (((b) * 2 + (h)) * HTB)
#define PG8_SB(b, h) ((4 + (b) * 2 + (h)) * HTB)
#define PG8_STAGE(bufoff, gbase, voff) do { _Pragma("unroll") for (int _i = 0; _i < 2; ++_i) \
        __builtin_amdgcn_global_load_lds((const unsigned*)((const char*)(gbase) + (voff)[_i]), (PG8_LAS unsigned*)(lds + (bufoff) + ldsw + _i * 8192), 16, 0, 0); } while (0)
#define PG8_LDA(dst, b, h) do { _Pragma("unroll") for (int m = 0; m < 4; ++m) _Pragma("unroll") for (int k = 0; k < 2; ++k) dst[m][k] = *(const PG8_LAS bf16x8*)(lds + PG8_SA(b, h) + aoff + m * 2048 + k * 1024); } while (0)
#define PG8_LDB(dst, b, h) do { _Pragma("unroll") for (int n = 0; n < 2; ++n) _Pragma("unroll") for (int k = 0; k < 2; ++k) dst[n][k] = *(const PG8_LAS bf16x8*)(lds + PG8_SB(b, h) + boff + n * 2048 + k * 1024); } while (0)
#define PG8_MMA(ai, bj, At, Bt) do { __builtin_amdgcn_s_setprio(1); _Pragma("unroll") for (int m = 0; m < 4; ++m) _Pragma("unroll") for (int n = 0; n < 2; ++n) _Pragma("unroll") for (int k = 0; k < 2; ++k) \
        acc[ai][bj][m][n] = __builtin_amdgcn_mfma_f32_16x16x32_bf16(Bt[n][k], At[m][k], acc[ai][bj][m][n], 0, 0, 0); __builtin_amdgcn_s_setprio(0); } while (0)
#define PG8_WAIT_V(n) asm volatile("s_waitcnt vmcnt(" #n ")" ::: "memory")
#define PG8_WAIT_L(n) asm volatile("s_waitcnt lgkmcnt(" #n ")" ::: "memory")
#define PG8_BAR __builtin_amdgcn_s_barrier()
#define PG8_SCHED __builtin_amdgcn_sched_barrier(0)
    Unit cur, nxt; int ui = 0;
    if (!S.next(0, cur)) return;
    f32x4 acc[2][2][4][2];
#pragma unroll
    for (int a = 0; a < 2; ++a)
#pragma unroll
        for (int b = 0; b < 2; ++b)
#pragma unroll
            for (int m = 0; m < 4; ++m)
#pragma unroll
                for (int n = 0; n < 2; ++n) acc[a][b][m][n] = (f32x4){0.f, 0.f, 0.f, 0.f};
    bf16x8 At[4][2], B0[2][2], B1[2][2];
    const char* cA = (const char*)g.A + (size_t)cur.pm * tstep + (size_t)cur.k0 * kstep; const char* cB = (const char*)g.Bt + (size_t)cur.pn * tstep + (size_t)cur.k0 * kstep;
    S.a_ready(cur);
    if constexpr (SP2) {
        PG8_STAGE(PG8_SB(0, 0), cB, voffB); PG8_STAGE(PG8_SB(0, 1), cB + hstep, voffB); PG8_STAGE(PG8_SA(0, 0), cA, voffA); PG8_STAGE(PG8_SA(0, 1), cA + hstep, voffA);
        if (wr == 1) PG8_BAR;
        PG8_WAIT_V(2); PG8_BAR;
        PG8_STAGE(PG8_SB(1, 0), cB + kstep, voffB); PG8_STAGE(PG8_SA(1, 0), cA + kstep, voffA); PG8_STAGE(PG8_SB(1, 1), cB + hstep + kstep, voffB);
        PG8_WAIT_V(6); PG8_BAR;
    } else {
        PG8_STAGE(PG8_SB(0, 0), cB, voffB); PG8_STAGE(PG8_SA(0, 0), cA, voffA); PG8_STAGE(PG8_SB(0, 1), cB + hstep, voffB); PG8_STAGE(PG8_SA(0, 1), cA + hstep, voffA);
        if (wr == 1) PG8_BAR;
        PG8_WAIT_V(4); PG8_BAR;
        PG8_STAGE(PG8_SB(1, 0), cB + kstep, voffB); PG8_STAGE(PG8_SA(1, 0), cA + kstep, voffA); PG8_STAGE(PG8_SB(1, 1), cB + hstep + kstep, voffB);
        PG8_WAIT_V(6); PG8_BAR;
    }
    for (;;) {
        const bool has_next = S.next(ui + 1, nxt);
        const char* nA = has_next ? (const char*)g.A + (size_t)nxt.pm * tstep + (size_t)nxt.k0 * kstep : cA; const char* nB = has_next ? (const char*)g.Bt + (size_t)nxt.pn * tstep + (size_t)nxt.k0 * kstep : cB;
        const int nt = cur.nt;
        for (int t = 0; t < nt; t += 2) {
            const bool last = (t == nt - 2);
            const char* a1 = cA + (size_t)(t + 1) * kstep;
            const char* a2 = last ? nA : cA + (size_t)(t + 2) * kstep; const char* b2 = last ? nB : cB + (size_t)(t + 2) * kstep;
            const char* a3 = a2 + kstep; const char* b3 = b2 + kstep;
            if (last && has_next) S.a_ready(nxt);
            if constexpr (SP2) {
            PG8_LDB(B0, 0, 0); PG8_LDB(B1, 0, 1); PG8_SCHED; PG8_LDA(At, 0, 0); PG8_STAGE(PG8_SA(1, 1), a1 + hstep, voffA);
            PG8_WAIT_V(8); PG8_WAIT_L(0); PG8_BAR; PG8_MMA(0, 0, At, B0); PG8_MMA(0, 1, At, B1); PG8_BAR; PG8_SCHED;
            PG8_LDA(At, 0, 1); PG8_STAGE(PG8_SB(0, 0), b2, voffB); PG8_STAGE(PG8_SB(0, 1), b2 + hstep, voffB); PG8_STAGE(PG8_SA(0, 0), a2, voffA);
            PG8_WAIT_V(8); PG8_WAIT_L(0); PG8_BAR; PG8_MMA(1, 0, At, B0); PG8_MMA(1, 1, At, B1); PG8_BAR; PG8_SCHED;
            PG8_LDB(B0, 1, 0); PG8_LDB(B1, 1, 1); PG8_SCHED; PG8_LDA(At, 1, 0); PG8_STAGE(PG8_SA(0, 1), a2 + hstep, voffA);
            PG8_WAIT_V(8); PG8_WAIT_L(0); PG8_BAR; PG8_MMA(0, 0, At, B0); PG8_MMA(0, 1, At, B1); PG8_BAR; PG8_SCHED;
            PG8_LDA(At, 1, 1); PG8_STAGE(PG8_SB(1, 0), b3, voffB); PG8_STAGE(PG8_SB(1, 1), b3 + hstep, voffB); PG8_STAGE(PG8_SA(1, 0), a3, voffA);
            PG8_WAIT_V(8); PG8_WAIT_L(0); PG8_BAR; PG8_MMA(1, 0, At, B0); PG8_MMA(1, 1, At, B1); PG8_BAR; PG8_SCHED;
            } else {
            PG8_LDB(B0, 0, 0); PG8_SCHED; PG8_LDA(At, 0, 0); PG8_STAGE(PG8_SA(1, 1), a1 + hstep, voffA);
            PG8_WAIT_L(8); PG8_BAR; PG8_WAIT_L(0); PG8_MMA(0, 0, At, B0); PG8_BAR; PG8_SCHED;
            PG8_LDB(B1, 0, 1); PG8_STAGE(PG8_SB(0, 0), b2, voffB);
            PG8_BAR; PG8_WAIT_L(0); PG8_MMA(0, 1, At, B1); PG8_BAR;
            PG8_LDA(At, 0, 1); PG8_STAGE(PG8_SA(0, 0), a2, voffA);
            PG8_BAR; PG8_WAIT_L(0); PG8_MMA(1, 0, At, B0); PG8_BAR; PG8_SCHED;
            PG8_STAGE(PG8_SB(0, 1), b2 + hstep, voffB);
            PG8_WAIT_V(6); PG8_BAR; PG8_MMA(1, 1, At, B1); PG8_BAR;
            PG8_LDB(B0, 1, 0); PG8_SCHED; PG8_LDA(At, 1, 0); PG8_STAGE(PG8_SA(0, 1), a2 + hstep, voffA);
            PG8_WAIT_L(8); PG8_BAR; PG8_WAIT_L(0); PG8_MMA(0, 0, At, B0); PG8_BAR; PG8_SCHED;
            PG8_LDB(B1, 1, 1); PG8_STAGE(PG8_SB(1, 0), b3, voffB);
            PG8_BAR; PG8_WAIT_L(0); PG8_MMA(0, 1, At, B1); PG8_BAR;
            PG8_LDA(At, 1, 1); PG8_STAGE(PG8_SA(1, 0), a3, voffA);
            PG8_BAR; PG8_WAIT_L(0); PG8_MMA(1, 0, At, B0); PG8_BAR; PG8_SCHED;
            PG8_STAGE(PG8_SB(1, 1), b3 + hstep, voffB);
            PG8_WAIT_V(6); PG8_BAR; PG8_MMA(1, 1, At, B1); PG8_BAR;
            }
        }
        if constexpr (ALIGN_EPI) { if (wr == 0) PG8_BAR; }
        if constexpr (!Epi::AFTER_DRAIN) { E(acc, cur, wr, wc, fr, fq); S.done(cur); }
        if (!has_next) break;
#pragma unroll
        for (int a = 0; a < 2; ++a)
#pragma unroll
            for (int b = 0; b < 2; ++b)
#pragma unroll
                for (int m = 0; m < 4; ++m)
#pragma unroll
                    for (int n = 0; n < 2; ++n) acc[a][b][m][n] = (f32x4){0.f, 0.f, 0.f, 0.f};
        cur = nxt; cA = nA; cB = nB; ++ui;
        if constexpr (ALIGN_EPI) { if (wr == 1) PG8_BAR; }
    }
    PG8_WAIT_V(0);
    if constexpr (!ALIGN_EPI) { if (wr == 0) PG8_BAR; }
    PG8_BAR;
    if constexpr (Epi::AFTER_DRAIN) { E.fused(acc, cur, wr, wc, fr, fq, lds, wid, lane); S.done(cur); }
#undef PG8_SA
#undef PG8_SB
#undef PG8_STAGE
#undef PG8_LDA
#undef PG8_LDB
#undef PG8_MMA
#undef PG8_WAIT_V
#undef PG8_WAIT_L
#undef PG8_BAR
#undef PG8_SCHED
}
}

#define LAS __attribute__((address_space(3)))
typedef unsigned short bf16;
typedef float f32x4 __attribute__((ext_vector_type(4)));
typedef float f32x2 __attribute__((ext_vector_type(2)));
typedef unsigned u32x4 __attribute__((ext_vector_type(4)));
typedef unsigned u32x2 __attribute__((ext_vector_type(2)));
typedef short bfx8 __attribute__((ext_vector_type(8)));
#define XB_TMO      128
#define XB_XCNT(j)  (256  + 64 * (j))
#define XB_XSUB(j)  (1280 + 64 * (j))
#define XB_XGEN(j)  (2304 + 64 * (j))
#define XB_TOP      3328
#define XB_TOPGEN   3392
#define XCD_BAR_WORDS 3456
#define XB_SPIN_CAP (1u << 18)

__device__ __forceinline__ unsigned xb_ld(unsigned* p)              { return __hip_atomic_load(p, __ATOMIC_RELAXED, __HIP_MEMORY_SCOPE_AGENT); }
__device__ __forceinline__ unsigned xb_add(unsigned* p, unsigned v) { return __hip_atomic_fetch_add(p, v, __ATOMIC_RELAXED, __HIP_MEMORY_SCOPE_AGENT); }
__device__ __forceinline__ unsigned xb_xcc_id() { return (unsigned)__builtin_amdgcn_s_getreg((3 << 11) | 20) & 0xFu; }
#define XB_SPIN(cond, bar) do { unsigned _sp = 0; while (cond) { __builtin_amdgcn_s_sleep(1); \
    if ((++_sp & 255u) == 0u) { if (xb_ld(&(bar)[XB_TMO])) break; if (_sp > XB_SPIN_CAP) { atomicAdd(&(bar)[XB_TMO], 1u); break; } } } } while (0)

struct XcdBarrier {
    unsigned* bar; unsigned x;
    volatile LAS unsigned* st;
};

__device__ __forceinline__ XcdBarrier xcd_barrier_post(unsigned* bar, volatile LAS unsigned* st, int tid) {
    XcdBarrier b; b.bar = bar; b.x = xb_xcc_id(); b.st = st;
    if (tid == 0) (void)xb_add(&bar[XB_XCNT(b.x)], 1u);
    return b;
}
__device__ __forceinline__ void xcd_barrier_complete(unsigned* bar, unsigned x, unsigned& nloc, unsigned& nx) {
    const unsigned G = gridDim.x * gridDim.y * gridDim.z;
    unsigned sum, cnt, mine, sp = 0u;
    for (;;) {
        sum = 0u; cnt = 0u; mine = 0u;
#pragma unroll
        for (unsigned j = 0; j < 16; ++j) { const unsigned c = xb_ld(&bar[XB_XCNT(j)]); sum += c; cnt += (c > 0u) ? 1u : 0u; mine = (j == x) ? c : mine; }
        if (sum == G) break;
        __builtin_amdgcn_s_sleep(1);
        if ((++sp & 255u) == 0u) { if (xb_ld(&bar[XB_TMO])) break; if (sp > XB_SPIN_CAP) { atomicAdd(&bar[XB_TMO], 1u); break; } }
    }
    nloc = mine > 0u ? mine : 1u; nx = cnt > 0u ? cnt : 1u;
}

__device__ __forceinline__ void xcd_barrier(const XcdBarrier& b, int tid) {
    asm volatile("s_waitcnt vmcnt(0)" ::: "memory");
    __syncthreads();
    if (tid == 0) {
        unsigned* bar = b.bar;
        __builtin_amdgcn_s_waitcnt(0);
        unsigned nloc = b.st[0], nx = b.st[1];
        if (nloc == 0u) { xcd_barrier_complete(bar, b.x, nloc, nx); b.st[0] = nloc; b.st[1] = nx; }
        const unsigned old = xb_add(&bar[XB_XSUB(b.x)], 1u);
        const unsigned gen = old / nloc;
        if (old + 1u == (gen + 1u) * nloc) {
            __builtin_amdgcn_fence(__ATOMIC_RELEASE, "agent");
            asm volatile("s_waitcnt vmcnt(0)" ::: "memory");
            const unsigned og = xb_add(&bar[XB_TOP], 1u);
            const unsigned tg = og / nx;
            if (og + 1u == (tg + 1u) * nx) xb_add(&bar[XB_TOPGEN], 1u);
            else XB_SPIN(xb_ld(&bar[XB_TOPGEN]) == tg, bar);
            __builtin_amdgcn_fence(__ATOMIC_ACQUIRE, "agent");
            xb_add(&bar[XB_XGEN(b.x)], 1u);
            asm volatile("s_waitcnt vmcnt(0)" ::: "memory");
        } else {
            XB_SPIN(xb_ld(&bar[XB_XGEN(b.x)]) == gen, bar);
            __builtin_amdgcn_fence(__ATOMIC_ACQUIRE, "agent");
            asm volatile("s_waitcnt vmcnt(0)" ::: "memory");
        }
    }
    __syncthreads();
}

constexpr int NWAVES = 8, NTHR = 512;
constexpr int TP = 8192, TS = 1024, T = 9216, D = 2048, NIN = 4800, NZ = 4864, FF = 5632, NGU = 11264;
constexpr int NH = 16, HS = 64, RD = 1024, RP = 3264, DEPTH = 4;
constexpr int ZQ = 1536;
constexpr float RMS_EPS = 1e-6f, LN_EPS = 1e-5f, GN_EPS = 64e-5f;
constexpr int SCR = 384;
constexpr size_t O_Y = 0;
constexpr size_t O_CONV_P = (size_t)T * D;
constexpr size_t O_POOL_P = O_CONV_P + (size_t)DEPTH * 4 * 30 * 512;
constexpr size_t O_SHIFT_P = O_POOL_P + (size_t)DEPTH * 4 * 15 * 512;
constexpr size_t O_WKV_P = O_SHIFT_P + (size_t)DEPTH * 4 * RP;
constexpr size_t O_CONV_S = O_WKV_P + (size_t)DEPTH * 4 * NH * 4096;
constexpr size_t O_POOL_S = O_CONV_S + (size_t)DEPTH * 16 * 30 * 512;
constexpr size_t O_SHIFT_S = O_POOL_S + (size_t)DEPTH * 16 * 15 * 512;
constexpr size_t O_WKV_S = O_SHIFT_S + (size_t)DEPTH * 16 * RP;
constexpr size_t O_END = O_WKV_S + (size_t)DEPTH * 16 * NH * 4096;
constexpr size_t WS_POOLW = 131072;
constexpr size_t WS_UPS = 262144;
constexpr size_t WS_WIN = 1u << 20;
constexpr size_t WS_WOUT = WS_WIN + (size_t)NZ * D * 2;
constexpr size_t WS_WGU = WS_WOUT + (size_t)D * D * 2;
constexpr size_t WS_WDN = WS_WGU + (size_t)NGU * D * 2;
constexpr size_t WS_X = WS_WDN + (size_t)D * FF * 2;
constexpr size_t WS_XN = WS_X + (size_t)T * D * 4;
constexpr size_t WS_MIX = WS_XN + (size_t)T * D * 2;
constexpr size_t WS_Z = WS_MIX + (size_t)T * D * 2;
constexpr size_t WS_ACT = WS_Z;
constexpr size_t WS_SC = WS_Z + (size_t)T * NZ * 2;
constexpr size_t WS_PART = WS_SC + (32u << 20);
constexpr size_t WS_Y = WS_SC + (size_t)T * NH * SCR * 4;
constexpr size_t WS_G = WS_Y + (size_t)T * RD * 4;
constexpr size_t WS_RK = WS_G + (size_t)T * RD * 4;
constexpr int NC = 16, CL = 128;
constexpr size_t WS_PQ = WS_RK + (size_t)T * NH * 4;
constexpr size_t WS_S0 = WS_PQ + (size_t)64 * NC * 2 * 4096 * 4;
constexpr size_t WS_GB = WS_S0 + (size_t)64 * NC * 4096 * 4;
constexpr size_t WS_W2 = WS_GB + (size_t)TP * RD * 4;
constexpr size_t WSET = WS_X - WS_WIN;
constexpr size_t WS_END = WS_W2 + WSET;
static_assert(WS_ACT + (size_t)T * FF * 2 <= WS_PART && WS_PART + (size_t)8 * 1024 * D * 4 <= WS_Y, "act / partial overlays");
constexpr int LDS_BYTES = 147456;

#ifndef REP_CVTW
#define REP_CVTW 1
#endif
#ifndef REP_YP
#define REP_YP 1
#endif
#ifndef REP_G1
#define REP_G1 1
#endif
#ifndef REP_N2
#define REP_N2 1
#endif
#ifndef REP_T4
#define REP_T4 1
#endif
#ifndef REP_G3
#define REP_G3 1
#endif
#ifndef REP_PREP
#define REP_PREP 1
#endif
#ifndef REP_POOL
#define REP_POOL 1
#endif
#ifndef REP_CONV
#define REP_CONV 1
#endif
#ifndef REP_P1
#define REP_P1 1
#endif
#ifndef REP_CB
#define REP_CB 1
#endif
#ifndef REP_MIXA
#define REP_MIXA 1
#endif
#ifndef REP_SCAN
#define REP_SCAN 1
#endif
#ifndef REP_POST
#define REP_POST 1
#endif
#ifndef REP_CVT
#define REP_CVT 1
#endif
#ifdef NO_SYNC
#define GSYNC() __syncthreads()
#else
#define GSYNC() do { int w_ = wave0; asm volatile("" : "+s"(w_)); xcd_barrier(xbar, w_ * 64 + (int)__builtin_amdgcn_mbcnt_hi(~0u, __builtin_amdgcn_mbcnt_lo(~0u, (unsigned)launder_v(0)))); } while (0)
#endif
__host__ __device__ __forceinline__ size_t sc_off(int t, int h) { return ((size_t)(((t >> 2) * NH + h) * 4 + (t & 3))) * SCR; }
struct Params { const float* in[31]; float* out; unsigned char* ws; };
typedef const __attribute__((address_space(4))) Params* KP;
__device__ __forceinline__ KP kargs() { KP k = (KP)__builtin_amdgcn_kernarg_segment_ptr(); asm volatile("" : "+s"(k)); return k; }
__device__ __forceinline__ int launder_v(int v) { asm volatile("" : "+v"(v)); return v; }
#define PH_BEGIN() KP kp = kargs(); int wave_ = wave0; asm volatile("" : "+s"(wave_)); const int wave = wave_; const int lane = (int)__builtin_amdgcn_mbcnt_hi(~0u, __builtin_amdgcn_mbcnt_lo(~0u, (unsigned)launder_v(0))); const int tid = wave * 64 + lane; \
    const int nb = gridDim.x, bid = blockIdx.x, gw = bid * NWAVES + wave, ngw = nb * NWAVES; unsigned char* const ws = kp->ws; (void)lane; (void)wave; (void)gw; (void)ngw; (void)ws; (void)nb; (void)bid

template <int M> __device__ __forceinline__ float swz_xor(float v) { return __builtin_bit_cast(float, __builtin_amdgcn_ds_swizzle(__builtin_bit_cast(int, v), 0x1f | (M << 10))); }
__device__ __forceinline__ float rowsum16(float v) { v += swz_xor<1>(v); v += swz_xor<2>(v); v += swz_xor<4>(v); v += swz_xor<8>(v); return v; }
__device__ __forceinline__ float wave_sum(float v) {
    v = rowsum16(v); v += swz_xor<16>(v);
    const int ln = (int)__builtin_amdgcn_mbcnt_hi(~0u, __builtin_amdgcn_mbcnt_lo(~0u, (unsigned)launder_v(0)));
    v += __builtin_bit_cast(float, __builtin_amdgcn_ds_bpermute((ln ^ 32) << 2, __builtin_bit_cast(int, v)));
    return v;
}
__device__ __forceinline__ unsigned f2bf(float f) { unsigned u = __builtin_bit_cast(unsigned, f); return (u + 0x7fffu + ((u >> 16) & 1u)) >> 16; }
__device__ __forceinline__ unsigned pk2(float lo, float hi) { return f2bf(lo) | (f2bf(hi) << 16); }
__device__ __forceinline__ float bf2f(bf16 v) { return __builtin_bit_cast(float, (unsigned)v << 16); }
__device__ __forceinline__ float sigm(float x) { return __builtin_amdgcn_rcpf(1.0f + __expf(-x)); }

__device__ __forceinline__ void transpose_item(const float* W, int K, int N, bf16* WT, int mode, LAS float* scr, int item, int lane) {
    const int nblk = N / 32, kb = item / nblk, nb = item % nblk, k0 = 64 * kb, n0 = 32 * nb;
    const int drow0 = (mode == 0) ? n0 : ((n0 >> 7) * 256 + (n0 & 127) + (mode == 2 ? 128 : 0));
    float wv[32];
#pragma unroll
    for (int i = 0; i < 32; ++i) { const int kk = 2 * i + (lane >> 5); wv[i] = W[(size_t)(k0 + kk) * N + n0 + (lane & 31)]; }
#pragma unroll
    for (int i = 0; i < 32; ++i) { const int kk = 2 * i + (lane >> 5); scr[kk * 33 + (lane & 31)] = wv[i]; }
    asm volatile("s_waitcnt lgkmcnt(0)" ::: "memory");
    const int c = lane & 7;
#pragma unroll
    for (int j = 0; j < 4; ++j) { const int n = (lane >> 3) + 8 * j; const LAS float* s = scr + (8 * c) * 33 + n;
        u32x4 o; o.x = pk2(s[0 * 33], s[1 * 33]); o.y = pk2(s[2 * 33], s[3 * 33]); o.z = pk2(s[4 * 33], s[5 * 33]); o.w = pk2(s[6 * 33], s[7 * 33]);
        *(u32x4*)(WT + (size_t)(drow0 + n) * K + k0 + 8 * c) = o; }
    asm volatile("s_waitcnt lgkmcnt(0)" ::: "memory");
}
__device__ __forceinline__ void convert_weights(KP kp, int l, LAS float* scr, int gw, int ngw, int lane) {
    unsigned char* ws = kp->ws;
    unsigned char* wsw = kp->ws + ((l & 1) ? (WS_W2 - WS_WIN) : 0);
    bf16* WIN = (bf16*)(wsw + WS_WIN); bf16* WOUT = (bf16*)(wsw + WS_WOUT); bf16* WGU = (bf16*)(wsw + WS_WGU); bf16* WDN = (bf16*)(wsw + WS_WDN);
    constexpr int I_IN = (D / 64) * (NIN / 32), I_OUT = (D / 64) * (D / 32), I_G = (D / 64) * (FF / 32), I_D = (FF / 64) * (D / 32);
    constexpr int I_P = 4 * 8, I_U = 3 * 32;
    constexpr int NITEMS = I_IN + I_OUT + 2 * I_G + I_D + I_P + I_U;
    for (int it = gw; it < NITEMS; it += ngw) {
        int r = it;
        if (r < I_IN) { transpose_item(kp->in[7] + (size_t)l * D * NIN, D, NIN, WIN, 0, scr, r, lane); continue; } r -= I_IN;
        if (r < I_OUT) { transpose_item(kp->in[25] + (size_t)l * D * D, D, D, WOUT, 0, scr, r, lane); continue; } r -= I_OUT;
        if (r < I_G) { transpose_item(kp->in[27] + (size_t)l * D * FF, D, FF, WGU, 1, scr, r, lane); continue; } r -= I_G;
        if (r < I_G) { transpose_item(kp->in[28] + (size_t)l * D * FF, D, FF, WGU, 2, scr, r, lane); continue; } r -= I_G;
        if (r < I_D) { transpose_item(kp->in[29] + (size_t)l * FF * D, FF, D, WDN, 0, scr, r, lane); continue; } r -= I_D;
        if (r < I_P) { const int g = r >> 3; transpose_item(kp->in[12] + (size_t)((l * 4 + g) * 128) * 128, 128, 128, (bf16*)(ws + WS_POOLW) + (size_t)g * 128 * 128, 0, scr, r & 7, lane); continue; } r -= I_P;
        { const int m = r >> 5; const float* src = (m == 0 ? kp->in[16] : (m == 1 ? kp->in[18] : kp->in[19])) + (size_t)l * 64 * RD;
          transpose_item(src, 64, RD, (bf16*)(ws + WS_UPS) + (size_t)m * RD * 64, 0, scr, r & 31, lane); }
    }
    { const unsigned z = (unsigned)launder_v(0); for (int e = gw * 64 + lane; e < 16384; e += ngw * 64) ((u32x4*)(WIN + (size_t)NIN * D))[e] = (u32x4){z, z, z, z}; }
}
__device__ __forceinline__ void norm_rows(const float* sa, const float* sb, const float* g, float* xcopy, bf16* xn, float* fout, const float* part, int gw, int ngw, int lane) {
    for (int m = gw; m < T; m += ngw) {
        const float* row = (m < TP) ? sa + (size_t)m * D : sb + (size_t)(m - TP) * D;
        f32x4 v[8]; float ss = 0.f;
#pragma unroll
        for (int j = 0; j < 8; ++j) v[j] = ((const f32x4*)row)[lane + 64 * j];
        if (part && m >= TP) {
#pragma unroll
            for (int k = 0; k < 8; ++k)
#pragma unroll
                for (int j = 0; j < 8; ++j) v[j] += ((const f32x4*)(part + ((size_t)k * 1024 + (m - TP)) * D))[lane + 64 * j];
#pragma unroll
            for (int j = 0; j < 8; ++j) ((f32x4*)(const_cast<float*>(sb) + (size_t)(m - TP) * D))[lane + 64 * j] = v[j];
        }
#pragma unroll
        for (int j = 0; j < 8; ++j) ss += (v[j].x * v[j].x + v[j].y * v[j].y) + (v[j].z * v[j].z + v[j].w * v[j].w);
        const float rinv = 1.0f / sqrtf(wave_sum(ss) * (1.0f / D) + RMS_EPS);
#pragma unroll
        for (int j = 0; j < 8; ++j) {
            if (xcopy) ((f32x4*)(xcopy + (size_t)m * D))[lane + 64 * j] = v[j];
            const f32x4 gj = ((const f32x4*)g)[lane + 64 * j];
            const f32x4 y = v[j] * rinv * gj;
            if (xn) { u32x2 o; o.x = pk2(y.x, y.y); o.y = pk2(y.z, y.w); ((u32x2*)(xn + (size_t)m * D))[lane + 64 * j] = o; }
            if (fout) ((f32x4*)(fout + (size_t)m * D))[lane + 64 * j] = y;
        }
    }
}

__device__ __forceinline__ void conv_item(KP kp, int l, int item, LAS float* lds, int tid_in) {
    const int tid = launder_v(tid_in);
    const bf16* Z = (const bf16*)(kp->ws + WS_Z); bf16* MIX = (bf16*)(kp->ws + WS_MIX);
    const int t0 = item * 32;
    int s, tau0, Ls; bool prompt;
    if (t0 < TP) { s = t0 >> 11; tau0 = t0 & 2047; Ls = 2048; prompt = true; } else { s = (t0 - TP) >> 6; tau0 = (t0 - TP) & 63; Ls = 64; prompt = false; }
    const int c = tid;
    const float* cw = kp->in[8] + (size_t)l * 31 * 512;
    float w[31];
#pragma unroll
    for (int j = 0; j < 31; ++j) w[j] = cw[j * 512 + c];
    const float bias = kp->in[9][l * 512 + c];
    float acc[32];
#pragma unroll
    for (int i = 0; i < 32; ++i) acc[i] = bias;
    const bool first = (tau0 == 0), lastit = (tau0 + 32 == Ls);
    float* oc = prompt ? kp->out + O_CONV_P + (size_t)((l * 4 + s) * 30) * 512 : kp->out + O_CONV_S + (size_t)((l * 16 + s) * 30) * 512;
    const float* cc = kp->in[2] + (size_t)((l * 16 + s) * 30) * 512;
#pragma unroll
    for (int hf = 0; hf < 2; ++hf) {
        float pv[31], pg[31];
#pragma unroll
        for (int k = 0; k < 31; ++k) { const int ii = hf * 31 + k;
            if (ii < 30 && first) { pv[k] = prompt ? 0.f : cc[ii * 512 + c]; pg[k] = 0.f; }
            else { const bf16* zr = Z + (size_t)(t0 + ii - 30) * NZ; pv[k] = bf2f(zr[c]); pg[k] = bf2f(zr[512 + c]); } }
#pragma unroll
        for (int k = 0; k < 31; ++k) { const int ii = hf * 31 + k;
            const float u = (ii < 30 && first) ? pv[k] : pv[k] * sigm(pg[k]);
            if (ii >= 32 && lastit) oc[(ii - 32) * 512 + c] = u;
#pragma unroll
            for (int oi = 0; oi < 32; ++oi) { const int j = ii - oi; if (j >= 0 && j <= 30) acc[oi] += w[j] * u; }
        }
    }
#pragma unroll
    for (int oi = 0; oi < 32; ++oi) lds[oi * 512 + c] = acc[oi];
    __syncthreads();
    const int wave = tid >> 6, lane = tid & 63;
    const f32x4 g0 = *(const f32x4*)(kp->in[10] + l * 512 + lane * 8), g1 = *(const f32x4*)(kp->in[10] + l * 512 + lane * 8 + 4);
    const f32x4 b0 = *(const f32x4*)(kp->in[11] + l * 512 + lane * 8), b1 = *(const f32x4*)(kp->in[11] + l * 512 + lane * 8 + 4);
#pragma unroll
    for (int q = 0; q < 4; ++q) {
        const int oi = wave * 4 + q;
        f32x4 a = *(const LAS f32x4*)(lds + oi * 512 + lane * 8), b = *(const LAS f32x4*)(lds + oi * 512 + lane * 8 + 4);
        const float mean = wave_sum((a.x + a.y) + (a.z + a.w) + (b.x + b.y) + (b.z + b.w)) * (1.0f / 512.0f);
        a = a - mean; b = b - mean;
        const float var = wave_sum((a.x * a.x + a.y * a.y) + (a.z * a.z + a.w * a.w) + (b.x * b.x + b.y * b.y) + (b.z * b.z + b.w * b.w)) * (1.0f / 512.0f);
        const float rstd = __builtin_amdgcn_rsqf(var + LN_EPS);
        a = a * rstd * g0 + b0; b = b * rstd * g1 + b1;
        float o[8] = {a.x, a.y, a.z, a.w, b.x, b.y, b.z, b.w};
#pragma unroll
        for (int k = 0; k < 8; ++k) o[k] = o[k] * sigm(o[k]);
        u32x4 wv; wv.x = pk2(o[0], o[1]); wv.y = pk2(o[2], o[3]); wv.z = pk2(o[4], o[5]); wv.w = pk2(o[6], o[7]);
        *(u32x4*)(MIX + (size_t)(t0 + oi) * D + lane * 8) = wv;
    }
    __syncthreads();
}
__device__ __forceinline__ void pool_item(KP kp, int l, int item, LAS unsigned char* ldsb, int tid_in) {
    const int tid = launder_v(tid_in);
    const bf16* Z = (const bf16*)(kp->ws + WS_Z); bf16* MIX = (bf16*)(kp->ws + WS_MIX);
    LAS float* pp = (LAS float*)ldsb;
    LAS bf16* db = (LAS bf16*)(ldsb + 47 * 512 * 4);
    const int t0 = item * 32;
    int s, tau0, Ls; bool prompt;
    if (t0 < TP) { s = t0 >> 11; tau0 = t0 & 2047; Ls = 2048; prompt = true; } else { s = (t0 - TP) >> 6; tau0 = (t0 - TP) & 63; Ls = 64; prompt = false; }
    const int c = tid;
    const bool first = (tau0 == 0), lastit = (tau0 + 32 == Ls);
    float* op = prompt ? kp->out + O_POOL_P + (size_t)((l * 4 + s) * 15) * 512 : kp->out + O_POOL_S + (size_t)((l * 16 + s) * 15) * 512;
    const float* cp = kp->in[3] + (size_t)((l * 16 + s) * 15) * 512;
    {
        float pvl[47];
#pragma unroll
        for (int ii = 0; ii < 47; ++ii) {
            if (ii < 15 && first) pvl[ii] = prompt ? 0.f : cp[ii * 512 + c];
            else pvl[ii] = bf2f(Z[(size_t)(t0 + ii - 15) * NZ + 1024 + c]);
        }
#pragma unroll
        for (int ii = 0; ii < 47; ++ii) {
            pp[ii * 512 + c] = pvl[ii];
            if (ii >= 32 && lastit) op[(ii - 32) * 512 + c] = pvl[ii];
        }
    }
    const int gi = c >> 7, w = 2 << gi;
    for (int oi = 0; oi < 32; ++oi) {
        float sum = 0.f;
        for (int k = 0; k < w; ++k) sum += pp[(oi + 15 - k) * 512 + c];
        const int cnt = prompt ? min(w, tau0 + oi + 1) : w;
        const float d = sum * __builtin_amdgcn_rcpf((float)cnt) - pp[(oi + 15) * 512 + c];
        db[oi * 520 + c] = (bf16)f2bf(d);
    }
    __syncthreads();
    const int lane = tid & 63, wave = tid >> 6, n16 = lane & 15, q = lane >> 4, g = wave >> 1, nh = wave & 1;
    const bf16* WT = (const bf16*)(kp->ws + WS_POOLW) + (size_t)g * 128 * 128;
    bfx8 Bf[4][4];
#pragma unroll
    for (int nt = 0; nt < 4; ++nt)
#pragma unroll
        for (int ks = 0; ks < 4; ++ks) Bf[nt][ks] = *(const bfx8*)(WT + (size_t)(nh * 64 + nt * 16 + n16) * 128 + ks * 32 + q * 8);
    float scale[4];
#pragma unroll
    for (int nt = 0; nt < 4; ++nt) scale[nt] = kp->in[13][l * 512 + g * 128 + nh * 64 + nt * 16 + n16];
#pragma unroll
    for (int mt = 0; mt < 2; ++mt) {
        bfx8 Af[4];
#pragma unroll
        for (int ks = 0; ks < 4; ++ks) Af[ks] = *(const LAS bfx8*)(db + (mt * 16 + n16) * 520 + g * 128 + ks * 32 + q * 8);
        f32x4 acc[4];
#pragma unroll
        for (int nt = 0; nt < 4; ++nt) { acc[nt] = (f32x4){0.f, 0.f, 0.f, 0.f};
#pragma unroll
            for (int ks = 0; ks < 4; ++ks) acc[nt] = __builtin_amdgcn_mfma_f32_16x16x32_bf16(Af[ks], Bf[nt][ks], acc[nt], 0, 0, 0); }
#pragma unroll
        for (int nt = 0; nt < 4; ++nt)
#pragma unroll
            for (int r = 0; r < 4; ++r) MIX[(size_t)(t0 + mt * 16 + 4 * q + r) * D + 512 + g * 128 + nh * 64 + nt * 16 + n16] = (bf16)f2bf(acc[nt][r] * scale[nt]);
    }
    __syncthreads();
}
__device__ __forceinline__ void prep_item(KP kp, int l, int item, LAS unsigned char* ldsb, int tid_in) {
    const int tid = launder_v(tid_in);
    const bf16* Z = (const bf16*)(kp->ws + WS_Z);
    float* SC = (float*)(kp->ws + WS_SC); float* G = (float*)(kp->ws + WS_G); float* RK = (float*)(kp->ws + WS_RK);
    const bf16* UPT = (const bf16*)(kp->ws + WS_UPS);
    LAS bf16* lo = (LAS bf16*)ldsb;
    const int t0 = item * 16;
    int s, tau0, Ls; bool prompt;
    if (t0 < TP) { s = t0 >> 11; tau0 = t0 & 2047; Ls = 2048; prompt = true; } else { s = (t0 - TP) >> 6; tau0 = (t0 - TP) & 63; Ls = 64; prompt = false; }
    const float* mu = kp->in[14] + (size_t)l * RP;
    const float* ssh = kp->in[4] + (size_t)(l * 16 + s) * RP;
    {
        float qv[6], qp[6], mq[6];
#pragma unroll
        for (int k = 0; k < 6; ++k) { const int e = tid + k * NTHR, tok = e / 192, col = e % 192, zc = 3072 + col, t = t0 + tok, tau = tau0 + tok;
            qv[k] = bf2f(Z[(size_t)t * NZ + ZQ + zc]);
            qp[k] = tau > 0 ? bf2f(Z[(size_t)(t - 1) * NZ + ZQ + zc]) : (prompt ? 0.f : ssh[zc]);
            mq[k] = mu[zc]; }
#pragma unroll
        for (int k = 0; k < 6; ++k) { const int e = tid + k * NTHR, tok = e / 192, col = e % 192;
            const float qs = qv[k] + (qp[k] - qv[k]) * mq[k];
            const float val = col < 64 ? (1.0f - 2.0f * __builtin_amdgcn_rcpf(1.0f + __expf(2.0f * qs))) : (col < 128 ? qs : sigm(qs));
            lo[((col >> 6) * 16 + tok) * 72 + (col & 63)] = (bf16)f2bf(val); }
    }
    __syncthreads();
    const int lane = tid & 63, wave = tid >> 6, n16 = lane & 15, q = lane >> 4;
#pragma unroll 1
    for (int hh = 0; hh < 2; ++hh) {
        const int h = wave * 2 + hh;
        f32x4 acc[3][4];
#pragma unroll
        for (int m = 0; m < 3; ++m) {
            bfx8 Af[2], Bf[4][2];
#pragma unroll
            for (int ks = 0; ks < 2; ++ks) Af[ks] = *(const LAS bfx8*)(lo + (m * 16 + n16) * 72 + ks * 32 + q * 8);
#pragma unroll
            for (int i = 0; i < 4; ++i)
#pragma unroll
                for (int ks = 0; ks < 2; ++ks) Bf[i][ks] = *(const bfx8*)(UPT + (size_t)(m * RD + h * 64 + i * 16 + n16) * 64 + ks * 32 + q * 8);
#pragma unroll
            for (int i = 0; i < 4; ++i) { acc[m][i] = (f32x4){0.f, 0.f, 0.f, 0.f};
#pragma unroll
                for (int ks = 0; ks < 2; ++ks) acc[m][i] = __builtin_amdgcn_mfma_f32_16x16x32_bf16(Af[ks], Bf[i][ks], acc[m][i], 0, 0, 0); }
        }
        float mur[4], muk[4], muv[4], w0c[4], a0c[4], kkc[4], kac[4], rkc[4], sr[4], sk[4], sv[4];
#pragma unroll
        for (int i = 0; i < 4; ++i) { const int c = h * 64 + i * 16 + n16;
            mur[i] = mu[c]; muk[i] = mu[RD + c]; muv[i] = mu[2 * RD + c];
            w0c[i] = kp->in[15][l * RD + c]; a0c[i] = kp->in[17][l * RD + c]; kkc[i] = kp->in[20][l * RD + c]; kac[i] = kp->in[21][l * RD + c]; rkc[i] = kp->in[22][l * RD + c];
            sr[i] = prompt ? 0.f : ssh[c]; sk[i] = prompt ? 0.f : ssh[RD + c]; sv[i] = prompt ? 0.f : ssh[2 * RD + c]; }
        float zc_[4][4][3], zp_[4][4][3];
#pragma unroll
        for (int r = 0; r < 4; ++r) {
            const int tok = 4 * q + r, t = t0 + tok, tau = tau0 + tok;
            const bf16* zr = Z + (size_t)t * NZ + ZQ;
#pragma unroll
            for (int i = 0; i < 4; ++i) { const int c = h * 64 + i * 16 + n16;
                zc_[r][i][0] = bf2f(zr[c]); zc_[r][i][1] = bf2f(zr[RD + c]); zc_[r][i][2] = bf2f(zr[2 * RD + c]);
                if (tau > 0) { zp_[r][i][0] = bf2f(zr[c - NZ]); zp_[r][i][1] = bf2f(zr[RD + c - NZ]); zp_[r][i][2] = bf2f(zr[2 * RD + c - NZ]); } else { zp_[r][i][0] = sr[i]; zp_[r][i][1] = sk[i]; zp_[r][i][2] = sv[i]; } }
        }
#pragma unroll
        for (int r = 0; r < 4; ++r) {
            const int tok = 4 * q + r, t = t0 + tok;
            float rv[4], kv[4], vv[4], av[4], dv[4], kk[4];
            float skk = 0.f;
#pragma unroll
            for (int i = 0; i < 4; ++i) { const int c = h * 64 + i * 16 + n16;
                float rr = zc_[r][i][0], k = zc_[r][i][1], v = zc_[r][i][2];
                rr += (zp_[r][i][0] - rr) * mur[i]; k += (zp_[r][i][1] - k) * muk[i]; v += (zp_[r][i][2] - v) * muv[i];
                const float xw = -(w0c[i] + acc[0][i][r]);
                const float sp = fmaxf(xw, 0.f) + __logf(1.0f + __expf(-fabsf(xw)));
                dv[i] = __expf(-__expf(-sp - 0.5f));
                av[i] = sigm(a0c[i] + acc[1][i][r]);
                rv[i] = rr; kv[i] = k; vv[i] = v; kk[i] = k * kkc[i]; skk += kk[i] * kk[i];
                G[(size_t)t * RD + c] = acc[2][i][r];
                }
            skk = rowsum16(skk);
            const float rinv = __builtin_amdgcn_rsqf(fmaxf(skk, 1e-24f));
            float srk = 0.f;
#pragma unroll
            for (int i = 0; i < 4; ++i) {
                const float kkn = kk[i] * rinv, kpv = kv[i] * (1.0f + (av[i] - 1.0f) * kac[i]), bb = kkn * av[i];
                srk += rv[i] * kpv * rkc[i];
                float* sc = SC + sc_off(t, h) + i * 16 + n16;
                sc[0] = dv[i]; sc[64] = kkn; sc[128] = bb; sc[192] = kpv; sc[256] = rv[i]; sc[320] = vv[i];
            }
            srk = rowsum16(srk);
            if (n16 == 0) RK[t * NH + h] = srk;
        }
    }
    if (tau0 + 16 == Ls) {
        float* osh = prompt ? kp->out + O_SHIFT_P + (size_t)(l * 4 + s) * RP : kp->out + O_SHIFT_S + (size_t)(l * 16 + s) * RP;
        const bf16* zr = Z + (size_t)(t0 + 15) * NZ + ZQ;
        for (int e = tid; e < RP; e += NTHR) osh[e] = bf2f(zr[e]);
    }
    __syncthreads();
}

__device__ __forceinline__ void sc_issue(f32x4 (&r)[4], const LAS f32x4* o, int c) {
    if (c < 4) {
#pragma unroll
        for (int i = 0; i < 4; ++i) r[i] = o[16 + 4 * c + i];
    } else { const int j = c - 4; r[0] = o[j]; r[1] = o[32 + j]; r[2] = o[48 + j]; r[3] = o[64 + j]; }
}
template <int MODE>
__device__ __forceinline__ void scan_run(const float* SC, int tg0, int nsteps, int h, LAS float* wl  , int lane,
                                         const float* Sinit, float* Y, float* GB, float* Sout, float* PQout) {
    constexpr int GS = 4, NCH = 20;
    f32x2 S[32];
    f32x2 P[(MODE == 3) ? 32 : 1];
    if (MODE == 3) {
        const int ln = launder_v(lane);
#pragma unroll
        for (int j = 0; j < 32; ++j) { S[j] = (f32x2){0.f, 0.f}; P[j] = (f32x2){(2 * j == ln) ? 1.f : 0.f, (2 * j + 1 == ln) ? 1.f : 0.f}; }
    } else {
#pragma unroll
        for (int j = 0; j < 16; ++j) { const f32x4 v = ((const f32x4*)(Sinit + lane * 64))[j]; S[2 * j] = (f32x2){v.x, v.y}; S[2 * j + 1] = (f32x2){v.z, v.w}; }
    }
#define SC_STAGE(g, buf) do { const float* rec_ = SC + sc_off(tg0 + (g) * GS, h) + lane * 4; \
        _Pragma("unroll") for (int k_ = 0; k_ < 6; ++k_) __builtin_amdgcn_global_load_lds((const unsigned*)(rec_ + k_ * 256), (LAS unsigned*)(wl + (buf) * GS * SCR + k_ * 256), 16, 0, 0); } while (0)
    SC_STAGE(0, 0);
    const int ngroups = nsteps / GS;
    for (int g = 0; g < ngroups; ++g) {
        asm volatile("s_waitcnt vmcnt(0)" ::: "memory");
        if (g + 1 < ngroups) SC_STAGE(g + 1, (g + 1) & 1);
        const LAS float* wb = wl + (g & 1) * GS * SCR;
        f32x4 R[4][4];
#pragma unroll
        for (int q = 0; q < 3; ++q) sc_issue(R[q & 3], (const LAS f32x4*)(wb + (q / NCH) * SCR), q % NCH);
        __builtin_amdgcn_sched_barrier(0);
#pragma unroll
        for (int s = 0; s < GS; ++s) {
            f32x2 d2a = (f32x2){0.f, 0.f}, y2a = (f32x2){0.f, 0.f};
            f32x2 e2a = (f32x2){0.f, 0.f}, g2a = (f32x2){0.f, 0.f};
            f32x2 sa2 = (f32x2){0.f, 0.f}, sp2 = (f32x2){0.f, 0.f};
            const float vs = wb[s * SCR + 320 + lane];
            const f32x2 v2 = (f32x2){vs, vs};
#pragma unroll
            for (int c = 0; c < NCH; ++c) {
                const int q = s * NCH + c, qn = q + 3;
                if (qn < GS * NCH) sc_issue(R[qn & 3], (const LAS f32x4*)(wb + (qn / NCH) * SCR), qn % NCH);
                __builtin_amdgcn_sched_barrier(0);
                f32x4 (&r)[4] = R[q & 3];
                if (c < 4) {
#pragma unroll
                    for (int i = 0; i < 4; ++i) { const int j = 4 * c + i; d2a += S[2 * j] * (f32x2){r[i].x, r[i].y}; d2a += S[2 * j + 1] * (f32x2){r[i].z, r[i].w};
                        if (MODE == 3) { e2a += P[2 * j] * (f32x2){r[i].x, r[i].y}; e2a += P[2 * j + 1] * (f32x2){r[i].z, r[i].w}; } }
                    if (c == 3) { const f32x2 d2 = d2a; const float sa = -(d2.x + d2.y); sa2 = (f32x2){sa, sa};
                        if (MODE == 3) { const f32x2 e2 = e2a; const float sp = -(e2.x + e2.y); sp2 = (f32x2){sp, sp}; } }
                } else {
                    const int j = c - 4;
                    f32x2 t0 = v2 * (f32x2){r[2].x, r[2].y}; t0 = sa2 * (f32x2){r[1].x, r[1].y} + t0; S[2 * j] = S[2 * j] * (f32x2){r[0].x, r[0].y} + t0;
                    f32x2 t1 = v2 * (f32x2){r[2].z, r[2].w}; t1 = sa2 * (f32x2){r[1].z, r[1].w} + t1; S[2 * j + 1] = S[2 * j + 1] * (f32x2){r[0].z, r[0].w} + t1;
                    y2a += S[2 * j] * (f32x2){r[3].x, r[3].y}; y2a += S[2 * j + 1] * (f32x2){r[3].z, r[3].w};
                    if (MODE == 3) {
                        const f32x2 u0 = sp2 * (f32x2){r[1].x, r[1].y}, u1 = sp2 * (f32x2){r[1].z, r[1].w};
                        P[2 * j] = P[2 * j] * (f32x2){r[0].x, r[0].y} + u0; P[2 * j + 1] = P[2 * j + 1] * (f32x2){r[0].z, r[0].w} + u1;
                        g2a += P[2 * j] * (f32x2){r[3].x, r[3].y}; g2a += P[2 * j + 1] * (f32x2){r[3].z, r[3].w};
                    }
                }
                __builtin_amdgcn_sched_barrier(0);
            }
            { const f32x2 y2 = y2a; Y[(size_t)(tg0 + g * GS + s) * RD + h * 64 + lane] = y2.x + y2.y; }
            if (MODE == 3) { const f32x2 g2 = g2a; GB[(size_t)(tg0 + g * GS + s) * RD + h * 64 + lane] = g2.x + g2.y; }
        }
        asm volatile("s_waitcnt lgkmcnt(0)" ::: "memory");
    }
#undef SC_STAGE
    if (MODE == 3) {
#pragma unroll
        for (int j = 0; j < 16; ++j) { ((f32x4*)PQout)[j * 64 + lane] = (f32x4){P[2 * j].x, P[2 * j].y, P[2 * j + 1].x, P[2 * j + 1].y};
                                       ((f32x4*)(PQout + 4096))[j * 64 + lane] = (f32x4){S[2 * j].x, S[2 * j].y, S[2 * j + 1].x, S[2 * j + 1].y}; }
    } else {
#pragma unroll
        for (int j = 0; j < 16; ++j) ((f32x4*)(Sout + lane * 64))[j] = (f32x4){S[2 * j].x, S[2 * j].y, S[2 * j + 1].x, S[2 * j + 1].y};
    }
}
template <int NMT>
__device__ __forceinline__ void ypost_task(KP kp, int l, const float* S0q  , int tg0, int h, int lane) {
    const float* GB = (const float*)(kp->ws + WS_GB); const float* Y = (const float*)(kp->ws + WS_Y); const float* SC = (const float*)(kp->ws + WS_SC);
    const float* G = (const float*)(kp->ws + WS_G); const float* RK = (const float*)(kp->ws + WS_RK); bf16* MIX = (bf16*)(kp->ws + WS_MIX);
    const int n = lane & 15, kq = lane >> 4;
    float Bv[4][16];
    if (S0q) {
#pragma unroll
        for (int nt = 0; nt < 4; ++nt)
#pragma unroll
            for (int ks = 0; ks < 16; ++ks) Bv[nt][ks] = S0q[(size_t)(ks * 64 + nt * 16 + n) * 4 + kq];
    }
    float gng[4], gnb[4];
#pragma unroll
    for (int nt = 0; nt < 4; ++nt) { gng[nt] = kp->in[23][l * RD + h * 64 + nt * 16 + n]; gnb[nt] = kp->in[24][l * RD + h * 64 + nt * 16 + n]; }
#pragma unroll 1
    for (int mt = 0; mt < NMT; ++mt) {
        const int tb = tg0 + mt * 16;
        float Av[16];
        if (S0q) { const float* grow = GB + (size_t)(tb + n) * RD + h * 64 + kq;
#pragma unroll
            for (int ks = 0; ks < 16; ++ks) Av[ks] = grow[ks * 4]; }
        f32x4 acc[4]; float vv[4][4], gg[4][4], rk[4];
#pragma unroll
        for (int r = 0; r < 4; ++r) { const int t = tb + 4 * kq + r; rk[r] = RK[t * NH + h];
#pragma unroll
            for (int nt = 0; nt < 4; ++nt) { acc[nt][r] = Y[(size_t)t * RD + h * 64 + nt * 16 + n]; vv[nt][r] = SC[sc_off(t, h) + 320 + nt * 16 + n]; gg[nt][r] = G[(size_t)t * RD + h * 64 + nt * 16 + n]; } }
        if (S0q) {
#pragma unroll
            for (int ks = 0; ks < 16; ++ks)
#pragma unroll
                for (int nt = 0; nt < 4; ++nt) acc[nt] = __builtin_amdgcn_mfma_f32_16x16x4f32(Av[ks], Bv[nt][ks], acc[nt], 0, 0, 0);
        }
#pragma unroll
        for (int r = 0; r < 4; ++r) {
            const int t = tb + 4 * kq + r;
            const float mean = rowsum16((acc[0][r] + acc[1][r]) + (acc[2][r] + acc[3][r])) * (1.0f / 64.0f);
            float d[4], qq = 0.f;
#pragma unroll
            for (int nt = 0; nt < 4; ++nt) { d[nt] = acc[nt][r] - mean; qq += d[nt] * d[nt]; }
            const float rstd = __builtin_amdgcn_rsqf(rowsum16(qq) * (1.0f / 64.0f) + GN_EPS);
#pragma unroll
            for (int nt = 0; nt < 4; ++nt) { const float o = ((d[nt] * rstd * gng[nt] + gnb[nt]) + rk[r] * vv[nt][r]) * gg[nt][r];
                MIX[(size_t)t * D + 1024 + h * 64 + nt * 16 + n] = (bf16)f2bf(o); }
        }
    }
}
__device__ __forceinline__ void combine_chain(const float* PQ, float* S0, float* Sfin, LAS unsigned char* lds, int tid, int wave, int lane) {
    constexpr int LDA = 66, LDB = 80;
    LAS float* Sl = (LAS float*)lds;
    LAS float* Pl = (LAS float*)(lds + 2 * 64 * LDA * 4);
    const int n = lane & 15, kq = lane >> 4, ib = wave >> 1, n0 = 32 * (wave & 1);
    for (int e = tid; e < 64 * LDA; e += NTHR) Sl[e] = 0.f;
    { const f32x4* Pc = (const f32x4*)PQ;
      for (int e = tid; e < 1024; e += NTHR) *(LAS f32x4*)(Pl + (e & 63) * LDB + (e >> 6) * 4) = Pc[e]; }
    f32x4 qn[2];
#pragma unroll
    for (int t = 0; t < 2; ++t)
#pragma unroll
        for (int r = 0; r < 4; ++r) { const int i = 16 * ib + 4 * kq + r, col = n0 + 16 * t + n; qn[t][r] = PQ[4096 + (size_t)((col >> 2) * 64 + i) * 4 + (col & 3)]; }
    for (int c = 0; c < NC; ++c) {
        f32x4 acc[2] = {qn[0], qn[1]};
        if (c + 1 < NC) { const float* Qn = PQ + (size_t)((c + 1) * 2 + 1) * 4096;
#pragma unroll
            for (int t = 0; t < 2; ++t)
#pragma unroll
                for (int r = 0; r < 4; ++r) { const int i = 16 * ib + 4 * kq + r, col = n0 + 16 * t + n; qn[t][r] = Qn[(size_t)((col >> 2) * 64 + i) * 4 + (col & 3)]; } }
        f32x4 pn0 = (f32x4){0.f, 0.f, 0.f, 0.f}, pn1 = pn0;
        if (c + 1 < NC) { const f32x4* Pn = (const f32x4*)(PQ + (size_t)((c + 1) * 2) * 4096); pn0 = Pn[tid]; pn1 = Pn[tid + 512]; }
        __syncthreads();
        const LAS float* sa = Sl + (c & 1) * 64 * LDA + (16 * ib + n) * LDA + kq;
        const LAS float* pb = Pl + (c & 1) * 64 * LDB + kq * LDB + n0 + n;
#pragma unroll
        for (int ks = 0; ks < 16; ++ks) {
            const float av = sa[4 * ks], b0 = pb[4 * ks * LDB], b1 = pb[4 * ks * LDB + 16];
            acc[0] = __builtin_amdgcn_mfma_f32_16x16x4f32(av, b0, acc[0], 0, 0, 0);
            acc[1] = __builtin_amdgcn_mfma_f32_16x16x4f32(av, b1, acc[1], 0, 0, 0);
        }
        if (c + 1 < NC) {
            LAS float* sn = Sl + ((c + 1) & 1) * 64 * LDA; float* So = S0 + (size_t)(c + 1) * 4096;
#pragma unroll
            for (int t = 0; t < 2; ++t)
#pragma unroll
                for (int r = 0; r < 4; ++r) { const int i = 16 * ib + 4 * kq + r, col = n0 + 16 * t + n;
                    sn[i * LDA + col] = acc[t][r]; So[(size_t)((col >> 2) * 64 + i) * 4 + (col & 3)] = acc[t][r]; }
            LAS float* pnl = Pl + ((c + 1) & 1) * 64 * LDB;
            *(LAS f32x4*)(pnl + (tid & 63) * LDB + (tid >> 6) * 4) = pn0; *(LAS f32x4*)(pnl + (tid & 63) * LDB + ((tid + 512) >> 6) * 4) = pn1;
        } else {
#pragma unroll
            for (int t = 0; t < 2; ++t)
#pragma unroll
                for (int r = 0; r < 4; ++r) Sfin[(16 * ib + 4 * kq + r) * 64 + n0 + 16 * t + n] = acc[t][r];
        }
    }
    __syncthreads();
}

__global__ void __launch_bounds__(NTHR, 2) fwd_mega(Params p) {
    extern __shared__ __attribute__((aligned(16))) unsigned char lds_raw[];
    LAS unsigned char* lds = (LAS unsigned char*)lds_raw;
    const int wave0 = __builtin_amdgcn_readfirstlane((int)threadIdx.x >> 6);
    volatile LAS unsigned* MISC = (volatile LAS unsigned*)(lds + 131072);
    if (threadIdx.x < 16) MISC[threadIdx.x] = 0u;
    __syncthreads();
    const XcdBarrier xbar = xcd_barrier_post((unsigned*)p.ws + 4096, MISC, (int)threadIdx.x);
    cg::this_grid().sync();

#pragma unroll 1
    for (int l = 0; l < DEPTH; ++l) {
        for (int rep = 0; rep < REP_CVT; ++rep) { PH_BEGIN();
#ifndef NO_CVT
          if (l == 0) convert_weights(kp, 0, (LAS float*)(lds + wave * 16384), gw, ngw, lane);
#endif
#ifndef NO_NORM
          float* X = (float*)(ws + WS_X); bf16* XN = (bf16*)(ws + WS_XN);
          if (l == 0) norm_rows(kp->in[0], kp->in[1], kp->in[6], X, XN, nullptr, nullptr, gw, ngw, lane);
          else norm_rows(X, X + (size_t)TP * D, kp->in[6] + l * D, nullptr, XN, nullptr, (const float*)(ws + WS_PART), gw, ngw, lane);
#endif
        }
        GSYNC();
#ifndef NO_GEMM1
        _Pragma("unroll 1") for (int rg = 0; rg < REP_G1; ++rg) { PH_BEGIN(); pg8::Gemm g{(const bf16*)(ws + WS_XN), (const bf16*)(ws + WS_WIN + ((l & 1) ? (WS_W2 - WS_WIN) : 0)), T, NZ, D}; pg8::StaticOrder S; S.init(T, NZ, D, nb, bid); pg8::EpiStoreBf16 E{(bf16*)(ws + WS_Z), NZ};
          pg8::gemm_phase<pg8::EpiStoreBf16, pg8::StaticOrder, true, true>(lds, g, S, E, tid); }
#endif
        GSYNC();
        for (int rep = 0; rep < REP_MIXA; ++rep) { PH_BEGIN();
          if (rep) __syncthreads();
          for (int it = bid; it < 1152; it += nb) {
#ifndef NO_PREP
            if (it < 576) _Pragma("unroll 1") for (int r_ = 0; r_ < REP_PREP; ++r_) prep_item(kp, l, it, lds, tid);
#endif
#ifndef NO_POOL
            if (it >= 576 && it < 864) _Pragma("unroll 1") for (int r_ = 0; r_ < REP_POOL; ++r_) pool_item(kp, l, it - 576, lds, tid);
#endif
#ifndef NO_CONV
            if (it >= 864) _Pragma("unroll 1") for (int r_ = 0; r_ < REP_CONV; ++r_) conv_item(kp, l, it - 864, (LAS float*)lds, tid);
#endif
          }
        }
        GSYNC();
#ifndef NO_SCAN
        for (int rep = 0; rep < REP_SCAN; ++rep) {
        if (rep) GSYNC();
        for (int rp = 0; rp < REP_P1; ++rp) { PH_BEGIN();
            const float* SC = (const float*)(ws + WS_SC); float* Y = (float*)(ws + WS_Y); float* PQ = (float*)(ws + WS_PQ); float* GB = (float*)(ws + WS_GB);
            LAS float* wl = (LAS float*)(lds + wave * 12288);
            if (wave >= 5 && l + 1 < DEPTH) convert_weights(kp, l + 1, (LAS float*)(lds + 98304 + (wave - 5) * 8448), bid * 3 + (wave - 5), nb * 3, lane);
            for (int task = wave * nb + bid; task < 64 * NC + 256; task += NWAVES * nb) {
                if (task < 64 * NC) {
                    const int ch = task / NC, c = task % NC, s = ch >> 4, h = ch & 15;
                    scan_run<3>(SC, s * 2048 + c * CL, CL, h, wl, lane, nullptr, Y, GB, nullptr, PQ + (size_t)((ch * NC + c) * 2) * 4096);
                } else {
                    const int ch = task - 64 * NC, b = ch >> 4, h = ch & 15;
                    scan_run<1>(SC, TP + b * 64, 64, h, wl, lane, kp->in[5] + (size_t)((l * 16 + b) * NH + h) * 4096, Y, nullptr, kp->out + O_WKV_S + (size_t)((l * 16 + b) * NH + h) * 4096, nullptr);
                }
            }
        }
        GSYNC();
        for (int rp = 0; rp < REP_CB; ++rp) { PH_BEGIN();
            for (int ch = bid; ch < 64; ch += nb) { const int s = ch >> 4, h = ch & 15;
                combine_chain((const float*)(ws + WS_PQ) + (size_t)ch * NC * 2 * 4096, (float*)(ws + WS_S0) + (size_t)ch * NC * 4096, kp->out + O_WKV_P + (size_t)((l * 4 + s) * NH + h) * 4096, lds, tid, wave, lane); }
        }
        GSYNC();
        _Pragma("unroll 1") for (int ry = 0; ry < REP_YP; ++ry) { PH_BEGIN();
            const float* S0 = (const float*)(ws + WS_S0);
            constexpr int UPC = CL / 64, NPU = 64 * NC * UPC;
            for (int u = wave * nb + bid; u < NPU + 256; u += NWAVES * nb) {
                if (u < NPU) { const int task = u / UPC, hf = u % UPC, ch = task / NC, c = task % NC, s = ch >> 4, h = ch & 15;
                    ypost_task<4>(kp, l, c == 0 ? nullptr : S0 + (size_t)(ch * NC + c) * 4096, s * 2048 + c * CL + hf * 64, h, lane); }
                else { const int ch = u - NPU, b = ch >> 4, h = ch & 15; ypost_task<4>(kp, l, nullptr, TP + b * 64, h, lane); }
            }
        }
        }
#endif
        GSYNC();
#ifndef NO_GEMM2
        { PH_BEGIN(); pg8::Gemm g{(const bf16*)(ws + WS_MIX), (const bf16*)(ws + WS_WOUT + ((l & 1) ? (WS_W2 - WS_WIN) : 0)), T, D, D}; pg8::TailOrder S; S.init(D, D, nb, bid); pg8::EpiResAdd E{(float*)(ws + WS_X), D, (float*)(ws + WS_PART)};
          pg8::gemm_phase<pg8::EpiResAdd, pg8::TailOrder, true, true>(lds, g, S, E, tid); }
#endif
        GSYNC();
#ifndef NO_NORM
        _Pragma("unroll 1") for (int rn = 0; rn < REP_N2; ++rn) { PH_BEGIN(); float* X = (float*)(ws + WS_X); norm_rows(X, X + (size_t)TP * D, kp->in[26] + l * D, nullptr, (bf16*)(ws + WS_XN), nullptr, rn == 0 ? (const float*)(ws + WS_PART) : nullptr, gw, ngw, lane); }
#endif
        GSYNC();
#ifndef NO_GEMM3
        _Pragma("unroll 1") for (int rg = 0; rg < REP_G3; ++rg) { PH_BEGIN(); pg8::Gemm g{(const bf16*)(ws + WS_XN), (const bf16*)(ws + WS_WGU + ((l & 1) ? (WS_W2 - WS_WIN) : 0)), T, NGU, D}; pg8::StaticOrder S; S.init(T, NGU, D, nb, bid); pg8::EpiSwiGLU E{(bf16*)(ws + WS_ACT), FF};
          pg8::gemm_phase<pg8::EpiSwiGLU, pg8::StaticOrder, true, true>(lds, g, S, E, tid); }
#endif
        GSYNC();
#ifndef NO_GEMM4
        _Pragma("unroll 1") for (int rt = 0; rt < REP_T4; ++rt) { PH_BEGIN(); pg8::Gemm g{(const bf16*)(ws + WS_ACT), (const bf16*)(ws + WS_WDN + ((l & 1) ? (WS_W2 - WS_WIN) : 0)), T, D, FF}; pg8::TailOrder S; S.init(D, FF, nb, bid, rt); pg8::EpiResAdd E{(float*)(ws + WS_X), D, (float*)(ws + WS_PART)};
          pg8::gemm_phase<pg8::EpiResAdd, pg8::TailOrder, true, true>(lds, g, S, E, tid); }
#endif
        GSYNC();
    }
#ifndef NO_NORM
    { PH_BEGIN(); float* X = (float*)(ws + WS_X); norm_rows(X, X + (size_t)TP * D, kp->in[30], nullptr, nullptr, kp->out + O_Y, (const float*)(ws + WS_PART), gw, ngw, lane); }
#endif
}

extern "C" void kernel_launch(void* const* d_in, const int* in_sizes, int n_in, void* d_out, int out_size, void* d_ws, size_t ws_size, hipStream_t stream) {
    static int grid = 0;
    if (grid == 0) {
        if (n_in != 31 || (size_t)out_size != O_END || ws_size < WS_END) { fprintf(stderr, "kernel_launch: unexpected shapes: n_in %d out %d ws %zu (need %zu)\n", n_in, out_size, ws_size, (size_t)WS_END); grid = -1; return; }
        int dev = 0, cus = 0, per_cu = 0;
        hipGetDevice(&dev);
        hipDeviceGetAttribute(&cus, hipDeviceAttributeMultiprocessorCount, dev);
        if (hipFuncSetAttribute((const void*)fwd_mega, hipFuncAttributeMaxDynamicSharedMemorySize, LDS_BYTES) != hipSuccess) { fprintf(stderr, "kernel_launch: hipFuncSetAttribute failed\n"); grid = -1; return; }
        hipOccupancyMaxActiveBlocksPerMultiprocessor(&per_cu, (const void*)fwd_mega, NTHR, LDS_BYTES);
        (void)hipGetLastError();
        if (per_cu < 1) { fprintf(stderr, "kernel_launch: occupancy query says %d blocks per CU\n", per_cu); per_cu = 1; }
        grid = cus * 1;
    }
    if (grid < 0) return;
    Params p{};
    for (int i = 0; i < 31; ++i) p.in[i] = (const float*)d_in[i];
    p.out = (float*)d_out; p.ws = (unsigned char*)d_ws;
    if (hipMemsetAsync(d_ws, 0, 65536, stream) != hipSuccess) { fprintf(stderr, "kernel_launch: memset failed\n"); return; }
    void* args[] = {&p};
    hipError_t e = hipLaunchCooperativeKernel((const void*)fwd_mega, dim3(grid), dim3(NTHR), args, LDS_BYTES, stream);
    if (e != hipSuccess) fprintf(stderr, "cooperative launch failed: %s (grid %d)\n", hipGetErrorString(e), grid);
}
```

```cpp
#include <hip/hip_runtime.h>
#include <hip/hip_cooperative_groups.h>
#include <cstdio>
#include <cstdint>
namespace cg = cooperative_groups;

namespace pg8 {
#define PG8_LAS __attribute__((address_space(3)))
typedef unsigned short bf16_t;
typedef short bf16x8 __attribute__((ext_vector_type(8)));
typedef float f32x4 __attribute__((ext_vector_type(4)));
typedef unsigned u32x4 __attribute__((ext_vector_type(4)));
constexpr int BM = 256, BK = 64, HALF = 128, HTB = HALF * BK * 2  , STAGE_BYTES = 8 * HTB, NXCD = 8, WGM = 8;

__host__ __device__ __forceinline__ int lds_byte(int r, int c) { const int st = (r >> 4) * 2 + (c >> 5), rr = r & 15, cc = c & 31, ob = rr * 64 + cc * 2; return st * 1024 + (ob ^ (((ob >> 9) & 1) << 5)); }
__host__ __device__ __forceinline__ void stage_rc(int b, int& R, int& C) { const int st = b / 1024, sb = b % 1024, swz = sb ^ (((sb >> 9) & 1) << 5); R = (st >> 1) * 16 + swz / 64; C = (st & 1) * 32 + (swz % 64) / 2; }
__host__ __device__ __forceinline__ int perm32(int rho) { const int n = rho >> 4, i = rho & 15; return 8 * (i >> 2) + 4 * n + (i & 3); }

struct Unit { int pm, pn, k0, nt, part; };
struct Gemm { const bf16_t* A; const bf16_t* Bt; int M, N, K; };

struct StaticOrder {
    int nM, nN, nwg, G, c, ntfull;
    __host__ __device__ void init(int M, int N, int K, int G_, int c_) { nM = M / BM; nN = N / BM; nwg = nM * nN; G = G_; c = c_; ntfull = K / BK; }
    __host__ __device__ __forceinline__ bool next(int i, Unit& u) const {
        const long L = (long)i * G + c; if (L >= nwg) return false;
        int wgid = (int)L; { const int q = nwg / NXCD, r = nwg % NXCD, xcd = wgid % NXCD, off = wgid / NXCD; wgid = (xcd < r ? xcd * (q + 1) : r * (q + 1) + (xcd - r) * q) + off; }
        const int nig = WGM * nN, gid = wgid / nig, fm = gid * WGM, gsz = (nM - fm) < WGM ? (nM - fm) : WGM;
        u.pm = fm + ((wgid % nig) % gsz); u.pn = (wgid % nig) / gsz; u.k0 = 0; u.nt = ntfull; u.part = -1; return true;
    }
    __device__ __forceinline__ void a_ready(const Unit&) const {}
    __device__ __forceinline__ void done(const Unit&) const {}
};


struct TailOrder {
    int nN, G, c, ntfull, skip;
    __host__ __device__ void init(int N, int K, int G_, int c_, int skip_ = 0) { nN = N / BM; G = G_; c = c_; ntfull = K / BK; skip = skip_; }
    __host__ __device__ __forceinline__ bool next(int i, Unit& u) const {
        const int nfull = 32 * nN, L = i * G + c + skip * nfull;
        if (L >= nfull + 4 * nN * 8) return false;
        const bool full = L < nfull;
        int wgid = full ? L : 0; { const int q = nfull / NXCD, r = nfull % NXCD, xcd = wgid % NXCD, off = wgid / NXCD; wgid = (xcd < r ? xcd * (q + 1) : r * (q + 1) + (xcd - r) * q) + off; }
        const int nig = WGM * nN, gid = wgid / nig, fm = gid * WGM;
        const int fpm = fm + ((wgid % nig) % WGM), fpn = (wgid % nig) / WGM;
        const int ut = full ? 0 : L - nfull, tile = ut >> 3, ks = ut & 7, base = (ntfull / 8) & ~1, extra = (ntfull - 8 * base) / 2;
        const int tpm = 32 + tile / nN, tpn = tile % nN, tnt = base + (ks < extra ? 2 : 0), tk0 = ks * base + 2 * (ks < extra ? ks : extra);
        Unit r_; r_.pm = full ? fpm : tpm; r_.pn = full ? fpn : tpn; r_.k0 = full ? 0 : tk0; r_.nt = full ? ntfull : tnt; r_.part = full ? -1 : ks;
        u = r_; return true;
    }
    __device__ __forceinline__ void a_ready(const Unit&) const {}
    __device__ __forceinline__ void done(const Unit&) const {}
};

__device__ __forceinline__ unsigned cvt_pk_bf16(float lo, float hi) { unsigned r; asm volatile("v_cvt_pk_bf16_f32 %0, %1, %2" : "=v"(r) : "v"(lo), "v"(hi)); return r; }

struct EpiStoreBf16 {
    static constexpr bool PERM = true, AFTER_DRAIN = false;
    bf16_t* O; int ldc;
    __device__ __forceinline__ void operator()(const f32x4 (&acc)[2][2][4][2], const Unit& u, int wr, int wc, int fr, int fq) const {
        const int row0 = u.pm * BM + wr * 64 + fr, col0 = u.pn * BM + wc * 32 + 8 * fq;
#pragma unroll
        for (int ai = 0; ai < 2; ++ai)
#pragma unroll
            for (int m = 0; m < 4; ++m) { bf16_t* rowp = O + (size_t)(row0 + ai * HALF + m * 16) * ldc + col0;
#pragma unroll
                for (int bj = 0; bj < 2; ++bj) { const f32x4 v0 = acc[ai][bj][m][0], v1 = acc[ai][bj][m][1];
                    u32x4 w; w.x = cvt_pk_bf16(v0[0], v0[1]); w.y = cvt_pk_bf16(v0[2], v0[3]); w.z = cvt_pk_bf16(v1[0], v1[1]); w.w = cvt_pk_bf16(v1[2], v1[3]);
                    *(u32x4*)(rowp + bj * HALF) = w; } }
    }
};
struct EpiResAdd {
    static constexpr bool PERM = true, AFTER_DRAIN = false;
    float* O; int ldc; float* P;
    __device__ __forceinline__ void operator()(const f32x4 (&acc)[2][2][4][2], const Unit& u, int wr, int wc, int fr, int fq) const {
        const int row0 = u.pm * BM + wr * 64 + fr, col0 = u.pn * BM + wc * 32 + 8 * fq;
        if (u.part < 0) {
#pragma unroll
            for (int ai = 0; ai < 2; ++ai)
#pragma unroll
                for (int m = 0; m < 4; ++m) { float* rowp = O + (size_t)(row0 + ai * HALF + m * 16) * ldc + col0;
#pragma unroll
                    for (int bj = 0; bj < 2; ++bj) {
                        f32x4 a = *(const f32x4*)(rowp + bj * HALF), b = *(const f32x4*)(rowp + bj * HALF + 4);
                        *(f32x4*)(rowp + bj * HALF) = a + acc[ai][bj][m][0]; *(f32x4*)(rowp + bj * HALF + 4) = b + acc[ai][bj][m][1]; } }
        } else {
            float* base = P + (size_t)u.part * 1024 * ldc;
#pragma unroll
            for (int ai = 0; ai < 2; ++ai)
#pragma unroll
                for (int m = 0; m < 4; ++m) { float* rowp = base + (size_t)(row0 - 8192 + ai * HALF + m * 16) * ldc + col0;
#pragma unroll
                    for (int bj = 0; bj < 2; ++bj) { *(f32x4*)(rowp + bj * HALF) = acc[ai][bj][m][0]; *(f32x4*)(rowp + bj * HALF + 4) = acc[ai][bj][m][1]; } }
        }
    }
};
struct EpiSwiGLU {
    static constexpr bool PERM = true, AFTER_DRAIN = false;
    bf16_t* O; int ldc;
    __device__ __forceinline__ void operator()(const f32x4 (&acc)[2][2][4][2], const Unit& u, int wr, int wc, int fr, int fq) const {
        const int row0 = u.pm * BM + wr * 64 + fr, col0 = u.pn * HALF + wc * 32 + 8 * fq;
#pragma unroll
        for (int ai = 0; ai < 2; ++ai)
#pragma unroll
            for (int m = 0; m < 4; ++m) { bf16_t* rowp = O + (size_t)(row0 + ai * HALF + m * 16) * ldc + col0;
                float o[8];
#pragma unroll
                for (int n = 0; n < 2; ++n)
#pragma unroll
                    for (int j = 0; j < 4; ++j) { const float g = acc[ai][0][m][n][j], up = acc[ai][1][m][n][j]; o[n * 4 + j] = g * up * __builtin_amdgcn_rcpf(1.0f + __expf(-g)); }
                u32x4 w; w.x = cvt_pk_bf16(o[0], o[1]); w.y = cvt_pk_bf16(o[2], o[3]); w.z = cvt_pk_bf16(o[4], o[5]); w.w = cvt_pk_bf16(o[6], o[7]);
                *(u32x4*)rowp = w; }
    }
};

template <class Epi, class Sched, bool ALIGN_EPI = false, bool SP2 = false>
__device__ __forceinline__ void gemm_phase(PG8_LAS unsigned char* lds, const Gemm g, const Sched& S, const Epi& E, const int tid) {
    const int wid = __builtin_amdgcn_readfirstlane(tid >> 6), lane = tid & 63, wr = wid >> 2, wc = wid & 3, fr = lane & 15, fq = lane >> 4;
    const int K = g.K;
    unsigned voffA[2], voffB[2];
#pragma unroll
    for (int i = 0; i < 2; ++i) { int R, C; stage_rc(tid * 16 + i * 8192, R, C); const int Rb = Epi::PERM ? ((R & ~31) + perm32(R & 31)) : R;
        voffA[i] = (unsigned)(R * K + C) * 2u; voffB[i] = (unsigned)(Rb * K + C) * 2u; }
    const size_t kstep = (size_t)(BK * 2);
    const size_t hstep = (size_t)HALF * K * 2;
    const size_t tstep = 2 * hstep;
    const unsigned ldsw = (unsigned)wid * 1024u;
    const int aoff = lds_byte(wr * 64 + fr, fq * 8), boff = lds_byte(wc * 32 + fr, fq * 8);
#define PG8_SA(b, h) (((b) * 2 + (h)) * HTB)
#define PG8_SB(b, h) ((4 + (b) * 2 + (h)) * HTB)
#define PG8_STAGE(bufoff, gbase, voff) do { _Pragma("unroll") for (int _i = 0; _i < 2; ++_i) \
        __builtin_amdgcn_global_load_lds((const unsigned*)((const char*)(gbase) + (voff)[_i]), (PG8_LAS unsigned*)(lds + (bufoff) + ldsw + _i * 8192), 16, 0, 0); } while (0)
#define PG8_LDA(dst, b, h) do { _Pragma("unroll") for (int m = 0; m < 4; ++m) _Pragma("unroll") for (int k = 0; k < 2; ++k) dst[m][k] = *(const PG8_LAS bf16x8*)(lds + PG8_SA(b, h) + aoff + m * 2048 + k * 1024); } while (0)
#define PG8_LDB(dst, b, h) do { _Pragma("unroll") for (int n = 0; n < 2; ++n) _Pragma("unroll") for (int k = 0; k < 2; ++k) dst[n][k] = *(const PG8_LAS bf16x8*)(lds + PG8_SB(b, h) + boff + n * 2048 + k * 1024); } while (0)
#define PG8_MMA(ai, bj, At, Bt) do { __builtin_amdgcn_s_setprio(1); _Pragma("unroll") for (int m = 0; m < 4; ++m) _Pragma("unroll") for (int n = 0; n < 2; ++n) _Pragma("unroll") for (int k = 0; k < 2; ++k) \
        acc[ai][bj][m][n] = __builtin_amdgcn_mfma_f32_16x16x32_bf16(Bt[n][k], At[m][k], acc[ai][bj][m][n], 0, 0, 0); __builtin_amdgcn_s_setprio(0); } while (0)
#define PG8_WAIT_V(n) asm volatile("s_waitcnt vmcnt(" #n ")" ::: "memory")
#define PG8_WAIT_L(n) asm volatile("s_waitcnt lgkmcnt(" #n ")" ::: "memory")
#define PG8_BAR __builtin_amdgcn_s_barrier()
#define PG8_SCHED __builtin_amdgcn_sched_barrier(0)
    Unit cur, nxt; int ui = 0;
    if (!S.next(0, cur)) return;
    f32x4 acc[2][2][4][2];
#pragma unroll
    for (int a = 0; a < 2; ++a)
#pragma unroll
        for (int b = 0; b < 2; ++b)
#pragma unroll
            for (int m = 0; m < 4; ++m)
#pragma unroll
                for (int n = 0; n < 2; ++n) acc[a][b][m][n] = (f32x4){0.f, 0.f, 0.f, 0.f};
    bf16x8 At[4][2], B0[2][2], B1[2][2];
    const char* cA = (const char*)g.A + (size_t)cur.pm * tstep + (size_t)cur.k0 * kstep; const char* cB = (const char*)g.Bt + (size_t)cur.pn * tstep + (size_t)cur.k0 * kstep;
    S.a_ready(cur);
    if constexpr (SP2) {
        PG8_STAGE(PG8_SB(0, 0), cB, voffB); PG8_STAGE(PG8_SB(0, 1), cB + hstep, voffB); PG8_STAGE(PG8_SA(0, 0), cA, voffA); PG8_STAGE(PG8_SA(0, 1), cA + hstep, voffA);
        if (wr == 1) PG8_BAR;
        PG8_WAIT_V(2); PG8_BAR;
        PG8_STAGE(PG8_SB(1, 0), cB + kstep, voffB); PG8_STAGE(PG8_SA(1, 0), cA + kstep, voffA); PG8_STAGE(PG8_SB(1, 1), cB + hstep + kstep, voffB);
        PG8_WAIT_V(6); PG8_BAR;
    } else {
        PG8_STAGE(PG8_SB(0, 0), cB, voffB); PG8_STAGE(PG8_SA(0, 0), cA, voffA); PG8_STAGE(PG8_SB(0, 1), cB + hstep, voffB); PG8_STAGE(PG8_SA(0, 1), cA + hstep, voffA);
        if (wr == 1) PG8_BAR;
        PG8_WAIT_V(4); PG8_BAR;
        PG8_STAGE(PG8_SB(1, 0), cB + kstep, voffB); PG8_STAGE(PG8_SA(1, 0), cA + kstep, voffA); PG8_STAGE(PG8_SB(1, 1), cB + hstep + kstep, voffB);
        PG8_WAIT_V(6); PG8_BAR;
    }
    for (;;) {
        const bool has_next = S.next(ui + 1, nxt);
        const char* nA = has_next ? (const char*)g.A + (size_t)nxt.pm * tstep + (size_t)nxt.k0 * kstep : cA; const char* nB = has_next ? (const char*)g.Bt + (size_t)nxt.pn * tstep + (size_t)nxt.k0 * kstep : cB;
        const int nt = cur.nt;
        for (int t = 0; t < nt; t += 2) {
            const bool last = (t == nt - 2);
            const char* a1 = cA + (size_t)(t + 1) * kstep;
            const char* a2 = last ? nA : cA + (size_t)(t + 2) * kstep; const char* b2 = last ? nB : cB + (size_t)(t + 2) * kstep;
            const char* a3 = a2 + kstep; const char* b3 = b2 + kstep;
            if (last && has_next) S.a_ready(nxt);
            if constexpr (SP2) {
            PG8_LDB(B0, 0, 0); PG8_LDB(B1, 0, 1); PG8_SCHED; PG8_LDA(At, 0, 0); PG8_STAGE(PG8_SA(1, 1), a1 + hstep, voffA);
            PG8_WAIT_V(8); PG8_WAIT_L(0); PG8_BAR; PG8_MMA(0, 0, At, B0); PG8_MMA(0, 1, At, B1); PG8_BAR; PG8_SCHED;
            PG8_LDA(At, 0, 1); PG8_STAGE(PG8_SB(0, 0), b2, voffB); PG8_STAGE(PG8_SB(0, 1), b2 + hstep, voffB); PG8_STAGE(PG8_SA(0, 0), a2, voffA);
            PG8_WAIT_V(8); PG8_WAIT_L(0); PG8_BAR; PG8_MMA(1, 0, At, B0); PG8_MMA(1, 1, At, B1); PG8_BAR; PG8_SCHED;
            PG8_LDB(B0, 1, 0); PG8_LDB(B1, 1, 1); PG8_SCHED; PG8_LDA(At, 1, 0); PG8_STAGE(PG8_SA(0, 1), a2 + hstep, voffA);
            PG8_WAIT_V(8); PG8_WAIT_L(0); PG8_BAR; PG8_MMA(0, 0, At, B0); PG8_MMA(0, 1, At, B1); PG8_BAR; PG8_SCHED;
            PG8_LDA(At, 1, 1); PG8_STAGE(PG8_SB(1, 0), b3, voffB); PG8_STAGE(PG8_SB(1, 1), b3 + hstep, voffB); PG8_STAGE(PG8_SA(1, 0), a3, voffA);
            PG8_WAIT_V(8); PG8_WAIT_L(0); PG8_BAR; PG8_MMA(1, 0, At, B0); PG8_MMA(1, 1, At, B1); PG8_BAR; PG8_SCHED;
            } else {
            PG8_LDB(B0, 0, 0); PG8_SCHED; PG8_LDA(At, 0, 0); PG8_STAGE(PG8_SA(1, 1), a1 + hstep, voffA);
            PG8_WAIT_L(8); PG8_BAR; PG8_WAIT_L(0); PG8_MMA(0, 0, At, B0); PG8_BAR; PG8_SCHED;
            PG8_LDB(B1, 0, 1); PG8_STAGE(PG8_SB(0, 0), b2, voffB);
            PG8_BAR; PG8_WAIT_L(0); PG8_MMA(0, 1, At, B1); PG8_BAR;
            PG8_LDA(At, 0, 1); PG8_STAGE(PG8_SA(0, 0), a2, voffA);
            PG8_BAR; PG8_WAIT_L(0); PG8_MMA(1, 0, At, B0); PG8_BAR; PG8_SCHED;
            PG8_STAGE(PG8_SB(0, 1), b2 + hstep, voffB);
            PG8_WAIT_V(6); PG8_BAR; PG8_MMA(1, 1, At, B1); PG8_BAR;
            PG8_LDB(B0, 1, 0); PG8_SCHED; PG8_LDA(At, 1, 0); PG8_STAGE(PG8_SA(0, 1), a2 + hstep, voffA);
            PG8_WAIT_L(8); PG8_BAR; PG8_WAIT_L(0); PG8_MMA(0, 0, At, B0); PG8_BAR; PG8_SCHED;
            PG8_LDB(B1, 1, 1); PG8_STAGE(PG8_SB(1, 0), b3, voffB);
            PG8_BAR; PG8_WAIT_L(0); PG8_MMA(0, 1, At, B1); PG8_BAR;
            PG8_LDA(At, 1, 1); PG8_STAGE(PG8_SA(1, 0), a3, voffA);
            PG8_BAR; PG8_WAIT_L(0); PG8_MMA(1, 0, At, B0); PG8_BAR; PG8_SCHED;
            PG8_STAGE(PG8_SB(1, 1), b3 + hstep, voffB);
            PG8_WAIT_V(6); PG8_BAR; PG8_MMA(1, 1, At, B1); PG8_BAR;
            }
        }
        if constexpr (ALIGN_EPI) { if (wr == 0) PG8_BAR; }
        if constexpr (!Epi::AFTER_DRAIN) { E(acc, cur, wr, wc, fr, fq); S.done(cur); }
        if (!has_next) break;
#pragma unroll
        for (int a = 0; a < 2; ++a)
#pragma unroll
            for (int b = 0; b < 2; ++b)
#pragma unroll
                for (int m = 0; m < 4; ++m)
#pragma unroll
                    for (int n = 0; n < 2; ++n) acc[a][b][m][n] = (f32x4){0.f, 0.f, 0.f, 0.f};
        cur = nxt; cA = nA; cB = nB; ++ui;
        if constexpr (ALIGN_EPI) { if (wr == 1) PG8_BAR; }
    }
    PG8_WAIT_V(0);
    if constexpr (!ALIGN_EPI) { if (wr == 0) PG8_BAR; }
    PG8_BAR;
    if constexpr (Epi::AFTER_DRAIN) { E.fused(acc, cur, wr, wc, fr, fq, lds, wid, lane); S.done(cur); }
#undef PG8_SA
#undef PG8_SB
#undef PG8_STAGE
#undef PG8_LDA
#undef PG8_LDB
#undef PG8_MMA
#undef PG8_WAIT_V
#undef PG8_WAIT_L
#undef PG8_BAR
#undef PG8_SCHED
}
}

#define LAS __attribute__((address_space(3)))
typedef unsigned short bf16;
typedef float f32x4 __attribute__((ext_vector_type(4)));
typedef float f32x2 __attribute__((ext_vector_type(2)));
typedef unsigned u32x4 __attribute__((ext_vector_type(4)));
typedef unsigned u32x2 __attribute__((ext_vector_type(2)));
typedef short bfx8 __attribute__((ext_vector_type(8)));
#define XB_TMO      128
#define XB_XCNT(j)  (256  + 64 * (j))
#define XB_XSUB(j)  (1280 + 64 * (j))
#define XB_XGEN(j)  (2304 + 64 * (j))
#define XB_TOP      3328
#define XB_TOPGEN   3392
#define XCD_BAR_WORDS 3456
#define XB_SPIN_CAP (1u << 18)

__device__ __forceinline__ unsigned xb_ld(unsigned* p)              { return __hip_atomic_load(p, __ATOMIC_RELAXED, __HIP_MEMORY_SCOPE_AGENT); }
__device__ __forceinline__ unsigned xb_add(unsigned* p, unsigned v) { return __hip_atomic_fetch_add(p, v, __ATOMIC_RELAXED, __HIP_MEMORY_SCOPE_AGENT); }
__device__ __forceinline__ unsigned xb_xcc_id() { return (unsigned)__builtin_amdgcn_s_getreg((3 << 11) | 20) & 0xFu; }
#define XB_SPIN(cond, bar) do { unsigned _sp = 0; while (cond) { __builtin_amdgcn_s_sleep(1); \
    if ((++_sp & 255u) == 0u) { if (xb_ld(&(bar)[XB_TMO])) break; if (_sp > XB_SPIN_CAP) { atomicAdd(&(bar)[XB_TMO], 1u); break; } } } } while (0)

struct XcdBarrier {
    unsigned* bar; unsigned x;
    volatile LAS unsigned* st;
};

__device__ __forceinline__ XcdBarrier xcd_barrier_post(unsigned* bar, volatile LAS unsigned* st, int tid) {
    XcdBarrier b; b.bar = bar; b.x = xb_xcc_id(); b.st = st;
    if (tid == 0) (void)xb_add(&bar[XB_XCNT(b.x)], 1u);
    return b;
}
__device__ __forceinline__ void xcd_barrier_complete(unsigned* bar, unsigned x, unsigned& nloc, unsigned& nx) {
    const unsigned G = gridDim.x * gridDim.y * gridDim.z;
    unsigned sum, cnt, mine, sp = 0u;
    for (;;) {
        sum = 0u; cnt = 0u; mine = 0u;
#pragma unroll
        for (unsigned j = 0; j < 16; ++j) { const unsigned c = xb_ld(&bar[XB_XCNT(j)]); sum += c; cnt += (c > 0u) ? 1u : 0u; mine = (j == x) ? c : mine; }
        if (sum == G) break;
        __builtin_amdgcn_s_sleep(1);
        if ((++sp & 255u) == 0u) { if (xb_ld(&bar[XB_TMO])) break; if (sp > XB_SPIN_CAP) { atomicAdd(&bar[XB_TMO], 1u); break; } }
    }
    nloc = mine > 0u ? mine : 1u; nx = cnt > 0u ? cnt : 1u;
}

__device__ __forceinline__ void xcd_barrier(const XcdBarrier& b, int tid) {
    asm volatile("s_waitcnt vmcnt(0)" ::: "memory");
    __syncthreads();
    if (tid == 0) {
        unsigned* bar = b.bar;
        __builtin_amdgcn_s_waitcnt(0);
        unsigned nloc = b.st[0], nx = b.st[1];
        if (nloc == 0u) { xcd_barrier_complete(bar, b.x, nloc, nx); b.st[0] = nloc; b.st[1] = nx; }
        const unsigned old = xb_add(&bar[XB_XSUB(b.x)], 1u);
        const unsigned gen = old / nloc;
        if (old + 1u == (gen + 1u) * nloc) {
            __builtin_amdgcn_fence(__ATOMIC_RELEASE, "agent");
            asm volatile("s_waitcnt vmcnt(0)" ::: "memory");
            const unsigned og = xb_add(&bar[XB_TOP], 1u);
            const unsigned tg = og / nx;
            if (og + 1u == (tg + 1u) * nx) xb_add(&bar[XB_TOPGEN], 1u);
            else XB_SPIN(xb_ld(&bar[XB_TOPGEN]) == tg, bar);
            __builtin_amdgcn_fence(__ATOMIC_ACQUIRE, "agent");
            xb_add(&bar[XB_XGEN(b.x)], 1u);
            asm volatile("s_waitcnt vmcnt(0)" ::: "memory");
        } else {
            XB_SPIN(xb_ld(&bar[XB_XGEN(b.x)]) == gen, bar);
            __builtin_amdgcn_fence(__ATOMIC_ACQUIRE, "agent");
            asm volatile("s_waitcnt vmcnt(0)" ::: "memory");
        }
    }
    __syncthreads();
}

constexpr int NWAVES = 8, NTHR = 512;
constexpr int TP = 8192, TS = 1024, T = 9216, D = 2048, NIN = 4800, NZ = 4864, FF = 5632, NGU = 11264;
constexpr int NH = 16, HS = 64, RD = 1024, RP = 3264, DEPTH = 4;
constexpr int ZQ = 1536;
constexpr float RMS_EPS = 1e-6f, LN_EPS = 1e-5f, GN_EPS = 64e-5f;
constexpr int SCR = 384;
constexpr size_t O_Y = 0;
constexpr size_t O_CONV_P = (size_t)T * D;
constexpr size_t O_POOL_P = O_CONV_P + (size_t)DEPTH * 4 * 30 * 512;
constexpr size_t O_SHIFT_P = O_POOL_P + (size_t)DEPTH * 4 * 15 * 512;
constexpr size_t O_WKV_P = O_SHIFT_P + (size_t)DEPTH * 4 * RP;
constexpr size_t O_CONV_S = O_WKV_P + (size_t)DEPTH * 4 * NH * 4096;
constexpr size_t O_POOL_S = O_CONV_S + (size_t)DEPTH * 16 * 30 * 512;
constexpr size_t O_SHIFT_S = O_POOL_S + (size_t)DEPTH * 16 * 15 * 512;
constexpr size_t O_WKV_S = O_SHIFT_S + (size_t)DEPTH * 16 * RP;
constexpr size_t O_END = O_WKV_S + (size_t)DEPTH * 16 * NH * 4096;
constexpr size_t WS_POOLW = 131072;
constexpr size_t WS_UPS = 262144;
constexpr size_t WS_WIN = 1u << 20;
constexpr size_t WS_WOUT = WS_WIN + (size_t)NZ * D * 2;
constexpr size_t WS_WGU = WS_WOUT + (size_t)D * D * 2;
constexpr size_t WS_WDN = WS_WGU + (size_t)NGU * D * 2;
constexpr size_t WS_X = WS_WDN + (size_t)D * FF * 2;
constexpr size_t WS_XN = WS_X + (size_t)T * D * 4;
constexpr size_t WS_MIX = WS_XN + (size_t)T * D * 2;
constexpr size_t WS_Z = WS_MIX + (size_t)T * D * 2;
constexpr size_t WS_ACT = WS_Z;
constexpr size_t WS_SC = WS_Z + (size_t)T * NZ * 2;
constexpr size_t WS_PART = WS_SC + (32u << 20);
constexpr size_t WS_Y = WS_SC + (size_t)T * NH * SCR * 4;
constexpr size_t WS_G = WS_Y + (size_t)T * RD * 4;
constexpr size_t WS_RK = WS_G + (size_t)T * RD * 4;
constexpr int NC = 16, CL = 128;
constexpr size_t WS_PQ = WS_RK + (size_t)T * NH * 4;
constexpr size_t WS_S0 = WS_PQ + (size_t)64 * NC * 2 * 4096 * 4;
constexpr size_t WS_GB = WS_S0 + (size_t)64 * NC * 4096 * 4;
constexpr size_t WS_W2 = WS_GB + (size_t)TP * RD * 4;
constexpr size_t WSET = WS_X - WS_WIN;
constexpr size_t WS_END = WS_W2 + WSET;
static_assert(WS_ACT + (size_t)T * FF * 2 <= WS_PART && WS_PART + (size_t)8 * 1024 * D * 4 <= WS_Y, "act / partial overlays");
constexpr int LDS_BYTES = 147456;

#ifndef REP_CVTW
#define REP_CVTW 1
#endif
#ifndef REP_YP
#define REP_YP 1
#endif
#ifndef REP_G1
#define REP_G1 1
#endif
#ifndef REP_N2
#define REP_N2 1
#endif
#ifndef REP_T4
#define REP_T4 1
#endif
#ifndef REP_G3
#define REP_G3 1
#endif
#ifndef REP_PREP
#define REP_PREP 1
#endif
#ifndef REP_POOL
#define REP_POOL 1
#endif
#ifndef REP_CONV
#define REP_CONV 1
#endif
#ifndef REP_P1
#define REP_P1 1
#endif
#ifndef REP_CB
#define REP_CB 1
#endif
#ifndef REP_MIXA
#define REP_MIXA 1
#endif
#ifndef REP_SCAN
#define REP_SCAN 1
#endif
#ifndef REP_POST
#define REP_POST 1
#endif
#ifndef REP_CVT
#define REP_CVT 1
#endif
#ifdef NO_SYNC
#define GSYNC() __syncthreads()
#else
#define GSYNC() do { int w_ = wave0; asm volatile("" : "+s"(w_)); xcd_barrier(xbar, w_ * 64 + (int)__builtin_amdgcn_mbcnt_hi(~0u, __builtin_amdgcn_mbcnt_lo(~0u, (unsigned)launder_v(0)))); } while (0)
#endif
__host__ __device__ __forceinline__ size_t sc_off(int t, int h) { return ((size_t)(((t >> 2) * NH + h) * 4 + (t & 3))) * SCR; }
struct Params { const float* in[31]; float* out; unsigned char* ws; };
typedef const __attribute__((address_space(4))) Params* KP;
__device__ __forceinline__ KP kargs() { KP k = (KP)__builtin_amdgcn_kernarg_segment_ptr(); asm volatile("" : "+s"(k)); return k; }
__device__ __forceinline__ int launder_v(int v) { asm volatile("" : "+v"(v)); return v; }
#define PH_BEGIN() KP kp = kargs(); int wave_ = wave0; asm volatile("" : "+s"(wave_)); const int wave = wave_; const int lane = (int)__builtin_amdgcn_mbcnt_hi(~0u, __builtin_amdgcn_mbcnt_lo(~0u, (unsigned)launder_v(0))); const int tid = wave * 64 + lane; \
    const int nb = gridDim.x, bid = blockIdx.x, gw = bid * NWAVES + wave, ngw = nb * NWAVES; unsigned char* const ws = kp->ws; (void)lane; (void)wave; (void)gw; (void)ngw; (void)ws; (void)nb; (void)bid

template <int M> __device__ __forceinline__ float swz_xor(float v) { return __builtin_bit_cast(float, __builtin_amdgcn_ds_swizzle(__builtin_bit_cast(int, v), 0x1f | (M << 10))); }
__device__ __forceinline__ float rowsum16(float v) { v += swz_xor<1>(v); v += swz_xor<2>(v); v += swz_xor<4>(v); v += swz_xor<8>(v); return v; }
__device__ __forceinline__ float wave_sum(float v) {
    v = rowsum16(v); v += swz_xor<16>(v);
    const int ln = (int)__builtin_amdgcn_mbcnt_hi(~0u, __builtin_amdgcn_mbcnt_lo(~0u, (unsigned)launder_v(0)));
    v += __builtin_bit_cast(float, __builtin_amdgcn_ds_bpermute((ln ^ 32) << 2, __builtin_bit_cast(int, v)));
    return v;
}
__device__ __forceinline__ unsigned f2bf(float f) { unsigned u = __builtin_bit_cast(unsigned, f); return (u + 0x7fffu + ((u >> 16) & 1u)) >> 16; }
__device__ __forceinline__ unsigned pk2(float lo, float hi) { return f2bf(lo) | (f2bf(hi) << 16); }
__device__ __forceinline__ float bf2f(bf16 v) { return __builtin_bit_cast(float, (unsigned)v << 16); }
__device__ __forceinline__ float sigm(float x) { return __builtin_amdgcn_rcpf(1.0f + __expf(-x)); }

__device__ __forceinline__ void transpose_item(const float* W, int K, int N, bf16* WT, int mode, LAS float* scr, int item, int lane) {
    const int nblk = N / 32, kb = item / nblk, nb = item % nblk, k0 = 64 * kb, n0 = 32 * nb;
    const int drow0 = (mode == 0) ? n0 : ((n0 >> 7) * 256 + (n0 & 127) + (mode == 2 ? 128 : 0));
    float wv[32];
#pragma unroll
    for (int i = 0; i < 32; ++i) { const int kk = 2 * i + (lane >> 5); wv[i] = W[(size_t)(k0 + kk) * N + n0 + (lane & 31)]; }
#pragma unroll
    for (int i = 0; i < 32; ++i) { const int kk = 2 * i + (lane >> 5); scr[kk * 33 + (lane & 31)] = wv[i]; }
    asm volatile("s_waitcnt lgkmcnt(0)" ::: "memory");
    const int c = lane & 7;
#pragma unroll
    for (int j = 0; j < 4; ++j) { const int n = (lane >> 3) + 8 * j; const LAS float* s = scr + (8 * c) * 33 + n;
        u32x4 o; o.x = pk2(s[0 * 33], s[1 * 33]); o.y = pk2(s[2 * 33], s[3 * 33]); o.z = pk2(s[4 * 33], s[5 * 33]); o.w = pk2(s[6 * 33], s[7 * 33]);
        *(u32x4*)(WT + (size_t)(drow0 + n) * K + k0 + 8 * c) = o; }
    asm volatile("s_waitcnt lgkmcnt(0)" ::: "memory");
}
__device__ __forceinline__ void convert_weights(KP kp, int l, LAS float* scr, int gw, int ngw, int lane) {
    unsigned char* ws = kp->ws;
    unsigned char* wsw = kp->ws + ((l & 1) ? (WS_W2 - WS_WIN) : 0);
    bf16* WIN = (bf16*)(wsw + WS_WIN); bf16* WOUT = (bf16*)(wsw + WS_WOUT); bf16* WGU = (bf16*)(wsw + WS_WGU); bf16* WDN = (bf16*)(wsw + WS_WDN);
    constexpr int I_IN = (D / 64) * (NIN / 32), I_OUT = (D / 64) * (D / 32), I_G = (D / 64) * (FF / 32), I_D = (FF / 64) * (D / 32);
    constexpr int I_P = 4 * 8, I_U = 3 * 32;
    constexpr int NITEMS = I_IN + I_OUT + 2 * I_G + I_D + I_P + I_U;
    for (int it = gw; it < NITEMS; it += ngw) {
        int r = it;
        if (r < I_IN) { transpose_item(kp->in[7] + (size_t)l * D * NIN, D, NIN, WIN, 0, scr, r, lane); continue; } r -= I_IN;
        if (r < I_OUT) { transpose_item(kp->in[25] + (size_t)l * D * D, D, D, WOUT, 0, scr, r, lane); continue; } r -= I_OUT;
        if (r < I_G) { transpose_item(kp->in[27] + (size_t)l * D * FF, D, FF, WGU, 1, scr, r, lane); continue; } r -= I_G;
        if (r < I_G) { transpose_item(kp->in[28] + (size_t)l * D * FF, D, FF, WGU, 2, scr, r, lane); continue; } r -= I_G;
        if (r < I_D) { transpose_item(kp->in[29] + (size_t)l * FF * D, FF, D, WDN, 0, scr, r, lane); continue; } r -= I_D;
        if (r < I_P) { const int g = r >> 3; transpose_item(kp->in[12] + (size_t)((l * 4 + g) * 128) * 128, 128, 128, (bf16*)(ws + WS_POOLW) + (size_t)g * 128 * 128, 0, scr, r & 7, lane); continue; } r -= I_P;
        { const int m = r >> 5; const float* src = (m == 0 ? kp->in[16] : (m == 1 ? kp->in[18] : kp->in[19])) + (size_t)l * 64 * RD;
          transpose_item(src, 64, RD, (bf16*)(ws + WS_UPS) + (size_t)m * RD * 64, 0, scr, r & 31, lane); }
    }
    { const unsigned z = (unsigned)launder_v(0); for (int e = gw * 64 + lane; e < 16384; e += ngw * 64) ((u32x4*)(WIN + (size_t)NIN * D))[e] = (u32x4){z, z, z, z}; }
}
__device__ __forceinline__ void norm_rows(const float* sa, const float* sb, const float* g, float* xcopy, bf16* xn, float* fout, const float* part, int gw, int ngw, int lane) {
    for (int m = gw; m < T; m += ngw) {
        const float* row = (m < TP) ? sa + (size_t)m * D : sb + (size_t)(m - TP) * D;
        f32x4 v[8]; float ss = 0.f;
#pragma unroll
        for (int j = 0; j < 8; ++j) v[j] = ((const f32x4*)row)[lane + 64 * j];
        if (part && m >= TP) {
#pragma unroll
            for (int k = 0; k < 8; ++k)
#pragma unroll
                for (int j = 0; j < 8; ++j) v[j] += ((const f32x4*)(part + ((size_t)k * 1024 + (m - TP)) * D))[lane + 64 * j];
#pragma unroll
            for (int j = 0; j < 8; ++j) ((f32x4*)(const_cast<float*>(sb) + (size_t)(m - TP) * D))[lane + 64 * j] = v[j];
        }
#pragma unroll
        for (int j = 0; j < 8; ++j) ss += (v[j].x * v[j].x + v[j].y * v[j].y) + (v[j].z * v[j].z + v[j].w * v[j].w);
        const float rinv = 1.0f / sqrtf(wave_sum(ss) * (1.0f / D) + RMS_EPS);
#pragma unroll
        for (int j = 0; j < 8; ++j) {
            if (xcopy) ((f32x4*)(xcopy + (size_t)m * D))[lane + 64 * j] = v[j];
            const f32x4 gj = ((const f32x4*)g)[lane + 64 * j];
            const f32x4 y = v[j] * rinv * gj;
            if (xn) { u32x2 o; o.x = pk2(y.x, y.y); o.y = pk2(y.z, y.w); ((u32x2*)(xn + (size_t)m * D))[lane + 64 * j] = o; }
            if (fout) ((f32x4*)(fout + (size_t)m * D))[lane + 64 * j] = y;
        }
    }
}

__device__ __forceinline__ void conv_item(KP kp, int l, int item, LAS float* lds, int tid_in) {
    const int tid = launder_v(tid_in);
    const bf16* Z = (const bf16*)(kp->ws + WS_Z); bf16* MIX = (bf16*)(kp->ws + WS_MIX);
    const int t0 = item * 32;
    int s, tau0, Ls; bool prompt;
    if (t0 < TP) { s = t0 >> 11; tau0 = t0 & 2047; Ls = 2048; prompt = true; } else { s = (t0 - TP) >> 6; tau0 = (t0 - TP) & 63; Ls = 64; prompt = false; }
    const int c = tid;
    const float* cw = kp->in[8] + (size_t)l * 31 * 512;
    float w[31];
#pragma unroll
    for (int j = 0; j < 31; ++j) w[j] = cw[j * 512 + c];
    const float bias = kp->in[9][l * 512 + c];
    float acc[32];
#pragma unroll
    for (int i = 0; i < 32; ++i) acc[i] = bias;
    const bool first = (tau0 == 0), lastit = (tau0 + 32 == Ls);
    float* oc = prompt ? kp->out + O_CONV_P + (size_t)((l * 4 + s) * 30) * 512 : kp->out + O_CONV_S + (size_t)((l * 16 + s) * 30) * 512;
    const float* cc = kp->in[2] + (size_t)((l * 16 + s) * 30) * 512;
#pragma unroll
    for (int hf = 0; hf < 2; ++hf) {
        float pv[31], pg[31];
#pragma unroll
        for (int k = 0; k < 31; ++k) { const int ii = hf * 31 + k;
            if (ii < 30 && first) { pv[k] = prompt ? 0.f : cc[ii * 512 + c]; pg[k] = 0.f; }
            else { const bf16* zr = Z + (size_t)(t0 + ii - 30) * NZ; pv[k] = bf2f(zr[c]); pg[k] = bf2f(zr[512 + c]); } }
#pragma unroll
        for (int k = 0; k < 31; ++k) { const int ii = hf * 31 + k;
            const float u = (ii < 30 && first) ? pv[k] : pv[k] * sigm(pg[k]);
            if (ii >= 32 && lastit) oc[(ii - 32) * 512 + c] = u;
#pragma unroll
            for (int oi = 0; oi < 32; ++oi) { const int j = ii - oi; if (j >= 0 && j <= 30) acc[oi] += w[j] * u; }
        }
    }
#pragma unroll
    for (int oi = 0; oi < 32; ++oi) lds[oi * 512 + c] = acc[oi];
    __syncthreads();
    const int wave = tid >> 6, lane = tid & 63;
    const f32x4 g0 = *(const f32x4*)(kp->in[10] + l * 512 + lane * 8), g1 = *(const f32x4*)(kp->in[10] + l * 512 + lane * 8 + 4);
    const f32x4 b0 = *(const f32x4*)(kp->in[11] + l * 512 + lane * 8), b1 = *(const f32x4*)(kp->in[11] + l * 512 + lane * 8 + 4);
#pragma unroll
    for (int q = 0; q < 4; ++q) {
        const int oi = wave * 4 + q;
        f32x4 a = *(const LAS f32x4*)(lds + oi * 512 + lane * 8), b = *(const LAS f32x4*)(lds + oi * 512 + lane * 8 + 4);
        const float mean = wave_sum((a.x + a.y) + (a.z + a.w) + (b.x + b.y) + (b.z + b.w)) * (1.0f / 512.0f);
        a = a - mean; b = b - mean;
        const float var = wave_sum((a.x * a.x + a.y * a.y) + (a.z * a.z + a.w * a.w) + (b.x * b.x + b.y * b.y) + (b.z * b.z + b.w * b.w)) * (1.0f / 512.0f);
        const float rstd = __builtin_amdgcn_rsqf(var + LN_EPS);
        a = a * rstd * g0 + b0; b = b * rstd * g1 + b1;
        float o[8] = {a.x, a.y, a.z, a.w, b.x, b.y, b.z, b.w};
#pragma unroll
        for (int k = 0; k < 8; ++k) o[k] = o[k] * sigm(o[k]);
        u32x4 wv; wv.x = pk2(o[0], o[1]); wv.y = pk2(o[2], o[3]); wv.z = pk2(o[4], o[5]); wv.w = pk2(o[6], o[7]);
        *(u32x4*)(MIX + (size_t)(t0 + oi) * D + lane * 8) = wv;
    }
    __syncthreads();
}
__device__ __forceinline__ void pool_item(KP kp, int l, int item, LAS unsigned char* ldsb, int tid_in) {
    const int tid = launder_v(tid_in);
    const bf16* Z = (const bf16*)(kp->ws + WS_Z); bf16* MIX = (bf16*)(kp->ws + WS_MIX);
    LAS float* pp = (LAS float*)ldsb;
    LAS bf16* db = (LAS bf16*)(ldsb + 47 * 512 * 4);
    const int t0 = item * 32;
    int s, tau0, Ls; bool prompt;
    if (t0 < TP) { s = t0 >> 11; tau0 = t0 & 2047; Ls = 2048; prompt = true; } else { s = (t0 - TP) >> 6; tau0 = (t0 - TP) & 63; Ls = 64; prompt = false; }
    const int c = tid;
    const bool first = (tau0 == 0), lastit = (tau0 + 32 == Ls);
    float* op = prompt ? kp->out + O_POOL_P + (size_t)((l * 4 + s) * 15) * 512 : kp->out + O_POOL_S + (size_t)((l * 16 + s) * 15) * 512;
    const float* cp = kp->in[3] + (size_t)((l * 16 + s) * 15) * 512;
    {
        float pvl[47];
#pragma unroll
        for (int ii = 0; ii < 47; ++ii) {
            if (ii < 15 && first) pvl[ii] = prompt ? 0.f : cp[ii * 512 + c];
            else pvl[ii] = bf2f(Z[(size_t)(t0 + ii - 15) * NZ + 1024 + c]);
        }
#pragma unroll
        for (int ii = 0; ii < 47; ++ii) {
            pp[ii * 512 + c] = pvl[ii];
            if (ii >= 32 && lastit) op[(ii - 32) * 512 + c] = pvl[ii];
        }
    }
    const int gi = c >> 7, w = 2 << gi;
    for (int oi = 0; oi < 32; ++oi) {
        float sum = 0.f;
        for (int k = 0; k < w; ++k) sum += pp[(oi + 15 - k) * 512 + c];
        const int cnt = prompt ? min(w, tau0 + oi + 1) : w;
        const float d = sum * __builtin_amdgcn_rcpf((float)cnt) - pp[(oi + 15) * 512 + c];
        db[oi * 520 + c] = (bf16)f2bf(d);
    }
    __syncthreads();
    const int lane = tid & 63, wave = tid >> 6, n16 = lane & 15, q = lane >> 4, g = wave >> 1, nh = wave & 1;
    const bf16* WT = (const bf16*)(kp->ws + WS_POOLW) + (size_t)g * 128 * 128;
    bfx8 Bf[4][4];
#pragma unroll
    for (int nt = 0; nt < 4; ++nt)
#pragma unroll
        for (int ks = 0; ks < 4; ++ks) Bf[nt][ks] = *(const bfx8*)(WT + (size_t)(nh * 64 + nt * 16 + n16) * 128 + ks * 32 + q * 8);
    float scale[4];
#pragma unroll
    for (int nt = 0; nt < 4; ++nt) scale[nt] = kp->in[13][l * 512 + g * 128 + nh * 64 + nt * 16 + n16];
#pragma unroll
    for (int mt = 0; mt < 2; ++mt) {
        bfx8 Af[4];
#pragma unroll
        for (int ks = 0; ks < 4; ++ks) Af[ks] = *(const LAS bfx8*)(db + (mt * 16 + n16) * 520 + g * 128 + ks * 32 + q * 8);
        f32x4 acc[4];
#pragma unroll
        for (int nt = 0; nt < 4; ++nt) { acc[nt] = (f32x4){0.f, 0.f, 0.f, 0.f};
#pragma unroll
            for (int ks = 0; ks < 4; ++ks) acc[nt] = __builtin_amdgcn_mfma_f32_16x16x32_bf16(Af[ks], Bf[nt][ks], acc[nt], 0, 0, 0); }
#pragma unroll
        for (int nt = 0; nt < 4; ++nt)
#pragma unroll
            for (int r = 0; r < 4; ++r) MIX[(size_t)(t0 + mt * 16 + 4 * q + r) * D + 512 + g * 128 + nh * 64 + nt * 16 + n16] = (bf16)f2bf(acc[nt][r] * scale[nt]);
    }
    __syncthreads();
}
__device__ __forceinline__ void prep_item(KP kp, int l, int item, LAS unsigned char* ldsb, int tid_in) {
    const int tid = launder_v(tid_in);
    const bf16* Z = (const bf16*)(kp->ws + WS_Z);
    float* SC = (float*)(kp->ws + WS_SC); float* G = (float*)(kp->ws + WS_G); float* RK = (float*)(kp->ws + WS_RK);
    const bf16* UPT = (const bf16*)(kp->ws + WS_UPS);
    LAS bf16* lo = (LAS bf16*)ldsb;
    const int t0 = item * 16;
    int s, tau0, Ls; bool prompt;
    if (t0 < TP) { s = t0 >> 11; tau0 = t0 & 2047; Ls = 2048; prompt = true; } else { s = (t0 - TP) >> 6; tau0 = (t0 - TP) & 63; Ls = 64; prompt = false; }
    const float* mu = kp->in[14] + (size_t)l * RP;
    const float* ssh = kp->in[4] + (size_t)(l * 16 + s) * RP;
    {
        float qv[6], qp[6], mq[6];
#pragma unroll
        for (int k = 0; k < 6; ++k) { const int e = tid + k * NTHR, tok = e / 192, col = e % 192, zc = 3072 + col, t = t0 + tok, tau = tau0 + tok;
            qv[k] = bf2f(Z[(size_t)t * NZ + ZQ + zc]);
            qp[k] = tau > 0 ? bf2f(Z[(size_t)(t - 1) * NZ + ZQ + zc]) : (prompt ? 0.f : ssh[zc]);
            mq[k] = mu[zc]; }
#pragma unroll
        for (int k = 0; k < 6; ++k) { const int e = tid + k * NTHR, tok = e / 192, col = e % 192;
            const float qs = qv[k] + (qp[k] - qv[k]) * mq[k];
            const float val = col < 64 ? (1.0f - 2.0f * __builtin_amdgcn_rcpf(1.0f + __expf(2.0f * qs))) : (col < 128 ? qs : sigm(qs));
            lo[((col >> 6) * 16 + tok) * 72 + (col & 63)] = (bf16)f2bf(val); }
    }
    __syncthreads();
    const int lane = tid & 63, wave = tid >> 6, n16 = lane & 15, q = lane >> 4;
#pragma unroll 1
    for (int hh = 0; hh < 2; ++hh) {
        const int h = wave * 2 + hh;
        f32x4 acc[3][4];
#pragma unroll
        for (int m = 0; m < 3; ++m) {
            bfx8 Af[2], Bf[4][2];
#pragma unroll
            for (int ks = 0; ks < 2; ++ks) Af[ks] = *(const LAS bfx8*)(lo + (m * 16 + n16) * 72 + ks * 32 + q * 8);
#pragma unroll
            for (int i = 0; i < 4; ++i)
#pragma unroll
                for (int ks = 0; ks < 2; ++ks) Bf[i][ks] = *(const bfx8*)(UPT + (size_t)(m * RD + h * 64 + i * 16 + n16) * 64 + ks * 32 + q * 8);
#pragma unroll
            for (int i = 0; i < 4; ++i) { acc[m][i] = (f32x4){0.f, 0.f, 0.f, 0.f};
#pragma unroll
                for (int ks = 0; ks < 2; ++ks) acc[m][i] = __builtin_amdgcn_mfma_f32_16x16x32_bf16(Af[ks], Bf[i][ks], acc[m][i], 0, 0, 0); }
        }
        float mur[4], muk[4], muv[4], w0c[4], a0c[4], kkc[4], kac[4], rkc[4], sr[4], sk[4], sv[4];
#pragma unroll
        for (int i = 0; i < 4; ++i) { const int c = h * 64 + i * 16 + n16;
            mur[i] = mu[c]; muk[i] = mu[RD + c]; muv[i] = mu[2 * RD + c];
            w0c[i] = kp->in[15][l * RD + c]; a0c[i] = kp->in[17][l * RD + c]; kkc[i] = kp->in[20][l * RD + c]; kac[i] = kp->in[21][l * RD + c]; rkc[i] = kp->in[22][l * RD + c];
            sr[i] = prompt ? 0.f : ssh[c]; sk[i] = prompt ? 0.f : ssh[RD + c]; sv[i] = prompt ? 0.f : ssh[2 * RD + c]; }
        float zc_[4][4][3], zp_[4][4][3];
#pragma unroll
        for (int r = 0; r < 4; ++r) {
            const int tok = 4 * q + r, t = t0 + tok, tau = tau0 + tok;
            const bf16* zr = Z + (size_t)t * NZ + ZQ;
#pragma unroll
            for (int i = 0; i < 4; ++i) { const int c = h * 64 + i * 16 + n16;
                zc_[r][i][0] = bf2f(zr[c]); zc_[r][i][1] = bf2f(zr[RD + c]); zc_[r][i][2] = bf2f(zr[2 * RD + c]);
                if (tau > 0) { zp_[r][i][0] = bf2f(zr[c - NZ]); zp_[r][i][1] = bf2f(zr[RD + c - NZ]); zp_[r][i][2] = bf2f(zr[2 * RD + c - NZ]); } else { zp_[r][i][0] = sr[i]; zp_[r][i][1] = sk[i]; zp_[r][i][2] = sv[i]; } }
        }
        float dv[4][4], av[4][4];
#pragma unroll
        for (int r = 0; r < 4; ++r)
#pragma unroll
            for (int i = 0; i < 4; ++i) {
                const float xw = -(w0c[i] + acc[0][i][r]);
                const float sp = fmaxf(xw, 0.f) + __logf(1.0f + __expf(-fabsf(xw)));
                dv[r][i] = __expf(-__expf(-sp - 0.5f));
                av[r][i] = sigm(a0c[i] + acc[1][i][r]);
            }
        float wpre[4];
        { const int lnx = (int)__builtin_amdgcn_mbcnt_hi(~0u, __builtin_amdgcn_mbcnt_lo(~0u, (unsigned)launder_v(0)));
#pragma unroll
          for (int i = 0; i < 4; ++i) {
            const float gq = (dv[0][i] * dv[1][i]) * (dv[2][i] * dv[3][i]);
            const float g0 = __builtin_bit_cast(float, __builtin_amdgcn_ds_bpermute(((lnx & 15)) << 2, __builtin_bit_cast(int, gq)));
            const float g1 = __builtin_bit_cast(float, __builtin_amdgcn_ds_bpermute(((lnx & 15) + 16) << 2, __builtin_bit_cast(int, gq)));
            const float g2 = __builtin_bit_cast(float, __builtin_amdgcn_ds_bpermute(((lnx & 15) + 32) << 2, __builtin_bit_cast(int, gq)));
            wpre[i] = (q > 0 ? g0 : 1.0f) * (q > 1 ? g1 : 1.0f) * (q > 2 ? g2 : 1.0f); } }
#pragma unroll
        for (int r = 0; r < 4; ++r) {
            const int tok = 4 * q + r, t = t0 + tok;
            float rv[4], kv[4], vv[4], kk[4], wex[4], win[4];
            float skk = 0.f;
#pragma unroll
            for (int i = 0; i < 4; ++i) { const int c = h * 64 + i * 16 + n16;
                float rr = zc_[r][i][0], k = zc_[r][i][1], v = zc_[r][i][2];
                rr += (zp_[r][i][0] - rr) * mur[i]; k += (zp_[r][i][1] - k) * muk[i]; v += (zp_[r][i][2] - v) * muv[i];
                rv[i] = rr; kv[i] = k; vv[i] = v; kk[i] = k * kkc[i]; skk += kk[i] * kk[i];
                wex[i] = wpre[i]; win[i] = wpre[i] * dv[r][i]; wpre[i] = win[i];
                G[(size_t)t * RD + c] = acc[2][i][r];
                }
            skk = rowsum16(skk);
            const float rinv = __builtin_amdgcn_rsqf(fmaxf(skk, 1e-24f));
            float srk = 0.f;
#pragma unroll
            for (int i = 0; i < 4; ++i) {
                const float kkn = kk[i] * rinv, kpv = kv[i] * (1.0f + (av[r][i] - 1.0f) * kac[i]), bb = kkn * av[r][i];
                srk += rv[i] * kpv * rkc[i];
                const float iw = __builtin_amdgcn_rcpf(win[i]);
                float* sc = SC + sc_off(t, h) + i * 16 + n16;
                sc[0] = wex[i] * kkn; sc[64] = bb * iw; sc[128] = kpv * iw; sc[192] = win[i] * rv[i]; sc[256] = vv[i]; sc[320] = win[i];
            }
            srk = rowsum16(srk);
            if (n16 == 0) RK[t * NH + h] = srk;
        }
    }
    if (tau0 + 16 == Ls) {
        float* osh = prompt ? kp->out + O_SHIFT_P + (size_t)(l * 4 + s) * RP : kp->out + O_SHIFT_S + (size_t)(l * 16 + s) * RP;
        const bf16* zr = Z + (size_t)(t0 + 15) * NZ + ZQ;
        for (int e = tid; e < RP; e += NTHR) osh[e] = bf2f(zr[e]);
    }
    __syncthreads();
}

__device__ __forceinline__ void sc_issue(f32x4 (&r)[4], const LAS f32x4* o, int c) {
    if (c < 4) {
#pragma unroll
        for (int i = 0; i < 4; ++i) r[i] = o[4 * c + i];
    } else { const int j = c - 4; r[1] = o[16 + j]; r[2] = o[32 + j]; r[3] = o[48 + j]; }
}
template <int MODE>
__device__ __forceinline__ void scan_run(const float* SC, int tg0, int nsteps, int h, LAS float* wl  , int lane,
                                         const float* Sinit, float* Y, float* GB, float* Sout, float* PQout) {
    constexpr int GS = 4, NCH = 20;
    f32x2 S[32];
    f32x2 P[(MODE == 3) ? 32 : 1];
    if (MODE == 3) {
        const int ln = launder_v(lane);
#pragma unroll
        for (int j = 0; j < 32; ++j) { S[j] = (f32x2){0.f, 0.f}; P[j] = (f32x2){(2 * j == ln) ? 1.f : 0.f, (2 * j + 1 == ln) ? 1.f : 0.f}; }
    } else {
#pragma unroll
        for (int j = 0; j < 16; ++j) { const f32x4 v = ((const f32x4*)(Sinit + lane * 64))[j]; S[2 * j] = (f32x2){v.x, v.y}; S[2 * j + 1] = (f32x2){v.z, v.w}; }
    }
#define SC_STAGE(g, buf) do { const float* rec_ = SC + sc_off(tg0 + (g) * GS, h) + lane * 4; \
        _Pragma("unroll") for (int k_ = 0; k_ < 6; ++k_) __builtin_amdgcn_global_load_lds((const unsigned*)(rec_ + k_ * 256), (LAS unsigned*)(wl + (buf) * GS * SCR + k_ * 256), 16, 0, 0); } while (0)
    SC_STAGE(0, 0);
    const int ngroups = nsteps / GS;
    for (int g = 0; g < ngroups; ++g) {
        asm volatile("s_waitcnt vmcnt(0)" ::: "memory");
        if (g + 1 < ngroups) SC_STAGE(g + 1, (g + 1) & 1);
        const LAS float* wb = wl + (g & 1) * GS * SCR;
        f32x4 R[4][4];
#pragma unroll
        for (int q = 0; q < 3; ++q) sc_issue(R[q & 3], (const LAS f32x4*)(wb + (q / NCH) * SCR), q % NCH);
        __builtin_amdgcn_sched_barrier(0);
#pragma unroll
        for (int s = 0; s < GS; ++s) {
            f32x2 d2a = (f32x2){0.f, 0.f}, y2a = (f32x2){0.f, 0.f};
            f32x2 e2a = (f32x2){0.f, 0.f}, g2a = (f32x2){0.f, 0.f};
            f32x2 sa2 = (f32x2){0.f, 0.f}, sp2 = (f32x2){0.f, 0.f};
            const float vs = wb[s * SCR + 256 + lane];
            const f32x2 v2 = (f32x2){vs, vs};
#pragma unroll
            for (int c = 0; c < NCH; ++c) {
                const int q = s * NCH + c, qn = q + 3;
                if (qn < GS * NCH) sc_issue(R[qn & 3], (const LAS f32x4*)(wb + (qn / NCH) * SCR), qn % NCH);
                __builtin_amdgcn_sched_barrier(0);
                f32x4 (&r)[4] = R[q & 3];
                if (c < 4) {
#pragma unroll
                    for (int i = 0; i < 4; ++i) { const int j = 4 * c + i; d2a += S[2 * j] * (f32x2){r[i].x, r[i].y}; d2a += S[2 * j + 1] * (f32x2){r[i].z, r[i].w};
                        if (MODE == 3) { e2a += P[2 * j] * (f32x2){r[i].x, r[i].y}; e2a += P[2 * j + 1] * (f32x2){r[i].z, r[i].w}; } }
                    if (c == 3) { const f32x2 d2 = d2a; const float sa = -(d2.x + d2.y); sa2 = (f32x2){sa, sa};
                        if (MODE == 3) { const f32x2 e2 = e2a; const float sp = -(e2.x + e2.y); sp2 = (f32x2){sp, sp}; } }
                } else {
                    const int j = c - 4;
                    S[2 * j] = sa2 * (f32x2){r[1].x, r[1].y} + S[2 * j]; S[2 * j] = v2 * (f32x2){r[2].x, r[2].y} + S[2 * j];
                    S[2 * j + 1] = sa2 * (f32x2){r[1].z, r[1].w} + S[2 * j + 1]; S[2 * j + 1] = v2 * (f32x2){r[2].z, r[2].w} + S[2 * j + 1];
                    y2a += S[2 * j] * (f32x2){r[3].x, r[3].y}; y2a += S[2 * j + 1] * (f32x2){r[3].z, r[3].w};
                    if (MODE == 3) {
                        P[2 * j] = sp2 * (f32x2){r[1].x, r[1].y} + P[2 * j]; P[2 * j + 1] = sp2 * (f32x2){r[1].z, r[1].w} + P[2 * j + 1];
                        g2a += P[2 * j] * (f32x2){r[3].x, r[3].y}; g2a += P[2 * j + 1] * (f32x2){r[3].z, r[3].w};
                    }
                }
                __builtin_amdgcn_sched_barrier(0);
            }
            { const f32x2 y2 = y2a; Y[(size_t)(tg0 + g * GS + s) * RD + h * 64 + lane] = y2.x + y2.y; }
            if (MODE == 3) { const f32x2 g2 = g2a; GB[(size_t)(tg0 + g * GS + s) * RD + h * 64 + lane] = g2.x + g2.y; }
        }
        if ((g & 3) == 3) {
            const LAS f32x4* wq = (const LAS f32x4*)(wb + (GS - 1) * SCR + 320);
#pragma unroll
            for (int j = 0; j < 16; ++j) { const f32x4 w4 = wq[j];
                S[2 * j] = S[2 * j] * (f32x2){w4.x, w4.y}; S[2 * j + 1] = S[2 * j + 1] * (f32x2){w4.z, w4.w};
                if (MODE == 3) { P[2 * j] = P[2 * j] * (f32x2){w4.x, w4.y}; P[2 * j + 1] = P[2 * j + 1] * (f32x2){w4.z, w4.w}; } }
        }
        asm volatile("s_waitcnt lgkmcnt(0)" ::: "memory");
    }
#undef SC_STAGE
    if (MODE == 3) {
#pragma unroll
        for (int j = 0; j < 16; ++j) { ((f32x4*)PQout)[j * 64 + lane] = (f32x4){P[2 * j].x, P[2 * j].y, P[2 * j + 1].x, P[2 * j + 1].y};
                                       ((f32x4*)(PQout + 4096))[j * 64 + lane] = (f32x4){S[2 * j].x, S[2 * j].y, S[2 * j + 1].x, S[2 * j + 1].y}; }
    } else {
#pragma unroll
        for (int j = 0; j < 16; ++j) ((f32x4*)(Sout + lane * 64))[j] = (f32x4){S[2 * j].x, S[2 * j].y, S[2 * j + 1].x, S[2 * j + 1].y};
    }
}
template <int NMT>
__device__ __forceinline__ void ypost_task(KP kp, int l, const float* S0q  , int tg0, int h, int lane) {
    const float* GB = (const float*)(kp->ws + WS_GB); const float* Y = (const float*)(kp->ws + WS_Y); const float* SC = (const float*)(kp->ws + WS_SC);
    const float* G = (const float*)(kp->ws + WS_G); const float* RK = (const float*)(kp->ws + WS_RK); bf16* MIX = (bf16*)(kp->ws + WS_MIX);
    const int n = lane & 15, kq = lane >> 4;
    float Bv[4][16];
    if (S0q) {
#pragma unroll
        for (int nt = 0; nt < 4; ++nt)
#pragma unroll
            for (int ks = 0; ks < 16; ++ks) Bv[nt][ks] = S0q[(size_t)(ks * 64 + nt * 16 + n) * 4 + kq];
    }
    float gng[4], gnb[4];
#pragma unroll
    for (int nt = 0; nt < 4; ++nt) { gng[nt] = kp->in[23][l * RD + h * 64 + nt * 16 + n]; gnb[nt] = kp->in[24][l * RD + h * 64 + nt * 16 + n]; }
#pragma unroll 1
    for (int mt = 0; mt < NMT; ++mt) {
        const int tb = tg0 + mt * 16;
        float Av[16];
        if (S0q) { const float* grow = GB + (size_t)(tb + n) * RD + h * 64 + kq;
#pragma unroll
            for (int ks = 0; ks < 16; ++ks) Av[ks] = grow[ks * 4]; }
        f32x4 acc[4]; float vv[4][4], gg[4][4], rk[4];
#pragma unroll
        for (int r = 0; r < 4; ++r) { const int t = tb + 4 * kq + r; rk[r] = RK[t * NH + h];
#pragma unroll
            for (int nt = 0; nt < 4; ++nt) { acc[nt][r] = Y[(size_t)t * RD + h * 64 + nt * 16 + n]; vv[nt][r] = SC[sc_off(t, h) + 256 + nt * 16 + n]; gg[nt][r] = G[(size_t)t * RD + h * 64 + nt * 16 + n]; } }
        if (S0q) {
#pragma unroll
            for (int ks = 0; ks < 16; ++ks)
#pragma unroll
                for (int nt = 0; nt < 4; ++nt) acc[nt] = __builtin_amdgcn_mfma_f32_16x16x4f32(Av[ks], Bv[nt][ks], acc[nt], 0, 0, 0);
        }
#pragma unroll
        for (int r = 0; r < 4; ++r) {
            const int t = tb + 4 * kq + r;
            const float mean = rowsum16((acc[0][r] + acc[1][r]) + (acc[2][r] + acc[3][r])) * (1.0f / 64.0f);
            float d[4], qq = 0.f;
#pragma unroll
            for (int nt = 0; nt < 4; ++nt) { d[nt] = acc[nt][r] - mean; qq += d[nt] * d[nt]; }
            const float rstd = __builtin_amdgcn_rsqf(rowsum16(qq) * (1.0f / 64.0f) + GN_EPS);
#pragma unroll
            for (int nt = 0; nt < 4; ++nt) { const float o = ((d[nt] * rstd * gng[nt] + gnb[nt]) + rk[r] * vv[nt][r]) * gg[nt][r];
                MIX[(size_t)t * D + 1024 + h * 64 + nt * 16 + n] = (bf16)f2bf(o); }
        }
    }
}
__device__ __forceinline__ void combine_chain(const float* PQ, float* S0, float* Sfin, LAS unsigned char* lds, int tid, int wave, int lane) {
    constexpr int LDA = 66, LDB = 80;
    LAS float* Sl = (LAS float*)lds;
    LAS float* Pl = (LAS float*)(lds + 2 * 64 * LDA * 4);
    const int n = lane & 15, kq = lane >> 4, ib = wave >> 1, n0 = 32 * (wave & 1);
    for (int e = tid; e < 64 * LDA; e += NTHR) Sl[e] = 0.f;
    { const f32x4* Pc = (const f32x4*)PQ;
      for (int e = tid; e < 1024; e += NTHR) *(LAS f32x4*)(Pl + (e & 63) * LDB + (e >> 6) * 4) = Pc[e]; }
    f32x4 qn[2];
#pragma unroll
    for (int t = 0; t < 2; ++t)
#pragma unroll
        for (int r = 0; r < 4; ++r) { const int i = 16 * ib + 4 * kq + r, col = n0 + 16 * t + n; qn[t][r] = PQ[4096 + (size_t)((col >> 2) * 64 + i) * 4 + (col & 3)]; }
    for (int c = 0; c < NC; ++c) {
        f32x4 acc[2] = {qn[0], qn[1]};
        if (c + 1 < NC) { const float* Qn = PQ + (size_t)((c + 1) * 2 + 1) * 4096;
#pragma unroll
            for (int t = 0; t < 2; ++t)
#pragma unroll
                for (int r = 0; r < 4; ++r) { const int i = 16 * ib + 4 * kq + r, col = n0 + 16 * t + n; qn[t][r] = Qn[(size_t)((col >> 2) * 64 + i) * 4 + (col & 3)]; } }
        f32x4 pn0 = (f32x4){0.f, 0.f, 0.f, 0.f}, pn1 = pn0;
        if (c + 1 < NC) { const f32x4* Pn = (const f32x4*)(PQ + (size_t)((c + 1) * 2) * 4096); pn0 = Pn[tid]; pn1 = Pn[tid + 512]; }
        __syncthreads();
        const LAS float* sa = Sl + (c & 1) * 64 * LDA + (16 * ib + n) * LDA + kq;
        const LAS float* pb = Pl + (c & 1) * 64 * LDB + kq * LDB + n0 + n;
#pragma unroll
        for (int ks = 0; ks < 16; ++ks) {
            const float av = sa[4 * ks], b0 = pb[4 * ks * LDB], b1 = pb[4 * ks * LDB + 16];
            acc[0] = __builtin_amdgcn_mfma_f32_16x16x4f32(av, b0, acc[0], 0, 0, 0);
            acc[1] = __builtin_amdgcn_mfma_f32_16x16x4f32(av, b1, acc[1], 0, 0, 0);
        }
        if (c + 1 < NC) {
            LAS float* sn = Sl + ((c + 1) & 1) * 64 * LDA; float* So = S0 + (size_t)(c + 1) * 4096;
#pragma unroll
            for (int t = 0; t < 2; ++t)
#pragma unroll
                for (int r = 0; r < 4; ++r) { const int i = 16 * ib + 4 * kq + r, col = n0 + 16 * t + n;
                    sn[i * LDA + col] = acc[t][r]; So[(size_t)((col >> 2) * 64 + i) * 4 + (col & 3)] = acc[t][r]; }
            LAS float* pnl = Pl + ((c + 1) & 1) * 64 * LDB;
            *(LAS f32x4*)(pnl + (tid & 63) * LDB + (tid >> 6) * 4) = pn0; *(LAS f32x4*)(pnl + (tid & 63) * LDB + ((tid + 512) >> 6) * 4) = pn1;
        } else {
#pragma unroll
            for (int t = 0; t < 2; ++t)
#pragma unroll
                for (int r = 0; r < 4; ++r) Sfin[(16 * ib + 4 * kq + r) * 64 + n0 + 16 * t + n] = acc[t][r];
        }
    }
    __syncthreads();
}

__global__ void __launch_bounds__(NTHR, 2) fwd_mega(Params p) {
    extern __shared__ __attribute__((aligned(16))) unsigned char lds_raw[];
    LAS unsigned char* lds = (LAS unsigned char*)lds_raw;
    const int wave0 = __builtin_amdgcn_readfirstlane((int)threadIdx.x >> 6);
    volatile LAS unsigned* MISC = (volatile LAS unsigned*)(lds + 131072);
    if (threadIdx.x < 16) MISC[threadIdx.x] = 0u;
    __syncthreads();
    const XcdBarrier xbar = xcd_barrier_post((unsigned*)p.ws + 4096, MISC, (int)threadIdx.x);
    cg::this_grid().sync();

#pragma unroll 1
    for (int l = 0; l < DEPTH; ++l) {
        for (int rep = 0; rep < REP_CVT; ++rep) { PH_BEGIN();
#ifndef NO_CVT
          if (l == 0) convert_weights(kp, 0, (LAS float*)(lds + wave * 16384), gw, ngw, lane);
#endif
#ifndef NO_NORM
          float* X = (float*)(ws + WS_X); bf16* XN = (bf16*)(ws + WS_XN);
          if (l == 0) norm_rows(kp->in[0], kp->in[1], kp->in[6], X, XN, nullptr, nullptr, gw, ngw, lane);
          else norm_rows(X, X + (size_t)TP * D, kp->in[6] + l * D, nullptr, XN, nullptr, (const float*)(ws + WS_PART), gw, ngw, lane);
#endif
        }
        GSYNC();
#ifndef NO_GEMM1
        _Pragma("unroll 1") for (int rg = 0; rg < REP_G1; ++rg) { PH_BEGIN(); pg8::Gemm g{(const bf16*)(ws + WS_XN), (const bf16*)(ws + WS_WIN + ((l & 1) ? (WS_W2 - WS_WIN) : 0)), T, NZ, D}; pg8::StaticOrder S; S.init(T, NZ, D, nb, bid); pg8::EpiStoreBf16 E{(bf16*)(ws + WS_Z), NZ};
          pg8::gemm_phase<pg8::EpiStoreBf16, pg8::StaticOrder, true, true>(lds, g, S, E, tid); }
#endif
        GSYNC();
        for (int rep = 0; rep < REP_MIXA; ++rep) { PH_BEGIN();
          if (rep) __syncthreads();
          for (int it = bid; it < 1152; it += nb) {
#ifndef NO_PREP
            if (it < 576) _Pragma("unroll 1") for (int r_ = 0; r_ < REP_PREP; ++r_) prep_item(kp, l, it, lds, tid);
#endif
#ifndef NO_POOL
            if (it >= 576 && it < 864) _Pragma("unroll 1") for (int r_ = 0; r_ < REP_POOL; ++r_) pool_item(kp, l, it - 576, lds, tid);
#endif
#ifndef NO_CONV
            if (it >= 864) _Pragma("unroll 1") for (int r_ = 0; r_ < REP_CONV; ++r_) conv_item(kp, l, it - 864, (LAS float*)lds, tid);
#endif
          }
        }
        GSYNC();
#ifndef NO_SCAN
        for (int rep = 0; rep < REP_SCAN; ++rep) {
        if (rep) GSYNC();
        for (int rp = 0; rp < REP_P1; ++rp) { PH_BEGIN();
            const float* SC = (const float*)(ws + WS_SC); float* Y = (float*)(ws + WS_Y); float* PQ = (float*)(ws + WS_PQ); float* GB = (float*)(ws + WS_GB);
            LAS float* wl = (LAS float*)(lds + wave * 12288);
            if (wave >= 5 && l + 1 < DEPTH) convert_weights(kp, l + 1, (LAS float*)(lds + 98304 + (wave - 5) * 8448), bid * 3 + (wave - 5), nb * 3, lane);
            for (int task = wave * nb + bid; task < 64 * NC + 256; task += NWAVES * nb) {
                if (task < 64 * NC) {
                    const int ch = task / NC, c = task % NC, s = ch >> 4, h = ch & 15;
                    scan_run<3>(SC, s * 2048 + c * CL, CL, h, wl, lane, nullptr, Y, GB, nullptr, PQ + (size_t)((ch * NC + c) * 2) * 4096);
                } else {
                    const int ch = task - 64 * NC, b = ch >> 4, h = ch & 15;
                    scan_run<1>(SC, TP + b * 64, 64, h, wl, lane, kp->in[5] + (size_t)((l * 16 + b) * NH + h) * 4096, Y, nullptr, kp->out + O_WKV_S + (size_t)((l * 16 + b) * NH + h) * 4096, nullptr);
                }
            }
        }
        GSYNC();
        for (int rp = 0; rp < REP_CB; ++rp) { PH_BEGIN();
            for (int ch = bid; ch < 64; ch += nb) { const int s = ch >> 4, h = ch & 15;
                combine_chain((const float*)(ws + WS_PQ) + (size_t)ch * NC * 2 * 4096, (float*)(ws + WS_S0) + (size_t)ch * NC * 4096, kp->out + O_WKV_P + (size_t)((l * 4 + s) * NH + h) * 4096, lds, tid, wave, lane); }
        }
        GSYNC();
        _Pragma("unroll 1") for (int ry = 0; ry < REP_YP; ++ry) { PH_BEGIN();
            const float* S0 = (const float*)(ws + WS_S0);
            constexpr int UPC = CL / 32, NPU = 64 * NC * UPC;
            for (int u = wave * nb + bid; u < NPU + 512; u += NWAVES * nb) {
                if (u < NPU) { const int task = u / UPC, hf = u % UPC, ch = task / NC, c = task % NC, s = ch >> 4, h = ch & 15;
                    ypost_task<2>(kp, l, c == 0 ? nullptr : S0 + (size_t)(ch * NC + c) * 4096, s * 2048 + c * CL + hf * 32, h, lane); }
                else { const int ch = (u - NPU) >> 1, hf = (u - NPU) & 1, b = ch >> 4, h = ch & 15; ypost_task<2>(kp, l, nullptr, TP + b * 64 + hf * 32, h, lane); }
            }
        }
        }
#endif
        GSYNC();
#ifndef NO_GEMM2
        { PH_BEGIN(); pg8::Gemm g{(const bf16*)(ws + WS_MIX), (const bf16*)(ws + WS_WOUT + ((l & 1) ? (WS_W2 - WS_WIN) : 0)), T, D, D}; pg8::TailOrder S; S.init(D, D, nb, bid); pg8::EpiResAdd E{(float*)(ws + WS_X), D, (float*)(ws + WS_PART)};
          pg8::gemm_phase<pg8::EpiResAdd, pg8::TailOrder, true, true>(lds, g, S, E, tid); }
#endif
        GSYNC();
#ifndef NO_NORM
        _Pragma("unroll 1") for (int rn = 0; rn < REP_N2; ++rn) { PH_BEGIN(); float* X = (float*)(ws + WS_X); norm_rows(X, X + (size_t)TP * D, kp->in[26] + l * D, nullptr, (bf16*)(ws + WS_XN), nullptr, rn == 0 ? (const float*)(ws + WS_PART) : nullptr, gw, ngw, lane); }
#endif
        GSYNC();
#ifndef NO_GEMM3
        _Pragma("unroll 1") for (int rg = 0; rg < REP_G3; ++rg) { PH_BEGIN(); pg8::Gemm g{(const bf16*)(ws + WS_XN), (const bf16*)(ws + WS_WGU + ((l & 1) ? (WS_W2 - WS_WIN) : 0)), T, NGU, D}; pg8::StaticOrder S; S.init(T, NGU, D, nb, bid); pg8::EpiSwiGLU E{(bf16*)(ws + WS_ACT), FF};
          pg8::gemm_phase<pg8::EpiSwiGLU, pg8::StaticOrder, true, true>(lds, g, S, E, tid); }
#endif
        GSYNC();
#ifndef NO_GEMM4
        _Pragma("unroll 1") for (int rt = 0; rt < REP_T4; ++rt) { PH_BEGIN(); pg8::Gemm g{(const bf16*)(ws + WS_ACT), (const bf16*)(ws + WS_WDN + ((l & 1) ? (WS_W2 - WS_WIN) : 0)), T, D, FF}; pg8::TailOrder S; S.init(D, FF, nb, bid, rt); pg8::EpiResAdd E{(float*)(ws + WS_X), D, (float*)(ws + WS_PART)};
          pg8::gemm_phase<pg8::EpiResAdd, pg8::TailOrder, true, true>(lds, g, S, E, tid); }
#endif
        GSYNC();
    }
#ifndef NO_NORM
    { PH_BEGIN(); float* X = (float*)(ws + WS_X); norm_rows(X, X + (size_t)TP * D, kp->in[30], nullptr, nullptr, kp->out + O_Y, (const float*)(ws + WS_PART), gw, ngw, lane); }
#endif
}

extern "C" void kernel_launch(void* const* d_in, const int* in_sizes, int n_in, void* d_out, int out_size, void* d_ws, size_t ws_size, hipStream_t stream) {
    static int grid = 0;
    if (grid == 0) {
        if (n_in != 31 || (size_t)out_size != O_END || ws_size < WS_END) { fprintf(stderr, "kernel_launch: unexpected shapes: n_in %d out %d ws %zu (need %zu)\n", n_in, out_size, ws_size, (size_t)WS_END); grid = -1; return; }
        int dev = 0, cus = 0, per_cu = 0;
        hipGetDevice(&dev);
        hipDeviceGetAttribute(&cus, hipDeviceAttributeMultiprocessorCount, dev);
        if (hipFuncSetAttribute((const void*)fwd_mega, hipFuncAttributeMaxDynamicSharedMemorySize, LDS_BYTES) != hipSuccess) { fprintf(stderr, "kernel_launch: hipFuncSetAttribute failed\n"); grid = -1; return; }
        hipOccupancyMaxActiveBlocksPerMultiprocessor(&per_cu, (const void*)fwd_mega, NTHR, LDS_BYTES);
        (void)hipGetLastError();
        if (per_cu < 1) { fprintf(stderr, "kernel_launch: occupancy query says %d blocks per CU\n", per_cu); per_cu = 1; }
        grid = cus * 1;
    }
    if (grid < 0) return;
    Params p{};
    for (int i = 0; i < 31; ++i) p.in[i] = (const float*)d_in[i];
    p.out = (float*)d_out; p.ws = (unsigned char*)d_ws;
    if (hipMemsetAsync(d_ws, 0, 65536, stream) != hipSuccess) { fprintf(stderr, "kernel_launch: memset failed\n"); return; }
    void* args[] = {&p};
    hipError_t e = hipLaunchCooperativeKernel((const void*)fwd_mega, dim3(grid), dim3(NTHR), args, LDS_BYTES, stream);
    if (e != hipSuccess) fprintf(stderr, "cooperative launch failed: %s (grid %d)\n", hipGetErrorString(e), grid);
}
```

```cpp
#include <hip/hip_runtime.h>
#include <hip/hip_cooperative_groups.h>
#include <cstdio>
#include <cstdint>
namespace cg = cooperative_groups;

namespace pg8 {
#define PG8_LAS __attribute__((address_space(3)))
typedef unsigned short bf16_t;
typedef short bf16x8 __attribute__((ext_vector_type(8)));
typedef float f32x4 __attribute__((ext_vector_type(4)));
typedef unsigned u32x4 __attribute__((ext_vector_type(4)));
constexpr int BM = 256, BK = 64, HALF = 128, HTB = HALF * BK * 2  , STAGE_BYTES = 8 * HTB, NXCD = 8, WGM = 8;

__host__ __device__ __forceinline__ int lds_byte(int r, int c) { const int st = (r >> 4) * 2 + (c >> 5), rr = r & 15, cc = c & 31, ob = rr * 64 + cc * 2; return st * 1024 + (ob ^ (((ob >> 9) & 1) << 5)); }
__host__ __device__ __forceinline__ void stage_rc(int b, int& R, int& C) { const int st = b / 1024, sb = b % 1024, swz = sb ^ (((sb >> 9) & 1) << 5); R = (st >> 1) * 16 + swz / 64; C = (st & 1) * 32 + (swz % 64) / 2; }
__host__ __device__ __forceinline__ int perm32(int rho) { const int n = rho >> 4, i = rho & 15; return 8 * (i >> 2) + 4 * n + (i & 3); }

struct Unit { int pm, pn, k0, nt, part; };
struct Gemm { const bf16_t* A; const bf16_t* Bt; int M, N, K; };

struct StaticOrder {
    int nM, nN, nwg, G, c, ntfull;
    __host__ __device__ void init(int M, int N, int K, int G_, int c_) { nM = M / BM; nN = N / BM; nwg = nM * nN; G = G_; c = c_; ntfull = K / BK; }
    __host__ __device__ __forceinline__ bool next(int i, Unit& u) const {
        const long L = (long)i * G + c; if (L >= nwg) return false;
        int wgid = (int)L; { const int q = nwg / NXCD, r = nwg % NXCD, xcd = wgid % NXCD, off = wgid / NXCD; wgid = (xcd < r ? xcd * (q + 1) : r * (q + 1) + (xcd - r) * q) + off; }
        const int nig = WGM * nN, gid = wgid / nig, fm = gid * WGM, gsz = (nM - fm) < WGM ? (nM - fm) : WGM;
        u.pm = fm + ((wgid % nig) % gsz); u.pn = (wgid % nig) / gsz; u.k0 = 0; u.nt = ntfull; u.part = -1; return true;
    }
    __device__ __forceinline__ void a_ready(const Unit&) const {}
    __device__ __forceinline__ void done(const Unit&) const {}
};


struct TailOrder {
    int nN, G, c, ntfull, skip;
    __host__ __device__ void init(int N, int K, int G_, int c_, int skip_ = 0) { nN = N / BM; G = G_; c = c_; ntfull = K / BK; skip = skip_; }
    __host__ __device__ __forceinline__ bool next(int i, Unit& u) const {
        const int nfull = 32 * nN, L = i * G + c + skip * nfull;
        if (L >= nfull + 4 * nN * 8) return false;
        const bool full = L < nfull;
        int wgid = full ? L : 0; { const int q = nfull / NXCD, r = nfull % NXCD, xcd = wgid % NXCD, off = wgid / NXCD; wgid = (xcd < r ? xcd * (q + 1) : r * (q + 1) + (xcd - r) * q) + off; }
        const int nig = WGM * nN, gid = wgid / nig, fm = gid * WGM;
        const int fpm = fm + ((wgid % nig) % WGM), fpn = (wgid % nig) / WGM;
        const int ut = full ? 0 : L - nfull, tile = ut >> 3, ks = ut & 7, base = (ntfull / 8) & ~1, extra = (ntfull - 8 * base) / 2;
        const int tpm = 32 + tile / nN, tpn = tile % nN, tnt = base + (ks < extra ? 2 : 0), tk0 = ks * base + 2 * (ks < extra ? ks : extra);
        Unit r_; r_.pm = full ? fpm : tpm; r_.pn = full ? fpn : tpn; r_.k0 = full ? 0 : tk0; r_.nt = full ? ntfull : tnt; r_.part = full ? -1 : ks;
        u = r_; return true;
    }
    __device__ __forceinline__ void a_ready(const Unit&) const {}
    __device__ __forceinline__ void done(const Unit&) const {}
};

__device__ __forceinline__ unsigned cvt_pk_bf16(float lo, float hi) { unsigned r; asm volatile("v_cvt_pk_bf16_f32 %0, %1, %2" : "=v"(r) : "v"(lo), "v"(hi)); return r; }

struct EpiStoreBf16 {
    static constexpr bool PERM = true, AFTER_DRAIN = false;
    bf16_t* O; int ldc;
    __device__ __forceinline__ void operator()(const f32x4 (&acc)[2][2][4][2], const Unit& u, int wr, int wc, int fr, int fq) const {
        const int row0 = u.pm * BM + wr * 64 + fr, col0 = u.pn * BM + wc * 32 + 8 * fq;
#pragma unroll
        for (int ai = 0; ai < 2; ++ai)
#pragma unroll
            for (int m = 0; m < 4; ++m) { bf16_t* rowp = O + (size_t)(row0 + ai * HALF + m * 16) * ldc + col0;
#pragma unroll
                for (int bj = 0; bj < 2; ++bj) { const f32x4 v0 = acc[ai][bj][m][0], v1 = acc[ai][bj][m][1];
                    u32x4 w; w.x = cvt_pk_bf16(v0[0], v0[1]); w.y = cvt_pk_bf16(v0[2], v0[3]); w.z = cvt_pk_bf16(v1[0], v1[1]); w.w = cvt_pk_bf16(v1[2], v1[3]);
                    *(u32x4*)(rowp + bj * HALF) = w; } }
    }
};
struct EpiResAdd {
    static constexpr bool PERM = true, AFTER_DRAIN = false;
    float* O; int ldc; float* P;
    __device__ __forceinline__ void operator()(const f32x4 (&acc)[2][2][4][2], const Unit& u, int wr, int wc, int fr, int fq) const {
        const int row0 = u.pm * BM + wr * 64 + fr, col0 = u.pn * BM + wc * 32 + 8 * fq;
        if (u.part < 0) {
#pragma unroll
            for (int ai = 0; ai < 2; ++ai)
#pragma unroll
                for (int m = 0; m < 4; ++m) { float* rowp = O + (size_t)(row0 + ai * HALF + m * 16) * ldc + col0;
#pragma unroll
                    for (int bj = 0; bj < 2; ++bj) {
                        f32x4 a = *(const f32x4*)(rowp + bj * HALF), b = *(const f32x4*)(rowp + bj * HALF + 4);
                        *(f32x4*)(rowp + bj * HALF) = a + acc[ai][bj][m][0]; *(f32x4*)(rowp + bj * HALF + 4) = b + acc[ai][bj][m][1]; } }
        } else {
            float* base = P + (size_t)u.part * 1024 * ldc;
#pragma unroll
            for (int ai = 0; ai < 2; ++ai)
#pragma unroll
                for (int m = 0; m < 4; ++m) { float* rowp = base + (size_t)(row0 - 8192 + ai * HALF + m * 16) * ldc + col0;
#pragma unroll
                    for (int bj = 0; bj < 2; ++bj) { *(f32x4*)(rowp + bj * HALF) = acc[ai][bj][m][0]; *(f32x4*)(rowp + bj * HALF + 4) = acc[ai][bj][m][1]; } }
        }
    }
};
struct EpiSwiGLU {
    static constexpr bool PERM = true, AFTER_DRAIN = false;
    bf16_t* O; int ldc;
    __device__ __forceinline__ void operator()(const f32x4 (&acc)[2][2][4][2], const Unit& u, int wr, int wc, int fr, int fq) const {
        const int row0 = u.pm * BM + wr * 64 + fr, col0 = u.pn * HALF + wc * 32 + 8 * fq;
#pragma unroll
        for (int ai = 0; ai < 2; ++ai)
#pragma unroll
            for (int m = 0; m < 4; ++m) { bf16_t* rowp = O + (size_t)(row0 + ai * HALF + m * 16) * ldc + col0;
                float o[8];
#pragma unroll
                for (int n = 0; n < 2; ++n)
#pragma unroll
                    for (int j = 0; j < 4; ++j) { const float g = acc[ai][0][m][n][j], up = acc[ai][1][m][n][j]; o[n * 4 + j] = g * up * __builtin_amdgcn_rcpf(1.0f + __expf(-g)); }
                u32x4 w; w.x = cvt_pk_bf16(o[0], o[1]); w.y = cvt_pk_bf16(o[2], o[3]); w.z = cvt_pk_bf16(o[4], o[5]); w.w = cvt_pk_bf16(o[6], o[7]);
                *(u32x4*)rowp = w; }
    }
};

template <class Epi, class Sched, bool ALIGN_EPI = false, bool SP2 = false>
__device__ __forceinline__ void gemm_phase(PG8_LAS unsigned char* lds, const Gemm g, const Sched& S, const Epi& E, const int tid) {
    const int wid = __builtin_amdgcn_readfirstlane(tid >> 6), lane = tid & 63, wr = wid >> 2, wc = wid & 3, fr = lane & 15, fq = lane >> 4;
    const int K = g.K;
    unsigned voffA[2], voffB[2];
#pragma unroll
    for (int i = 0; i < 2; ++i) { int R, C; stage_rc(tid * 16 + i * 8192, R, C); const int Rb = Epi::PERM ? ((R & ~31) + perm32(R & 31)) : R;
        voffA[i] = (unsigned)(R * K + C) * 2u; voffB[i] = (unsigned)(Rb * K + C) * 2u; }
    const size_t kstep = (size_t)(BK * 2);
    const size_t hstep = (size_t)HALF * K * 2;
    const size_t tstep = 2 * hstep;
    const unsigned ldsw = (unsigned)wid * 1024u;
    const int aoff = lds_byte(wr * 64 + fr, fq * 8), boff = lds_byte(wc * 32 + fr, fq * 8);
#define PG8_SA(b, h) (((b) * 2 + (h)) * HTB)
#define PG8_SB(b, h) ((4 + (b) * 2 + (h)) * HTB)
#define PG8_STAGE(bufoff, gbase, voff) do { _Pragma("unroll") for (int _i = 0; _i < 2; ++_i) \
        __builtin_amdgcn_global_load_lds((const unsigned*)((const char*)(gbase) + (voff)[_i]), (PG8_LAS unsigned*)(lds + (bufoff) + ldsw + _i * 8192), 16, 0, 0); } while (0)
#define PG8_LDA(dst, b, h) do { _Pragma("unroll") for (int m = 0; m < 4; ++m) _Pragma("unroll") for (int k = 0; k < 2; ++k) dst[m][k] = *(const PG8_LAS bf16x8*)(lds + PG8_SA(b, h) + aoff + m * 2048 + k * 1024); } while (0)
#define PG8_LDB(dst, b, h) do { _Pragma("unroll") for (int n = 0; n < 2; ++n) _Pragma("unroll") for (int k = 0; k < 2; ++k) dst[n][k] = *(const PG8_LAS bf16x8*)(lds + PG8_SB(b, h) + boff + n * 2048 + k * 1024); } while (0)
#define PG8_MMA(ai, bj, At, Bt) do { __builtin_amdgcn_s_setprio(1); _Pragma("unroll") for (int m = 0; m < 4; ++m) _Pragma("unroll") for (int n = 0; n < 2; ++n) _Pragma("unroll") for (int k = 0; k < 2; ++k) \
        acc[ai][bj][m][n] = __builtin_amdgcn_mfma_f32_16x16x32_bf16(Bt[n][k], At[m][k], acc[ai][bj][m][n], 0, 0, 0); __builtin_amdgcn_s_setprio(0); } while (0)
#define PG8_WAIT_V(n) asm volatile("s_waitcnt vmcnt(" #n ")" ::: "memory")
#define PG8_WAIT_L(n) asm volatile("s_waitcnt lgkmcnt(" #n ")" ::: "memory")
#define PG8_BAR __builtin_amdgcn_s_barrier()
#define PG8_SCHED __builtin_amdgcn_sched_barrier(0)
    Unit cur, nxt; int ui = 0;
    if (!S.next(0, cur)) return;
    f32x4 acc[2][2][4][2];
#pragma unroll
    for (int a = 0; a < 2; ++a)
#pragma unroll
        for (int b = 0; b < 2; ++b)
#pragma unroll
            for (int m = 0; m < 4; ++m)
#pragma unroll
                for (int n = 0; n < 2; ++n) acc[a][b][m][n] = (f32x4){0.f, 0.f, 0.f, 0.f};
    bf16x8 At[4][2], B0[2][2], B1[2][2];
    const char* cA = (const char*)g.A + (size_t)cur.pm * tstep + (size_t)cur.k0 * kstep; const char* cB = (const char*)g.Bt + (size_t)cur.pn * tstep + (size_t)cur.k0 * kstep;
    S.a_ready(cur);
    if constexpr (SP2) {
        PG8_STAGE(PG8_SB(0, 0), cB, voffB); PG8_STAGE(PG8_SB(0, 1), cB + hstep, voffB); PG8_STAGE(PG8_SA(0, 0), cA, voffA); PG8_STAGE(PG8_SA(0, 1), cA + hstep, voffA);
        if (wr == 1) PG8_BAR;
        PG8_WAIT_V(2); PG8_BAR;
        PG8_STAGE(PG8_SB(1, 0), cB + kstep, voffB); PG8_STAGE(PG8_SA(1, 0), cA + kstep, voffA); PG8_STAGE(PG8_SB(1, 1), cB + hstep + kstep, voffB);
        PG8_WAIT_V(6); PG8_BAR;
    } else {
        PG8_STAGE(PG8_SB(0, 0), cB, voffB); PG8_STAGE(PG8_SA(0, 0), cA, voffA); PG8_STAGE(PG8_SB(0, 1), cB + hstep, voffB); PG8_STAGE(PG8_SA(0, 1), cA + hstep, voffA);
        if (wr == 1) PG8_BAR;
        PG8_WAIT_V(4); PG8_BAR;
        PG8_STAGE(PG8_SB(1, 0), cB + kstep, voffB); PG8_STAGE(PG8_SA(1, 0), cA + kstep, voffA); PG8_STAGE(PG8_SB(1, 1), cB + hstep + kstep, voffB);
        PG8_WAIT_V(6); PG8_BAR;
    }
    for (;;) {
        const bool has_next = S.next(ui + 1, nxt);
        const char* nA = has_next ? (const char*)g.A + (size_t)nxt.pm * tstep + (size_t)nxt.k0 * kstep : cA; const char* nB = has_next ? (const char*)g.Bt + (size_t)nxt.pn * tstep + (size_t)nxt.k0 * kstep : cB;
        const int nt = cur.nt;
        for (int t = 0; t < nt; t += 2) {
            const bool last = (t == nt - 2);
            const char* a1 = cA + (size_t)(t + 1) * kstep;
            const char* a2 = last ? nA : cA + (size_t)(t + 2) * kstep; const char* b2 = last ? nB : cB + (size_t)(t + 2) * kstep;
            const char* a3 = a2 + kstep; const char* b3 = b2 + kstep;
            if (last && has_next) S.a_ready(nxt);
            if constexpr (SP2) {
            PG8_LDB(B0, 0, 0); PG8_LDB(B1, 0, 1); PG8_SCHED; PG8_LDA(At, 0, 0); PG8_STAGE(PG8_SA(1, 1), a1 + hstep, voffA);
            PG8_WAIT_V(8); PG8_WAIT_L(0); PG8_BAR; PG8_MMA(0, 0, At, B0); PG8_MMA(0, 1, At, B1); PG8_BAR; PG8_SCHED;
            PG8_LDA(At, 0, 1); PG8_STAGE(PG8_SB(0, 0), b2, voffB); PG8_STAGE(PG8_SB(0, 1), b2 + hstep, voffB); PG8_STAGE(PG8_SA(0, 0), a2, voffA);
            PG8_WAIT_V(8); PG8_WAIT_L(0); PG8_BAR; PG8_MMA(1, 0, At, B0); PG8_MMA(1, 1, At, B1); PG8_BAR; PG8_SCHED;
            PG8_LDB(B0, 1, 0); PG8_LDB(B1, 1, 1); PG8_SCHED; PG8_LDA(At, 1, 0); PG8_STAGE(PG8_SA(0, 1), a2 + hstep, voffA);
            PG8_WAIT_V(8); PG8_WAIT_L(0); PG8_BAR; PG8_MMA(0, 0, At, B0); PG8_MMA(0, 1, At, B1); PG8_BAR; PG8_SCHED;
            PG8_LDA(At, 1, 1); PG8_STAGE(PG8_SB(1, 0), b3, voffB); PG8_STAGE(PG8_SB(1, 1), b3 + hstep, voffB); PG8_STAGE(PG8_SA(1, 0), a3, voffA);
            PG8_WAIT_V(8); PG8_WAIT_L(0); PG8_BAR; PG8_MMA(1, 0, At, B0); PG8_MMA(1, 1, At, B1); PG8_BAR; PG8_SCHED;
            } else {
            PG8_LDB(B0, 0, 0); PG8_SCHED; PG8_LDA(At, 0, 0); PG8_STAGE(PG8_SA(1, 1), a1 + hstep, voffA);
            PG8_WAIT_L(8); PG8_BAR; PG8_WAIT_L(0); PG8_MMA(0, 0, At, B0); PG8_BAR; PG8_SCHED;
            PG8_LDB(B1, 0, 1); PG8_STAGE(PG8_SB(0, 0), b2, voffB);
            PG8_BAR; PG8_WAIT_L(0); PG8_MMA(0, 1, At, B1); PG8_BAR;
            PG8_LDA(At, 0, 1); PG8_STAGE(PG8_SA(0, 0), a2, voffA);
            PG8_BAR; PG8_WAIT_L(0); PG8_MMA(1, 0, At, B0); PG8_BAR; PG8_SCHED;
            PG8_STAGE(PG8_SB(0, 1), b2 + hstep, voffB);
            PG8_WAIT_V(6); PG8_BAR; PG8_MMA(1, 1, At, B1); PG8_BAR;
            PG8_LDB(B0, 1, 0); PG8_SCHED; PG8_LDA(At, 1, 0); PG8_STAGE(PG8_SA(0, 1), a2 + hstep, voffA);
            PG8_WAIT_L(8); PG8_BAR; PG8_WAIT_L(0); PG8_MMA(0, 0, At, B0); PG8_BAR; PG8_SCHED;
            PG8_LDB(B1, 1, 1); PG8_STAGE(PG8_SB(1, 0), b3, voffB);
            PG8_BAR; PG8_WAIT_L(0); PG8_MMA(0, 1, At, B1); PG8_BAR;
            PG8_LDA(At, 1, 1); PG8_STAGE(PG8_SA(1, 0), a3, voffA);
            PG8_BAR; PG8_WAIT_L(0); PG8_MMA(1, 0, At, B0); PG8_BAR; PG8_SCHED;
            PG8_STAGE(PG8_SB(1, 1), b3 + hstep, voffB);
            PG8_WAIT_V(6); PG8_BAR; PG8_MMA(1, 1, At, B1); PG8_BAR;
            }
        }
        if constexpr (ALIGN_EPI) { if (wr == 0) PG8_BAR; }
        if constexpr (!Epi::AFTER_DRAIN) { E(acc, cur, wr, wc, fr, fq); S.done(cur); }
        if (!has_next) break;
#pragma unroll
        for (int a = 0; a < 2; ++a)
#pragma unroll
            for (int b = 0; b < 2; ++b)
#pragma unroll
                for (int m = 0; m < 4; ++m)
#pragma unroll
                    for (int n = 0; n < 2; ++n) acc[a][b][m][n] = (f32x4){0.f, 0.f, 0.f, 0.f};
        cur = nxt; cA = nA; cB = nB; ++ui;
        if constexpr (ALIGN_EPI) { if (wr == 1) PG8_BAR; }
    }
    PG8_WAIT_V(0);
    if constexpr (!ALIGN_EPI) { if (wr == 0) PG8_BAR; }
    PG8_BAR;
    if constexpr (Epi::AFTER_DRAIN) { E.fused(acc, cur, wr, wc, fr, fq, lds, wid, lane); S.done(cur); }
#undef PG8_SA
#undef PG8_SB
#undef PG8_STAGE
#undef PG8_LDA
#undef PG8_LDB
#undef PG8_MMA
#undef PG8_WAIT_V
#undef PG8_WAIT_L
#undef PG8_BAR
#undef PG8_SCHED
}
}

#define LAS __attribute__((address_space(3)))
typedef unsigned short bf16;
typedef float f32x4 __attribute__((ext_vector_type(4)));
typedef float f32x2 __attribute__((ext_vector_type(2)));
typedef unsigned u32x4 __attribute__((ext_vector_type(4)));
typedef unsigned u32x2 __attribute__((ext_vector_type(2)));
typedef short bfx8 __attribute__((ext_vector_type(8)));
#define XB_TMO      128
#define XB_XCNT(j)  (256  + 64 * (j))
#define XB_XSUB(j)  (1280 + 64 * (j))
#define XB_XGEN(j)  (2304 + 64 * (j))
#define XB_TOP      3328
#define XB_TOPGEN   3392
#define XCD_BAR_WORDS 3456
#define XB_SPIN_CAP (1u << 18)

__device__ __forceinline__ unsigned xb_ld(unsigned* p)              { return __hip_atomic_load(p, __ATOMIC_RELAXED, __HIP_MEMORY_SCOPE_AGENT); }
__device__ __forceinline__ unsigned xb_add(unsigned* p, unsigned v) { return __hip_atomic_fetch_add(p, v, __ATOMIC_RELAXED, __HIP_MEMORY_SCOPE_AGENT); }
__device__ __forceinline__ unsigned xb_xcc_id() { return (unsigned)__builtin_amdgcn_s_getreg((3 << 11) | 20) & 0xFu; }
#define XB_SPIN(cond, bar) do { unsigned _sp = 0; while (cond) { __builtin_amdgcn_s_sleep(1); \
    if ((++_sp & 255u) == 0u) { if (xb_ld(&(bar)[XB_TMO])) break; if (_sp > XB_SPIN_CAP) { atomicAdd(&(bar)[XB_TMO], 1u); break; } } } } while (0)

struct XcdBarrier {
    unsigned* bar; unsigned x;
    volatile LAS unsigned* st;
};

__device__ __forceinline__ XcdBarrier xcd_barrier_post(unsigned* bar, volatile LAS unsigned* st, int tid) {
    XcdBarrier b; b.bar = bar; b.x = xb_xcc_id(); b.st = st;
    if (tid == 0) (void)xb_add(&bar[XB_XCNT(b.x)], 1u);
    return b;
}
__device__ __forceinline__ void xcd_barrier_complete(unsigned* bar, unsigned x, unsigned& nloc, unsigned& nx) {
    const unsigned G = gridDim.x * gridDim.y * gridDim.z;
    unsigned sum, cnt, mine, sp = 0u;
    for (;;) {
        sum = 0u; cnt = 0u; mine = 0u;
#pragma unroll
        for (unsigned j = 0; j < 16; ++j) { const unsigned c = xb_ld(&bar[XB_XCNT(j)]); sum += c; cnt += (c > 0u) ? 1u : 0u; mine = (j == x) ? c : mine; }
        if (sum == G) break;
        __builtin_amdgcn_s_sleep(1);
        if ((++sp & 255u) == 0u) { if (xb_ld(&bar[XB_TMO])) break; if (sp > XB_SPIN_CAP) { atomicAdd(&bar[XB_TMO], 1u); break; } }
    }
    nloc = mine > 0u ? mine : 1u; nx = cnt > 0u ? cnt : 1u;
}

__device__ __forceinline__ void xcd_barrier(const XcdBarrier& b, int tid) {
    asm volatile("s_waitcnt vmcnt(0)" ::: "memory");
    __syncthreads();
    if (tid == 0) {
        unsigned* bar = b.bar;
        __builtin_amdgcn_s_waitcnt(0);
        unsigned nloc = b.st[0], nx = b.st[1];
        if (nloc == 0u) { xcd_barrier_complete(bar, b.x, nloc, nx); b.st[0] = nloc; b.st[1] = nx; }
        const unsigned old = xb_add(&bar[XB_XSUB(b.x)], 1u);
        const unsigned gen = old / nloc;
        if (old + 1u == (gen + 1u) * nloc) {
            __builtin_amdgcn_fence(__ATOMIC_RELEASE, "agent");
            asm volatile("s_waitcnt vmcnt(0)" ::: "memory");
            const unsigned og = xb_add(&bar[XB_TOP], 1u);
            const unsigned tg = og / nx;
            if (og + 1u == (tg + 1u) * nx) xb_add(&bar[XB_TOPGEN], 1u);
            else XB_SPIN(xb_ld(&bar[XB_TOPGEN]) == tg, bar);
            __builtin_amdgcn_fence(__ATOMIC_ACQUIRE, "agent");
            xb_add(&bar[XB_XGEN(b.x)], 1u);
            asm volatile("s_waitcnt vmcnt(0)" ::: "memory");
        } else {
            XB_SPIN(xb_ld(&bar[XB_XGEN(b.x)]) == gen, bar);
            __builtin_amdgcn_fence(__ATOMIC_ACQUIRE, "agent");
            asm volatile("s_waitcnt vmcnt(0)" ::: "memory");
        }
    }
    __syncthreads();
}

constexpr int NWAVES = 8, NTHR = 512;
constexpr int TP = 8192, TS = 1024, T = 9216, D = 2048, NIN = 4800, NZ = 4864, FF = 5632, NGU = 11264;
constexpr int NH = 16, HS = 64, RD = 1024, RP = 3264, DEPTH = 4;
constexpr int ZQ = 1536;
constexpr float RMS_EPS = 1e-6f, LN_EPS = 1e-5f, GN_EPS = 64e-5f;
constexpr int SCR = 384;
constexpr size_t O_Y = 0;
constexpr size_t O_CONV_P = (size_t)T * D;
constexpr size_t O_POOL_P = O_CONV_P + (size_t)DEPTH * 4 * 30 * 512;
constexpr size_t O_SHIFT_P = O_POOL_P + (size_t)DEPTH * 4 * 15 * 512;
constexpr size_t O_WKV_P = O_SHIFT_P + (size_t)DEPTH * 4 * RP;
constexpr size_t O_CONV_S = O_WKV_P + (size_t)DEPTH * 4 * NH * 4096;
constexpr size_t O_POOL_S = O_CONV_S + (size_t)DEPTH * 16 * 30 * 512;
constexpr size_t O_SHIFT_S = O_POOL_S + (size_t)DEPTH * 16 * 15 * 512;
constexpr size_t O_WKV_S = O_SHIFT_S + (size_t)DEPTH * 16 * RP;
constexpr size_t O_END = O_WKV_S + (size_t)DEPTH * 16 * NH * 4096;
constexpr size_t WS_POOLW = 131072;
constexpr size_t WS_UPS = 262144;
constexpr size_t WS_WIN = 1u << 20;
constexpr size_t WS_WOUT = WS_WIN + (size_t)NZ * D * 2;
constexpr size_t WS_WGU = WS_WOUT + (size_t)D * D * 2;
constexpr size_t WS_WDN = WS_WGU + (size_t)NGU * D * 2;
constexpr size_t WS_X = WS_WDN + (size_t)D * FF * 2;
constexpr size_t WS_XN = WS_X + (size_t)T * D * 4;
constexpr size_t WS_MIX = WS_XN + (size_t)T * D * 2;
constexpr size_t WS_Z = WS_MIX + (size_t)T * D * 2;
constexpr size_t WS_ACT = WS_Z;
constexpr size_t WS_SC = WS_Z + (size_t)T * NZ * 2;
constexpr size_t WS_PART = WS_SC + (32u << 20);
constexpr size_t WS_Y = WS_SC + (size_t)T * NH * SCR * 4;
constexpr size_t WS_G = WS_Y + (size_t)T * RD * 4;
constexpr size_t WS_RK = WS_G + (size_t)T * RD * 4;
constexpr int NC = 16, CL = 128;
constexpr size_t WS_PQ = WS_RK + (size_t)T * NH * 4;
constexpr size_t WS_S0 = WS_PQ + (size_t)64 * NC * 2 * 4096 * 4;
constexpr size_t WS_GB = WS_S0 + (size_t)64 * NC * 4096 * 4;
constexpr size_t WS_W2 = WS_GB + (size_t)TP * RD * 4;
constexpr size_t WSET = WS_X - WS_WIN;
constexpr size_t WS_END = WS_W2 + WSET;
static_assert(WS_ACT + (size_t)T * FF * 2 <= WS_PART && WS_PART + (size_t)8 * 1024 * D * 4 <= WS_Y, "act / partial overlays");
constexpr int LDS_BYTES = 147456;
constexpr int CVT_SPLIT = 20500;

#define GSYNC() do { int w_ = wave0; asm volatile("" : "+s"(w_)); xcd_barrier(xbar, w_ * 64 + (int)__builtin_amdgcn_mbcnt_hi(~0u, __builtin_amdgcn_mbcnt_lo(~0u, (unsigned)launder_v(0)))); } while (0)
__host__ __device__ __forceinline__ size_t sc_off(int t, int h) { return ((size_t)(((t >> 2) * NH + h) * 4 + (t & 3))) * SCR; }
struct Params { const float* in[31]; float* out; unsigned char* ws; };
typedef const __attribute__((address_space(4))) Params* KP;
__device__ __forceinline__ KP kargs() { KP k = (KP)__builtin_amdgcn_kernarg_segment_ptr(); asm volatile("" : "+s"(k)); return k; }
__device__ __forceinline__ int launder_v(int v) { asm volatile("" : "+v"(v)); return v; }
#define PH_BEGIN() KP kp = kargs(); int wave_ = wave0; asm volatile("" : "+s"(wave_)); const int wave = wave_; const int lane = (int)__builtin_amdgcn_mbcnt_hi(~0u, __builtin_amdgcn_mbcnt_lo(~0u, (unsigned)launder_v(0))); const int tid = wave * 64 + lane; \
    const int nb = gridDim.x, bid = blockIdx.x, gw = bid * NWAVES + wave, ngw = nb * NWAVES; unsigned char* const ws = kp->ws; (void)lane; (void)wave; (void)gw; (void)ngw; (void)ws; (void)nb; (void)bid

template <int M> __device__ __forceinline__ float swz_xor(float v) { return __builtin_bit_cast(float, __builtin_amdgcn_ds_swizzle(__builtin_bit_cast(int, v), 0x1f | (M << 10))); }
__device__ __forceinline__ float rowsum16(float v) { v += swz_xor<1>(v); v += swz_xor<2>(v); v += swz_xor<4>(v); v += swz_xor<8>(v); return v; }
__device__ __forceinline__ float wave_sum(float v) {
    v = rowsum16(v); v += swz_xor<16>(v);
    const int ln = (int)__builtin_amdgcn_mbcnt_hi(~0u, __builtin_amdgcn_mbcnt_lo(~0u, (unsigned)launder_v(0)));
    v += __builtin_bit_cast(float, __builtin_amdgcn_ds_bpermute((ln ^ 32) << 2, __builtin_bit_cast(int, v)));
    return v;
}
__device__ __forceinline__ unsigned f2bf(float f) { unsigned u = __builtin_bit_cast(unsigned, f); return (u + 0x7fffu + ((u >> 16) & 1u)) >> 16; }
__device__ __forceinline__ unsigned pk2(float lo, float hi) { return f2bf(lo) | (f2bf(hi) << 16); }
__device__ __forceinline__ float bf2f(bf16 v) { return __builtin_bit_cast(float, (unsigned)v << 16); }
__device__ __forceinline__ float sigm(float x) { return __builtin_amdgcn_rcpf(1.0f + __expf(-x)); }

__device__ __forceinline__ void transpose_item(const float* W, int K, int N, bf16* WT, int mode, LAS float* scr, int item, int lane) {
    const int nblk = N / 32, kb = item / nblk, nb = item % nblk, k0 = 64 * kb, n0 = 32 * nb;
    const int drow0 = (mode == 0) ? n0 : ((n0 >> 7) * 256 + (n0 & 127) + (mode == 2 ? 128 : 0));
    float wv[32];
#pragma unroll
    for (int i = 0; i < 32; ++i) { const int kk = 2 * i + (lane >> 5); wv[i] = W[(size_t)(k0 + kk) * N + n0 + (lane & 31)]; }
#pragma unroll
    for (int i = 0; i < 32; ++i) { const int kk = 2 * i + (lane >> 5); scr[kk * 33 + (lane & 31)] = wv[i]; }
    asm volatile("s_waitcnt lgkmcnt(0)" ::: "memory");
    const int c = lane & 7;
#pragma unroll
    for (int j = 0; j < 4; ++j) { const int n = (lane >> 3) + 8 * j; const LAS float* s = scr + (8 * c) * 33 + n;
        u32x4 o; o.x = pk2(s[0 * 33], s[1 * 33]); o.y = pk2(s[2 * 33], s[3 * 33]); o.z = pk2(s[4 * 33], s[5 * 33]); o.w = pk2(s[6 * 33], s[7 * 33]);
        *(u32x4*)(WT + (size_t)(drow0 + n) * K + k0 + 8 * c) = o; }
    asm volatile("s_waitcnt lgkmcnt(0)" ::: "memory");
}
__device__ __forceinline__ void convert_weights(KP kp, int l, LAS float* scr, int gw, int ngw, int lane, int item_lo = 0, int item_hi = 1 << 30) {
    unsigned char* ws = kp->ws;
    unsigned char* wsw = kp->ws + ((l & 1) ? (WS_W2 - WS_WIN) : 0);
    bf16* WIN = (bf16*)(wsw + WS_WIN); bf16* WOUT = (bf16*)(wsw + WS_WOUT); bf16* WGU = (bf16*)(wsw + WS_WGU); bf16* WDN = (bf16*)(wsw + WS_WDN);
    constexpr int I_IN = (D / 64) * (NIN / 32), I_OUT = (D / 64) * (D / 32), I_G = (D / 64) * (FF / 32), I_D = (FF / 64) * (D / 32);
    constexpr int I_P = 4 * 8, I_U = 3 * 32;
    constexpr int NITEMS = I_IN + I_OUT + 2 * I_G + I_D + I_P + I_U;
    const int it_end = item_hi < NITEMS ? item_hi : NITEMS;
    for (int it = item_lo + gw; it < it_end; it += ngw) {
        int r = it;
        if (r < I_IN) { transpose_item(kp->in[7] + (size_t)l * D * NIN, D, NIN, WIN, 0, scr, r, lane); continue; } r -= I_IN;
        if (r < I_OUT) { transpose_item(kp->in[25] + (size_t)l * D * D, D, D, WOUT, 0, scr, r, lane); continue; } r -= I_OUT;
        if (r < I_G) { transpose_item(kp->in[27] + (size_t)l * D * FF, D, FF, WGU, 1, scr, r, lane); continue; } r -= I_G;
        if (r < I_G) { transpose_item(kp->in[28] + (size_t)l * D * FF, D, FF, WGU, 2, scr, r, lane); continue; } r -= I_G;
        if (r < I_D) { transpose_item(kp->in[29] + (size_t)l * FF * D, FF, D, WDN, 0, scr, r, lane); continue; } r -= I_D;
        if (r < I_P) { const int g = r >> 3; transpose_item(kp->in[12] + (size_t)((l * 4 + g) * 128) * 128, 128, 128, (bf16*)(ws + WS_POOLW) + (size_t)g * 128 * 128, 0, scr, r & 7, lane); continue; } r -= I_P;
        { const int m = r >> 5; const float* src = (m == 0 ? kp->in[16] : (m == 1 ? kp->in[18] : kp->in[19])) + (size_t)l * 64 * RD;
          transpose_item(src, 64, RD, (bf16*)(ws + WS_UPS) + (size_t)m * RD * 64, 0, scr, r & 31, lane); }
    }
    if (item_lo == 0) { const unsigned z = (unsigned)launder_v(0); for (int e = gw * 64 + lane; e < 16384; e += ngw * 64) ((u32x4*)(WIN + (size_t)NIN * D))[e] = (u32x4){z, z, z, z}; }
}
__device__ __forceinline__ void norm_rows(const float* sa, const float* sb, const float* g, float* xcopy, bf16* xn, float* fout, const float* part, int gw, int ngw, int lane) {
    f32x4 vn[8];
    if (gw < T) { const float* row = (gw < TP) ? sa + (size_t)gw * D : sb + (size_t)(gw - TP) * D;
#pragma unroll
        for (int j = 0; j < 8; ++j) vn[j] = ((const f32x4*)row)[lane + 64 * j]; }
    for (int m = gw; m < T; m += ngw) {
        f32x4 v[8]; float ss = 0.f;
#pragma unroll
        for (int j = 0; j < 8; ++j) v[j] = vn[j];
        { const int mn = m + ngw;
          if (mn < T) { const float* row = (mn < TP) ? sa + (size_t)mn * D : sb + (size_t)(mn - TP) * D;
#pragma unroll
            for (int j = 0; j < 8; ++j) vn[j] = ((const f32x4*)row)[lane + 64 * j]; } }
        if (part && m >= TP) {
#pragma unroll
            for (int k = 0; k < 8; ++k)
#pragma unroll
                for (int j = 0; j < 8; ++j) v[j] += ((const f32x4*)(part + ((size_t)k * 1024 + (m - TP)) * D))[lane + 64 * j];
#pragma unroll
            for (int j = 0; j < 8; ++j) ((f32x4*)(const_cast<float*>(sb) + (size_t)(m - TP) * D))[lane + 64 * j] = v[j];
        }
#pragma unroll
        for (int j = 0; j < 8; ++j) ss += (v[j].x * v[j].x + v[j].y * v[j].y) + (v[j].z * v[j].z + v[j].w * v[j].w);
        const float rinv = __builtin_amdgcn_rsqf(wave_sum(ss) * (1.0f / D) + RMS_EPS);
#pragma unroll
        for (int j = 0; j < 8; ++j) {
            if (xcopy) ((f32x4*)(xcopy + (size_t)m * D))[lane + 64 * j] = v[j];
            const f32x4 gj = ((const f32x4*)g)[lane + 64 * j];
            const f32x4 y = v[j] * rinv * gj;
            if (xn) { u32x2 o; o.x = pk2(y.x, y.y); o.y = pk2(y.z, y.w); ((u32x2*)(xn + (size_t)m * D))[lane + 64 * j] = o; }
            if (fout) ((f32x4*)(fout + (size_t)m * D))[lane + 64 * j] = y;
        }
    }
}

__device__ __forceinline__ void conv_item(KP kp, int l, int item, LAS float* lds, int tid_in) {
    const int tid = launder_v(tid_in);
    const bf16* Z = (const bf16*)(kp->ws + WS_Z); bf16* MIX = (bf16*)(kp->ws + WS_MIX);
    const int t0 = item * 32;
    int s, tau0, Ls; bool prompt;
    if (t0 < TP) { s = t0 >> 11; tau0 = t0 & 2047; Ls = 2048; prompt = true; } else { s = (t0 - TP) >> 6; tau0 = (t0 - TP) & 63; Ls = 64; prompt = false; }
    const int c = tid;
    const float* cw = kp->in[8] + (size_t)l * 31 * 512;
    float w[31];
#pragma unroll
    for (int j = 0; j < 31; ++j) w[j] = cw[j * 512 + c];
    const float bias = kp->in[9][l * 512 + c];
    float acc[32];
#pragma unroll
    for (int i = 0; i < 32; ++i) acc[i] = bias;
    const bool first = (tau0 == 0), lastit = (tau0 + 32 == Ls);
    float* oc = prompt ? kp->out + O_CONV_P + (size_t)((l * 4 + s) * 30) * 512 : kp->out + O_CONV_S + (size_t)((l * 16 + s) * 30) * 512;
    const float* cc = kp->in[2] + (size_t)((l * 16 + s) * 30) * 512;
#pragma unroll
    for (int hf = 0; hf < 2; ++hf) {
        float pv[31], pg[31];
#pragma unroll
        for (int k = 0; k < 31; ++k) { const int ii = hf * 31 + k;
            if (ii < 30 && first) { pv[k] = prompt ? 0.f : cc[ii * 512 + c]; pg[k] = 0.f; }
            else { const bf16* zr = Z + (size_t)(t0 + ii - 30) * NZ; pv[k] = bf2f(zr[c]); pg[k] = bf2f(zr[512 + c]); } }
#pragma unroll
        for (int k = 0; k < 31; ++k) { const int ii = hf * 31 + k;
            const float u = (ii < 30 && first) ? pv[k] : pv[k] * sigm(pg[k]);
            if (ii >= 32 && lastit) oc[(ii - 32) * 512 + c] = u;
#pragma unroll
            for (int oi = 0; oi < 32; ++oi) { const int j = ii - oi; if (j >= 0 && j <= 30) acc[oi] += w[j] * u; }
        }
    }
#pragma unroll
    for (int oi = 0; oi < 32; ++oi) lds[oi * 512 + c] = acc[oi];
    __syncthreads();
    const int wave = tid >> 6, lane = tid & 63;
    const f32x4 g0 = *(const f32x4*)(kp->in[10] + l * 512 + lane * 8), g1 = *(const f32x4*)(kp->in[10] + l * 512 + lane * 8 + 4);
    const f32x4 b0 = *(const f32x4*)(kp->in[11] + l * 512 + lane * 8), b1 = *(const f32x4*)(kp->in[11] + l * 512 + lane * 8 + 4);
#pragma unroll
    for (int q = 0; q < 4; ++q) {
        const int oi = wave * 4 + q;
        f32x4 a = *(const LAS f32x4*)(lds + oi * 512 + lane * 8), b = *(const LAS f32x4*)(lds + oi * 512 + lane * 8 + 4);
        const float mean = wave_sum((a.x + a.y) + (a.z + a.w) + (b.x + b.y) + (b.z + b.w)) * (1.0f / 512.0f);
        a = a - mean; b = b - mean;
        const float var = wave_sum((a.x * a.x + a.y * a.y) + (a.z * a.z + a.w * a.w) + (b.x * b.x + b.y * b.y) + (b.z * b.z + b.w * b.w)) * (1.0f / 512.0f);
        const float rstd = __builtin_amdgcn_rsqf(var + LN_EPS);
        a = a * rstd * g0 + b0; b = b * rstd * g1 + b1;
        float o[8] = {a.x, a.y, a.z, a.w, b.x, b.y, b.z, b.w};
#pragma unroll
        for (int k = 0; k < 8; ++k) o[k] = o[k] * sigm(o[k]);
        u32x4 wv; wv.x = pk2(o[0], o[1]); wv.y = pk2(o[2], o[3]); wv.z = pk2(o[4], o[5]); wv.w = pk2(o[6], o[7]);
        *(u32x4*)(MIX + (size_t)(t0 + oi) * D + lane * 8) = wv;
    }
    __syncthreads();
}
template <int W> __device__ __forceinline__ void pool_window(const float (&pvl)[47], LAS bf16* db, int c, bool prompt, int tau0) {
    float sum = 0.f;
#pragma unroll
    for (int k = 0; k < W; ++k) sum += pvl[15 - k];
#pragma unroll
    for (int oi = 0; oi < 32; ++oi) {
        if (oi > 0) sum += pvl[oi + 15] - pvl[oi + 15 - W];
        const int cnt = prompt ? min(W, tau0 + oi + 1) : W;
        db[oi * 520 + c] = (bf16)f2bf(sum * __builtin_amdgcn_rcpf((float)cnt) - pvl[oi + 15]);
    }
}
__device__ __forceinline__ void pool_item(KP kp, int l, int item, LAS unsigned char* ldsb, int tid_in) {
    const int tid = launder_v(tid_in);
    const bf16* Z = (const bf16*)(kp->ws + WS_Z); bf16* MIX = (bf16*)(kp->ws + WS_MIX);
    LAS float* pp = (LAS float*)ldsb;
    LAS bf16* db = (LAS bf16*)(ldsb + 47 * 512 * 4);
    const int t0 = item * 32;
    int s, tau0, Ls; bool prompt;
    if (t0 < TP) { s = t0 >> 11; tau0 = t0 & 2047; Ls = 2048; prompt = true; } else { s = (t0 - TP) >> 6; tau0 = (t0 - TP) & 63; Ls = 64; prompt = false; }
    const int c = tid;
    const bool first = (tau0 == 0), lastit = (tau0 + 32 == Ls);
    float* op = prompt ? kp->out + O_POOL_P + (size_t)((l * 4 + s) * 15) * 512 : kp->out + O_POOL_S + (size_t)((l * 16 + s) * 15) * 512;
    const float* cp = kp->in[3] + (size_t)((l * 16 + s) * 15) * 512;
    {
        float pvl[47];
#pragma unroll
        for (int ii = 0; ii < 47; ++ii) {
            if (ii < 15 && first) pvl[ii] = prompt ? 0.f : cp[ii * 512 + c];
            else pvl[ii] = bf2f(Z[(size_t)(t0 + ii - 15) * NZ + 1024 + c]);
        }
        if (lastit) {
#pragma unroll
            for (int ii = 32; ii < 47; ++ii) op[(ii - 32) * 512 + c] = pvl[ii];
        }
        const int gi = c >> 7;
        if (gi == 0) pool_window<2>(pvl, db, c, prompt, tau0);
        else if (gi == 1) pool_window<4>(pvl, db, c, prompt, tau0);
        else if (gi == 2) pool_window<8>(pvl, db, c, prompt, tau0);
        else pool_window<16>(pvl, db, c, prompt, tau0);
    }
    __syncthreads();
    const int lane = tid & 63, wave = tid >> 6, n16 = lane & 15, q = lane >> 4, g = wave >> 1, nh = wave & 1;
    const bf16* WT = (const bf16*)(kp->ws + WS_POOLW) + (size_t)g * 128 * 128;
    bfx8 Bf[4][4];
#pragma unroll
    for (int nt = 0; nt < 4; ++nt)
#pragma unroll
        for (int ks = 0; ks < 4; ++ks) Bf[nt][ks] = *(const bfx8*)(WT + (size_t)(nh * 64 + nt * 16 + n16) * 128 + ks * 32 + q * 8);
    float scale[4];
#pragma unroll
    for (int nt = 0; nt < 4; ++nt) scale[nt] = kp->in[13][l * 512 + g * 128 + nh * 64 + nt * 16 + n16];
#pragma unroll
    for (int mt = 0; mt < 2; ++mt) {
        bfx8 Af[4];
#pragma unroll
        for (int ks = 0; ks < 4; ++ks) Af[ks] = *(const LAS bfx8*)(db + (mt * 16 + n16) * 520 + g * 128 + ks * 32 + q * 8);
        f32x4 acc[4];
#pragma unroll
        for (int nt = 0; nt < 4; ++nt) { acc[nt] = (f32x4){0.f, 0.f, 0.f, 0.f};
#pragma unroll
            for (int ks = 0; ks < 4; ++ks) acc[nt] = __builtin_amdgcn_mfma_f32_16x16x32_bf16(Af[ks], Bf[nt][ks], acc[nt], 0, 0, 0); }
#pragma unroll
        for (int nt = 0; nt < 4; ++nt)
#pragma unroll
            for (int r = 0; r < 4; ++r) MIX[(size_t)(t0 + mt * 16 + 4 * q + r) * D + 512 + g * 128 + nh * 64 + nt * 16 + n16] = (bf16)f2bf(acc[nt][r] * scale[nt]);
    }
    __syncthreads();
}
__device__ __forceinline__ void prep_item(KP kp, int l, int item, LAS unsigned char* ldsb, int tid_in) {
    const int tid = launder_v(tid_in);
    const bf16* Z = (const bf16*)(kp->ws + WS_Z);
    float* SC = (float*)(kp->ws + WS_SC); float* G = (float*)(kp->ws + WS_G); float* RK = (float*)(kp->ws + WS_RK);
    const bf16* UPT = (const bf16*)(kp->ws + WS_UPS);
    LAS bf16* lo = (LAS bf16*)ldsb;
    const int t0 = item * 16;
    int s, tau0, Ls; bool prompt;
    if (t0 < TP) { s = t0 >> 11; tau0 = t0 & 2047; Ls = 2048; prompt = true; } else { s = (t0 - TP) >> 6; tau0 = (t0 - TP) & 63; Ls = 64; prompt = false; }
    const float* mu = kp->in[14] + (size_t)l * RP;
    const float* ssh = kp->in[4] + (size_t)(l * 16 + s) * RP;
    {
        float qv[6], qp[6], mq[6];
#pragma unroll
        for (int k = 0; k < 6; ++k) { const int e = tid + k * NTHR, tok = e / 192, col = e % 192, zc = 3072 + col, t = t0 + tok, tau = tau0 + tok;
            qv[k] = bf2f(Z[(size_t)t * NZ + ZQ + zc]);
            qp[k] = tau > 0 ? bf2f(Z[(size_t)(t - 1) * NZ + ZQ + zc]) : (prompt ? 0.f : ssh[zc]);
            mq[k] = mu[zc]; }
#pragma unroll
        for (int k = 0; k < 6; ++k) { const int e = tid + k * NTHR, tok = e / 192, col = e % 192;
            const float qs = qv[k] + (qp[k] - qv[k]) * mq[k];
            const float val = col < 64 ? (1.0f - 2.0f * __builtin_amdgcn_rcpf(1.0f + __expf(2.0f * qs))) : (col < 128 ? qs : sigm(qs));
            lo[((col >> 6) * 16 + tok) * 72 + (col & 63)] = (bf16)f2bf(val); }
    }
    __syncthreads();
    const int lane = tid & 63, wave = tid >> 6, n16 = lane & 15, q = lane >> 4;
#pragma unroll 1
    for (int hh = 0; hh < 2; ++hh) {
        const int h = wave * 2 + hh;
        f32x4 acc[3][4];
#pragma unroll
        for (int m = 0; m < 3; ++m) {
            bfx8 Af[2], Bf[4][2];
#pragma unroll
            for (int ks = 0; ks < 2; ++ks) Af[ks] = *(const LAS bfx8*)(lo + (m * 16 + n16) * 72 + ks * 32 + q * 8);
#pragma unroll
            for (int i = 0; i < 4; ++i)
#pragma unroll
                for (int ks = 0; ks < 2; ++ks) Bf[i][ks] = *(const bfx8*)(UPT + (size_t)(m * RD + h * 64 + i * 16 + n16) * 64 + ks * 32 + q * 8);
#pragma unroll
            for (int i = 0; i < 4; ++i) { acc[m][i] = (f32x4){0.f, 0.f, 0.f, 0.f};
#pragma unroll
                for (int ks = 0; ks < 2; ++ks) acc[m][i] = __builtin_amdgcn_mfma_f32_16x16x32_bf16(Af[ks], Bf[i][ks], acc[m][i], 0, 0, 0); }
        }
        float mur[4], muk[4], muv[4], w0c[4], a0c[4], kkc[4], kac[4], rkc[4], sr[4], sk[4], sv[4];
#pragma unroll
        for (int i = 0; i < 4; ++i) { const int c = h * 64 + i * 16 + n16;
            mur[i] = mu[c]; muk[i] = mu[RD + c]; muv[i] = mu[2 * RD + c];
            w0c[i] = kp->in[15][l * RD + c]; a0c[i] = kp->in[17][l * RD + c]; kkc[i] = kp->in[20][l * RD + c]; kac[i] = kp->in[21][l * RD + c]; rkc[i] = kp->in[22][l * RD + c];
            sr[i] = prompt ? 0.f : ssh[c]; sk[i] = prompt ? 0.f : ssh[RD + c]; sv[i] = prompt ? 0.f : ssh[2 * RD + c]; }
        float zc_[4][4][3], zp_[4][4][3];
#pragma unroll
        for (int r = 0; r < 4; ++r) {
            const int tok = 4 * q + r, t = t0 + tok, tau = tau0 + tok;
            const bf16* zr = Z + (size_t)t * NZ + ZQ;
#pragma unroll
            for (int i = 0; i < 4; ++i) { const int c = h * 64 + i * 16 + n16;
                zc_[r][i][0] = bf2f(zr[c]); zc_[r][i][1] = bf2f(zr[RD + c]); zc_[r][i][2] = bf2f(zr[2 * RD + c]);
                if (tau > 0) { zp_[r][i][0] = bf2f(zr[c - NZ]); zp_[r][i][1] = bf2f(zr[RD + c - NZ]); zp_[r][i][2] = bf2f(zr[2 * RD + c - NZ]); } else { zp_[r][i][0] = sr[i]; zp_[r][i][1] = sk[i]; zp_[r][i][2] = sv[i]; } }
        }
        float dv[4][4], av[4][4];
#pragma unroll
        for (int r = 0; r < 4; ++r)
#pragma unroll
            for (int i = 0; i < 4; ++i) {
                const float xw = -(w0c[i] + acc[0][i][r]);
                const float sp = fmaxf(xw, 0.f) + __logf(1.0f + __expf(-fabsf(xw)));
                dv[r][i] = __expf(-__expf(-sp - 0.5f));
                av[r][i] = sigm(a0c[i] + acc[1][i][r]);
            }
        float wpre[4];
        { const int lnx = (int)__builtin_amdgcn_mbcnt_hi(~0u, __builtin_amdgcn_mbcnt_lo(~0u, (unsigned)launder_v(0)));
#pragma unroll
          for (int i = 0; i < 4; ++i) {
            const float gq = (dv[0][i] * dv[1][i]) * (dv[2][i] * dv[3][i]);
            const float g0 = __builtin_bit_cast(float, __builtin_amdgcn_ds_bpermute(((lnx & 15)) << 2, __builtin_bit_cast(int, gq)));
            const float g1 = __builtin_bit_cast(float, __builtin_amdgcn_ds_bpermute(((lnx & 15) + 16) << 2, __builtin_bit_cast(int, gq)));
            const float g2 = __builtin_bit_cast(float, __builtin_amdgcn_ds_bpermute(((lnx & 15) + 32) << 2, __builtin_bit_cast(int, gq)));
            wpre[i] = (q > 0 ? g0 : 1.0f) * (q > 1 ? g1 : 1.0f) * (q > 2 ? g2 : 1.0f); } }
#pragma unroll
        for (int r = 0; r < 4; ++r) {
            const int tok = 4 * q + r, t = t0 + tok;
            float rv[4], kv[4], vv[4], kk[4], wex[4], win[4];
            float skk = 0.f;
#pragma unroll
            for (int i = 0; i < 4; ++i) { const int c = h * 64 + i * 16 + n16;
                float rr = zc_[r][i][0], k = zc_[r][i][1], v = zc_[r][i][2];
                rr += (zp_[r][i][0] - rr) * mur[i]; k += (zp_[r][i][1] - k) * muk[i]; v += (zp_[r][i][2] - v) * muv[i];
                rv[i] = rr; kv[i] = k; vv[i] = v; kk[i] = k * kkc[i]; skk += kk[i] * kk[i];
                wex[i] = wpre[i]; win[i] = wpre[i] * dv[r][i]; wpre[i] = win[i];
                G[(size_t)t * RD + c] = acc[2][i][r];
                }
            skk = rowsum16(skk);
            const float rinv = __builtin_amdgcn_rsqf(fmaxf(skk, 1e-24f));
            float srk = 0.f;
#pragma unroll
            for (int i = 0; i < 4; ++i) {
                const float kkn = kk[i] * rinv, kpv = kv[i] * (1.0f + (av[r][i] - 1.0f) * kac[i]), bb = kkn * av[r][i];
                srk += rv[i] * kpv * rkc[i];
                const float iw = __builtin_amdgcn_rcpf(win[i]);
                float* sc = SC + sc_off(t, h) + i * 16 + n16;
                sc[0] = wex[i] * kkn; sc[64] = bb * iw; sc[128] = kpv * iw; sc[192] = win[i] * rv[i]; sc[256] = vv[i]; sc[320] = win[i];
            }
            srk = rowsum16(srk);
            if (n16 == 0) RK[t * NH + h] = srk;
        }
    }
    if (tau0 + 16 == Ls) {
        float* osh = prompt ? kp->out + O_SHIFT_P + (size_t)(l * 4 + s) * RP : kp->out + O_SHIFT_S + (size_t)(l * 16 + s) * RP;
        const bf16* zr = Z + (size_t)(t0 + 15) * NZ + ZQ;
        for (int e = tid; e < RP; e += NTHR) osh[e] = bf2f(zr[e]);
    }
    __syncthreads();
}

__device__ __forceinline__ void sc_issue(f32x4 (&r)[4], const LAS f32x4* o, int c) {
    if (c < 4) {
#pragma unroll
        for (int i = 0; i < 4; ++i) r[i] = o[4 * c + i];
    } else { const int j = c - 4; r[1] = o[16 + j]; r[2] = o[32 + j]; r[3] = o[48 + j]; }
}
template <int MODE>
__device__ __forceinline__ void scan_run(const float* SC, int tg0, int nsteps, int h, LAS float* wl  , LAS float* yb  , int lane,
                                         const float* Sinit, float* Y, float* GB, float* Sout, float* PQout) {
    constexpr int GS = 4, NCH = 20;
    f32x2 S[32];
    f32x2 P[(MODE == 3) ? 32 : 1];
    if (MODE == 3) {
        const int ln = launder_v(lane);
#pragma unroll
        for (int j = 0; j < 32; ++j) { S[j] = (f32x2){0.f, 0.f}; P[j] = (f32x2){(2 * j == ln) ? 1.f : 0.f, (2 * j + 1 == ln) ? 1.f : 0.f}; }
    } else {
#pragma unroll
        for (int j = 0; j < 16; ++j) { const f32x4 v = ((const f32x4*)(Sinit + lane * 64))[j]; S[2 * j] = (f32x2){v.x, v.y}; S[2 * j + 1] = (f32x2){v.z, v.w}; }
    }
#define SC_STAGE(g, buf) do { const float* rec_ = SC + sc_off(tg0 + (g) * GS, h) + lane * 4; \
        _Pragma("unroll") for (int k_ = 0; k_ < 6; ++k_) __builtin_amdgcn_global_load_lds((const unsigned*)(rec_ + k_ * 256), (LAS unsigned*)(wl + (buf) * GS * SCR + k_ * 256), 16, 0, 0); } while (0)
    SC_STAGE(0, 0);
    const int ngroups = nsteps / GS;
    for (int g = 0; g < ngroups; ++g) {
        asm volatile("s_waitcnt vmcnt(0)" ::: "memory");
        if (g > 0) {
#pragma unroll
            for (int s = 0; s < GS; ++s) { Y[(size_t)(tg0 + (g - 1) * GS + s) * RD + h * 64 + lane] = yb[s * 64 + lane]; if (MODE == 3) GB[(size_t)(tg0 + (g - 1) * GS + s) * RD + h * 64 + lane] = yb[(GS + s) * 64 + lane]; }
        }
        if (g + 1 < ngroups) SC_STAGE(g + 1, (g + 1) & 1);
        const LAS float* wb = wl + (g & 1) * GS * SCR;
        f32x4 R[4][4];
#pragma unroll
        for (int q = 0; q < 3; ++q) sc_issue(R[q & 3], (const LAS f32x4*)(wb + (q / NCH) * SCR), q % NCH);
        __builtin_amdgcn_sched_barrier(0);
#pragma unroll
        for (int s = 0; s < GS; ++s) {
            f32x2 d2a = (f32x2){0.f, 0.f}, y2a = (f32x2){0.f, 0.f};
            f32x2 e2a = (f32x2){0.f, 0.f}, g2a = (f32x2){0.f, 0.f};
            f32x2 sa2 = (f32x2){0.f, 0.f}, sp2 = (f32x2){0.f, 0.f};
            const float vs = wb[s * SCR + 256 + lane];
            const f32x2 v2 = (f32x2){vs, vs};
#pragma unroll
            for (int c = 0; c < NCH; ++c) {
                const int q = s * NCH + c, qn = q + 3;
                if (qn < GS * NCH) sc_issue(R[qn & 3], (const LAS f32x4*)(wb + (qn / NCH) * SCR), qn % NCH);
                __builtin_amdgcn_sched_barrier(0);
                f32x4 (&r)[4] = R[q & 3];
                if (c < 4) {
#pragma unroll
                    for (int i = 0; i < 4; ++i) { const int j = 4 * c + i; d2a += S[2 * j] * (f32x2){r[i].x, r[i].y}; d2a += S[2 * j + 1] * (f32x2){r[i].z, r[i].w};
                        if (MODE == 3) { e2a += P[2 * j] * (f32x2){r[i].x, r[i].y}; e2a += P[2 * j + 1] * (f32x2){r[i].z, r[i].w}; } }
                    if (c == 3) { const f32x2 d2 = d2a; const float sa = -(d2.x + d2.y); sa2 = (f32x2){sa, sa};
                        if (MODE == 3) { const f32x2 e2 = e2a; const float sp = -(e2.x + e2.y); sp2 = (f32x2){sp, sp}; } }
                } else {
                    const int j = c - 4;
                    S[2 * j] = sa2 * (f32x2){r[1].x, r[1].y} + S[2 * j]; S[2 * j] = v2 * (f32x2){r[2].x, r[2].y} + S[2 * j];
                    S[2 * j + 1] = sa2 * (f32x2){r[1].z, r[1].w} + S[2 * j + 1]; S[2 * j + 1] = v2 * (f32x2){r[2].z, r[2].w} + S[2 * j + 1];
                    y2a += S[2 * j] * (f32x2){r[3].x, r[3].y}; y2a += S[2 * j + 1] * (f32x2){r[3].z, r[3].w};
                    if (MODE == 3) {
                        P[2 * j] = sp2 * (f32x2){r[1].x, r[1].y} + P[2 * j]; P[2 * j + 1] = sp2 * (f32x2){r[1].z, r[1].w} + P[2 * j + 1];
                        g2a += P[2 * j] * (f32x2){r[3].x, r[3].y}; g2a += P[2 * j + 1] * (f32x2){r[3].z, r[3].w};
                    }
                }
                __builtin_amdgcn_sched_barrier(0);
            }
            yb[s * 64 + lane] = y2a.x + y2a.y;
            if (MODE == 3) yb[(GS + s) * 64 + lane] = g2a.x + g2a.y;
        }
        if ((g & 3) == 3) {
            const LAS f32x4* wq = (const LAS f32x4*)(wb + (GS - 1) * SCR + 320);
#pragma unroll
            for (int j = 0; j < 16; ++j) { const f32x4 w4 = wq[j];
                S[2 * j] = S[2 * j] * (f32x2){w4.x, w4.y}; S[2 * j + 1] = S[2 * j + 1] * (f32x2){w4.z, w4.w};
                if (MODE == 3) { P[2 * j] = P[2 * j] * (f32x2){w4.x, w4.y}; P[2 * j + 1] = P[2 * j + 1] * (f32x2){w4.z, w4.w}; } }
        }
        asm volatile("s_waitcnt lgkmcnt(0)" ::: "memory");
    }
#undef SC_STAGE
#pragma unroll
    for (int s = 0; s < GS; ++s) { Y[(size_t)(tg0 + (ngroups - 1) * GS + s) * RD + h * 64 + lane] = yb[s * 64 + lane]; if (MODE == 3) GB[(size_t)(tg0 + (ngroups - 1) * GS + s) * RD + h * 64 + lane] = yb[(GS + s) * 64 + lane]; }
    if (MODE == 3) {
#pragma unroll
        for (int j = 0; j < 16; ++j) { ((f32x4*)PQout)[j * 64 + lane] = (f32x4){P[2 * j].x, P[2 * j].y, P[2 * j + 1].x, P[2 * j + 1].y};
                                       ((f32x4*)(PQout + 4096))[j * 64 + lane] = (f32x4){S[2 * j].x, S[2 * j].y, S[2 * j + 1].x, S[2 * j + 1].y}; }
    } else {
#pragma unroll
        for (int j = 0; j < 16; ++j) ((f32x4*)(Sout + lane * 64))[j] = (f32x4){S[2 * j].x, S[2 * j].y, S[2 * j + 1].x, S[2 * j + 1].y};
    }
}
template <int NMT>
__device__ __forceinline__ void ypost_task(KP kp, int l, const float* S0q  , int tg0, int h, int lane) {
    const float* GB = (const float*)(kp->ws + WS_GB); const float* Y = (const float*)(kp->ws + WS_Y); const float* SC = (const float*)(kp->ws + WS_SC);
    const float* G = (const float*)(kp->ws + WS_G); const float* RK = (const float*)(kp->ws + WS_RK); bf16* MIX = (bf16*)(kp->ws + WS_MIX);
    const int n = lane & 15, kq = lane >> 4;
    float Bv[4][16];
    if (S0q) {
#pragma unroll
        for (int nt = 0; nt < 4; ++nt)
#pragma unroll
            for (int ks = 0; ks < 16; ++ks) Bv[nt][ks] = S0q[(size_t)(ks * 64 + nt * 16 + n) * 4 + kq];
    }
    float gng[4], gnb[4];
#pragma unroll
    for (int nt = 0; nt < 4; ++nt) { gng[nt] = kp->in[23][l * RD + h * 64 + nt * 16 + n]; gnb[nt] = kp->in[24][l * RD + h * 64 + nt * 16 + n]; }
#pragma unroll 1
    for (int mt = 0; mt < NMT; ++mt) {
        const int tb = tg0 + mt * 16;
        float Av[16];
        if (S0q) { const float* grow = GB + (size_t)(tb + n) * RD + h * 64 + kq;
#pragma unroll
            for (int ks = 0; ks < 16; ++ks) Av[ks] = grow[ks * 4]; }
        f32x4 acc[4]; float vv[4][4], gg[4][4], rk[4];
#pragma unroll
        for (int r = 0; r < 4; ++r) { const int t = tb + 4 * kq + r; rk[r] = RK[t * NH + h];
#pragma unroll
            for (int nt = 0; nt < 4; ++nt) { acc[nt][r] = Y[(size_t)t * RD + h * 64 + nt * 16 + n]; vv[nt][r] = SC[sc_off(t, h) + 256 + nt * 16 + n]; gg[nt][r] = G[(size_t)t * RD + h * 64 + nt * 16 + n]; } }
        if (S0q) {
#pragma unroll
            for (int ks = 0; ks < 16; ++ks)
#pragma unroll
                for (int nt = 0; nt < 4; ++nt) acc[nt] = __builtin_amdgcn_mfma_f32_16x16x4f32(Av[ks], Bv[nt][ks], acc[nt], 0, 0, 0);
        }
#pragma unroll
        for (int r = 0; r < 4; ++r) {
            const int t = tb + 4 * kq + r;
            const float mean = rowsum16((acc[0][r] + acc[1][r]) + (acc[2][r] + acc[3][r])) * (1.0f / 64.0f);
            float d[4], qq = 0.f;
#pragma unroll
            for (int nt = 0; nt < 4; ++nt) { d[nt] = acc[nt][r] - mean; qq += d[nt] * d[nt]; }
            const float rstd = __builtin_amdgcn_rsqf(rowsum16(qq) * (1.0f / 64.0f) + GN_EPS);
#pragma unroll
            for (int nt = 0; nt < 4; ++nt) { const float o = ((d[nt] * rstd * gng[nt] + gnb[nt]) + rk[r] * vv[nt][r]) * gg[nt][r];
                MIX[(size_t)t * D + 1024 + h * 64 + nt * 16 + n] = (bf16)f2bf(o); }
        }
    }
}
__device__ __forceinline__ void combine_chain(const float* PQ, float* S0, float* Sfin, LAS unsigned char* lds, int tid, int wave, int lane) {
    constexpr int LDA = 66, LDB = 80;
    LAS float* Sl = (LAS float*)lds;
    LAS float* Pl = (LAS float*)(lds + 2 * 64 * LDA * 4);
    const int n = lane & 15, kq = lane >> 4, ib = wave >> 1, n0 = 32 * (wave & 1);
    for (int e = tid; e < 64 * LDA; e += NTHR) Sl[e] = 0.f;
    { const f32x4* Pc = (const f32x4*)PQ;
      for (int e = tid; e < 1024; e += NTHR) *(LAS f32x4*)(Pl + (e & 63) * LDB + (e >> 6) * 4) = Pc[e]; }
    f32x4 qn[2];
#pragma unroll
    for (int t = 0; t < 2; ++t)
#pragma unroll
        for (int r = 0; r < 4; ++r) { const int i = 16 * ib + 4 * kq + r, col = n0 + 16 * t + n; qn[t][r] = PQ[4096 + (size_t)((col >> 2) * 64 + i) * 4 + (col & 3)]; }
    for (int c = 0; c < NC; ++c) {
        f32x4 acc[2] = {qn[0], qn[1]};
        if (c + 1 < NC) { const float* Qn = PQ + (size_t)((c + 1) * 2 + 1) * 4096;
#pragma unroll
            for (int t = 0; t < 2; ++t)
#pragma unroll
                for (int r = 0; r < 4; ++r) { const int i = 16 * ib + 4 * kq + r, col = n0 + 16 * t + n; qn[t][r] = Qn[(size_t)((col >> 2) * 64 + i) * 4 + (col & 3)]; } }
        f32x4 pn0 = (f32x4){0.f, 0.f, 0.f, 0.f}, pn1 = pn0;
        if (c + 1 < NC) { const f32x4* Pn = (const f32x4*)(PQ + (size_t)((c + 1) * 2) * 4096); pn0 = Pn[tid]; pn1 = Pn[tid + 512]; }
        __syncthreads();
        const LAS float* sa = Sl + (c & 1) * 64 * LDA + (16 * ib + n) * LDA + kq;
        const LAS float* pb = Pl + (c & 1) * 64 * LDB + kq * LDB + n0 + n;
#pragma unroll
        for (int ks = 0; ks < 16; ++ks) {
            const float av = sa[4 * ks], b0 = pb[4 * ks * LDB], b1 = pb[4 * ks * LDB + 16];
            acc[0] = __builtin_amdgcn_mfma_f32_16x16x4f32(av, b0, acc[0], 0, 0, 0);
            acc[1] = __builtin_amdgcn_mfma_f32_16x16x4f32(av, b1, acc[1], 0, 0, 0);
        }
        if (c + 1 < NC) {
            LAS float* sn = Sl + ((c + 1) & 1) * 64 * LDA; float* So = S0 + (size_t)(c + 1) * 4096;
#pragma unroll
            for (int t = 0; t < 2; ++t)
#pragma unroll
                for (int r = 0; r < 4; ++r) { const int i = 16 * ib + 4 * kq + r, col = n0 + 16 * t + n;
                    sn[i * LDA + col] = acc[t][r]; So[(size_t)((col >> 2) * 64 + i) * 4 + (col & 3)] = acc[t][r]; }
            LAS float* pnl = Pl + ((c + 1) & 1) * 64 * LDB;
            *(LAS f32x4*)(pnl + (tid & 63) * LDB + (tid >> 6) * 4) = pn0; *(LAS f32x4*)(pnl + (tid & 63) * LDB + ((tid + 512) >> 6) * 4) = pn1;
        } else {
#pragma unroll
            for (int t = 0; t < 2; ++t)
#pragma unroll
                for (int r = 0; r < 4; ++r) Sfin[(16 * ib + 4 * kq + r) * 64 + n0 + 16 * t + n] = acc[t][r];
        }
    }
    __syncthreads();
}

__global__ void __launch_bounds__(NTHR, 2) fwd_mega(Params p) {
    extern __shared__ __attribute__((aligned(16))) unsigned char lds_raw[];
    LAS unsigned char* lds = (LAS unsigned char*)lds_raw;
    const int wave0 = __builtin_amdgcn_readfirstlane((int)threadIdx.x >> 6);
    volatile LAS unsigned* MISC = (volatile LAS unsigned*)(lds + 131072);
    if (threadIdx.x < 16) MISC[threadIdx.x] = 0u;
    __syncthreads();
    const XcdBarrier xbar = xcd_barrier_post((unsigned*)p.ws + 4096, MISC, (int)threadIdx.x);
    cg::this_grid().sync();

#pragma unroll 1
    for (int l = 0; l < DEPTH; ++l) {
        const size_t wsel = (l & 1) ? (WS_W2 - WS_WIN) : 0;
        { PH_BEGIN();
          if (l == 0) convert_weights(kp, 0, (LAS float*)(lds + wave * 16384), gw, ngw, lane);
          float* X = (float*)(ws + WS_X); bf16* XN = (bf16*)(ws + WS_XN);
          if (l == 0) norm_rows(kp->in[0], kp->in[1], kp->in[6], X, XN, nullptr, nullptr, gw, ngw, lane);
          else norm_rows(X, X + (size_t)TP * D, kp->in[6] + l * D, nullptr, XN, nullptr, (const float*)(ws + WS_PART), gw, ngw, lane);
        }
        GSYNC();
        { PH_BEGIN(); pg8::Gemm g{(const bf16*)(ws + WS_XN), (const bf16*)(ws + WS_WIN + wsel), T, NZ, D}; pg8::StaticOrder S; S.init(T, NZ, D, nb, bid); pg8::EpiStoreBf16 E{(bf16*)(ws + WS_Z), NZ};
          pg8::gemm_phase<pg8::EpiStoreBf16, pg8::StaticOrder, true, true>(lds, g, S, E, tid); }
        GSYNC();
        { PH_BEGIN();
          if (nb == 256) {
            const int vcu = (bid & 7) * 32 + (bid >> 3);
#pragma unroll 1
            for (int k = 0; k < 5; ++k) {
              int it = -1;
              if (k < 2) it = 2 * vcu + k;
              else if ((vcu & 3) == 3) { if (k == 2) it = 512 + (vcu >> 2); }
              else { const int c = 3 * ((vcu >> 2) * 3 + (vcu & 3)) + (k - 2); it = (c & 1) ? 864 + (c >> 1) : 576 + (c >> 1); }
              if (it < 0) continue;
              if (it < 576) prep_item(kp, l, it, lds, tid);
              else if (it < 864) pool_item(kp, l, it - 576, lds, tid);
              else conv_item(kp, l, it - 864, (LAS float*)lds, tid);
            }
          } else {
            for (int it = bid; it < 1152; it += nb) {
              if (it < 576) prep_item(kp, l, it, lds, tid);
              else if (it < 864) pool_item(kp, l, it - 576, lds, tid);
              else conv_item(kp, l, it - 864, (LAS float*)lds, tid);
            }
          }
        }
        GSYNC();
        { PH_BEGIN();
            const float* SC = (const float*)(ws + WS_SC); float* Y = (float*)(ws + WS_Y); float* PQ = (float*)(ws + WS_PQ); float* GB = (float*)(ws + WS_GB);
            LAS float* wl = (LAS float*)(lds + wave * 12288); LAS float* yb = (LAS float*)(lds + 98304 + wave * 2048);
            for (int task = wave * nb + bid; task < 64 * NC + 256; task += NWAVES * nb) {
                if (task < 64 * NC) {
                    const int ch = task / NC, c = task % NC, s = ch >> 4, h = ch & 15;
                    scan_run<3>(SC, s * 2048 + c * CL, CL, h, wl, yb, lane, nullptr, Y, GB, nullptr, PQ + (size_t)((ch * NC + c) * 2) * 4096);
                } else {
                    const int ch = task - 64 * NC, b = ch >> 4, h = ch & 15;
                    scan_run<1>(SC, TP + b * 64, 64, h, wl, yb, lane, kp->in[5] + (size_t)((l * 16 + b) * NH + h) * 4096, Y, nullptr, kp->out + O_WKV_S + (size_t)((l * 16 + b) * NH + h) * 4096, nullptr);
                }
            }
            if (l + 1 < DEPTH) {
                if (wave >= 5) convert_weights(kp, l + 1, (LAS float*)(lds + 61440 + (wave - 4) * 8448), bid * 3 + (wave - 5), nb * 3, lane, 0, CVT_SPLIT);
                else if (wave == 4) convert_weights(kp, l + 1, (LAS float*)(lds + 61440), bid, nb, lane, CVT_SPLIT);
            }
        }
        GSYNC();
        { PH_BEGIN();
            for (int ch = bid; ch < 64; ch += nb) { const int s = ch >> 4, h = ch & 15;
                combine_chain((const float*)(ws + WS_PQ) + (size_t)ch * NC * 2 * 4096, (float*)(ws + WS_S0) + (size_t)ch * NC * 4096, kp->out + O_WKV_P + (size_t)((l * 4 + s) * NH + h) * 4096, lds, tid, wave, lane); }
        }
        GSYNC();
        { PH_BEGIN();
            const float* S0 = (const float*)(ws + WS_S0);
            constexpr int UPC = CL / 32, NPU = 64 * NC * UPC;
            for (int u = wave * nb + bid; u < NPU + 512; u += NWAVES * nb) {
                if (u < NPU) { const int task = u / UPC, hf = u % UPC, ch = task / NC, c = task % NC, s = ch >> 4, h = ch & 15;
                    ypost_task<2>(kp, l, c == 0 ? nullptr : S0 + (size_t)(ch * NC + c) * 4096, s * 2048 + c * CL + hf * 32, h, lane); }
                else { const int ch = (u - NPU) >> 1, hf = (u - NPU) & 1, b = ch >> 4, h = ch & 15; ypost_task<2>(kp, l, nullptr, TP + b * 64 + hf * 32, h, lane); }
            }
        }
        GSYNC();
        { PH_BEGIN(); pg8::Gemm g{(const bf16*)(ws + WS_MIX), (const bf16*)(ws + WS_WOUT + wsel), T, D, D}; pg8::TailOrder S; S.init(D, D, nb, bid); pg8::EpiResAdd E{(float*)(ws + WS_X), D, (float*)(ws + WS_PART)};
          pg8::gemm_phase<pg8::EpiResAdd, pg8::TailOrder, true, true>(lds, g, S, E, tid); }
        GSYNC();
        { PH_BEGIN(); float* X = (float*)(ws + WS_X); norm_rows(X, X + (size_t)TP * D, kp->in[26] + l * D, nullptr, (bf16*)(ws + WS_XN), nullptr, (const float*)(ws + WS_PART), gw, ngw, lane); }
        GSYNC();
        { PH_BEGIN(); pg8::Gemm g{(const bf16*)(ws + WS_XN), (const bf16*)(ws + WS_WGU + wsel), T, NGU, D}; pg8::StaticOrder S; S.init(T, NGU, D, nb, bid); pg8::EpiSwiGLU E{(bf16*)(ws + WS_ACT), FF};
          pg8::gemm_phase<pg8::EpiSwiGLU, pg8::StaticOrder, true, true>(lds, g, S, E, tid); }
        GSYNC();
        { PH_BEGIN(); pg8::Gemm g{(const bf16*)(ws + WS_ACT), (const bf16*)(ws + WS_WDN + wsel), T, D, FF}; pg8::TailOrder S; S.init(D, FF, nb, bid); pg8::EpiResAdd E{(float*)(ws + WS_X), D, (float*)(ws + WS_PART)};
          pg8::gemm_phase<pg8::EpiResAdd, pg8::TailOrder, true, true>(lds, g, S, E, tid); }
        GSYNC();
    }
    { PH_BEGIN(); float* X = (float*)(ws + WS_X); norm_rows(X, X + (size_t)TP * D, kp->in[30], nullptr, nullptr, kp->out + O_Y, (const float*)(ws + WS_PART), gw, ngw, lane); }
}

extern "C" void kernel_launch(void* const* d_in, const int* in_sizes, int n_in, void* d_out, int out_size, void* d_ws, size_t ws_size, hipStream_t stream) {
    static int grid = 0;
    if (grid == 0) {
        if (n_in != 31 || (size_t)out_size != O_END || ws_size < WS_END) { fprintf(stderr, "kernel_launch: unexpected shapes: n_in %d out %d ws %zu (need %zu)\n", n_in, out_size, ws_size, (size_t)WS_END); grid = -1; return; }
        int dev = 0, cus = 0, per_cu = 0;
        hipGetDevice(&dev);
        hipDeviceGetAttribute(&cus, hipDeviceAttributeMultiprocessorCount, dev);
        if (hipFuncSetAttribute((const void*)fwd_mega, hipFuncAttributeMaxDynamicSharedMemorySize, LDS_BYTES) != hipSuccess) { fprintf(stderr, "kernel_launch: hipFuncSetAttribute failed\n"); grid = -1; return; }
        hipOccupancyMaxActiveBlocksPerMultiprocessor(&per_cu, (const void*)fwd_mega, NTHR, LDS_BYTES);
        (void)hipGetLastError();
        if (per_cu < 1) { fprintf(stderr, "kernel_launch: occupancy query says %d blocks per CU\n", per_cu); per_cu = 1; }
        grid = cus * 1;
    }
    if (grid < 0) return;
    Params p{};
    for (int i = 0; i < 31; ++i) p.in[i] = (const float*)d_in[i];
    p.out = (float*)d_out; p.ws = (unsigned char*)d_ws;
    if (hipMemsetAsync(d_ws, 0, 65536, stream) != hipSuccess) { fprintf(stderr, "kernel_launch: memset failed\n"); return; }
    void* args[] = {&p};
    hipError_t e = hipLaunchCooperativeKernel((const void*)fwd_mega, dim3(grid), dim3(NTHR), args, LDS_BYTES, stream);
    if (e != hipSuccess) fprintf(stderr, "cooperative launch failed: %s (grid %d)\n", hipGetErrorString(e), grid);
}
```

```cpp
#include <hip/hip_runtime.h>
#include <hip/hip_cooperative_groups.h>
#include <cstdio>
#include <cstdint>
namespace cg = cooperative_groups;

namespace pg8 {
#define PG8_LAS __attribute__((address_space(3)))
typedef unsigned short bf16_t;
typedef short bf16x8 __attribute__((ext_vector_type(8)));
typedef float f32x4 __attribute__((ext_vector_type(4)));
typedef unsigned u32x4 __attribute__((ext_vector_type(4)));
constexpr int BM = 256, BK = 64, HALF = 128, HTB = HALF * BK * 2  , STAGE_BYTES = 8 * HTB, NXCD = 8, WGM = 8;

__host__ __device__ __forceinline__ int lds_byte(int r, int c) { const int st = (r >> 4) * 2 + (c >> 5), rr = r & 15, cc = c & 31, ob = rr * 64 + cc * 2; return st * 1024 + (ob ^ (((ob >> 9) & 1) << 5)); }
__host__ __device__ __forceinline__ void stage_rc(int b, int& R, int& C) { const int st = b / 1024, sb = b % 1024, swz = sb ^ (((sb >> 9) & 1) << 5); R = (st >> 1) * 16 + swz / 64; C = (st & 1) * 32 + (swz % 64) / 2; }
__host__ __device__ __forceinline__ int perm32(int rho) { const int n = rho >> 4, i = rho & 15; return 8 * (i >> 2) + 4 * n + (i & 3); }

struct Unit { int pm, pn, k0, nt, part; };
struct Gemm { const bf16_t* A; const bf16_t* Bt; int M, N, K; };

struct StaticOrder {
    int nM, nN, nwg, G, c, ntfull;
    __host__ __device__ void init(int M, int N, int K, int G_, int c_) { nM = M / BM; nN = N / BM; nwg = nM * nN; G = G_; c = c_; ntfull = K / BK; }
    __host__ __device__ __forceinline__ bool next(int i, Unit& u) const {
        const long L = (long)i * G + c; if (L >= nwg) return false;
        int wgid = (int)L; { const int q = nwg / NXCD, r = nwg % NXCD, xcd = wgid % NXCD, off = wgid / NXCD; wgid = (xcd < r ? xcd * (q + 1) : r * (q + 1) + (xcd - r) * q) + off; }
        const int nig = WGM * nN, gid = wgid / nig, fm = gid * WGM, gsz = (nM - fm) < WGM ? (nM - fm) : WGM;
        u.pm = fm + ((wgid % nig) % gsz); u.pn = (wgid % nig) / gsz; u.k0 = 0; u.nt = ntfull; u.part = -1; return true;
    }
    __device__ __forceinline__ void a_ready(const Unit&) const {}
    __device__ __forceinline__ void done(const Unit&) const {}
};


struct TailOrder {
    int nN, G, c, ntfull, skip;
    __host__ __device__ void init(int N, int K, int G_, int c_, int skip_ = 0) { nN = N / BM; G = G_; c = c_; ntfull = K / BK; skip = skip_; }
    __host__ __device__ __forceinline__ bool next(int i, Unit& u) const {
        const int nfull = 32 * nN, L = i * G + c + skip * nfull;
        if (L >= nfull + 4 * nN * 8) return false;
        const bool full = L < nfull;
        int wgid = full ? L : 0; { const int q = nfull / NXCD, r = nfull % NXCD, xcd = wgid % NXCD, off = wgid / NXCD; wgid = (xcd < r ? xcd * (q + 1) : r * (q + 1) + (xcd - r) * q) + off; }
        const int nig = WGM * nN, gid = wgid / nig, fm = gid * WGM;
        const int fpm = fm + ((wgid % nig) % WGM), fpn = (wgid % nig) / WGM;
        const int ut = full ? 0 : L - nfull, tile = ut >> 3, ks = ut & 7, base = (ntfull / 8) & ~1, extra = (ntfull - 8 * base) / 2;
        const int tpm = 32 + tile / nN, tpn = tile % nN, tnt = base + (ks < extra ? 2 : 0), tk0 = ks * base + 2 * (ks < extra ? ks : extra);
        Unit r_; r_.pm = full ? fpm : tpm; r_.pn = full ? fpn : tpn; r_.k0 = full ? 0 : tk0; r_.nt = full ? ntfull : tnt; r_.part = full ? -1 : ks;
        u = r_; return true;
    }
    __device__ __forceinline__ void a_ready(const Unit&) const {}
    __device__ __forceinline__ void done(const Unit&) const {}
};

__device__ __forceinline__ unsigned cvt_pk_bf16(float lo, float hi) { unsigned r; asm volatile("v_cvt_pk_bf16_f32 %0, %1, %2" : "=v"(r) : "v"(lo), "v"(hi)); return r; }

struct EpiStoreBf16 {
    static constexpr bool PERM = true, AFTER_DRAIN = false;
    bf16_t* O; int ldc;
    __device__ __forceinline__ void operator()(const f32x4 (&acc)[2][2][4][2], const Unit& u, int wr, int wc, int fr, int fq) const {
        const int row0 = u.pm * BM + wr * 64 + fr, col0 = u.pn * BM + wc * 32 + 8 * fq;
#pragma unroll
        for (int ai = 0; ai < 2; ++ai)
#pragma unroll
            for (int m = 0; m < 4; ++m) { bf16_t* rowp = O + (size_t)(row0 + ai * HALF + m * 16) * ldc + col0;
#pragma unroll
                for (int bj = 0; bj < 2; ++bj) { const f32x4 v0 = acc[ai][bj][m][0], v1 = acc[ai][bj][m][1];
                    u32x4 w; w.x = cvt_pk_bf16(v0[0], v0[1]); w.y = cvt_pk_bf16(v0[2], v0[3]); w.z = cvt_pk_bf16(v1[0], v1[1]); w.w = cvt_pk_bf16(v1[2], v1[3]);
                    *(u32x4*)(rowp + bj * HALF) = w; } }
    }
};
struct EpiResAdd {
    static constexpr bool PERM = true, AFTER_DRAIN = false;
    float* O; int ldc; float* P;
    __device__ __forceinline__ void operator()(const f32x4 (&acc)[2][2][4][2], const Unit& u, int wr, int wc, int fr, int fq) const {
        const int row0 = u.pm * BM + wr * 64 + fr, col0 = u.pn * BM + wc * 32 + 8 * fq;
        if (u.part < 0) {
#pragma unroll
            for (int ai = 0; ai < 2; ++ai)
#pragma unroll
                for (int m = 0; m < 4; ++m) { float* rowp = O + (size_t)(row0 + ai * HALF + m * 16) * ldc + col0;
#pragma unroll
                    for (int bj = 0; bj < 2; ++bj) {
                        f32x4 a = *(const f32x4*)(rowp + bj * HALF), b = *(const f32x4*)(rowp + bj * HALF + 4);
                        *(f32x4*)(rowp + bj * HALF) = a + acc[ai][bj][m][0]; *(f32x4*)(rowp + bj * HALF + 4) = b + acc[ai][bj][m][1]; } }
        } else {
            float* base = P + (size_t)u.part * 1024 * ldc;
#pragma unroll
            for (int ai = 0; ai < 2; ++ai)
#pragma unroll
                for (int m = 0; m < 4; ++m) { float* rowp = base + (size_t)(row0 - 8192 + ai * HALF + m * 16) * ldc + col0;
#pragma unroll
                    for (int bj = 0; bj < 2; ++bj) { *(f32x4*)(rowp + bj * HALF) = acc[ai][bj][m][0]; *(f32x4*)(rowp + bj * HALF + 4) = acc[ai][bj][m][1]; } }
        }
    }
};
struct EpiSwiGLU {
    static constexpr bool PERM = true, AFTER_DRAIN = false;
    bf16_t* O; int ldc;
    __device__ __forceinline__ void operator()(const f32x4 (&acc)[2][2][4][2], const Unit& u, int wr, int wc, int fr, int fq) const {
        const int row0 = u.pm * BM + wr * 64 + fr, col0 = u.pn * HALF + wc * 32 + 8 * fq;
#pragma unroll
        for (int ai = 0; ai < 2; ++ai)
#pragma unroll
            for (int m = 0; m < 4; ++m) { bf16_t* rowp = O + (size_t)(row0 + ai * HALF + m * 16) * ldc + col0;
                float o[8];
#pragma unroll
                for (int n = 0; n < 2; ++n)
#pragma unroll
                    for (int j = 0; j < 4; ++j) { const float g = acc[ai][0][m][n][j], up = acc[ai][1][m][n][j]; o[n * 4 + j] = g * up * __builtin_amdgcn_rcpf(1.0f + __expf(-g)); }
                u32x4 w; w.x = cvt_pk_bf16(o[0], o[1]); w.y = cvt_pk_bf16(o[2], o[3]); w.z = cvt_pk_bf16(o[4], o[5]); w.w = cvt_pk_bf16(o[6], o[7]);
                *(u32x4*)rowp = w; }
    }
};

template <class Epi, class Sched, bool ALIGN_EPI = false, bool SP2 = false>
__device__ __forceinline__ void gemm_phase(PG8_LAS unsigned char* lds, const Gemm g, const Sched& S, const Epi& E, const int tid) {
    const int wid = __builtin_amdgcn_readfirstlane(tid >> 6), lane = tid & 63, wr = wid >> 2, wc = wid & 3, fr = lane & 15, fq = lane >> 4;
    const int K = g.K;
    unsigned voffA[2], voffB[2];
#pragma unroll
    for (int i = 0; i < 2; ++i) { int R, C; stage_rc(tid * 16 + i * 8192, R, C); const int Rb = Epi::PERM ? ((R & ~31) + perm32(R & 31)) : R;
        voffA[i] = (unsigned)(R * K + C) * 2u; voffB[i] = (unsigned)(Rb * K + C) * 2u; }
    const size_t kstep = (size_t)(BK * 2);
    const size_t hstep = (size_t)HALF * K * 2;
    const size_t tstep = 2 * hstep;
    const unsigned ldsw = (unsigned)wid * 1024u;
    const int aoff = lds_byte(wr * 64 + fr, fq * 8), boff = lds_byte(wc * 32 + fr, fq * 8);
#define PG8_SA(b, h) (((b) * 2 + (h)) * HTB)
#define PG8_SB(b, h) ((4 + (b) * 2 + (h)) * HTB)
#define PG8_STAGE(bufoff, gbase, voff) do { _Pragma("unroll") for (int _i = 0; _i < 2; ++_i) \
        __builtin_amdgcn_global_load_lds((const unsigned*)((const char*)(gbase) + (voff)[_i]), (PG8_LAS unsigned*)(lds + (bufoff) + ldsw + _i * 8192), 16, 0, 0); } while (0)
#define PG8_LDA(dst, b, h) do { _Pragma("unroll") for (int m = 0; m < 4; ++m) _Pragma("unroll") for (int k = 0; k < 2; ++k) dst[m][k] = *(const PG8_LAS bf16x8*)(lds + PG8_SA(b, h) + aoff + m * 2048 + k * 1024); } while (0)
#define PG8_LDB(dst, b, h) do { _Pragma("unroll") for (int n = 0; n < 2; ++n) _Pragma("unroll") for (int k = 0; k < 2; ++k) dst[n][k] = *(const PG8_LAS bf16x8*)(lds + PG8_SB(b, h) + boff + n * 2048 + k * 1024); } while (0)
#define PG8_MMA(ai, bj, At, Bt) do { __builtin_amdgcn_s_setprio(1); _Pragma("unroll") for (int m = 0; m < 4; ++m) _Pragma("unroll") for (int n = 0; n < 2; ++n) _Pragma("unroll") for (int k = 0; k < 2; ++k) \
        acc[ai][bj][m][n] = __builtin_amdgcn_mfma_f32_16x16x32_bf16(Bt[n][k], At[m][k], acc[ai][bj][m][n], 0, 0, 0); __builtin_amdgcn_s_setprio(0); } while (0)
#define PG8_WAIT_V(n) asm volatile("s_waitcnt vmcnt(" #n ")" ::: "memory")
#define PG8_WAIT_L(n) asm volatile("s_waitcnt lgkmcnt(" #n ")" ::: "memory")
#define PG8_BAR __builtin_amdgcn_s_barrier()
#define PG8_SCHED __builtin_amdgcn_sched_barrier(0)
    Unit cur, nxt; int ui = 0;
    if (!S.next(0, cur)) return;
    f32x4 acc[2][2][4][2];
#pragma unroll
    for (int a = 0; a < 2; ++a)
#pragma unroll
        for (int b = 0; b < 2; ++b)
#pragma unroll
            for (int m = 0; m < 4; ++m)
#pragma unroll
                for (int n = 0; n < 2; ++n) acc[a][b][m][n] = (f32x4){0.f, 0.f, 0.f, 0.f};
    bf16x8 At[4][2], B0[2][2], B1[2][2];
    const char* cA = (const char*)g.A + (size_t)cur.pm * tstep + (size_t)cur.k0 * kstep; const char* cB = (const char*)g.Bt + (size_t)cur.pn * tstep + (size_t)cur.k0 * kstep;
    S.a_ready(cur);
    if constexpr (SP2) {
        PG8_STAGE(PG8_SB(0, 0), cB, voffB); PG8_STAGE(PG8_SB(0, 1), cB + hstep, voffB); PG8_STAGE(PG8_SA(0, 0), cA, voffA); PG8_STAGE(PG8_SA(0, 1), cA + hstep, voffA);
        if (wr == 1) PG8_BAR;
        PG8_WAIT_V(2); PG8_BAR;
        PG8_STAGE(PG8_SB(1, 0), cB + kstep, voffB); PG8_STAGE(PG8_SA(1, 0), cA + kstep, voffA); PG8_STAGE(PG8_SB(1, 1), cB + hstep + kstep, voffB);
        PG8_WAIT_V(6); PG8_BAR;
    } else {
        PG8_STAGE(PG8_SB(0, 0), cB, voffB); PG8_STAGE(PG8_SA(0, 0), cA, voffA); PG8_STAGE(PG8_SB(0, 1), cB + hstep, voffB); PG8_STAGE(PG8_SA(0, 1), cA + hstep, voffA);
        if (wr == 1) PG8_BAR;
        PG8_WAIT_V(4); PG8_BAR;
        PG8_STAGE(PG8_SB(1, 0), cB + kstep, voffB); PG8_STAGE(PG8_SA(1, 0), cA + kstep, voffA); PG8_STAGE(PG8_SB(1, 1), cB + hstep + kstep, voffB);
        PG8_WAIT_V(6); PG8_BAR;
    }
    for (;;) {
        const bool has_next = S.next(ui + 1, nxt);
        const char* nA = has_next ? (const char*)g.A + (size_t)nxt.pm * tstep + (size_t)nxt.k0 * kstep : cA; const char* nB = has_next ? (const char*)g.Bt + (size_t)nxt.pn * tstep + (size_t)nxt.k0 * kstep : cB;
        const int nt = cur.nt;
        for (int t = 0; t < nt; t += 2) {
            const bool last = (t == nt - 2);
            const char* a1 = cA + (size_t)(t + 1) * kstep;
            const char* a2 = last ? nA : cA + (size_t)(t + 2) * kstep; const char* b2 = last ? nB : cB + (size_t)(t + 2) * kstep;
            const char* a3 = a2 + kstep; const char* b3 = b2 + kstep;
            if (last && has_next) S.a_ready(nxt);
            if constexpr (SP2) {
            PG8_LDB(B0, 0, 0); PG8_LDB(B1, 0, 1); PG8_SCHED; PG8_LDA(At, 0, 0); PG8_STAGE(PG8_SA(1, 1), a1 + hstep, voffA);
            PG8_WAIT_V(8); PG8_WAIT_L(0); PG8_BAR; PG8_MMA(0, 0, At, B0); PG8_MMA(0, 1, At, B1); PG8_BAR; PG8_SCHED;
            PG8_LDA(At, 0, 1); PG8_STAGE(PG8_SB(0, 0), b2, voffB); PG8_STAGE(PG8_SB(0, 1), b2 + hstep, voffB); PG8_STAGE(PG8_SA(0, 0), a2, voffA);
            PG8_WAIT_V(8); PG8_WAIT_L(0); PG8_BAR; PG8_MMA(1, 0, At, B0); PG8_MMA(1, 1, At, B1); PG8_BAR; PG8_SCHED;
            PG8_LDB(B0, 1, 0); PG8_LDB(B1, 1, 1); PG8_SCHED; PG8_LDA(At, 1, 0); PG8_STAGE(PG8_SA(0, 1), a2 + hstep, voffA);
            PG8_WAIT_V(8); PG8_WAIT_L(0); PG8_BAR; PG8_MMA(0, 0, At, B0); PG8_MMA(0, 1, At, B1); PG8_BAR; PG8_SCHED;
            PG8_LDA(At, 1, 1); PG8_STAGE(PG8_SB(1, 0), b3, voffB); PG8_STAGE(PG8_SB(1, 1), b3 + hstep, voffB); PG8_STAGE(PG8_SA(1, 0), a3, voffA);
            PG8_WAIT_V(8); PG8_WAIT_L(0); PG8_BAR; PG8_MMA(1, 0, At, B0); PG8_MMA(1, 1, At, B1); PG8_BAR; PG8_SCHED;
            } else {
            PG8_LDB(B0, 0, 0); PG8_SCHED; PG8_LDA(At, 0, 0); PG8_STAGE(PG8_SA(1, 1), a1 + hstep, voffA);
            PG8_WAIT_L(8); PG8_BAR; PG8_WAIT_L(0); PG8_MMA(0, 0, At, B0); PG8_BAR; PG8_SCHED;
            PG8_LDB(B1, 0, 1); PG8_STAGE(PG8_SB(0, 0), b2, voffB);
            PG8_BAR; PG8_WAIT_L(0); PG8_MMA(0, 1, At, B1); PG8_BAR;
            PG8_LDA(At, 0, 1); PG8_STAGE(PG8_SA(0, 0), a2, voffA);
            PG8_BAR; PG8_WAIT_L(0); PG8_MMA(1, 0, At, B0); PG8_BAR; PG8_SCHED;
            PG8_STAGE(PG8_SB(0, 1), b2 + hstep, voffB);
            PG8_WAIT_V(6); PG8_BAR; PG8_MMA(1, 1, At, B1); PG8_BAR;
            PG8_LDB(B0, 1, 0); PG8_SCHED; PG8_LDA(At, 1, 0); PG8_STAGE(PG8_SA(0, 1), a2 + hstep, voffA);
            PG8_WAIT_L(8); PG8_BAR; PG8_WAIT_L(0); PG8_MMA(0, 0, At, B0); PG8_BAR; PG8_SCHED;
            PG8_LDB(B1, 1, 1); PG8_STAGE(PG8_SB(1, 0), b3, voffB);
            PG8_BAR; PG8_WAIT_L(0); PG8_MMA(0, 1, At, B1); PG8_BAR;
            PG8_LDA(At, 1, 1); PG8_STAGE(PG8_SA(1, 0), a3, voffA);
            PG8_BAR; PG8_WAIT_L(0); PG8_MMA(1, 0, At, B0); PG8_BAR; PG8_SCHED;
            PG8_STAGE(PG8_SB(1, 1), b3 + hstep, voffB);
            PG8_WAIT_V(6); PG8_BAR; PG8_MMA(1, 1, At, B1); PG8_BAR;
            }
        }
        if constexpr (ALIGN_EPI) { if (wr == 0) PG8_BAR; }
        if constexpr (!Epi::AFTER_DRAIN) { E(acc, cur, wr, wc, fr, fq); S.done(cur); }
        if (!has_next) break;
#pragma unroll
        for (int a = 0; a < 2; ++a)
#pragma unroll
            for (int b = 0; b < 2; ++b)
#pragma unroll
                for (int m = 0; m < 4; ++m)
#pragma unroll
                    for (int n = 0; n < 2; ++n) acc[a][b][m][n] = (f32x4){0.f, 0.f, 0.f, 0.f};
        cur = nxt; cA = nA; cB = nB; ++ui;
        if constexpr (ALIGN_EPI) { if (wr == 1) PG8_BAR; }
    }
    PG8_WAIT_V(0);
    if constexpr (!ALIGN_EPI) { if (wr == 0) PG8_BAR; }
    PG8_BAR;
    if constexpr (Epi::AFTER_DRAIN) { E.fused(acc, cur, wr, wc, fr, fq, lds, wid, lane); S.done(cur); }
#undef PG8_SA
#undef PG8_SB
#undef PG8_STAGE
#undef PG8_LDA
#undef PG8_LDB
#undef PG8_MMA
#undef PG8_WAIT_V
#undef PG8_WAIT_L
#undef PG8_BAR
#undef PG8_SCHED
}
}

#define LAS __attribute__((address_space(3)))
typedef unsigned short bf16;
typedef float f32x4 __attribute__((ext_vector_type(4)));
typedef float f32x2 __attribute__((ext_vector_type(2)));
typedef unsigned u32x4 __attribute__((ext_vector_type(4)));
typedef unsigned u32x2 __attribute__((ext_vector_type(2)));
typedef short bfx8 __attribute__((ext_vector_type(8)));
#define XB_TMO      128
#define XB_XCNT(j)  (256  + 64 * (j))
#define XB_XSUB(j)  (1280 + 64 * (j))
#define XB_XGEN(j)  (2304 + 64 * (j))
#define XB_TOP      3328
#define XB_TOPGEN   3392
#define XCD_BAR_WORDS 3456
#define XB_SPIN_CAP (1u << 18)

__device__ __forceinline__ unsigned xb_ld(unsigned* p)              { return __hip_atomic_load(p, __ATOMIC_RELAXED, __HIP_MEMORY_SCOPE_AGENT); }
__device__ __forceinline__ unsigned xb_add(unsigned* p, unsigned v) { return __hip_atomic_fetch_add(p, v, __ATOMIC_RELAXED, __HIP_MEMORY_SCOPE_AGENT); }
__device__ __forceinline__ unsigned xb_xcc_id() { return (unsigned)__builtin_amdgcn_s_getreg((3 << 11) | 20) & 0xFu; }
#define XB_SPIN(cond, bar) do { unsigned _sp = 0; while (cond) { __builtin_amdgcn_s_sleep(1); \
    if ((++_sp & 255u) == 0u) { if (xb_ld(&(bar)[XB_TMO])) break; if (_sp > XB_SPIN_CAP) { atomicAdd(&(bar)[XB_TMO], 1u); break; } } } } while (0)

struct XcdBarrier {
    unsigned* bar; unsigned x;
    volatile LAS unsigned* st;
};

__device__ __forceinline__ XcdBarrier xcd_barrier_post(unsigned* bar, volatile LAS unsigned* st, int tid) {
    XcdBarrier b; b.bar = bar; b.x = xb_xcc_id(); b.st = st;
    if (tid == 0) (void)xb_add(&bar[XB_XCNT(b.x)], 1u);
    return b;
}
__device__ __forceinline__ void xcd_barrier_complete(unsigned* bar, unsigned x, unsigned& nloc, unsigned& nx) {
    const unsigned G = gridDim.x * gridDim.y * gridDim.z;
    unsigned sum, cnt, mine, sp = 0u;
    for (;;) {
        sum = 0u; cnt = 0u; mine = 0u;
#pragma unroll
        for (unsigned j = 0; j < 16; ++j) { const unsigned c = xb_ld(&bar[XB_XCNT(j)]); sum += c; cnt += (c > 0u) ? 1u : 0u; mine = (j == x) ? c : mine; }
        if (sum == G) break;
        __builtin_amdgcn_s_sleep(1);
        if ((++sp & 255u) == 0u) { if (xb_ld(&bar[XB_TMO])) break; if (sp > XB_SPIN_CAP) { atomicAdd(&bar[XB_TMO], 1u); break; } }
    }
    nloc = mine > 0u ? mine : 1u; nx = cnt > 0u ? cnt : 1u;
}

__device__ __forceinline__ void xcd_barrier(const XcdBarrier& b, int tid) {
    asm volatile("s_waitcnt vmcnt(0)" ::: "memory");
    __syncthreads();
    if (tid == 0) {
        unsigned* bar = b.bar;
        __builtin_amdgcn_s_waitcnt(0);
        unsigned nloc = b.st[0], nx = b.st[1];
        if (nloc == 0u) { xcd_barrier_complete(bar, b.x, nloc, nx); b.st[0] = nloc; b.st[1] = nx; }
        const unsigned old = xb_add(&bar[XB_XSUB(b.x)], 1u);
        const unsigned gen = old / nloc;
        if (old + 1u == (gen + 1u) * nloc) {
            __builtin_amdgcn_fence(__ATOMIC_RELEASE, "agent");
            asm volatile("s_waitcnt vmcnt(0)" ::: "memory");
            const unsigned og = xb_add(&bar[XB_TOP], 1u);
            const unsigned tg = og / nx;
            if (og + 1u == (tg + 1u) * nx) xb_add(&bar[XB_TOPGEN], 1u);
            else XB_SPIN(xb_ld(&bar[XB_TOPGEN]) == tg, bar);
            __builtin_amdgcn_fence(__ATOMIC_ACQUIRE, "agent");
            xb_add(&bar[XB_XGEN(b.x)], 1u);
            asm volatile("s_waitcnt vmcnt(0)" ::: "memory");
        } else {
            XB_SPIN(xb_ld(&bar[XB_XGEN(b.x)]) == gen, bar);
            __builtin_amdgcn_fence(__ATOMIC_ACQUIRE, "agent");
            asm volatile("s_waitcnt vmcnt(0)" ::: "memory");
        }
    }
    __syncthreads();
}

constexpr int NWAVES = 8, NTHR = 512;
constexpr int TP = 8192, TS = 1024, T = 9216, D = 2048, NIN = 4800, NZ = 4864, FF = 5632, NGU = 11264;
constexpr int NH = 16, HS = 64, RD = 1024, RP = 3264, DEPTH = 4;
constexpr int ZQ = 1536;
constexpr float RMS_EPS = 1e-6f, LN_EPS = 1e-5f, GN_EPS = 64e-5f;
constexpr int SCR = 384;
constexpr size_t O_Y = 0;
constexpr size_t O_CONV_P = (size_t)T * D;
constexpr size_t O_POOL_P = O_CONV_P + (size_t)DEPTH * 4 * 30 * 512;
constexpr size_t O_SHIFT_P = O_POOL_P + (size_t)DEPTH * 4 * 15 * 512;
constexpr size_t O_WKV_P = O_SHIFT_P + (size_t)DEPTH * 4 * RP;
constexpr size_t O_CONV_S = O_WKV_P + (size_t)DEPTH * 4 * NH * 4096;
constexpr size_t O_POOL_S = O_CONV_S + (size_t)DEPTH * 16 * 30 * 512;
constexpr size_t O_SHIFT_S = O_POOL_S + (size_t)DEPTH * 16 * 15 * 512;
constexpr size_t O_WKV_S = O_SHIFT_S + (size_t)DEPTH * 16 * RP;
constexpr size_t O_END = O_WKV_S + (size_t)DEPTH * 16 * NH * 4096;
constexpr size_t WS_POOLW = 131072;
constexpr size_t WS_UPS = 262144;
constexpr size_t WS_WIN = 1u << 20;
constexpr size_t WS_WOUT = WS_WIN + (size_t)NZ * D * 2;
constexpr size_t WS_WGU = WS_WOUT + (size_t)D * D * 2;
constexpr size_t WS_WDN = WS_WGU + (size_t)NGU * D * 2;
constexpr size_t WS_X = WS_WDN + (size_t)D * FF * 2;
constexpr size_t WS_XN = WS_X + (size_t)T * D * 4;
constexpr size_t WS_MIX = WS_XN + (size_t)T * D * 2;
constexpr size_t WS_Z = WS_MIX + (size_t)T * D * 2;
constexpr size_t WS_ACT = WS_Z;
constexpr size_t WS_SC = WS_Z + (size_t)T * NZ * 2;
constexpr size_t WS_PART = WS_SC + (32u << 20);
constexpr size_t WS_Y = WS_SC + (size_t)T * NH * SCR * 4;
constexpr size_t WS_G = WS_Y + (size_t)T * RD * 4;
constexpr size_t WS_RK = WS_G + (size_t)T * RD * 4;
constexpr int NC = 16, CL = 128;
constexpr size_t WS_PQ = WS_RK + (size_t)T * NH * 4;
constexpr size_t WS_S0 = WS_PQ + (size_t)64 * NC * 2 * 4096 * 4;
constexpr size_t WS_GB = WS_S0 + (size_t)64 * NC * 4096 * 4;
constexpr size_t WS_W2 = WS_GB + (size_t)TP * RD * 4;
constexpr size_t WSET = WS_X - WS_WIN;
constexpr size_t WS_END = WS_W2 + WSET;
static_assert(WS_ACT + (size_t)T * FF * 2 <= WS_PART && WS_PART + (size_t)8 * 1024 * D * 4 <= WS_Y, "act / partial overlays");
constexpr int LDS_BYTES = 147456;
constexpr int CVT_SPLIT = 20500;

#define GSYNC() do { int w_ = wave0; asm volatile("" : "+s"(w_)); xcd_barrier(xbar, w_ * 64 + (int)__builtin_amdgcn_mbcnt_hi(~0u, __builtin_amdgcn_mbcnt_lo(~0u, (unsigned)launder_v(0)))); } while (0)
__host__ __device__ __forceinline__ size_t sc_off(int t, int h) { return ((size_t)(((t >> 2) * NH + h) * 4 + (t & 3))) * SCR; }
struct Params { const float* in[31]; float* out; unsigned char* ws; };
typedef const __attribute__((address_space(4))) Params* KP;
__device__ __forceinline__ KP kargs() { KP k = (KP)__builtin_amdgcn_kernarg_segment_ptr(); asm volatile("" : "+s"(k)); return k; }
__device__ __forceinline__ int launder_v(int v) { asm volatile("" : "+v"(v)); return v; }
#define PH_BEGIN() KP kp = kargs(); int wave_ = wave0; asm volatile("" : "+s"(wave_)); const int wave = wave_; const int lane = (int)__builtin_amdgcn_mbcnt_hi(~0u, __builtin_amdgcn_mbcnt_lo(~0u, (unsigned)launder_v(0))); const int tid = wave * 64 + lane; \
    const int nb = gridDim.x, bid = blockIdx.x, gw = bid * NWAVES + wave, ngw = nb * NWAVES; unsigned char* const ws = kp->ws; (void)lane; (void)wave; (void)gw; (void)ngw; (void)ws; (void)nb; (void)bid

template <int M> __device__ __forceinline__ float swz_xor(float v) { return __builtin_bit_cast(float, __builtin_amdgcn_ds_swizzle(__builtin_bit_cast(int, v), 0x1f | (M << 10))); }
__device__ __forceinline__ float rowsum16(float v) { v += swz_xor<1>(v); v += swz_xor<2>(v); v += swz_xor<4>(v); v += swz_xor<8>(v); return v; }
__device__ __forceinline__ float wave_sum(float v) {
    v = rowsum16(v); v += swz_xor<16>(v);
    const int ln = (int)__builtin_amdgcn_mbcnt_hi(~0u, __builtin_amdgcn_mbcnt_lo(~0u, (unsigned)launder_v(0)));
    v += __builtin_bit_cast(float, __builtin_amdgcn_ds_bpermute((ln ^ 32) << 2, __builtin_bit_cast(int, v)));
    return v;
}
__device__ __forceinline__ unsigned f2bf(float f) { unsigned u = __builtin_bit_cast(unsigned, f); return (u + 0x7fffu + ((u >> 16) & 1u)) >> 16; }
__device__ __forceinline__ unsigned pk2(float lo, float hi) { return f2bf(lo) | (f2bf(hi) << 16); }
__device__ __forceinline__ float bf2f(bf16 v) { return __builtin_bit_cast(float, (unsigned)v << 16); }
__device__ __forceinline__ float sigm(float x) { return __builtin_amdgcn_rcpf(1.0f + __expf(-x)); }

__device__ __forceinline__ void transpose_item(const float* W, int K, int N, bf16* WT, int mode, LAS float* scr, int item, int lane) {
    const int nblk = N / 32, kb = item / nblk, nb = item % nblk, k0 = 64 * kb, n0 = 32 * nb;
    const int drow0 = (mode == 0) ? n0 : ((n0 >> 7) * 256 + (n0 & 127) + (mode == 2 ? 128 : 0));
    float wv[32];
#pragma unroll
    for (int i = 0; i < 32; ++i) { const int kk = 2 * i + (lane >> 5); wv[i] = __builtin_nontemporal_load(W + (size_t)(k0 + kk) * N + n0 + (lane & 31)); }
#pragma unroll
    for (int i = 0; i < 32; ++i) { const int kk = 2 * i + (lane >> 5); scr[kk * 33 + (lane & 31)] = wv[i]; }
    asm volatile("s_waitcnt lgkmcnt(0)" ::: "memory");
    const int c = lane & 7;
#pragma unroll
    for (int j = 0; j < 4; ++j) { const int n = (lane >> 3) + 8 * j; const LAS float* s = scr + (8 * c) * 33 + n;
        u32x4 o; o.x = pk2(s[0 * 33], s[1 * 33]); o.y = pk2(s[2 * 33], s[3 * 33]); o.z = pk2(s[4 * 33], s[5 * 33]); o.w = pk2(s[6 * 33], s[7 * 33]);
        *(u32x4*)(WT + (size_t)(drow0 + n) * K + k0 + 8 * c) = o; }
    asm volatile("s_waitcnt lgkmcnt(0)" ::: "memory");
}
__device__ __forceinline__ void convert_weights(KP kp, int l, LAS float* scr, int gw, int ngw, int lane, int item_lo = 0, int item_hi = 1 << 30) {
    unsigned char* ws = kp->ws;
    unsigned char* wsw = kp->ws + ((l & 1) ? (WS_W2 - WS_WIN) : 0);
    bf16* WIN = (bf16*)(wsw + WS_WIN); bf16* WOUT = (bf16*)(wsw + WS_WOUT); bf16* WGU = (bf16*)(wsw + WS_WGU); bf16* WDN = (bf16*)(wsw + WS_WDN);
    constexpr int I_IN = (D / 64) * (NIN / 32), I_OUT = (D / 64) * (D / 32), I_G = (D / 64) * (FF / 32), I_D = (FF / 64) * (D / 32);
    constexpr int I_P = 4 * 8, I_U = 3 * 32;
    constexpr int NITEMS = I_IN + I_OUT + 2 * I_G + I_D + I_P + I_U;
    const int it_end = item_hi < NITEMS ? item_hi : NITEMS;
    for (int it = item_lo + gw; it < it_end; it += ngw) {
        int r = it;
        if (r < I_IN) { transpose_item(kp->in[7] + (size_t)l * D * NIN, D, NIN, WIN, 0, scr, r, lane); continue; } r -= I_IN;
        if (r < I_OUT) { transpose_item(kp->in[25] + (size_t)l * D * D, D, D, WOUT, 0, scr, r, lane); continue; } r -= I_OUT;
        if (r < I_G) { transpose_item(kp->in[27] + (size_t)l * D * FF, D, FF, WGU, 1, scr, r, lane); continue; } r -= I_G;
        if (r < I_G) { transpose_item(kp->in[28] + (size_t)l * D * FF, D, FF, WGU, 2, scr, r, lane); continue; } r -= I_G;
        if (r < I_D) { transpose_item(kp->in[29] + (size_t)l * FF * D, FF, D, WDN, 0, scr, r, lane); continue; } r -= I_D;
        if (r < I_P) { const int g = r >> 3; transpose_item(kp->in[12] + (size_t)((l * 4 + g) * 128) * 128, 128, 128, (bf16*)(ws + WS_POOLW) + (size_t)g * 128 * 128, 0, scr, r & 7, lane); continue; } r -= I_P;
        { const int m = r >> 5; const float* src = (m == 0 ? kp->in[16] : (m == 1 ? kp->in[18] : kp->in[19])) + (size_t)l * 64 * RD;
          transpose_item(src, 64, RD, (bf16*)(ws + WS_UPS) + (size_t)m * RD * 64, 0, scr, r & 31, lane); }
    }
    if (item_lo == 0) { const unsigned z = (unsigned)launder_v(0); for (int e = gw * 64 + lane; e < 16384; e += ngw * 64) ((u32x4*)(WIN + (size_t)NIN * D))[e] = (u32x4){z, z, z, z}; }
}
__device__ __forceinline__ void norm_rows(const float* sa, const float* sb, const float* g, float* xcopy, bf16* xn, float* fout, const float* part, int gw, int ngw, int lane) {
    f32x4 vn[8];
    if (gw < T) { const float* row = (gw < TP) ? sa + (size_t)gw * D : sb + (size_t)(gw - TP) * D;
#pragma unroll
        for (int j = 0; j < 8; ++j) vn[j] = ((const f32x4*)row)[lane + 64 * j]; }
    for (int m = gw; m < T; m += ngw) {
        f32x4 v[8]; float ss = 0.f;
#pragma unroll
        for (int j = 0; j < 8; ++j) v[j] = vn[j];
        { const int mn = m + ngw;
          if (mn < T) { const float* row = (mn < TP) ? sa + (size_t)mn * D : sb + (size_t)(mn - TP) * D;
#pragma unroll
            for (int j = 0; j < 8; ++j) vn[j] = ((const f32x4*)row)[lane + 64 * j]; } }
        if (part && m >= TP) {
#pragma unroll
            for (int k = 0; k < 8; ++k)
#pragma unroll
                for (int j = 0; j < 8; ++j) v[j] += ((const f32x4*)(part + ((size_t)k * 1024 + (m - TP)) * D))[lane + 64 * j];
#pragma unroll
            for (int j = 0; j < 8; ++j) ((f32x4*)(const_cast<float*>(sb) + (size_t)(m - TP) * D))[lane + 64 * j] = v[j];
        }
#pragma unroll
        for (int j = 0; j < 8; ++j) ss += (v[j].x * v[j].x + v[j].y * v[j].y) + (v[j].z * v[j].z + v[j].w * v[j].w);
        const float rinv = __builtin_amdgcn_rsqf(wave_sum(ss) * (1.0f / D) + RMS_EPS);
#pragma unroll
        for (int j = 0; j < 8; ++j) {
            if (xcopy) ((f32x4*)(xcopy + (size_t)m * D))[lane + 64 * j] = v[j];
            const f32x4 gj = ((const f32x4*)g)[lane + 64 * j];
            const f32x4 y = v[j] * rinv * gj;
            if (xn) { u32x2 o; o.x = pk2(y.x, y.y); o.y = pk2(y.z, y.w); ((u32x2*)(xn + (size_t)m * D))[lane + 64 * j] = o; }
            if (fout) ((f32x4*)(fout + (size_t)m * D))[lane + 64 * j] = y;
        }
    }
}

__device__ __forceinline__ void conv_item(KP kp, int l, int item, LAS float* lds, int tid_in) {
    const int tid = launder_v(tid_in);
    const bf16* Z = (const bf16*)(kp->ws + WS_Z); bf16* MIX = (bf16*)(kp->ws + WS_MIX);
    const int t0 = item * 32;
    int s, tau0, Ls; bool prompt;
    if (t0 < TP) { s = t0 >> 11; tau0 = t0 & 2047; Ls = 2048; prompt = true; } else { s = (t0 - TP) >> 6; tau0 = (t0 - TP) & 63; Ls = 64; prompt = false; }
    const int c = tid;
    const float* cw = kp->in[8] + (size_t)l * 31 * 512;
    float w[31];
#pragma unroll
    for (int j = 0; j < 31; ++j) w[j] = cw[j * 512 + c];
    const float bias = kp->in[9][l * 512 + c];
    float acc[32];
#pragma unroll
    for (int i = 0; i < 32; ++i) acc[i] = bias;
    const bool first = (tau0 == 0), lastit = (tau0 + 32 == Ls);
    float* oc = prompt ? kp->out + O_CONV_P + (size_t)((l * 4 + s) * 30) * 512 : kp->out + O_CONV_S + (size_t)((l * 16 + s) * 30) * 512;
    const float* cc = kp->in[2] + (size_t)((l * 16 + s) * 30) * 512;
#pragma unroll
    for (int hf = 0; hf < 2; ++hf) {
        float pv[31], pg[31];
#pragma unroll
        for (int k = 0; k < 31; ++k) { const int ii = hf * 31 + k;
            if (ii < 30 && first) { pv[k] = prompt ? 0.f : cc[ii * 512 + c]; pg[k] = 0.f; }
            else { const bf16* zr = Z + (size_t)(t0 + ii - 30) * NZ; pv[k] = bf2f(zr[c]); pg[k] = bf2f(zr[512 + c]); } }
#pragma unroll
        for (int k = 0; k < 31; ++k) { const int ii = hf * 31 + k;
            const float u = (ii < 30 && first) ? pv[k] : pv[k] * sigm(pg[k]);
            if (ii >= 32 && lastit) oc[(ii - 32) * 512 + c] = u;
#pragma unroll
            for (int oi = 0; oi < 32; ++oi) { const int j = ii - oi; if (j >= 0 && j <= 30) acc[oi] += w[j] * u; }
        }
    }
#pragma unroll
    for (int oi = 0; oi < 32; ++oi) lds[oi * 512 + c] = acc[oi];
    __syncthreads();
    const int wave = tid >> 6, lane = tid & 63;
    const f32x4 g0 = *(const f32x4*)(kp->in[10] + l * 512 + lane * 8), g1 = *(const f32x4*)(kp->in[10] + l * 512 + lane * 8 + 4);
    const f32x4 b0 = *(const f32x4*)(kp->in[11] + l * 512 + lane * 8), b1 = *(const f32x4*)(kp->in[11] + l * 512 + lane * 8 + 4);
#pragma unroll
    for (int q = 0; q < 4; ++q) {
        const int oi = wave * 4 + q;
        f32x4 a = *(const LAS f32x4*)(lds + oi * 512 + lane * 8), b = *(const LAS f32x4*)(lds + oi * 512 + lane * 8 + 4);
        const float mean = wave_sum((a.x + a.y) + (a.z + a.w) + (b.x + b.y) + (b.z + b.w)) * (1.0f / 512.0f);
        a = a - mean; b = b - mean;
        const float var = wave_sum((a.x * a.x + a.y * a.y) + (a.z * a.z + a.w * a.w) + (b.x * b.x + b.y * b.y) + (b.z * b.z + b.w * b.w)) * (1.0f / 512.0f);
        const float rstd = __builtin_amdgcn_rsqf(var + LN_EPS);
        a = a * rstd * g0 + b0; b = b * rstd * g1 + b1;
        float o[8] = {a.x, a.y, a.z, a.w, b.x, b.y, b.z, b.w};
#pragma unroll
        for (int k = 0; k < 8; ++k) o[k] = o[k] * sigm(o[k]);
        u32x4 wv; wv.x = pk2(o[0], o[1]); wv.y = pk2(o[2], o[3]); wv.z = pk2(o[4], o[5]); wv.w = pk2(o[6], o[7]);
        *(u32x4*)(MIX + (size_t)(t0 + oi) * D + lane * 8) = wv;
    }
    __syncthreads();
}
template <int W> __device__ __forceinline__ void pool_window(const float (&pvl)[47], LAS bf16* db, int c, bool prompt, int tau0) {
    float sum = 0.f;
#pragma unroll
    for (int k = 0; k < W; ++k) sum += pvl[15 - k];
#pragma unroll
    for (int oi = 0; oi < 32; ++oi) {
        if (oi > 0) sum += pvl[oi + 15] - pvl[oi + 15 - W];
        const int cnt = prompt ? min(W, tau0 + oi + 1) : W;
        db[oi * 520 + c] = (bf16)f2bf(sum * __builtin_amdgcn_rcpf((float)cnt) - pvl[oi + 15]);
    }
}
__device__ __forceinline__ void pool_item(KP kp, int l, int item, LAS unsigned char* ldsb, int tid_in) {
    const int tid = launder_v(tid_in);
    const bf16* Z = (const bf16*)(kp->ws + WS_Z); bf16* MIX = (bf16*)(kp->ws + WS_MIX);
    LAS float* pp = (LAS float*)ldsb;
    LAS bf16* db = (LAS bf16*)(ldsb + 47 * 512 * 4);
    const int t0 = item * 32;
    int s, tau0, Ls; bool prompt;
    if (t0 < TP) { s = t0 >> 11; tau0 = t0 & 2047; Ls = 2048; prompt = true; } else { s = (t0 - TP) >> 6; tau0 = (t0 - TP) & 63; Ls = 64; prompt = false; }
    const int c = tid;
    const bool first = (tau0 == 0), lastit = (tau0 + 32 == Ls);
    float* op = prompt ? kp->out + O_POOL_P + (size_t)((l * 4 + s) * 15) * 512 : kp->out + O_POOL_S + (size_t)((l * 16 + s) * 15) * 512;
    const float* cp = kp->in[3] + (size_t)((l * 16 + s) * 15) * 512;
    {
        float pvl[47];
#pragma unroll
        for (int ii = 0; ii < 47; ++ii) {
            if (ii < 15 && first) pvl[ii] = prompt ? 0.f : cp[ii * 512 + c];
            else pvl[ii] = bf2f(Z[(size_t)(t0 + ii - 15) * NZ + 1024 + c]);
        }
        if (lastit) {
#pragma unroll
            for (int ii = 32; ii < 47; ++ii) op[(ii - 32) * 512 + c] = pvl[ii];
        }
        const int gi = c >> 7;
        if (gi == 0) pool_window<2>(pvl, db, c, prompt, tau0);
        else if (gi == 1) pool_window<4>(pvl, db, c, prompt, tau0);
        else if (gi == 2) pool_window<8>(pvl, db, c, prompt, tau0);
        else pool_window<16>(pvl, db, c, prompt, tau0);
    }
    __syncthreads();
    const int lane = tid & 63, wave = tid >> 6, n16 = lane & 15, q = lane >> 4, g = wave >> 1, nh = wave & 1;
    const bf16* WT = (const bf16*)(kp->ws + WS_POOLW) + (size_t)g * 128 * 128;
    bfx8 Bf[4][4];
#pragma unroll
    for (int nt = 0; nt < 4; ++nt)
#pragma unroll
        for (int ks = 0; ks < 4; ++ks) Bf[nt][ks] = *(const bfx8*)(WT + (size_t)(nh * 64 + nt * 16 + n16) * 128 + ks * 32 + q * 8);
    float scale[4];
#pragma unroll
    for (int nt = 0; nt < 4; ++nt) scale[nt] = kp->in[13][l * 512 + g * 128 + nh * 64 + nt * 16 + n16];
#pragma unroll
    for (int mt = 0; mt < 2; ++mt) {
        bfx8 Af[4];
#pragma unroll
        for (int ks = 0; ks < 4; ++ks) Af[ks] = *(const LAS bfx8*)(db + (mt * 16 + n16) * 520 + g * 128 + ks * 32 + q * 8);
        f32x4 acc[4];
#pragma unroll
        for (int nt = 0; nt < 4; ++nt) { acc[nt] = (f32x4){0.f, 0.f, 0.f, 0.f};
#pragma unroll
            for (int ks = 0; ks < 4; ++ks) acc[nt] = __builtin_amdgcn_mfma_f32_16x16x32_bf16(Af[ks], Bf[nt][ks], acc[nt], 0, 0, 0); }
#pragma unroll
        for (int nt = 0; nt < 4; ++nt)
#pragma unroll
            for (int r = 0; r < 4; ++r) MIX[(size_t)(t0 + mt * 16 + 4 * q + r) * D + 512 + g * 128 + nh * 64 + nt * 16 + n16] = (bf16)f2bf(acc[nt][r] * scale[nt]);
    }
    __syncthreads();
}
__device__ __forceinline__ void prep_item(KP kp, int l, int item, LAS unsigned char* ldsb, int tid_in) {
    const int tid = launder_v(tid_in);
    const bf16* Z = (const bf16*)(kp->ws + WS_Z);
    float* SC = (float*)(kp->ws + WS_SC); float* G = (float*)(kp->ws + WS_G); float* RK = (float*)(kp->ws + WS_RK);
    const bf16* UPT = (const bf16*)(kp->ws + WS_UPS);
    LAS bf16* lo = (LAS bf16*)ldsb;
    const int t0 = item * 16;
    int s, tau0, Ls; bool prompt;
    if (t0 < TP) { s = t0 >> 11; tau0 = t0 & 2047; Ls = 2048; prompt = true; } else { s = (t0 - TP) >> 6; tau0 = (t0 - TP) & 63; Ls = 64; prompt = false; }
    const float* mu = kp->in[14] + (size_t)l * RP;
    const float* ssh = kp->in[4] + (size_t)(l * 16 + s) * RP;
    {
        float qv[6], qp[6], mq[6];
#pragma unroll
        for (int k = 0; k < 6; ++k) { const int e = tid + k * NTHR, tok = e / 192, col = e % 192, zc = 3072 + col, t = t0 + tok, tau = tau0 + tok;
            qv[k] = bf2f(Z[(size_t)t * NZ + ZQ + zc]);
            qp[k] = tau > 0 ? bf2f(Z[(size_t)(t - 1) * NZ + ZQ + zc]) : (prompt ? 0.f : ssh[zc]);
            mq[k] = mu[zc]; }
#pragma unroll
        for (int k = 0; k < 6; ++k) { const int e = tid + k * NTHR, tok = e / 192, col = e % 192;
            const float qs = qv[k] + (qp[k] - qv[k]) * mq[k];
            const float val = col < 64 ? (1.0f - 2.0f * __builtin_amdgcn_rcpf(1.0f + __expf(2.0f * qs))) : (col < 128 ? qs : sigm(qs));
            lo[((col >> 6) * 16 + tok) * 72 + (col & 63)] = (bf16)f2bf(val); }
    }
    __syncthreads();
    const int lane = tid & 63, wave = tid >> 6, n16 = lane & 15, q = lane >> 4;
#pragma unroll 1
    for (int hh = 0; hh < 2; ++hh) {
        const int h = wave * 2 + hh;
        f32x4 acc[3][4];
#pragma unroll
        for (int m = 0; m < 3; ++m) {
            bfx8 Af[2], Bf[4][2];
#pragma unroll
            for (int ks = 0; ks < 2; ++ks) Af[ks] = *(const LAS bfx8*)(lo + (m * 16 + n16) * 72 + ks * 32 + q * 8);
#pragma unroll
            for (int i = 0; i < 4; ++i)
#pragma unroll
                for (int ks = 0; ks < 2; ++ks) Bf[i][ks] = *(const bfx8*)(UPT + (size_t)(m * RD + h * 64 + i * 16 + n16) * 64 + ks * 32 + q * 8);
#pragma unroll
            for (int i = 0; i < 4; ++i) { acc[m][i] = (f32x4){0.f, 0.f, 0.f, 0.f};
#pragma unroll
                for (int ks = 0; ks < 2; ++ks) acc[m][i] = __builtin_amdgcn_mfma_f32_16x16x32_bf16(Af[ks], Bf[i][ks], acc[m][i], 0, 0, 0); }
        }
        float mur[4], muk[4], muv[4], w0c[4], a0c[4], kkc[4], kac[4], rkc[4], sr[4], sk[4], sv[4];
#pragma unroll
        for (int i = 0; i < 4; ++i) { const int c = h * 64 + i * 16 + n16;
            mur[i] = mu[c]; muk[i] = mu[RD + c]; muv[i] = mu[2 * RD + c];
            w0c[i] = kp->in[15][l * RD + c]; a0c[i] = kp->in[17][l * RD + c]; kkc[i] = kp->in[20][l * RD + c]; kac[i] = kp->in[21][l * RD + c]; rkc[i] = kp->in[22][l * RD + c];
            sr[i] = prompt ? 0.f : ssh[c]; sk[i] = prompt ? 0.f : ssh[RD + c]; sv[i] = prompt ? 0.f : ssh[2 * RD + c]; }
        float zc_[4][4][3], zp_[4][4][3];
#pragma unroll
        for (int r = 0; r < 4; ++r) {
            const int tok = 4 * q + r, t = t0 + tok, tau = tau0 + tok;
            const bf16* zr = Z + (size_t)t * NZ + ZQ;
#pragma unroll
            for (int i = 0; i < 4; ++i) { const int c = h * 64 + i * 16 + n16;
                zc_[r][i][0] = bf2f(zr[c]); zc_[r][i][1] = bf2f(zr[RD + c]); zc_[r][i][2] = bf2f(zr[2 * RD + c]);
                if (tau > 0) { zp_[r][i][0] = bf2f(zr[c - NZ]); zp_[r][i][1] = bf2f(zr[RD + c - NZ]); zp_[r][i][2] = bf2f(zr[2 * RD + c - NZ]); } else { zp_[r][i][0] = sr[i]; zp_[r][i][1] = sk[i]; zp_[r][i][2] = sv[i]; } }
        }
        float dv[4][4], av[4][4];
#pragma unroll
        for (int r = 0; r < 4; ++r)
#pragma unroll
            for (int i = 0; i < 4; ++i) {
                const float xw = -(w0c[i] + acc[0][i][r]);
                const float sp = fmaxf(xw, 0.f) + __logf(1.0f + __expf(-fabsf(xw)));
                dv[r][i] = __expf(-__expf(-sp - 0.5f));
                av[r][i] = sigm(a0c[i] + acc[1][i][r]);
            }
        float wpre[4];
        { const int lnx = (int)__builtin_amdgcn_mbcnt_hi(~0u, __builtin_amdgcn_mbcnt_lo(~0u, (unsigned)launder_v(0)));
#pragma unroll
          for (int i = 0; i < 4; ++i) {
            const float gq = (dv[0][i] * dv[1][i]) * (dv[2][i] * dv[3][i]);
            const float g0 = __builtin_bit_cast(float, __builtin_amdgcn_ds_bpermute(((lnx & 15)) << 2, __builtin_bit_cast(int, gq)));
            const float g1 = __builtin_bit_cast(float, __builtin_amdgcn_ds_bpermute(((lnx & 15) + 16) << 2, __builtin_bit_cast(int, gq)));
            const float g2 = __builtin_bit_cast(float, __builtin_amdgcn_ds_bpermute(((lnx & 15) + 32) << 2, __builtin_bit_cast(int, gq)));
            wpre[i] = (q > 0 ? g0 : 1.0f) * (q > 1 ? g1 : 1.0f) * (q > 2 ? g2 : 1.0f); } }
#pragma unroll
        for (int r = 0; r < 4; ++r) {
            const int tok = 4 * q + r, t = t0 + tok;
            float rv[4], kv[4], vv[4], kk[4], wex[4], win[4];
            float skk = 0.f;
#pragma unroll
            for (int i = 0; i < 4; ++i) { const int c = h * 64 + i * 16 + n16;
                float rr = zc_[r][i][0], k = zc_[r][i][1], v = zc_[r][i][2];
                rr += (zp_[r][i][0] - rr) * mur[i]; k += (zp_[r][i][1] - k) * muk[i]; v += (zp_[r][i][2] - v) * muv[i];
                rv[i] = rr; kv[i] = k; vv[i] = v; kk[i] = k * kkc[i]; skk += kk[i] * kk[i];
                wex[i] = wpre[i]; win[i] = wpre[i] * dv[r][i]; wpre[i] = win[i];
                G[(size_t)t * RD + c] = acc[2][i][r];
                }
            skk = rowsum16(skk);
            const float rinv = __builtin_amdgcn_rsqf(fmaxf(skk, 1e-24f));
            float srk = 0.f;
#pragma unroll
            for (int i = 0; i < 4; ++i) {
                const float kkn = kk[i] * rinv, kpv = kv[i] * (1.0f + (av[r][i] - 1.0f) * kac[i]), bb = kkn * av[r][i];
                srk += rv[i] * kpv * rkc[i];
                const float iw = __builtin_amdgcn_rcpf(win[i]);
                float* sc = SC + sc_off(t, h) + i * 16 + n16;
                sc[0] = wex[i] * kkn; sc[64] = bb * iw; sc[128] = kpv * iw; sc[192] = win[i] * rv[i]; sc[256] = vv[i]; sc[320] = win[i];
            }
            srk = rowsum16(srk);
            if (n16 == 0) RK[t * NH + h] = srk;
        }
    }
    if (tau0 + 16 == Ls) {
        float* osh = prompt ? kp->out + O_SHIFT_P + (size_t)(l * 4 + s) * RP : kp->out + O_SHIFT_S + (size_t)(l * 16 + s) * RP;
        const bf16* zr = Z + (size_t)(t0 + 15) * NZ + ZQ;
        for (int e = tid; e < RP; e += NTHR) osh[e] = bf2f(zr[e]);
    }
    __syncthreads();
}

__device__ __forceinline__ void sc_issue(f32x4 (&r)[4], const LAS f32x4* o, int c) {
    if (c < 4) {
#pragma unroll
        for (int i = 0; i < 4; ++i) r[i] = o[4 * c + i];
    } else { const int j = c - 4; r[1] = o[16 + j]; r[2] = o[32 + j]; r[3] = o[48 + j]; }
}
template <int MODE>
__device__ __forceinline__ void scan_run(const float* SC, int tg0, int nsteps, int h, LAS float* wl  , LAS float* yb  , int lane,
                                         const float* Sinit, float* Y, float* GB, float* Sout, float* PQout) {
    constexpr int GS = 4, NCH = 20;
    f32x2 S[32];
    f32x2 P[(MODE == 3) ? 32 : 1];
    if (MODE == 3) {
        const int ln = launder_v(lane);
#pragma unroll
        for (int j = 0; j < 32; ++j) { S[j] = (f32x2){0.f, 0.f}; P[j] = (f32x2){(2 * j == ln) ? 1.f : 0.f, (2 * j + 1 == ln) ? 1.f : 0.f}; }
    } else {
#pragma unroll
        for (int j = 0; j < 16; ++j) { const f32x4 v = ((const f32x4*)(Sinit + lane * 64))[j]; S[2 * j] = (f32x2){v.x, v.y}; S[2 * j + 1] = (f32x2){v.z, v.w}; }
    }
#define SC_STAGE(g, buf) do { const float* rec_ = SC + sc_off(tg0 + (g) * GS, h) + lane * 4; \
        _Pragma("unroll") for (int k_ = 0; k_ < 6; ++k_) __builtin_amdgcn_global_load_lds((const unsigned*)(rec_ + k_ * 256), (LAS unsigned*)(wl + (buf) * GS * SCR + k_ * 256), 16, 0, 0); } while (0)
    SC_STAGE(0, 0);
    const int ngroups = nsteps / GS;
    for (int g = 0; g < ngroups; ++g) {
        asm volatile("s_waitcnt vmcnt(0)" ::: "memory");
        if (g > 0) {
#pragma unroll
            for (int s = 0; s < GS; ++s) { Y[(size_t)(tg0 + (g - 1) * GS + s) * RD + h * 64 + lane] = yb[s * 64 + lane]; if (MODE == 3) GB[(size_t)(tg0 + (g - 1) * GS + s) * RD + h * 64 + lane] = yb[(GS + s) * 64 + lane]; }
        }
        if (g + 1 < ngroups) SC_STAGE(g + 1, (g + 1) & 1);
        const LAS float* wb = wl + (g & 1) * GS * SCR;
        f32x4 R[4][4];
#pragma unroll
        for (int q = 0; q < 3; ++q) sc_issue(R[q & 3], (const LAS f32x4*)(wb + (q / NCH) * SCR), q % NCH);
        __builtin_amdgcn_sched_barrier(0);
#pragma unroll
        for (int s = 0; s < GS; ++s) {
            f32x2 d2a = (f32x2){0.f, 0.f}, y2a = (f32x2){0.f, 0.f};
            f32x2 e2a = (f32x2){0.f, 0.f}, g2a = (f32x2){0.f, 0.f};
            f32x2 sa2 = (f32x2){0.f, 0.f}, sp2 = (f32x2){0.f, 0.f};
            const float vs = wb[s * SCR + 256 + lane];
            const f32x2 v2 = (f32x2){vs, vs};
#pragma unroll
            for (int c = 0; c < NCH; ++c) {
                const int q = s * NCH + c, qn = q + 3;
                if (qn < GS * NCH) sc_issue(R[qn & 3], (const LAS f32x4*)(wb + (qn / NCH) * SCR), qn % NCH);
                __builtin_amdgcn_sched_barrier(0);
                f32x4 (&r)[4] = R[q & 3];
                if (c < 4) {
#pragma unroll
                    for (int i = 0; i < 4; ++i) { const int j = 4 * c + i; d2a += S[2 * j] * (f32x2){r[i].x, r[i].y}; d2a += S[2 * j + 1] * (f32x2){r[i].z, r[i].w};
                        if (MODE == 3) { e2a += P[2 * j] * (f32x2){r[i].x, r[i].y}; e2a += P[2 * j + 1] * (f32x2){r[i].z, r[i].w}; } }
                    if (c == 3) { const f32x2 d2 = d2a; const float sa = -(d2.x + d2.y); sa2 = (f32x2){sa, sa};
                        if (MODE == 3) { const f32x2 e2 = e2a; const float sp = -(e2.x + e2.y); sp2 = (f32x2){sp, sp}; } }
                } else {
                    const int j = c - 4;
                    S[2 * j] = sa2 * (f32x2){r[1].x, r[1].y} + S[2 * j]; S[2 * j] = v2 * (f32x2){r[2].x, r[2].y} + S[2 * j];
                    S[2 * j + 1] = sa2 * (f32x2){r[1].z, r[1].w} + S[2 * j + 1]; S[2 * j + 1] = v2 * (f32x2){r[2].z, r[2].w} + S[2 * j + 1];
                    y2a += S[2 * j] * (f32x2){r[3].x, r[3].y}; y2a += S[2 * j + 1] * (f32x2){r[3].z, r[3].w};
                    if (MODE == 3) {
                        P[2 * j] = sp2 * (f32x2){r[1].x, r[1].y} + P[2 * j]; P[2 * j + 1] = sp2 * (f32x2){r[1].z, r[1].w} + P[2 * j + 1];
                        g2a += P[2 * j] * (f32x2){r[3].x, r[3].y}; g2a += P[2 * j + 1] * (f32x2){r[3].z, r[3].w};
                    }
                }
                __builtin_amdgcn_sched_barrier(0);
            }
            yb[s * 64 + lane] = y2a.x + y2a.y;
            if (MODE == 3) yb[(GS + s) * 64 + lane] = g2a.x + g2a.y;
        }
        if ((g & 3) == 3) {
            const LAS f32x4* wq = (const LAS f32x4*)(wb + (GS - 1) * SCR + 320);
#pragma unroll
            for (int j = 0; j < 16; ++j) { const f32x4 w4 = wq[j];
                S[2 * j] = S[2 * j] * (f32x2){w4.x, w4.y}; S[2 * j + 1] = S[2 * j + 1] * (f32x2){w4.z, w4.w};
                if (MODE == 3) { P[2 * j] = P[2 * j] * (f32x2){w4.x, w4.y}; P[2 * j + 1] = P[2 * j + 1] * (f32x2){w4.z, w4.w}; } }
        }
        asm volatile("s_waitcnt lgkmcnt(0)" ::: "memory");
    }
#undef SC_STAGE
#pragma unroll
    for (int s = 0; s < GS; ++s) { Y[(size_t)(tg0 + (ngroups - 1) * GS + s) * RD + h * 64 + lane] = yb[s * 64 + lane]; if (MODE == 3) GB[(size_t)(tg0 + (ngroups - 1) * GS + s) * RD + h * 64 + lane] = yb[(GS + s) * 64 + lane]; }
    if (MODE == 3) {
#pragma unroll
        for (int j = 0; j < 16; ++j) { ((f32x4*)PQout)[j * 64 + lane] = (f32x4){P[2 * j].x, P[2 * j].y, P[2 * j + 1].x, P[2 * j + 1].y};
                                       ((f32x4*)(PQout + 4096))[j * 64 + lane] = (f32x4){S[2 * j].x, S[2 * j].y, S[2 * j + 1].x, S[2 * j + 1].y}; }
    } else {
#pragma unroll
        for (int j = 0; j < 16; ++j) ((f32x4*)(Sout + lane * 64))[j] = (f32x4){S[2 * j].x, S[2 * j].y, S[2 * j + 1].x, S[2 * j + 1].y};
    }
}
template <int NMT>
__device__ __forceinline__ void ypost_task(KP kp, int l, const float* S0q  , int tg0, int h, int lane) {
    const float* GB = (const float*)(kp->ws + WS_GB); const float* Y = (const float*)(kp->ws + WS_Y); const float* SC = (const float*)(kp->ws + WS_SC);
    const float* G = (const float*)(kp->ws + WS_G); const float* RK = (const float*)(kp->ws + WS_RK); bf16* MIX = (bf16*)(kp->ws + WS_MIX);
    const int n = lane & 15, kq = lane >> 4;
    float Bv[4][16];
    if (S0q) {
#pragma unroll
        for (int nt = 0; nt < 4; ++nt)
#pragma unroll
            for (int ks = 0; ks < 16; ++ks) Bv[nt][ks] = S0q[(size_t)(ks * 64 + nt * 16 + n) * 4 + kq];
    }
    float gng[4], gnb[4];
#pragma unroll
    for (int nt = 0; nt < 4; ++nt) { gng[nt] = kp->in[23][l * RD + h * 64 + nt * 16 + n]; gnb[nt] = kp->in[24][l * RD + h * 64 + nt * 16 + n]; }
#pragma unroll 1
    for (int mt = 0; mt < NMT; ++mt) {
        const int tb = tg0 + mt * 16;
        float Av[16];
        if (S0q) { const float* grow = GB + (size_t)(tb + n) * RD + h * 64 + kq;
#pragma unroll
            for (int ks = 0; ks < 16; ++ks) Av[ks] = grow[ks * 4]; }
        f32x4 acc[4]; float vv[4][4], gg[4][4], rk[4];
#pragma unroll
        for (int r = 0; r < 4; ++r) { const int t = tb + 4 * kq + r; rk[r] = RK[t * NH + h];
#pragma unroll
            for (int nt = 0; nt < 4; ++nt) { acc[nt][r] = Y[(size_t)t * RD + h * 64 + nt * 16 + n]; vv[nt][r] = SC[sc_off(t, h) + 256 + nt * 16 + n]; gg[nt][r] = G[(size_t)t * RD + h * 64 + nt * 16 + n]; } }
        if (S0q) {
#pragma unroll
            for (int ks = 0; ks < 16; ++ks)
#pragma unroll
                for (int nt = 0; nt < 4; ++nt) acc[nt] = __builtin_amdgcn_mfma_f32_16x16x4f32(Av[ks], Bv[nt][ks], acc[nt], 0, 0, 0);
        }
#pragma unroll
        for (int r = 0; r < 4; ++r) {
            const int t = tb + 4 * kq + r;
            const float mean = rowsum16((acc[0][r] + acc[1][r]) + (acc[2][r] + acc[3][r])) * (1.0f / 64.0f);
            float d[4], qq = 0.f;
#pragma unroll
            for (int nt = 0; nt < 4; ++nt) { d[nt] = acc[nt][r] - mean; qq += d[nt] * d[nt]; }
            const float rstd = __builtin_amdgcn_rsqf(rowsum16(qq) * (1.0f / 64.0f) + GN_EPS);
#pragma unroll
            for (int nt = 0; nt < 4; ++nt) { const float o = ((d[nt] * rstd * gng[nt] + gnb[nt]) + rk[r] * vv[nt][r]) * gg[nt][r];
                MIX[(size_t)t * D + 1024 + h * 64 + nt * 16 + n] = (bf16)f2bf(o); }
        }
    }
}
__device__ __forceinline__ void combine_chain(const float* PQ, float* S0, float* Sfin, LAS unsigned char* lds, int tid, int wave, int lane) {
    constexpr int LDA = 66, LDB = 80;
    LAS float* Sl = (LAS float*)lds;
    LAS float* Pl = (LAS float*)(lds + 2 * 64 * LDA * 4);
    const int n = lane & 15, kq = lane >> 4, ib = wave >> 1, n0 = 32 * (wave & 1);
    for (int e = tid; e < 64 * LDA; e += NTHR) Sl[e] = 0.f;
    { const f32x4* Pc = (const f32x4*)PQ;
      for (int e = tid; e < 1024; e += NTHR) *(LAS f32x4*)(Pl + (e & 63) * LDB + (e >> 6) * 4) = Pc[e]; }
    f32x4 qn[2];
#pragma unroll
    for (int t = 0; t < 2; ++t)
#pragma unroll
        for (int r = 0; r < 4; ++r) { const int i = 16 * ib + 4 * kq + r, col = n0 + 16 * t + n; qn[t][r] = PQ[4096 + (size_t)((col >> 2) * 64 + i) * 4 + (col & 3)]; }
    for (int c = 0; c < NC; ++c) {
        f32x4 acc[2] = {qn[0], qn[1]};
        if (c + 1 < NC) { const float* Qn = PQ + (size_t)((c + 1) * 2 + 1) * 4096;
#pragma unroll
            for (int t = 0; t < 2; ++t)
#pragma unroll
                for (int r = 0; r < 4; ++r) { const int i = 16 * ib + 4 * kq + r, col = n0 + 16 * t + n; qn[t][r] = Qn[(size_t)((col >> 2) * 64 + i) * 4 + (col & 3)]; } }
        f32x4 pn0 = (f32x4){0.f, 0.f, 0.f, 0.f}, pn1 = pn0;
        if (c + 1 < NC) { const f32x4* Pn = (const f32x4*)(PQ + (size_t)((c + 1) * 2) * 4096); pn0 = Pn[tid]; pn1 = Pn[tid + 512]; }
        __syncthreads();
        const LAS float* sa = Sl + (c & 1) * 64 * LDA + (16 * ib + n) * LDA + kq;
        const LAS float* pb = Pl + (c & 1) * 64 * LDB + kq * LDB + n0 + n;
#pragma unroll
        for (int ks = 0; ks < 16; ++ks) {
            const float av = sa[4 * ks], b0 = pb[4 * ks * LDB], b1 = pb[4 * ks * LDB + 16];
            acc[0] = __builtin_amdgcn_mfma_f32_16x16x4f32(av, b0, acc[0], 0, 0, 0);
            acc[1] = __builtin_amdgcn_mfma_f32_16x16x4f32(av, b1, acc[1], 0, 0, 0);
        }
        if (c + 1 < NC) {
            LAS float* sn = Sl + ((c + 1) & 1) * 64 * LDA; float* So = S0 + (size_t)(c + 1) * 4096;
#pragma unroll
            for (int t = 0; t < 2; ++t)
#pragma unroll
                for (int r = 0; r < 4; ++r) { const int i = 16 * ib + 4 * kq + r, col = n0 + 16 * t + n;
                    sn[i * LDA + col] = acc[t][r]; So[(size_t)((col >> 2) * 64 + i) * 4 + (col & 3)] = acc[t][r]; }
            LAS float* pnl = Pl + ((c + 1) & 1) * 64 * LDB;
            *(LAS f32x4*)(pnl + (tid & 63) * LDB + (tid >> 6) * 4) = pn0; *(LAS f32x4*)(pnl + (tid & 63) * LDB + ((tid + 512) >> 6) * 4) = pn1;
        } else {
#pragma unroll
            for (int t = 0; t < 2; ++t)
#pragma unroll
                for (int r = 0; r < 4; ++r) Sfin[(16 * ib + 4 * kq + r) * 64 + n0 + 16 * t + n] = acc[t][r];
        }
    }
    __syncthreads();
}

__global__ void __launch_bounds__(NTHR, 2) fwd_mega(Params p) {
    extern __shared__ __attribute__((aligned(16))) unsigned char lds_raw[];
    LAS unsigned char* lds = (LAS unsigned char*)lds_raw;
    const int wave0 = __builtin_amdgcn_readfirstlane((int)threadIdx.x >> 6);
    volatile LAS unsigned* MISC = (volatile LAS unsigned*)(lds + 131072);
    if (threadIdx.x < 16) MISC[threadIdx.x] = 0u;
    __syncthreads();
    const XcdBarrier xbar = xcd_barrier_post((unsigned*)p.ws + 4096, MISC, (int)threadIdx.x);
    cg::this_grid().sync();

#pragma unroll 1
    for (int l = 0; l < DEPTH; ++l) {
        const size_t wsel = (l & 1) ? (WS_W2 - WS_WIN) : 0;
        { PH_BEGIN();
          if (l == 0) convert_weights(kp, 0, (LAS float*)(lds + wave * 16384), gw, ngw, lane);
          float* X = (float*)(ws + WS_X); bf16* XN = (bf16*)(ws + WS_XN);
          if (l == 0) norm_rows(kp->in[0], kp->in[1], kp->in[6], X, XN, nullptr, nullptr, gw, ngw, lane);
          else norm_rows(X, X + (size_t)TP * D, kp->in[6] + l * D, nullptr, XN, nullptr, (const float*)(ws + WS_PART), gw, ngw, lane);
        }
        GSYNC();
        { PH_BEGIN(); pg8::Gemm g{(const bf16*)(ws + WS_XN), (const bf16*)(ws + WS_WIN + wsel), T, NZ, D}; pg8::StaticOrder S; S.init(T, NZ, D, nb, bid); pg8::EpiStoreBf16 E{(bf16*)(ws + WS_Z), NZ};
          pg8::gemm_phase<pg8::EpiStoreBf16, pg8::StaticOrder, true, true>(lds, g, S, E, tid); }
        GSYNC();
        { PH_BEGIN();
          for (int it = bid; it < 1152; it += nb) {
            if (it < 576) prep_item(kp, l, it, lds, tid);
            else if (it < 864) pool_item(kp, l, it - 576, lds, tid);
            else conv_item(kp, l, it - 864, (LAS float*)lds, tid);
          }
        }
        GSYNC();
        { PH_BEGIN();
            const float* SC = (const float*)(ws + WS_SC); float* Y = (float*)(ws + WS_Y); float* PQ = (float*)(ws + WS_PQ); float* GB = (float*)(ws + WS_GB);
            LAS float* wl = (LAS float*)(lds + wave * 12288); LAS float* yb = (LAS float*)(lds + 98304 + wave * 2048);
            for (int task = wave * nb + bid; task < 64 * NC + 256; task += NWAVES * nb) {
                if (task < 64 * NC) {
                    const int ch = task / NC, c = task % NC, s = ch >> 4, h = ch & 15;
                    scan_run<3>(SC, s * 2048 + c * CL, CL, h, wl, yb, lane, nullptr, Y, GB, nullptr, PQ + (size_t)((ch * NC + c) * 2) * 4096);
                } else {
                    const int ch = task - 64 * NC, b = ch >> 4, h = ch & 15;
                    scan_run<1>(SC, TP + b * 64, 64, h, wl, yb, lane, kp->in[5] + (size_t)((l * 16 + b) * NH + h) * 4096, Y, nullptr, kp->out + O_WKV_S + (size_t)((l * 16 + b) * NH + h) * 4096, nullptr);
                }
            }
            if (l + 1 < DEPTH) {
                if (wave >= 5) convert_weights(kp, l + 1, (LAS float*)(lds + 61440 + (wave - 4) * 8448), bid * 3 + (wave - 5), nb * 3, lane, 0, CVT_SPLIT);
                else if (wave == 4) convert_weights(kp, l + 1, (LAS float*)(lds + 61440), bid, nb, lane, CVT_SPLIT);
            }
        }
        GSYNC();
        { PH_BEGIN();
            for (int ch = bid; ch < 64; ch += nb) { const int s = ch >> 4, h = ch & 15;
                combine_chain((const float*)(ws + WS_PQ) + (size_t)ch * NC * 2 * 4096, (float*)(ws + WS_S0) + (size_t)ch * NC * 4096, kp->out + O_WKV_P + (size_t)((l * 4 + s) * NH + h) * 4096, lds, tid, wave, lane); }
        }
        GSYNC();
        { PH_BEGIN();
            const float* S0 = (const float*)(ws + WS_S0);
            constexpr int UPC = CL / 32, NPU = 64 * NC * UPC;
            for (int u = wave * nb + bid; u < NPU + 512; u += NWAVES * nb) {
                if (u < NPU) { const int task = u / UPC, hf = u % UPC, ch = task / NC, c = task % NC, s = ch >> 4, h = ch & 15;
                    ypost_task<2>(kp, l, c == 0 ? nullptr : S0 + (size_t)(ch * NC + c) * 4096, s * 2048 + c * CL + hf * 32, h, lane); }
                else { const int ch = (u - NPU) >> 1, hf = (u - NPU) & 1, b = ch >> 4, h = ch & 15; ypost_task<2>(kp, l, nullptr, TP + b * 64 + hf * 32, h, lane); }
            }
        }
        GSYNC();
        { PH_BEGIN(); pg8::Gemm g{(const bf16*)(ws + WS_MIX), (const bf16*)(ws + WS_WOUT + wsel), T, D, D}; pg8::TailOrder S; S.init(D, D, nb, bid); pg8::EpiResAdd E{(float*)(ws + WS_X), D, (float*)(ws + WS_PART)};
          pg8::gemm_phase<pg8::EpiResAdd, pg8::TailOrder, true, true>(lds, g, S, E, tid); }
        GSYNC();
        { PH_BEGIN(); float* X = (float*)(ws + WS_X); norm_rows(X, X + (size_t)TP * D, kp->in[26] + l * D, nullptr, (bf16*)(ws + WS_XN), nullptr, (const float*)(ws + WS_PART), gw, ngw, lane); }
        GSYNC();
        { PH_BEGIN(); pg8::Gemm g{(const bf16*)(ws + WS_XN), (const bf16*)(ws + WS_WGU + wsel), T, NGU, D}; pg8::StaticOrder S; S.init(T, NGU, D, nb, bid); pg8::EpiSwiGLU E{(bf16*)(ws + WS_ACT), FF};
          pg8::gemm_phase<pg8::EpiSwiGLU, pg8::StaticOrder, true, true>(lds, g, S, E, tid); }
        GSYNC();
        { PH_BEGIN(); pg8::Gemm g{(const bf16*)(ws + WS_ACT), (const bf16*)(ws + WS_WDN + wsel), T, D, FF}; pg8::TailOrder S; S.init(D, FF, nb, bid); pg8::EpiResAdd E{(float*)(ws + WS_X), D, (float*)(ws + WS_PART)};
          pg8::gemm_phase<pg8::EpiResAdd, pg8::TailOrder, true, true>(lds, g, S, E, tid); }
        GSYNC();
    }
    { PH_BEGIN(); float* X = (float*)(ws + WS_X); norm_rows(X, X + (size_t)TP * D, kp->in[30], nullptr, nullptr, kp->out + O_Y, (const float*)(ws + WS_PART), gw, ngw, lane); }
}

extern "C" void kernel_launch(void* const* d_in, const int* in_sizes, int n_in, void* d_out, int out_size, void* d_ws, size_t ws_size, hipStream_t stream) {
    static int grid = 0;
    if (grid == 0) {
        if (n_in != 31 || (size_t)out_size != O_END || ws_size < WS_END) { fprintf(stderr, "kernel_launch: unexpected shapes: n_in %d out %d ws %zu (need %zu)\n", n_in, out_size, ws_size, (size_t)WS_END); grid = -1; return; }
        int dev = 0, cus = 0, per_cu = 0;
        hipGetDevice(&dev);
        hipDeviceGetAttribute(&cus, hipDeviceAttributeMultiprocessorCount, dev);
        if (hipFuncSetAttribute((const void*)fwd_mega, hipFuncAttributeMaxDynamicSharedMemorySize, LDS_BYTES) != hipSuccess) { fprintf(stderr, "kernel_launch: hipFuncSetAttribute failed\n"); grid = -1; return; }
        hipOccupancyMaxActiveBlocksPerMultiprocessor(&per_cu, (const void*)fwd_mega, NTHR, LDS_BYTES);
        (void)hipGetLastError();
        if (per_cu < 1) { fprintf(stderr, "kernel_launch: occupancy query says %d blocks per CU\n", per_cu); per_cu = 1; }
        grid = cus * 1;
    }
    if (grid < 0) return;
    Params p{};
    for (int i = 0; i < 31; ++i) p.in[i] = (const float*)d_in[i];
    p.out = (float*)d_out; p.ws = (unsigned char*)d_ws;
    if (hipMemsetAsync(d_ws, 0, 65536, stream) != hipSuccess) { fprintf(stderr, "kernel_launch: memset failed\n"); return; }
    void* args[] = {&p};
    hipError_t e = hipLaunchCooperativeKernel((const void*)fwd_mega, dim3(grid), dim3(NTHR), args, LDS_BYTES, stream);
    if (e != hipSuccess) fprintf(stderr, "cooperative launch failed: %s (grid %d)\n", hipGetErrorString(e), grid);
}
```

```cpp
#include <hip/hip_runtime.h>
#include <hip/hip_cooperative_groups.h>
#include <cstdio>
#include <cstdint>
namespace cg = cooperative_groups;

namespace pg8 {
#define PG8_LAS __attribute__((address_space(3)))
typedef unsigned short bf16_t;
typedef short bf16x8 __attribute__((ext_vector_type(8)));
typedef float f32x4 __attribute__((ext_vector_type(4)));
typedef unsigned u32x4 __attribute__((ext_vector_type(4)));
constexpr int BM = 256, BK = 64, HALF = 128, HTB = HALF * BK * 2  , STAGE_BYTES = 8 * HTB, NXCD = 8, WGM = 8;

__host__ __device__ __forceinline__ int lds_byte(int r, int c) { const int st = (r >> 4) * 2 + (c >> 5), rr = r & 15, cc = c & 31, ob = rr * 64 + cc * 2; return st * 1024 + (ob ^ (((ob >> 9) & 1) << 5)); }
__host__ __device__ __forceinline__ void stage_rc(int b, int& R, int& C) { const int st = b / 1024, sb = b % 1024, swz = sb ^ (((sb >> 9) & 1) << 5); R = (st >> 1) * 16 + swz / 64; C = (st & 1) * 32 + (swz % 64) / 2; }
__host__ __device__ __forceinline__ int perm32(int rho) { const int n = rho >> 4, i = rho & 15; return 8 * (i >> 2) + 4 * n + (i & 3); }

struct Unit { int pm, pn, k0, nt, part; };
struct Gemm { const bf16_t* A; const bf16_t* Bt; int M, N, K; };

struct StaticOrder {
    int nM, nN, nwg, G, c, ntfull;
    __host__ __device__ void init(int M, int N, int K, int G_, int c_) { nM = M / BM; nN = N / BM; nwg = nM * nN; G = G_; c = c_; ntfull = K / BK; }
    __host__ __device__ __forceinline__ bool next(int i, Unit& u) const {
        const long L = (long)i * G + c; if (L >= nwg) return false;
        int wgid = (int)L; { const int q = nwg / NXCD, r = nwg % NXCD, xcd = wgid % NXCD, off = wgid / NXCD; wgid = (xcd < r ? xcd * (q + 1) : r * (q + 1) + (xcd - r) * q) + off; }
        const int nig = WGM * nN, gid = wgid / nig, fm = gid * WGM, gsz = (nM - fm) < WGM ? (nM - fm) : WGM;
        u.pm = fm + ((wgid % nig) % gsz); u.pn = (wgid % nig) / gsz; u.k0 = 0; u.nt = ntfull; u.part = -1; return true;
    }
    __device__ __forceinline__ void a_ready(const Unit&) const {}
    __device__ __forceinline__ void done(const Unit&) const {}
};


struct TailOrder {
    int nN, G, c, ntfull, skip;
    __host__ __device__ void init(int N, int K, int G_, int c_, int skip_ = 0) { nN = N / BM; G = G_; c = c_; ntfull = K / BK; skip = skip_; }
    __host__ __device__ __forceinline__ bool next(int i, Unit& u) const {
        const int nfull = 32 * nN, L = i * G + c + skip * nfull;
        if (L >= nfull + 4 * nN * 8) return false;
        const bool full = L < nfull;
        int wgid = full ? L : 0; { const int q = nfull / NXCD, r = nfull % NXCD, xcd = wgid % NXCD, off = wgid / NXCD; wgid = (xcd < r ? xcd * (q + 1) : r * (q + 1) + (xcd - r) * q) + off; }
        const int nig = WGM * nN, gid = wgid / nig, fm = gid * WGM;
        const int fpm = fm + ((wgid % nig) % WGM), fpn = (wgid % nig) / WGM;
        const int ut = full ? 0 : L - nfull, tile = ut >> 3, ks = ut & 7, base = (ntfull / 8) & ~1, extra = (ntfull - 8 * base) / 2;
        const int tpm = 32 + tile / nN, tpn = tile % nN, tnt = base + (ks < extra ? 2 : 0), tk0 = ks * base + 2 * (ks < extra ? ks : extra);
        Unit r_; r_.pm = full ? fpm : tpm; r_.pn = full ? fpn : tpn; r_.k0 = full ? 0 : tk0; r_.nt = full ? ntfull : tnt; r_.part = full ? -1 : ks;
        u = r_; return true;
    }
    __device__ __forceinline__ void a_ready(const Unit&) const {}
    __device__ __forceinline__ void done(const Unit&) const {}
};

__device__ __forceinline__ unsigned cvt_pk_bf16(float lo, float hi) { unsigned r; asm volatile("v_cvt_pk_bf16_f32 %0, %1, %2" : "=v"(r) : "v"(lo), "v"(hi)); return r; }

struct EpiStoreBf16 {
    static constexpr bool PERM = true, AFTER_DRAIN = false;
    bf16_t* O; int ldc;
    __device__ __forceinline__ void operator()(const f32x4 (&acc)[2][2][4][2], const Unit& u, int wr, int wc, int fr, int fq) const {
        const int row0 = u.pm * BM + wr * 64 + fr, col0 = u.pn * BM + wc * 32 + 8 * fq;
#pragma unroll
        for (int ai = 0; ai < 2; ++ai)
#pragma unroll
            for (int m = 0; m < 4; ++m) { bf16_t* rowp = O + (size_t)(row0 + ai * HALF + m * 16) * ldc + col0;
#pragma unroll
                for (int bj = 0; bj < 2; ++bj) { const f32x4 v0 = acc[ai][bj][m][0], v1 = acc[ai][bj][m][1];
                    u32x4 w; w.x = cvt_pk_bf16(v0[0], v0[1]); w.y = cvt_pk_bf16(v0[2], v0[3]); w.z = cvt_pk_bf16(v1[0], v1[1]); w.w = cvt_pk_bf16(v1[2], v1[3]);
                    *(u32x4*)(rowp + bj * HALF) = w; } }
    }
};
struct EpiResAdd {
    static constexpr bool PERM = true, AFTER_DRAIN = false;
    float* O; int ldc; float* P;
    __device__ __forceinline__ void operator()(const f32x4 (&acc)[2][2][4][2], const Unit& u, int wr, int wc, int fr, int fq) const {
        const int row0 = u.pm * BM + wr * 64 + fr, col0 = u.pn * BM + wc * 32 + 8 * fq;
        if (u.part < 0) {
#pragma unroll
            for (int ai = 0; ai < 2; ++ai)
#pragma unroll
                for (int m = 0; m < 4; ++m) { float* rowp = O + (size_t)(row0 + ai * HALF + m * 16) * ldc + col0;
#pragma unroll
                    for (int bj = 0; bj < 2; ++bj) {
                        f32x4 a = *(const f32x4*)(rowp + bj * HALF), b = *(const f32x4*)(rowp + bj * HALF + 4);
                        *(f32x4*)(rowp + bj * HALF) = a + acc[ai][bj][m][0]; *(f32x4*)(rowp + bj * HALF + 4) = b + acc[ai][bj][m][1]; } }
        } else {
            float* base = P + (size_t)u.part * 1024 * ldc;
#pragma unroll
            for (int ai = 0; ai < 2; ++ai)
#pragma unroll
                for (int m = 0; m < 4; ++m) { float* rowp = base + (size_t)(row0 - 8192 + ai * HALF + m * 16) * ldc + col0;
#pragma unroll
                    for (int bj = 0; bj < 2; ++bj) { *(f32x4*)(rowp + bj * HALF) = acc[ai][bj][m][0]; *(f32x4*)(rowp + bj * HALF + 4) = acc[ai][bj][m][1]; } }
        }
    }
};
struct EpiSwiGLU {
    static constexpr bool PERM = true, AFTER_DRAIN = false;
    bf16_t* O; int ldc;
    __device__ __forceinline__ void operator()(const f32x4 (&acc)[2][2][4][2], const Unit& u, int wr, int wc, int fr, int fq) const {
        const int row0 = u.pm * BM + wr * 64 + fr, col0 = u.pn * HALF + wc * 32 + 8 * fq;
#pragma unroll
        for (int ai = 0; ai < 2; ++ai)
#pragma unroll
            for (int m = 0; m < 4; ++m) { bf16_t* rowp = O + (size_t)(row0 + ai * HALF + m * 16) * ldc + col0;
                float o[8];
#pragma unroll
                for (int n = 0; n < 2; ++n)
#pragma unroll
                    for (int j = 0; j < 4; ++j) { const float g = acc[ai][0][m][n][j], up = acc[ai][1][m][n][j]; o[n * 4 + j] = g * up * __builtin_amdgcn_rcpf(1.0f + __expf(-g)); }
                u32x4 w; w.x = cvt_pk_bf16(o[0], o[1]); w.y = cvt_pk_bf16(o[2], o[3]); w.z = cvt_pk_bf16(o[4], o[5]); w.w = cvt_pk_bf16(o[6], o[7]);
                *(u32x4*)rowp = w; }
    }
};

template <class Epi, class Sched, bool ALIGN_EPI = false, bool SP2 = false>
__device__ __forceinline__ void gemm_phase(PG8_LAS unsigned char* lds, const Gemm g, const Sched& S, const Epi& E, const int tid) {
    const int wid = __builtin_amdgcn_readfirstlane(tid >> 6), lane = tid & 63, wr = wid >> 2, wc = wid & 3, fr = lane & 15, fq = lane >> 4;
    const int K = g.K;
    unsigned voffA[2], voffB[2];
#pragma unroll
    for (int i = 0; i < 2; ++i) { int R, C; stage_rc(tid * 16 + i * 8192, R, C); const int Rb = Epi::PERM ? ((R & ~31) + perm32(R & 31)) : R;
        voffA[i] = (unsigned)(R * K + C) * 2u; voffB[i] = (unsigned)(Rb * K + C) * 2u; }
    const size_t kstep = (size_t)(BK * 2);
    const size_t hstep = (size_t)HALF * K * 2;
    const size_t tstep = 2 * hstep;
    const unsigned ldsw = (unsigned)wid * 1024u;
    const int aoff = lds_byte(wr * 64 + fr, fq * 8), boff = lds_byte(wc * 32 + fr, fq * 8);
#define PG8_SA(b, h) (((b) * 2 + (h)) * HTB)
#define PG8_SB(b, h) ((4 + (b) * 2 + (h)) * HTB)
#define PG8_STAGE(bufoff, gbase, voff) do { _Pragma("unroll") for (int _i = 0; _i < 2; ++_i) \
        __builtin_amdgcn_global_load_lds((const unsigned*)((const char*)(gbase) + (voff)[_i]), (PG8_LAS unsigned*)(lds + (bufoff) + ldsw + _i * 8192), 16, 0, 0); } while (0)
#define PG8_LDA(dst, b, h) do { _Pragma("unroll") for (int m = 0; m < 4; ++m) _Pragma("unroll") for (int k = 0; k < 2; ++k) dst[m][k] = *(const PG8_LAS bf16x8*)(lds + PG8_SA(b, h) + aoff + m * 2048 + k * 1024); } while (0)
#define PG8_LDB(dst, b, h) do { _Pragma("unroll") for (int n = 0; n < 2; ++n) _Pragma("unroll") for (int k = 0; k < 2; ++k) dst[n][k] = *(const PG8_LAS bf16x8*)(lds + PG8_SB(b, h) + boff + n * 2048 + k * 1024); } while (0)
#define PG8_MMA(ai, bj, At, Bt) do { __builtin_amdgcn_s_setprio(1); _Pragma("unroll") for (int m = 0; m < 4; ++m) _Pragma("unroll") for (int n = 0; n < 2; ++n) _Pragma("unroll") for (int k = 0; k < 2; ++k) \
        acc[ai][bj][m][n] = __builtin_amdgcn_mfma_f32_16x16x32_bf16(Bt[n][k], At[m][k], acc[ai][bj][m][n], 0, 0, 0); __builtin_amdgcn_s_setprio(0); } while (0)
#define PG8_WAIT_V(n) asm volatile("s_waitcnt vmcnt(" #n ")" ::: "memory")
#define PG8_WAIT_L(n) asm volatile("s_waitcnt lgkmcnt(" #n ")" ::: "memory")
#define PG8_BAR __builtin_amdgcn_s_barrier()
#define PG8_SCHED __builtin_amdgcn_sched_barrier(0)
    Unit cur, nxt; int ui = 0;
    if (!S.next(0, cur)) return;
    f32x4 acc[2][2][4][2];
#pragma unroll
    for (int a = 0; a < 2; ++a)
#pragma unroll
        for (int b = 0; b < 2; ++b)
#pragma unroll
            for (int m = 0; m < 4; ++m)
#pragma unroll
                for (int n = 0; n < 2; ++n) acc[a][b][m][n] = (f32x4){0.f, 0.f, 0.f, 0.f};
    bf16x8 At[4][2], B0[2][2], B1[2][2];
    const char* cA = (const char*)g.A + (size_t)cur.pm * tstep + (size_t)cur.k0 * kstep; const char* cB = (const char*)g.Bt + (size_t)cur.pn * tstep + (size_t)cur.k0 * kstep;
    S.a_ready(cur);
    if constexpr (SP2) {
        PG8_STAGE(PG8_SB(0, 0), cB, voffB); PG8_STAGE(PG8_SB(0, 1), cB + hstep, voffB); PG8_STAGE(PG8_SA(0, 0), cA, voffA); PG8_STAGE(PG8_SA(0, 1), cA + hstep, voffA);
        if (wr == 1) PG8_BAR;
        PG8_WAIT_V(2); PG8_BAR;
        PG8_STAGE(PG8_SB(1, 0), cB + kstep, voffB); PG8_STAGE(PG8_SA(1, 0), cA + kstep, voffA); PG8_STAGE(PG8_SB(1, 1), cB + hstep + kstep, voffB);
        PG8_WAIT_V(6); PG8_BAR;
    } else {
        PG8_STAGE(PG8_SB(0, 0), cB, voffB); PG8_STAGE(PG8_SA(0, 0), cA, voffA); PG8_STAGE(PG8_SB(0, 1), cB + hstep, voffB); PG8_STAGE(PG8_SA(0, 1), cA + hstep, voffA);
        if (wr == 1) PG8_BAR;
        PG8_WAIT_V(4); PG8_BAR;
        PG8_STAGE(PG8_SB(1, 0), cB + kstep, voffB); PG8_STAGE(PG8_SA(1, 0), cA + kstep, voffA); PG8_STAGE(PG8_SB(1, 1), cB + hstep + kstep, voffB);
        PG8_WAIT_V(6); PG8_BAR;
    }
    for (;;) {
        const bool has_next = S.next(ui + 1, nxt);
        const char* nA = has_next ? (const char*)g.A + (size_t)nxt.pm * tstep + (size_t)nxt.k0 * kstep : cA; const char* nB = has_next ? (const char*)g.Bt + (size_t)nxt.pn * tstep + (size_t)nxt.k0 * kstep : cB;
        const int nt = cur.nt;
        for (int t = 0; t < nt; t += 2) {
            const bool last = (t == nt - 2);
            const char* a1 = cA + (size_t)(t + 1) * kstep;
            const char* a2 = last ? nA : cA + (size_t)(t + 2) * kstep; const char* b2 = last ? nB : cB + (size_t)(t + 2) * kstep;
            const char* a3 = a2 + kstep; const char* b3 = b2 + kstep;
            if (last && has_next) S.a_ready(nxt);
            if constexpr (SP2) {
            PG8_LDB(B0, 0, 0); PG8_LDB(B1, 0, 1); PG8_SCHED; PG8_LDA(At, 0, 0); PG8_STAGE(PG8_SA(1, 1), a1 + hstep, voffA);
            PG8_WAIT_V(8); PG8_WAIT_L(0); PG8_BAR; PG8_MMA(0, 0, At, B0); PG8_MMA(0, 1, At, B1); PG8_BAR; PG8_SCHED;
            PG8_LDA(At, 0, 1); PG8_STAGE(PG8_SB(0, 0), b2, voffB); PG8_STAGE(PG8_SB(0, 1), b2 + hstep, voffB); PG8_STAGE(PG8_SA(0, 0), a2, voffA);
            PG8_WAIT_V(8); PG8_WAIT_L(0); PG8_BAR; PG8_MMA(1, 0, At, B0); PG8_MMA(1, 1, At, B1); PG8_BAR; PG8_SCHED;
            PG8_LDB(B0, 1, 0); PG8_LDB(B1, 1, 1); PG8_SCHED; PG8_LDA(At, 1, 0); PG8_STAGE(PG8_SA(0, 1), a2 + hstep, voffA);
            PG8_WAIT_V(8); PG8_WAIT_L(0); PG8_BAR; PG8_MMA(0, 0, At, B0); PG8_MMA(0, 1, At, B1); PG8_BAR; PG8_SCHED;
            PG8_LDA(At, 1, 1); PG8_STAGE(PG8_SB(1, 0), b3, voffB); PG8_STAGE(PG8_SB(1, 1), b3 + hstep, voffB); PG8_STAGE(PG8_SA(1, 0), a3, voffA);
            PG8_WAIT_V(8); PG8_WAIT_L(0); PG8_BAR; PG8_MMA(1, 0, At, B0); PG8_MMA(1, 1, At, B1); PG8_BAR; PG8_SCHED;
            } else {
            PG8_LDB(B0, 0, 0); PG8_SCHED; PG8_LDA(At, 0, 0); PG8_STAGE(PG8_SA(1, 1), a1 + hstep, voffA);
            PG8_WAIT_L(8); PG8_BAR; PG8_WAIT_L(0); PG8_MMA(0, 0, At, B0); PG8_BAR; PG8_SCHED;
            PG8_LDB(B1, 0, 1); PG8_STAGE(PG8_SB(0, 0), b2, voffB);
            PG8_BAR; PG8_WAIT_L(0); PG8_MMA(0, 1, At, B1); PG8_BAR;
            PG8_LDA(At, 0, 1); PG8_STAGE(PG8_SA(0, 0), a2, voffA);
            PG8_BAR; PG8_WAIT_L(0); PG8_MMA(1, 0, At, B0); PG8_BAR; PG8_SCHED;
            PG8_STAGE(PG8_SB(0, 1), b2 + hstep, voffB);
            PG8_WAIT_V(6); PG8_BAR; PG8_MMA(1, 1, At, B1); PG8_BAR;
            PG8_LDB(B0, 1, 0); PG8_SCHED; PG8_LDA(At, 1, 0); PG8_STAGE(PG8_SA(0, 1), a2 + hstep, voffA);
            PG8_WAIT_L(8); PG8_BAR; PG8_WAIT_L(0); PG8_MMA(0, 0, At, B0); PG8_BAR; PG8_SCHED;
            PG8_LDB(B1, 1, 1); PG8_STAGE(PG8_SB(1, 0), b3, voffB);
            PG8_BAR; PG8_WAIT_L(0); PG8_MMA(0, 1, At, B1); PG8_BAR;
            PG8_LDA(At, 1, 1); PG8_STAGE(PG8_SA(1, 0), a3, voffA);
            PG8_BAR; PG8_WAIT_L(0); PG8_MMA(1, 0, At, B0); PG8_BAR; PG8_SCHED;
            PG8_STAGE(PG8_SB(1, 1), b3 + hstep, voffB);
            PG8_WAIT_V(6); PG8_BAR; PG8_MMA(1, 1, At, B1); PG8_BAR;
            }
        }
        if constexpr (ALIGN_EPI) { if (wr == 0) PG8_BAR; }
        if constexpr (!Epi::AFTER_DRAIN) { E(acc, cur, wr, wc, fr, fq); S.done(cur); }
        if (!has_next) break;
#pragma unroll
        for (int a = 0; a < 2; ++a)
#pragma unroll
            for (int b = 0; b < 2; ++b)
#pragma unroll
                for (int m = 0; m < 4; ++m)
#pragma unroll
                    for (int n = 0; n < 2; ++n) acc[a][b][m][n] = (f32x4){0.f, 0.f, 0.f, 0.f};
        cur = nxt; cA = nA; cB = nB; ++ui;
        if constexpr (ALIGN_EPI) { if (wr == 1) PG8_BAR; }
    }
    PG8_WAIT_V(0);
    if constexpr (!ALIGN_EPI) { if (wr == 0) PG8_BAR; }
    PG8_BAR;
    if constexpr (Epi::AFTER_DRAIN) { E.fused(acc, cur, wr, wc, fr, fq, lds, wid, lane); S.done(cur); }
#undef PG8_SA
#undef PG8_SB
#undef PG8_STAGE
#undef PG8_LDA
#undef PG8_LDB
#undef PG8_MMA
#undef PG8_WAIT_V
#undef PG8_WAIT_L
#undef PG8_BAR
#undef PG8_SCHED
}
}

#define LAS __attribute__((address_space(3)))
typedef unsigned short bf16;
typedef float f32x4 __attribute__((ext_vector_type(4)));
typedef float f32x2 __attribute__((ext_vector_type(2)));
typedef unsigned u32x4 __attribute__((ext_vector_type(4)));
typedef unsigned u32x2 __attribute__((ext_vector_type(2)));
typedef short bfx8 __attribute__((ext_vector_type(8)));
#define XB_TMO      128
#define XB_XCNT(j)  (256  + 64 * (j))
#define XB_XSUB(j)  (1280 + 64 * (j))
#define XB_XGEN(j)  (2304 + 64 * (j))
#define XB_TOP      3328
#define XB_TOPGEN   3392
#define XCD_BAR_WORDS 3456
#define XB_SPIN_CAP (1u << 18)

__device__ __forceinline__ unsigned xb_ld(unsigned* p)              { return __hip_atomic_load(p, __ATOMIC_RELAXED, __HIP_MEMORY_SCOPE_AGENT); }
__device__ __forceinline__ unsigned xb_add(unsigned* p, unsigned v) { return __hip_atomic_fetch_add(p, v, __ATOMIC_RELAXED, __HIP_MEMORY_SCOPE_AGENT); }
__device__ __forceinline__ unsigned xb_xcc_id() { return (unsigned)__builtin_amdgcn_s_getreg((3 << 11) | 20) & 0xFu; }
#define XB_SPIN(cond, bar) do { unsigned _sp = 0; while (cond) { __builtin_amdgcn_s_sleep(1); \
    if ((++_sp & 255u) == 0u) { if (xb_ld(&(bar)[XB_TMO])) break; if (_sp > XB_SPIN_CAP) { atomicAdd(&(bar)[XB_TMO], 1u); break; } } } } while (0)

struct XcdBarrier {
    unsigned* bar; unsigned x;
    volatile LAS unsigned* st;
};

__device__ __forceinline__ XcdBarrier xcd_barrier_post(unsigned* bar, volatile LAS unsigned* st, int tid) {
    XcdBarrier b; b.bar = bar; b.x = xb_xcc_id(); b.st = st;
    if (tid == 0) (void)xb_add(&bar[XB_XCNT(b.x)], 1u);
    return b;
}
__device__ __forceinline__ void xcd_barrier_complete(unsigned* bar, unsigned x, unsigned& nloc, unsigned& nx) {
    const unsigned G = gridDim.x * gridDim.y * gridDim.z;
    unsigned sum, cnt, mine, sp = 0u;
    for (;;) {
        sum = 0u; cnt = 0u; mine = 0u;
#pragma unroll
        for (unsigned j = 0; j < 16; ++j) { const unsigned c = xb_ld(&bar[XB_XCNT(j)]); sum += c; cnt += (c > 0u) ? 1u : 0u; mine = (j == x) ? c : mine; }
        if (sum == G) break;
        __builtin_amdgcn_s_sleep(1);
        if ((++sp & 255u) == 0u) { if (xb_ld(&bar[XB_TMO])) break; if (sp > XB_SPIN_CAP) { atomicAdd(&bar[XB_TMO], 1u); break; } }
    }
    nloc = mine > 0u ? mine : 1u; nx = cnt > 0u ? cnt : 1u;
}

__device__ __forceinline__ void xcd_barrier(const XcdBarrier& b, int tid) {
    asm volatile("s_waitcnt vmcnt(0)" ::: "memory");
    __syncthreads();
    if (tid == 0) {
        unsigned* bar = b.bar;
        __builtin_amdgcn_s_waitcnt(0);
        unsigned nloc = b.st[0], nx = b.st[1];
        if (nloc == 0u) { xcd_barrier_complete(bar, b.x, nloc, nx); b.st[0] = nloc; b.st[1] = nx; }
        const unsigned old = xb_add(&bar[XB_XSUB(b.x)], 1u);
        const unsigned gen = old / nloc;
        if (old + 1u == (gen + 1u) * nloc) {
            __builtin_amdgcn_fence(__ATOMIC_RELEASE, "agent");
            asm volatile("s_waitcnt vmcnt(0)" ::: "memory");
            const unsigned og = xb_add(&bar[XB_TOP], 1u);
            const unsigned tg = og / nx;
            if (og + 1u == (tg + 1u) * nx) xb_add(&bar[XB_TOPGEN], 1u);
            else XB_SPIN(xb_ld(&bar[XB_TOPGEN]) == tg, bar);
            __builtin_amdgcn_fence(__ATOMIC_ACQUIRE, "agent");
            xb_add(&bar[XB_XGEN(b.x)], 1u);
            asm volatile("s_waitcnt vmcnt(0)" ::: "memory");
        } else {
            XB_SPIN(xb_ld(&bar[XB_XGEN(b.x)]) == gen, bar);
            __builtin_amdgcn_fence(__ATOMIC_ACQUIRE, "agent");
            asm volatile("s_waitcnt vmcnt(0)" ::: "memory");
        }
    }
    __syncthreads();
}

constexpr int NWAVES = 8, NTHR = 512;
constexpr int TP = 8192, TS = 1024, T = 9216, D = 2048, NIN = 4800, NZ = 4864, FF = 5632, NGU = 11264;
constexpr int NH = 16, HS = 64, RD = 1024, RP = 3264, DEPTH = 4;
constexpr int ZQ = 1536;
constexpr float RMS_EPS = 1e-6f, LN_EPS = 1e-5f, GN_EPS = 64e-5f;
constexpr int SCR = 384;
constexpr size_t O_Y = 0;
constexpr size_t O_CONV_P = (size_t)T * D;
constexpr size_t O_POOL_P = O_CONV_P + (size_t)DEPTH * 4 * 30 * 512;
constexpr size_t O_SHIFT_P = O_POOL_P + (size_t)DEPTH * 4 * 15 * 512;
constexpr size_t O_WKV_P = O_SHIFT_P + (size_t)DEPTH * 4 * RP;
constexpr size_t O_CONV_S = O_WKV_P + (size_t)DEPTH * 4 * NH * 4096;
constexpr size_t O_POOL_S = O_CONV_S + (size_t)DEPTH * 16 * 30 * 512;
constexpr size_t O_SHIFT_S = O_POOL_S + (size_t)DEPTH * 16 * 15 * 512;
constexpr size_t O_WKV_S = O_SHIFT_S + (size_t)DEPTH * 16 * RP;
constexpr size_t O_END = O_WKV_S + (size_t)DEPTH * 16 * NH * 4096;
constexpr size_t WS_POOLW = 131072;
constexpr size_t WS_UPS = 262144;
constexpr size_t WS_WIN = 1u << 20;
constexpr size_t WS_WOUT = WS_WIN + (size_t)NZ * D * 2;
constexpr size_t WS_WGU = WS_WOUT + (size_t)D * D * 2;
constexpr size_t WS_WDN = WS_WGU + (size_t)NGU * D * 2;
constexpr size_t WS_X = WS_WDN + (size_t)D * FF * 2;
constexpr size_t WS_XN = WS_X + (size_t)T * D * 4;
constexpr size_t WS_MIX = WS_XN + (size_t)T * D * 2;
constexpr size_t WS_Z = WS_MIX + (size_t)T * D * 2;
constexpr size_t WS_ACT = WS_Z;
constexpr size_t WS_SC = WS_Z + (size_t)T * NZ * 2;
constexpr size_t WS_PART = WS_SC + (32u << 20);
constexpr size_t WS_Y = WS_SC + (size_t)T * NH * SCR * 4;
constexpr size_t WS_G = WS_Y + (size_t)T * RD * 4;
constexpr size_t WS_RK = WS_G + (size_t)T * RD * 4;
constexpr int NC = 16, CL = 128;
constexpr size_t WS_PQ = WS_RK + (size_t)T * NH * 4;
constexpr size_t WS_S0 = WS_PQ + (size_t)64 * NC * 2 * 4096 * 4;
constexpr size_t WS_GB = WS_S0 + (size_t)64 * NC * 4096 * 4;
constexpr size_t WS_W2 = WS_GB + (size_t)TP * RD * 4;
constexpr size_t WSET = WS_X - WS_WIN;
constexpr size_t WS_END = WS_W2 + WSET;
static_assert(WS_ACT + (size_t)T * FF * 2 <= WS_PART && WS_PART + (size_t)8 * 1024 * D * 4 <= WS_Y, "act / partial overlays");
constexpr int LDS_BYTES = 147456;
constexpr int CVT_SPLIT = 20500;

#define GSYNC() do { int w_ = wave0; asm volatile("" : "+s"(w_)); xcd_barrier(xbar, w_ * 64 + (int)__builtin_amdgcn_mbcnt_hi(~0u, __builtin_amdgcn_mbcnt_lo(~0u, (unsigned)launder_v(0)))); } while (0)
__host__ __device__ __forceinline__ size_t sc_off(int t, int h) { return ((size_t)(((t >> 2) * NH + h) * 4 + (t & 3))) * SCR; }
struct Params { const float* in[31]; float* out; unsigned char* ws; };
typedef const __attribute__((address_space(4))) Params* KP;
__device__ __forceinline__ KP kargs() { KP k = (KP)__builtin_amdgcn_kernarg_segment_ptr(); asm volatile("" : "+s"(k)); return k; }
__device__ __forceinline__ int launder_v(int v) { asm volatile("" : "+v"(v)); return v; }
#define PH_BEGIN() KP kp = kargs(); int wave_ = wave0; asm volatile("" : "+s"(wave_)); const int wave = wave_; const int lane = (int)__builtin_amdgcn_mbcnt_hi(~0u, __builtin_amdgcn_mbcnt_lo(~0u, (unsigned)launder_v(0))); const int tid = wave * 64 + lane; \
    const int nb = gridDim.x, bid = blockIdx.x, gw = bid * NWAVES + wave, ngw = nb * NWAVES; unsigned char* const ws = kp->ws; (void)lane; (void)wave; (void)gw; (void)ngw; (void)ws; (void)nb; (void)bid

template <int M> __device__ __forceinline__ float swz_xor(float v) { return __builtin_bit_cast(float, __builtin_amdgcn_ds_swizzle(__builtin_bit_cast(int, v), 0x1f | (M << 10))); }
__device__ __forceinline__ float rowsum16(float v) { v += swz_xor<1>(v); v += swz_xor<2>(v); v += swz_xor<4>(v); v += swz_xor<8>(v); return v; }
__device__ __forceinline__ float wave_sum(float v) {
    v = rowsum16(v); v += swz_xor<16>(v);
    const int ln = (int)__builtin_amdgcn_mbcnt_hi(~0u, __builtin_amdgcn_mbcnt_lo(~0u, (unsigned)launder_v(0)));
    v += __builtin_bit_cast(float, __builtin_amdgcn_ds_bpermute((ln ^ 32) << 2, __builtin_bit_cast(int, v)));
    return v;
}
__device__ __forceinline__ unsigned f2bf(float f) { unsigned u = __builtin_bit_cast(unsigned, f); return (u + 0x7fffu + ((u >> 16) & 1u)) >> 16; }
__device__ __forceinline__ unsigned pk2(float lo, float hi) { return f2bf(lo) | (f2bf(hi) << 16); }
__device__ __forceinline__ float bf2f(bf16 v) { return __builtin_bit_cast(float, (unsigned)v << 16); }
__device__ __forceinline__ float sigm(float x) { return __builtin_amdgcn_rcpf(1.0f + __expf(-x)); }

__device__ __forceinline__ void transpose_item(const float* W, int K, int N, bf16* WT, int mode, LAS float* scr, int item, int lane) {
    const int nblk = N / 32, kb = item / nblk, nb = item % nblk, k0 = 64 * kb, n0 = 32 * nb;
    const int drow0 = (mode == 0) ? n0 : ((n0 >> 7) * 256 + (n0 & 127) + (mode == 2 ? 128 : 0));
    float wv[32];
#pragma unroll
    for (int i = 0; i < 32; ++i) { const int kk = 2 * i + (lane >> 5); wv[i] = __builtin_nontemporal_load(W + (size_t)(k0 + kk) * N + n0 + (lane & 31)); }
#pragma unroll
    for (int i = 0; i < 32; ++i) { const int kk = 2 * i + (lane >> 5); scr[kk * 33 + (lane & 31)] = wv[i]; }
    asm volatile("s_waitcnt lgkmcnt(0)" ::: "memory");
    const int c = lane & 7;
#pragma unroll
    for (int j = 0; j < 4; ++j) { const int n = (lane >> 3) + 8 * j; const LAS float* s = scr + (8 * c) * 33 + n;
        u32x4 o; o.x = pk2(s[0 * 33], s[1 * 33]); o.y = pk2(s[2 * 33], s[3 * 33]); o.z = pk2(s[4 * 33], s[5 * 33]); o.w = pk2(s[6 * 33], s[7 * 33]);
        __builtin_nontemporal_store(o, (u32x4*)(WT + (size_t)(drow0 + n) * K + k0 + 8 * c)); }
    asm volatile("s_waitcnt lgkmcnt(0)" ::: "memory");
}
__device__ __forceinline__ void convert_weights(KP kp, int l, LAS float* scr, int gw, int ngw, int lane, int item_lo = 0, int item_hi = 1 << 30) {
    unsigned char* ws = kp->ws;
    unsigned char* wsw = kp->ws + ((l & 1) ? (WS_W2 - WS_WIN) : 0);
    bf16* WIN = (bf16*)(wsw + WS_WIN); bf16* WOUT = (bf16*)(wsw + WS_WOUT); bf16* WGU = (bf16*)(wsw + WS_WGU); bf16* WDN = (bf16*)(wsw + WS_WDN);
    constexpr int I_IN = (D / 64) * (NIN / 32), I_OUT = (D / 64) * (D / 32), I_G = (D / 64) * (FF / 32), I_D = (FF / 64) * (D / 32);
    constexpr int I_P = 4 * 8, I_U = 3 * 32;
    constexpr int NITEMS = I_IN + I_OUT + 2 * I_G + I_D + I_P + I_U;
    const int it_end = item_hi < NITEMS ? item_hi : NITEMS;
    for (int it = item_lo + gw; it < it_end; it += ngw) {
        int r = it;
        if (r < I_IN) { transpose_item(kp->in[7] + (size_t)l * D * NIN, D, NIN, WIN, 0, scr, r, lane); continue; } r -= I_IN;
        if (r < I_OUT) { transpose_item(kp->in[25] + (size_t)l * D * D, D, D, WOUT, 0, scr, r, lane); continue; } r -= I_OUT;
        if (r < I_G) { transpose_item(kp->in[27] + (size_t)l * D * FF, D, FF, WGU, 1, scr, r, lane); continue; } r -= I_G;
        if (r < I_G) { transpose_item(kp->in[28] + (size_t)l * D * FF, D, FF, WGU, 2, scr, r, lane); continue; } r -= I_G;
        if (r < I_D) { transpose_item(kp->in[29] + (size_t)l * FF * D, FF, D, WDN, 0, scr, r, lane); continue; } r -= I_D;
        if (r < I_P) { const int g = r >> 3; transpose_item(kp->in[12] + (size_t)((l * 4 + g) * 128) * 128, 128, 128, (bf16*)(ws + WS_POOLW) + (size_t)g * 128 * 128, 0, scr, r & 7, lane); continue; } r -= I_P;
        { const int m = r >> 5; const float* src = (m == 0 ? kp->in[16] : (m == 1 ? kp->in[18] : kp->in[19])) + (size_t)l * 64 * RD;
          transpose_item(src, 64, RD, (bf16*)(ws + WS_UPS) + (size_t)m * RD * 64, 0, scr, r & 31, lane); }
    }
    if (item_lo == 0) { const unsigned z = (unsigned)launder_v(0); for (int e = gw * 64 + lane; e < 16384; e += ngw * 64) ((u32x4*)(WIN + (size_t)NIN * D))[e] = (u32x4){z, z, z, z}; }
}
__device__ __forceinline__ void norm_rows(const float* sa, const float* sb, const float* g, float* xcopy, bf16* xn, float* fout, const float* part, int gw, int ngw, int lane) {
    f32x4 vn[8];
    if (gw < T) { const float* row = (gw < TP) ? sa + (size_t)gw * D : sb + (size_t)(gw - TP) * D;
#pragma unroll
        for (int j = 0; j < 8; ++j) vn[j] = ((const f32x4*)row)[lane + 64 * j]; }
    for (int m = gw; m < T; m += ngw) {
        f32x4 v[8]; float ss = 0.f;
#pragma unroll
        for (int j = 0; j < 8; ++j) v[j] = vn[j];
        { const int mn = m + ngw;
          if (mn < T) { const float* row = (mn < TP) ? sa + (size_t)mn * D : sb + (size_t)(mn - TP) * D;
#pragma unroll
            for (int j = 0; j < 8; ++j) vn[j] = ((const f32x4*)row)[lane + 64 * j]; } }
        if (part && m >= TP) {
#pragma unroll
            for (int k = 0; k < 8; ++k)
#pragma unroll
                for (int j = 0; j < 8; ++j) v[j] += ((const f32x4*)(part + ((size_t)k * 1024 + (m - TP)) * D))[lane + 64 * j];
#pragma unroll
            for (int j = 0; j < 8; ++j) ((f32x4*)(const_cast<float*>(sb) + (size_t)(m - TP) * D))[lane + 64 * j] = v[j];
        }
#pragma unroll
        for (int j = 0; j < 8; ++j) ss += (v[j].x * v[j].x + v[j].y * v[j].y) + (v[j].z * v[j].z + v[j].w * v[j].w);
        const float rinv = __builtin_amdgcn_rsqf(wave_sum(ss) * (1.0f / D) + RMS_EPS);
#pragma unroll
        for (int j = 0; j < 8; ++j) {
            if (xcopy) ((f32x4*)(xcopy + (size_t)m * D))[lane + 64 * j] = v[j];
            const f32x4 gj = ((const f32x4*)g)[lane + 64 * j];
            const f32x4 y = v[j] * rinv * gj;
            if (xn) { u32x2 o; o.x = pk2(y.x, y.y); o.y = pk2(y.z, y.w); ((u32x2*)(xn + (size_t)m * D))[lane + 64 * j] = o; }
            if (fout) ((f32x4*)(fout + (size_t)m * D))[lane + 64 * j] = y;
        }
    }
}

__device__ __forceinline__ void conv_item(KP kp, int l, int item, LAS float* lds, int tid_in) {
    const int tid = launder_v(tid_in);
    const bf16* Z = (const bf16*)(kp->ws + WS_Z); bf16* MIX = (bf16*)(kp->ws + WS_MIX);
    const int t0 = item * 32;
    int s, tau0, Ls; bool prompt;
    if (t0 < TP) { s = t0 >> 11; tau0 = t0 & 2047; Ls = 2048; prompt = true; } else { s = (t0 - TP) >> 6; tau0 = (t0 - TP) & 63; Ls = 64; prompt = false; }
    const int c = tid;
    const float* cw = kp->in[8] + (size_t)l * 31 * 512;
    float w[31];
#pragma unroll
    for (int j = 0; j < 31; ++j) w[j] = cw[j * 512 + c];
    const float bias = kp->in[9][l * 512 + c];
    float acc[32];
#pragma unroll
    for (int i = 0; i < 32; ++i) acc[i] = bias;
    const bool first = (tau0 == 0), lastit = (tau0 + 32 == Ls);
    float* oc = prompt ? kp->out + O_CONV_P + (size_t)((l * 4 + s) * 30) * 512 : kp->out + O_CONV_S + (size_t)((l * 16 + s) * 30) * 512;
    const float* cc = kp->in[2] + (size_t)((l * 16 + s) * 30) * 512;
#pragma unroll
    for (int hf = 0; hf < 2; ++hf) {
        float pv[31], pg[31];
#pragma unroll
        for (int k = 0; k < 31; ++k) { const int ii = hf * 31 + k;
            if (ii < 30 && first) { pv[k] = prompt ? 0.f : cc[ii * 512 + c]; pg[k] = 0.f; }
            else { const bf16* zr = Z + (size_t)(t0 + ii - 30) * NZ; pv[k] = bf2f(zr[c]); pg[k] = bf2f(zr[512 + c]); } }
#pragma unroll
        for (int k = 0; k < 31; ++k) { const int ii = hf * 31 + k;
            const float u = (ii < 30 && first) ? pv[k] : pv[k] * sigm(pg[k]);
            if (ii >= 32 && lastit) oc[(ii - 32) * 512 + c] = u;
#pragma unroll
            for (int oi = 0; oi < 32; ++oi) { const int j = ii - oi; if (j >= 0 && j <= 30) acc[oi] += w[j] * u; }
        }
    }
#pragma unroll
    for (int oi = 0; oi < 32; ++oi) lds[oi * 512 + c] = acc[oi];
    __syncthreads();
    const int wave = tid >> 6, lane = tid & 63;
    const f32x4 g0 = *(const f32x4*)(kp->in[10] + l * 512 + lane * 8), g1 = *(const f32x4*)(kp->in[10] + l * 512 + lane * 8 + 4);
    const f32x4 b0 = *(const f32x4*)(kp->in[11] + l * 512 + lane * 8), b1 = *(const f32x4*)(kp->in[11] + l * 512 + lane * 8 + 4);
#pragma unroll
    for (int q = 0; q < 4; ++q) {
        const int oi = wave * 4 + q;
        f32x4 a = *(const LAS f32x4*)(lds + oi * 512 + lane * 8), b = *(const LAS f32x4*)(lds + oi * 512 + lane * 8 + 4);
        const float mean = wave_sum((a.x + a.y) + (a.z + a.w) + (b.x + b.y) + (b.z + b.w)) * (1.0f / 512.0f);
        a = a - mean; b = b - mean;
        const float var = wave_sum((a.x * a.x + a.y * a.y) + (a.z * a.z + a.w * a.w) + (b.x * b.x + b.y * b.y) + (b.z * b.z + b.w * b.w)) * (1.0f / 512.0f);
        const float rstd = __builtin_amdgcn_rsqf(var + LN_EPS);
        a = a * rstd * g0 + b0; b = b * rstd * g1 + b1;
        float o[8] = {a.x, a.y, a.z, a.w, b.x, b.y, b.z, b.w};
#pragma unroll
        for (int k = 0; k < 8; ++k) o[k] = o[k] * sigm(o[k]);
        u32x4 wv; wv.x = pk2(o[0], o[1]); wv.y = pk2(o[2], o[3]); wv.z = pk2(o[4], o[5]); wv.w = pk2(o[6], o[7]);
        *(u32x4*)(MIX + (size_t)(t0 + oi) * D + lane * 8) = wv;
    }
    __syncthreads();
}
template <int W> __device__ __forceinline__ void pool_window(const float (&pvl)[47], LAS bf16* db, int c, bool prompt, int tau0) {
    float sum = 0.f;
#pragma unroll
    for (int k = 0; k < W; ++k) sum += pvl[15 - k];
#pragma unroll
    for (int oi = 0; oi < 32; ++oi) {
        if (oi > 0) sum += pvl[oi + 15] - pvl[oi + 15 - W];
        const int cnt = prompt ? min(W, tau0 + oi + 1) : W;
        db[oi * 520 + c] = (bf16)f2bf(sum * __builtin_amdgcn_rcpf((float)cnt) - pvl[oi + 15]);
    }
}
__device__ __forceinline__ void pool_item(KP kp, int l, int item, LAS unsigned char* ldsb, int tid_in) {
    const int tid = launder_v(tid_in);
    const bf16* Z = (const bf16*)(kp->ws + WS_Z); bf16* MIX = (bf16*)(kp->ws + WS_MIX);
    LAS float* pp = (LAS float*)ldsb;
    LAS bf16* db = (LAS bf16*)(ldsb + 47 * 512 * 4);
    const int t0 = item * 32;
    int s, tau0, Ls; bool prompt;
    if (t0 < TP) { s = t0 >> 11; tau0 = t0 & 2047; Ls = 2048; prompt = true; } else { s = (t0 - TP) >> 6; tau0 = (t0 - TP) & 63; Ls = 64; prompt = false; }
    const int c = tid;
    const bool first = (tau0 == 0), lastit = (tau0 + 32 == Ls);
    float* op = prompt ? kp->out + O_POOL_P + (size_t)((l * 4 + s) * 15) * 512 : kp->out + O_POOL_S + (size_t)((l * 16 + s) * 15) * 512;
    const float* cp = kp->in[3] + (size_t)((l * 16 + s) * 15) * 512;
    {
        float pvl[47];
#pragma unroll
        for (int ii = 0; ii < 47; ++ii) {
            if (ii < 15 && first) pvl[ii] = prompt ? 0.f : cp[ii * 512 + c];
            else pvl[ii] = bf2f(Z[(size_t)(t0 + ii - 15) * NZ + 1024 + c]);
        }
        if (lastit) {
#pragma unroll
            for (int ii = 32; ii < 47; ++ii) op[(ii - 32) * 512 + c] = pvl[ii];
        }
        const int gi = c >> 7;
        if (gi == 0) pool_window<2>(pvl, db, c, prompt, tau0);
        else if (gi == 1) pool_window<4>(pvl, db, c, prompt, tau0);
        else if (gi == 2) pool_window<8>(pvl, db, c, prompt, tau0);
        else pool_window<16>(pvl, db, c, prompt, tau0);
    }
    __syncthreads();
    const int lane = tid & 63, wave = tid >> 6, n16 = lane & 15, q = lane >> 4, g = wave >> 1, nh = wave & 1;
    const bf16* WT = (const bf16*)(kp->ws + WS_POOLW) + (size_t)g * 128 * 128;
    bfx8 Bf[4][4];
#pragma unroll
    for (int nt = 0; nt < 4; ++nt)
#pragma unroll
        for (int ks = 0; ks < 4; ++ks) Bf[nt][ks] = *(const bfx8*)(WT + (size_t)(nh * 64 + nt * 16 + n16) * 128 + ks * 32 + q * 8);
    float scale[4];
#pragma unroll
    for (int nt = 0; nt < 4; ++nt) scale[nt] = kp->in[13][l * 512 + g * 128 + nh * 64 + nt * 16 + n16];
#pragma unroll
    for (int mt = 0; mt < 2; ++mt) {
        bfx8 Af[4];
#pragma unroll
        for (int ks = 0; ks < 4; ++ks) Af[ks] = *(const LAS bfx8*)(db + (mt * 16 + n16) * 520 + g * 128 + ks * 32 + q * 8);
        f32x4 acc[4];
#pragma unroll
        for (int nt = 0; nt < 4; ++nt) { acc[nt] = (f32x4){0.f, 0.f, 0.f, 0.f};
#pragma unroll
            for (int ks = 0; ks < 4; ++ks) acc[nt] = __builtin_amdgcn_mfma_f32_16x16x32_bf16(Af[ks], Bf[nt][ks], acc[nt], 0, 0, 0); }
#pragma unroll
        for (int nt = 0; nt < 4; ++nt)
#pragma unroll
            for (int r = 0; r < 4; ++r) MIX[(size_t)(t0 + mt * 16 + 4 * q + r) * D + 512 + g * 128 + nh * 64 + nt * 16 + n16] = (bf16)f2bf(acc[nt][r] * scale[nt]);
    }
    __syncthreads();
}
__device__ __forceinline__ void prep_item(KP kp, int l, int item, LAS unsigned char* ldsb, int tid_in) {
    const int tid = launder_v(tid_in);
    const bf16* Z = (const bf16*)(kp->ws + WS_Z);
    float* SC = (float*)(kp->ws + WS_SC); float* G = (float*)(kp->ws + WS_G); float* RK = (float*)(kp->ws + WS_RK);
    const bf16* UPT = (const bf16*)(kp->ws + WS_UPS);
    LAS bf16* lo = (LAS bf16*)ldsb;
    const int t0 = item * 16;
    int s, tau0, Ls; bool prompt;
    if (t0 < TP) { s = t0 >> 11; tau0 = t0 & 2047; Ls = 2048; prompt = true; } else { s = (t0 - TP) >> 6; tau0 = (t0 - TP) & 63; Ls = 64; prompt = false; }
    const float* mu = kp->in[14] + (size_t)l * RP;
    const float* ssh = kp->in[4] + (size_t)(l * 16 + s) * RP;
    {
        float qv[6], qp[6], mq[6];
#pragma unroll
        for (int k = 0; k < 6; ++k) { const int e = tid + k * NTHR, tok = e / 192, col = e % 192, zc = 3072 + col, t = t0 + tok, tau = tau0 + tok;
            qv[k] = bf2f(Z[(size_t)t * NZ + ZQ + zc]);
            qp[k] = tau > 0 ? bf2f(Z[(size_t)(t - 1) * NZ + ZQ + zc]) : (prompt ? 0.f : ssh[zc]);
            mq[k] = mu[zc]; }
#pragma unroll
        for (int k = 0; k < 6; ++k) { const int e = tid + k * NTHR, tok = e / 192, col = e % 192;
            const float qs = qv[k] + (qp[k] - qv[k]) * mq[k];
            const float val = col < 64 ? (1.0f - 2.0f * __builtin_amdgcn_rcpf(1.0f + __expf(2.0f * qs))) : (col < 128 ? qs : sigm(qs));
            lo[((col >> 6) * 16 + tok) * 72 + (col & 63)] = (bf16)f2bf(val); }
    }
    __syncthreads();
    const int lane = tid & 63, wave = tid >> 6, n16 = lane & 15, q = lane >> 4;
#pragma unroll 1
    for (int hh = 0; hh < 2; ++hh) {
        const int h = wave * 2 + hh;
        f32x4 acc[3][4];
#pragma unroll
        for (int m = 0; m < 3; ++m) {
            bfx8 Af[2], Bf[4][2];
#pragma unroll
            for (int ks = 0; ks < 2; ++ks) Af[ks] = *(const LAS bfx8*)(lo + (m * 16 + n16) * 72 + ks * 32 + q * 8);
#pragma unroll
            for (int i = 0; i < 4; ++i)
#pragma unroll
                for (int ks = 0; ks < 2; ++ks) Bf[i][ks] = *(const bfx8*)(UPT + (size_t)(m * RD + h * 64 + i * 16 + n16) * 64 + ks * 32 + q * 8);
#pragma unroll
            for (int i = 0; i < 4; ++i) { acc[m][i] = (f32x4){0.f, 0.f, 0.f, 0.f};
#pragma unroll
                for (int ks = 0; ks < 2; ++ks) acc[m][i] = __builtin_amdgcn_mfma_f32_16x16x32_bf16(Af[ks], Bf[i][ks], acc[m][i], 0, 0, 0); }
        }
        float mur[4], muk[4], muv[4], w0c[4], a0c[4], kkc[4], kac[4], rkc[4], sr[4], sk[4], sv[4];
#pragma unroll
        for (int i = 0; i < 4; ++i) { const int c = h * 64 + i * 16 + n16;
            mur[i] = mu[c]; muk[i] = mu[RD + c]; muv[i] = mu[2 * RD + c];
            w0c[i] = kp->in[15][l * RD + c]; a0c[i] = kp->in[17][l * RD + c]; kkc[i] = kp->in[20][l * RD + c]; kac[i] = kp->in[21][l * RD + c]; rkc[i] = kp->in[22][l * RD + c];
            sr[i] = prompt ? 0.f : ssh[c]; sk[i] = prompt ? 0.f : ssh[RD + c]; sv[i] = prompt ? 0.f : ssh[2 * RD + c]; }
        float zc_[4][4][3], zp_[4][4][3];
#pragma unroll
        for (int r = 0; r < 4; ++r) {
            const int tok = 4 * q + r, t = t0 + tok, tau = tau0 + tok;
            const bf16* zr = Z + (size_t)t * NZ + ZQ;
#pragma unroll
            for (int i = 0; i < 4; ++i) { const int c = h * 64 + i * 16 + n16;
                zc_[r][i][0] = bf2f(zr[c]); zc_[r][i][1] = bf2f(zr[RD + c]); zc_[r][i][2] = bf2f(zr[2 * RD + c]);
                if (tau > 0) { zp_[r][i][0] = bf2f(zr[c - NZ]); zp_[r][i][1] = bf2f(zr[RD + c - NZ]); zp_[r][i][2] = bf2f(zr[2 * RD + c - NZ]); } else { zp_[r][i][0] = sr[i]; zp_[r][i][1] = sk[i]; zp_[r][i][2] = sv[i]; } }
        }
        float dv[4][4], av[4][4];
#pragma unroll
        for (int r = 0; r < 4; ++r)
#pragma unroll
            for (int i = 0; i < 4; ++i) {
                const float xw = -(w0c[i] + acc[0][i][r]);
                const float sp = fmaxf(xw, 0.f) + __logf(1.0f + __expf(-fabsf(xw)));
                dv[r][i] = __expf(-__expf(-sp - 0.5f));
                av[r][i] = sigm(a0c[i] + acc[1][i][r]);
            }
        float wpre[4];
        { const int lnx = (int)__builtin_amdgcn_mbcnt_hi(~0u, __builtin_amdgcn_mbcnt_lo(~0u, (unsigned)launder_v(0)));
#pragma unroll
          for (int i = 0; i < 4; ++i) {
            const float gq = (dv[0][i] * dv[1][i]) * (dv[2][i] * dv[3][i]);
            const float g0 = __builtin_bit_cast(float, __builtin_amdgcn_ds_bpermute(((lnx & 15)) << 2, __builtin_bit_cast(int, gq)));
            const float g1 = __builtin_bit_cast(float, __builtin_amdgcn_ds_bpermute(((lnx & 15) + 16) << 2, __builtin_bit_cast(int, gq)));
            const float g2 = __builtin_bit_cast(float, __builtin_amdgcn_ds_bpermute(((lnx & 15) + 32) << 2, __builtin_bit_cast(int, gq)));
            wpre[i] = (q > 0 ? g0 : 1.0f) * (q > 1 ? g1 : 1.0f) * (q > 2 ? g2 : 1.0f); } }
#pragma unroll
        for (int r = 0; r < 4; ++r) {
            const int tok = 4 * q + r, t = t0 + tok;
            float rv[4], kv[4], vv[4], kk[4], wex[4], win[4];
            float skk = 0.f;
#pragma unroll
            for (int i = 0; i < 4; ++i) { const int c = h * 64 + i * 16 + n16;
                float rr = zc_[r][i][0], k = zc_[r][i][1], v = zc_[r][i][2];
                rr += (zp_[r][i][0] - rr) * mur[i]; k += (zp_[r][i][1] - k) * muk[i]; v += (zp_[r][i][2] - v) * muv[i];
                rv[i] = rr; kv[i] = k; vv[i] = v; kk[i] = k * kkc[i]; skk += kk[i] * kk[i];
                wex[i] = wpre[i]; win[i] = wpre[i] * dv[r][i]; wpre[i] = win[i];
                G[(size_t)t * RD + c] = acc[2][i][r];
                }
            skk = rowsum16(skk);
            const float rinv = __builtin_amdgcn_rsqf(fmaxf(skk, 1e-24f));
            float srk = 0.f;
#pragma unroll
            for (int i = 0; i < 4; ++i) {
                const float kkn = kk[i] * rinv, kpv = kv[i] * (1.0f + (av[r][i] - 1.0f) * kac[i]), bb = kkn * av[r][i];
                srk += rv[i] * kpv * rkc[i];
                const float iw = __builtin_amdgcn_rcpf(win[i]);
                float* sc = SC + sc_off(t, h) + i * 16 + n16;
                sc[0] = wex[i] * kkn; sc[64] = bb * iw; sc[128] = kpv * iw; sc[192] = win[i] * rv[i]; sc[256] = vv[i]; sc[320] = win[i];
            }
            srk = rowsum16(srk);
            if (n16 == 0) RK[t * NH + h] = srk;
        }
    }
    if (tau0 + 16 == Ls) {
        float* osh = prompt ? kp->out + O_SHIFT_P + (size_t)(l * 4 + s) * RP : kp->out + O_SHIFT_S + (size_t)(l * 16 + s) * RP;
        const bf16* zr = Z + (size_t)(t0 + 15) * NZ + ZQ;
        for (int e = tid; e < RP; e += NTHR) osh[e] = bf2f(zr[e]);
    }
    __syncthreads();
}

__device__ __forceinline__ void sc_issue(f32x4 (&r)[4], const LAS f32x4* o, int c) {
    if (c < 4) {
#pragma unroll
        for (int i = 0; i < 4; ++i) r[i] = o[4 * c + i];
    } else { const int j = c - 4; r[1] = o[16 + j]; r[2] = o[32 + j]; r[3] = o[48 + j]; }
}
template <int MODE>
__device__ __forceinline__ void scan_run(const float* SC, int tg0, int nsteps, int h, LAS float* wl  , LAS float* yb  , int lane,
                                         const float* Sinit, float* Y, float* GB, float* Sout, float* PQout) {
    constexpr int GS = 4, NCH = 20;
    f32x2 S[32];
    f32x2 P[(MODE == 3) ? 32 : 1];
    if (MODE == 3) {
        const int ln = launder_v(lane);
#pragma unroll
        for (int j = 0; j < 32; ++j) { S[j] = (f32x2){0.f, 0.f}; P[j] = (f32x2){(2 * j == ln) ? 1.f : 0.f, (2 * j + 1 == ln) ? 1.f : 0.f}; }
    } else {
#pragma unroll
        for (int j = 0; j < 16; ++j) { const f32x4 v = ((const f32x4*)(Sinit + lane * 64))[j]; S[2 * j] = (f32x2){v.x, v.y}; S[2 * j + 1] = (f32x2){v.z, v.w}; }
    }
#define SC_STAGE(g, buf) do { const float* rec_ = SC + sc_off(tg0 + (g) * GS, h) + lane * 4; \
        _Pragma("unroll") for (int k_ = 0; k_ < 6; ++k_) __builtin_amdgcn_global_load_lds((const unsigned*)(rec_ + k_ * 256), (LAS unsigned*)(wl + (buf) * GS * SCR + k_ * 256), 16, 0, 0); } while (0)
    SC_STAGE(0, 0);
    const int ngroups = nsteps / GS;
    for (int g = 0; g < ngroups; ++g) {
        asm volatile("s_waitcnt vmcnt(0)" ::: "memory");
        if (g > 0) {
#pragma unroll
            for (int s = 0; s < GS; ++s) { Y[(size_t)(tg0 + (g - 1) * GS + s) * RD + h * 64 + lane] = yb[s * 64 + lane]; if (MODE == 3) GB[(size_t)(tg0 + (g - 1) * GS + s) * RD + h * 64 + lane] = yb[(GS + s) * 64 + lane]; }
        }
        if (g + 1 < ngroups) SC_STAGE(g + 1, (g + 1) & 1);
        const LAS float* wb = wl + (g & 1) * GS * SCR;
        f32x4 R[4][4];
#pragma unroll
        for (int q = 0; q < 3; ++q) sc_issue(R[q & 3], (const LAS f32x4*)(wb + (q / NCH) * SCR), q % NCH);
        __builtin_amdgcn_sched_barrier(0);
#pragma unroll
        for (int s = 0; s < GS; ++s) {
            f32x2 d2a = (f32x2){0.f, 0.f}, y2a = (f32x2){0.f, 0.f};
            f32x2 e2a = (f32x2){0.f, 0.f}, g2a = (f32x2){0.f, 0.f};
            f32x2 sa2 = (f32x2){0.f, 0.f}, sp2 = (f32x2){0.f, 0.f};
            const float vs = wb[s * SCR + 256 + lane];
            const f32x2 v2 = (f32x2){vs, vs};
#pragma unroll
            for (int c = 0; c < NCH; ++c) {
                const int q = s * NCH + c, qn = q + 3;
                if (qn < GS * NCH) sc_issue(R[qn & 3], (const LAS f32x4*)(wb + (qn / NCH) * SCR), qn % NCH);
                __builtin_amdgcn_sched_barrier(0);
                f32x4 (&r)[4] = R[q & 3];
                if (c < 4) {
#pragma unroll
                    for (int i = 0; i < 4; ++i) { const int j = 4 * c + i; d2a += S[2 * j] * (f32x2){r[i].x, r[i].y}; d2a += S[2 * j + 1] * (f32x2){r[i].z, r[i].w};
                        if (MODE == 3) { e2a += P[2 * j] * (f32x2){r[i].x, r[i].y}; e2a += P[2 * j + 1] * (f32x2){r[i].z, r[i].w}; } }
                    if (c == 3) { const f32x2 d2 = d2a; const float sa = -(d2.x + d2.y); sa2 = (f32x2){sa, sa};
                        if (MODE == 3) { const f32x2 e2 = e2a; const float sp = -(e2.x + e2.y); sp2 = (f32x2){sp, sp}; } }
                } else {
                    const int j = c - 4;
                    S[2 * j] = sa2 * (f32x2){r[1].x, r[1].y} + S[2 * j]; S[2 * j] = v2 * (f32x2){r[2].x, r[2].y} + S[2 * j];
                    S[2 * j + 1] = sa2 * (f32x2){r[1].z, r[1].w} + S[2 * j + 1]; S[2 * j + 1] = v2 * (f32x2){r[2].z, r[2].w} + S[2 * j + 1];
                    y2a += S[2 * j] * (f32x2){r[3].x, r[3].y}; y2a += S[2 * j + 1] * (f32x2){r[3].z, r[3].w};
                    if (MODE == 3) {
                        P[2 * j] = sp2 * (f32x2){r[1].x, r[1].y} + P[2 * j]; P[2 * j + 1] = sp2 * (f32x2){r[1].z, r[1].w} + P[2 * j + 1];
                        g2a += P[2 * j] * (f32x2){r[3].x, r[3].y}; g2a += P[2 * j + 1] * (f32x2){r[3].z, r[3].w};
                    }
                }
                __builtin_amdgcn_sched_barrier(0);
            }
            yb[s * 64 + lane] = y2a.x + y2a.y;
            if (MODE == 3) yb[(GS + s) * 64 + lane] = g2a.x + g2a.y;
        }
        if ((g & 3) == 3) {
            const LAS f32x4* wq = (const LAS f32x4*)(wb + (GS - 1) * SCR + 320);
#pragma unroll
            for (int j = 0; j < 16; ++j) { const f32x4 w4 = wq[j];
                S[2 * j] = S[2 * j] * (f32x2){w4.x, w4.y}; S[2 * j + 1] = S[2 * j + 1] * (f32x2){w4.z, w4.w};
                if (MODE == 3) { P[2 * j] = P[2 * j] * (f32x2){w4.x, w4.y}; P[2 * j + 1] = P[2 * j + 1] * (f32x2){w4.z, w4.w}; } }
        }
        asm volatile("s_waitcnt lgkmcnt(0)" ::: "memory");
    }
#undef SC_STAGE
#pragma unroll
    for (int s = 0; s < GS; ++s) { Y[(size_t)(tg0 + (ngroups - 1) * GS + s) * RD + h * 64 + lane] = yb[s * 64 + lane]; if (MODE == 3) GB[(size_t)(tg0 + (ngroups - 1) * GS + s) * RD + h * 64 + lane] = yb[(GS + s) * 64 + lane]; }
    if (MODE == 3) {
#pragma unroll
        for (int j = 0; j < 16; ++j) { ((f32x4*)PQout)[j * 64 + lane] = (f32x4){P[2 * j].x, P[2 * j].y, P[2 * j + 1].x, P[2 * j + 1].y};
                                       ((f32x4*)(PQout + 4096))[j * 64 + lane] = (f32x4){S[2 * j].x, S[2 * j].y, S[2 * j + 1].x, S[2 * j + 1].y}; }
    } else {
#pragma unroll
        for (int j = 0; j < 16; ++j) ((f32x4*)(Sout + lane * 64))[j] = (f32x4){S[2 * j].x, S[2 * j].y, S[2 * j + 1].x, S[2 * j + 1].y};
    }
}
template <int NMT>
__device__ __forceinline__ void ypost_task(KP kp, int l, const float* S0q  , int tg0, int h, int lane) {
    const float* GB = (const float*)(kp->ws + WS_GB); const float* Y = (const float*)(kp->ws + WS_Y); const float* SC = (const float*)(kp->ws + WS_SC);
    const float* G = (const float*)(kp->ws + WS_G); const float* RK = (const float*)(kp->ws + WS_RK); bf16* MIX = (bf16*)(kp->ws + WS_MIX);
    const int n = lane & 15, kq = lane >> 4;
    float Bv[4][16];
    if (S0q) {
#pragma unroll
        for (int nt = 0; nt < 4; ++nt)
#pragma unroll
            for (int ks = 0; ks < 16; ++ks) Bv[nt][ks] = S0q[(size_t)(ks * 64 + nt * 16 + n) * 4 + kq];
    }
    float gng[4], gnb[4];
#pragma unroll
    for (int nt = 0; nt < 4; ++nt) { gng[nt] = kp->in[23][l * RD + h * 64 + nt * 16 + n]; gnb[nt] = kp->in[24][l * RD + h * 64 + nt * 16 + n]; }
#pragma unroll 1
    for (int mt = 0; mt < NMT; ++mt) {
        const int tb = tg0 + mt * 16;
        float Av[16];
        if (S0q) { const float* grow = GB + (size_t)(tb + n) * RD + h * 64 + kq;
#pragma unroll
            for (int ks = 0; ks < 16; ++ks) Av[ks] = grow[ks * 4]; }
        f32x4 acc[4]; float vv[4][4], gg[4][4], rk[4];
#pragma unroll
        for (int r = 0; r < 4; ++r) { const int t = tb + 4 * kq + r; rk[r] = RK[t * NH + h];
#pragma unroll
            for (int nt = 0; nt < 4; ++nt) { acc[nt][r] = Y[(size_t)t * RD + h * 64 + nt * 16 + n]; vv[nt][r] = SC[sc_off(t, h) + 256 + nt * 16 + n]; gg[nt][r] = G[(size_t)t * RD + h * 64 + nt * 16 + n]; } }
        if (S0q) {
#pragma unroll
            for (int ks = 0; ks < 16; ++ks)
#pragma unroll
                for (int nt = 0; nt < 4; ++nt) acc[nt] = __builtin_amdgcn_mfma_f32_16x16x4f32(Av[ks], Bv[nt][ks], acc[nt], 0, 0, 0);
        }
#pragma unroll
        for (int r = 0; r < 4; ++r) {
            const int t = tb + 4 * kq + r;
            const float mean = rowsum16((acc[0][r] + acc[1][r]) + (acc[2][r] + acc[3][r])) * (1.0f / 64.0f);
            float d[4], qq = 0.f;
#pragma unroll
            for (int nt = 0; nt < 4; ++nt) { d[nt] = acc[nt][r] - mean; qq += d[nt] * d[nt]; }
            const float rstd = __builtin_amdgcn_rsqf(rowsum16(qq) * (1.0f / 64.0f) + GN_EPS);
#pragma unroll
            for (int nt = 0; nt < 4; ++nt) { const float o = ((d[nt] * rstd * gng[nt] + gnb[nt]) + rk[r] * vv[nt][r]) * gg[nt][r];
                MIX[(size_t)t * D + 1024 + h * 64 + nt * 16 + n] = (bf16)f2bf(o); }
        }
    }
}
__device__ __forceinline__ void combine_chain(const float* PQ, float* S0, float* Sfin, LAS unsigned char* lds, int tid, int wave, int lane) {
    constexpr int LDA = 66, LDB = 80;
    LAS float* Sl = (LAS float*)lds;
    LAS float* Pl = (LAS float*)(lds + 2 * 64 * LDA * 4);
    const int n = lane & 15, kq = lane >> 4, ib = wave >> 1, n0 = 32 * (wave & 1);
    for (int e = tid; e < 64 * LDA; e += NTHR) Sl[e] = 0.f;
    { const f32x4* Pc = (const f32x4*)PQ;
      for (int e = tid; e < 1024; e += NTHR) *(LAS f32x4*)(Pl + (e & 63) * LDB + (e >> 6) * 4) = Pc[e]; }
    f32x4 qn[2];
#pragma unroll
    for (int t = 0; t < 2; ++t)
#pragma unroll
        for (int r = 0; r < 4; ++r) { const int i = 16 * ib + 4 * kq + r, col = n0 + 16 * t + n; qn[t][r] = PQ[4096 + (size_t)((col >> 2) * 64 + i) * 4 + (col & 3)]; }
    for (int c = 0; c < NC; ++c) {
        f32x4 acc[2] = {qn[0], qn[1]};
        if (c + 1 < NC) { const float* Qn = PQ + (size_t)((c + 1) * 2 + 1) * 4096;
#pragma unroll
            for (int t = 0; t < 2; ++t)
#pragma unroll
                for (int r = 0; r < 4; ++r) { const int i = 16 * ib + 4 * kq + r, col = n0 + 16 * t + n; qn[t][r] = Qn[(size_t)((col >> 2) * 64 + i) * 4 + (col & 3)]; } }
        f32x4 pn0 = (f32x4){0.f, 0.f, 0.f, 0.f}, pn1 = pn0;
        if (c + 1 < NC) { const f32x4* Pn = (const f32x4*)(PQ + (size_t)((c + 1) * 2) * 4096); pn0 = Pn[tid]; pn1 = Pn[tid + 512]; }
        __syncthreads();
        const LAS float* sa = Sl + (c & 1) * 64 * LDA + (16 * ib + n) * LDA + kq;
        const LAS float* pb = Pl + (c & 1) * 64 * LDB + kq * LDB + n0 + n;
#pragma unroll
        for (int ks = 0; ks < 16; ++ks) {
            const float av = sa[4 * ks], b0 = pb[4 * ks * LDB], b1 = pb[4 * ks * LDB + 16];
            acc[0] = __builtin_amdgcn_mfma_f32_16x16x4f32(av, b0, acc[0], 0, 0, 0);
            acc[1] = __builtin_amdgcn_mfma_f32_16x16x4f32(av, b1, acc[1], 0, 0, 0);
        }
        if (c + 1 < NC) {
            LAS float* sn = Sl + ((c + 1) & 1) * 64 * LDA; float* So = S0 + (size_t)(c + 1) * 4096;
#pragma unroll
            for (int t = 0; t < 2; ++t)
#pragma unroll
                for (int r = 0; r < 4; ++r) { const int i = 16 * ib + 4 * kq + r, col = n0 + 16 * t + n;
                    sn[i * LDA + col] = acc[t][r]; So[(size_t)((col >> 2) * 64 + i) * 4 + (col & 3)] = acc[t][r]; }
            LAS float* pnl = Pl + ((c + 1) & 1) * 64 * LDB;
            *(LAS f32x4*)(pnl + (tid & 63) * LDB + (tid >> 6) * 4) = pn0; *(LAS f32x4*)(pnl + (tid & 63) * LDB + ((tid + 512) >> 6) * 4) = pn1;
        } else {
#pragma unroll
            for (int t = 0; t < 2; ++t)
#pragma unroll
                for (int r = 0; r < 4; ++r) Sfin[(16 * ib + 4 * kq + r) * 64 + n0 + 16 * t + n] = acc[t][r];
        }
    }
    __syncthreads();
}

__global__ void __launch_bounds__(NTHR, 2) fwd_mega(Params p) {
    extern __shared__ __attribute__((aligned(16))) unsigned char lds_raw[];
    LAS unsigned char* lds = (LAS unsigned char*)lds_raw;
    const int wave0 = __builtin_amdgcn_readfirstlane((int)threadIdx.x >> 6);
    volatile LAS unsigned* MISC = (volatile LAS unsigned*)(lds + 131072);
    if (threadIdx.x < 16) MISC[threadIdx.x] = 0u;
    __syncthreads();
    const XcdBarrier xbar = xcd_barrier_post((unsigned*)p.ws + 4096, MISC, (int)threadIdx.x);
    cg::this_grid().sync();

#pragma unroll 1
    for (int l = 0; l < DEPTH; ++l) {
        const size_t wsel = (l & 1) ? (WS_W2 - WS_WIN) : 0;
        { PH_BEGIN();
          if (l == 0) convert_weights(kp, 0, (LAS float*)(lds + wave * 16384), gw, ngw, lane);
          float* X = (float*)(ws + WS_X); bf16* XN = (bf16*)(ws + WS_XN);
          if (l == 0) norm_rows(kp->in[0], kp->in[1], kp->in[6], X, XN, nullptr, nullptr, gw, ngw, lane);
          else norm_rows(X, X + (size_t)TP * D, kp->in[6] + l * D, nullptr, XN, nullptr, (const float*)(ws + WS_PART), gw, ngw, lane);
        }
        GSYNC();
        { PH_BEGIN(); pg8::Gemm g{(const bf16*)(ws + WS_XN), (const bf16*)(ws + WS_WIN + wsel), T, NZ, D}; pg8::StaticOrder S; S.init(T, NZ, D, nb, bid); pg8::EpiStoreBf16 E{(bf16*)(ws + WS_Z), NZ};
          pg8::gemm_phase<pg8::EpiStoreBf16, pg8::StaticOrder, true, true>(lds, g, S, E, tid); }
        GSYNC();
        { PH_BEGIN();
          for (int it = bid; it < 1152; it += nb) {
            if (it < 576) prep_item(kp, l, it, lds, tid);
            else if (it < 864) pool_item(kp, l, it - 576, lds, tid);
            else conv_item(kp, l, it - 864, (LAS float*)lds, tid);
          }
        }
        GSYNC();
        { PH_BEGIN();
            const float* SC = (const float*)(ws + WS_SC); float* Y = (float*)(ws + WS_Y); float* PQ = (float*)(ws + WS_PQ); float* GB = (float*)(ws + WS_GB);
            LAS float* wl = (LAS float*)(lds + wave * 12288); LAS float* yb = (LAS float*)(lds + 98304 + wave * 2048);
            for (int task = wave * nb + bid; task < 64 * NC + 256; task += NWAVES * nb) {
                if (task < 64 * NC) {
                    const int ch = task / NC, c = task % NC, s = ch >> 4, h = ch & 15;
                    scan_run<3>(SC, s * 2048 + c * CL, CL, h, wl, yb, lane, nullptr, Y, GB, nullptr, PQ + (size_t)((ch * NC + c) * 2) * 4096);
                } else {
                    const int ch = task - 64 * NC, b = ch >> 4, h = ch & 15;
                    scan_run<1>(SC, TP + b * 64, 64, h, wl, yb, lane, kp->in[5] + (size_t)((l * 16 + b) * NH + h) * 4096, Y, nullptr, kp->out + O_WKV_S + (size_t)((l * 16 + b) * NH + h) * 4096, nullptr);
                }
            }
            if (l + 1 < DEPTH) {
                if (wave >= 5) convert_weights(kp, l + 1, (LAS float*)(lds + 61440 + (wave - 4) * 8448), bid * 3 + (wave - 5), nb * 3, lane, 0, CVT_SPLIT);
                else if (wave == 4) convert_weights(kp, l + 1, (LAS float*)(lds + 61440), bid, nb, lane, CVT_SPLIT);
            }
        }
        GSYNC();
        { PH_BEGIN();
            for (int ch = bid; ch < 64; ch += nb) { const int s = ch >> 4, h = ch & 15;
                combine_chain((const float*)(ws + WS_PQ) + (size_t)ch * NC * 2 * 4096, (float*)(ws + WS_S0) + (size_t)ch * NC * 4096, kp->out + O_WKV_P + (size_t)((l * 4 + s) * NH + h) * 4096, lds, tid, wave, lane); }
        }
        GSYNC();
        { PH_BEGIN();
            const float* S0 = (const float*)(ws + WS_S0);
            constexpr int UPC = CL / 32, NPU = 64 * NC * UPC;
            for (int u = wave * nb + bid; u < NPU + 512; u += NWAVES * nb) {
                if (u < NPU) { const int task = u / UPC, hf = u % UPC, ch = task / NC, c = task % NC, s = ch >> 4, h = ch & 15;
                    ypost_task<2>(kp, l, c == 0 ? nullptr : S0 + (size_t)(ch * NC + c) * 4096, s * 2048 + c * CL + hf * 32, h, lane); }
                else { const int ch = (u - NPU) >> 1, hf = (u - NPU) & 1, b = ch >> 4, h = ch & 15; ypost_task<2>(kp, l, nullptr, TP + b * 64 + hf * 32, h, lane); }
            }
        }
        GSYNC();
        { PH_BEGIN(); pg8::Gemm g{(const bf16*)(ws + WS_MIX), (const bf16*)(ws + WS_WOUT + wsel), T, D, D}; pg8::TailOrder S; S.init(D, D, nb, bid); pg8::EpiResAdd E{(float*)(ws + WS_X), D, (float*)(ws + WS_PART)};
          pg8::gemm_phase<pg8::EpiResAdd, pg8::TailOrder, true, true>(lds, g, S, E, tid); }
        GSYNC();
        { PH_BEGIN(); float* X = (float*)(ws + WS_X); norm_rows(X, X + (size_t)TP * D, kp->in[26] + l * D, nullptr, (bf16*)(ws + WS_XN), nullptr, (const float*)(ws + WS_PART), gw, ngw, lane); }
        GSYNC();
        { PH_BEGIN(); pg8::Gemm g{(const bf16*)(ws + WS_XN), (const bf16*)(ws + WS_WGU + wsel), T, NGU, D}; pg8::StaticOrder S; S.init(T, NGU, D, nb, bid); pg8::EpiSwiGLU E{(bf16*)(ws + WS_ACT), FF};
          pg8::gemm_phase<pg8::EpiSwiGLU, pg8::StaticOrder, true, true>(lds, g, S, E, tid); }
        GSYNC();
        { PH_BEGIN(); pg8::Gemm g{(const bf16*)(ws + WS_ACT), (const bf16*)(ws + WS_WDN + wsel), T, D, FF}; pg8::TailOrder S; S.init(D, FF, nb, bid); pg8::EpiResAdd E{(float*)(ws + WS_X), D, (float*)(ws + WS_PART)};
          pg8::gemm_phase<pg8::EpiResAdd, pg8::TailOrder, true, true>(lds, g, S, E, tid); }
        GSYNC();
    }
    { PH_BEGIN(); float* X = (float*)(ws + WS_X); norm_rows(X, X + (size_t)TP * D, kp->in[30], nullptr, nullptr, kp->out + O_Y, (const float*)(ws + WS_PART), gw, ngw, lane); }
}

extern "C" void kernel_launch(void* const* d_in, const int* in_sizes, int n_in, void* d_out, int out_size, void* d_ws, size_t ws_size, hipStream_t stream) {
    static int grid = 0;
    if (grid == 0) {
        if (n_in != 31 || (size_t)out_size != O_END || ws_size < WS_END) { fprintf(stderr, "kernel_launch: unexpected shapes: n_in %d out %d ws %zu (need %zu)\n", n_in, out_size, ws_size, (size_t)WS_END); grid = -1; return; }
        int dev = 0, cus = 0, per_cu = 0;
        hipGetDevice(&dev);
        hipDeviceGetAttribute(&cus, hipDeviceAttributeMultiprocessorCount, dev);
        if (hipFuncSetAttribute((const void*)fwd_mega, hipFuncAttributeMaxDynamicSharedMemorySize, LDS_BYTES) != hipSuccess) { fprintf(stderr, "kernel_launch: hipFuncSetAttribute failed\n"); grid = -1; return; }
        hipOccupancyMaxActiveBlocksPerMultiprocessor(&per_cu, (const void*)fwd_mega, NTHR, LDS_BYTES);
        (void)hipGetLastError();
        if (per_cu < 1) { fprintf(stderr, "kernel_launch: occupancy query says %d blocks per CU\n", per_cu); per_cu = 1; }
        grid = cus * 1;
    }
    if (grid < 0) return;
    Params p{};
    for (int i = 0; i < 31; ++i) p.in[i] = (const float*)d_in[i];
    p.out = (float*)d_out; p.ws = (unsigned char*)d_ws;
    if (hipMemsetAsync(d_ws, 0, 65536, stream) != hipSuccess) { fprintf(stderr, "kernel_launch: memset failed\n"); return; }
    void* args[] = {&p};
    hipError_t e = hipLaunchCooperativeKernel((const void*)fwd_mega, dim3(grid), dim3(NTHR), args, LDS_BYTES, stream);
    if (e != hipSuccess) fprintf(stderr, "cooperative launch failed: %s (grid %d)\n", hipGetErrorString(e), grid);
}
```
